# Optimizing an MI355X kernel written in HIP

```python
import math
import jax
import jax.numpy as jnp
from jax import lax
import numpy as np

D_MODEL = 2048
BATCH = 2
SEQ = 4096
DEPTH = 4

GRID_W = 64
CTX_LEN = 256
N_MIXERS = 3
N_MOD = 9
NORM_EPS = 1e-6
ROPE_THETA = 10000.0
NEG_INF = -1e30
D_FF = 5504
A_HEAD_DIM = 128
A_HEADS = D_MODEL // A_HEAD_DIM
A_KV_HEADS = 4
A_GROUP = A_HEADS // A_KV_HEADS
A_Q_WIDTH = A_HEADS * A_HEAD_DIM
A_KV_WIDTH = A_KV_HEADS * A_HEAD_DIM
A_WINDOW = 128
A_BLOCK = 128
B_CHUNK = 128
B_WIDTH = 3 * D_MODEL
B_GROUPS = 8
B_GROUP_W = B_WIDTH // B_GROUPS
C_HEAD_DIM = 128
C_HEADS = D_MODEL // (2 * C_HEAD_DIM)
C_WIDTH = C_HEADS * 2 * C_HEAD_DIM
C_BLOCK = 128

N_A = len(range(0, DEPTH, N_MIXERS))
N_B = len(range(1, DEPTH, N_MIXERS))
N_C = len(range(2, DEPTH, N_MIXERS))

kernel_name = 'hybrid_diffusion_block'


def rms_norm(x, g, eps=NORM_EPS):
    xf = x.astype(jnp.float32)
    y = xf * lax.rsqrt(jnp.mean(xf * xf, axis=-1, keepdims=True) + eps)
    return (y * g.astype(jnp.float32)).astype(x.dtype)


def layer_norm(x, g, b, eps=NORM_EPS):
    xf = x.astype(jnp.float32)
    mu = jnp.mean(xf, axis=-1, keepdims=True)
    xc = xf - mu
    y = xc * lax.rsqrt(jnp.mean(xc * xc, axis=-1, keepdims=True) + eps)
    return (y * g.astype(jnp.float32) + b.astype(jnp.float32)).astype(x.dtype)


def axial_rope(n_tokens, head_dim):
    rows = n_tokens // GRID_W
    row = jnp.repeat(jnp.arange(rows, dtype=jnp.float32), GRID_W)
    col = jnp.tile(jnp.arange(GRID_W, dtype=jnp.float32), rows)
    axis_dim = head_dim // 2
    inv = ROPE_THETA ** (-jnp.arange(0, axis_dim, 2, dtype=jnp.float32) / axis_dim)
    ang = jnp.concatenate([row[:, None] * inv, col[:, None] * inv], axis=-1)
    return jnp.cos(ang), jnp.sin(ang)


def apply_rope(x, cos, sin):
    xr = x.reshape(*x.shape[:-1], -1, 2)
    x0, x1 = xr[..., 0], xr[..., 1]
    c = cos[:, None, :].astype(x.dtype)
    s = sin[:, None, :].astype(x.dtype)
    return jnp.stack([x0 * c - x1 * s, x0 * s + x1 * c], axis=-1).reshape(x.shape)


def swiglu(h, w_in, w_out):
    g, u = jnp.split(h @ w_in, 2, axis=-1)
    return (jax.nn.silu(g) * u) @ w_out


def _pre(t, g, m, s):
    return rms_norm(t, g[2 * s]) * (1 + m[:, :, 3 * s + 1]) + m[:, :, 3 * s]


def _post(y, g, m, s):
    return m[:, :, 3 * s + 2] * rms_norm(y, g[2 * s + 1])


def _band(t):
    b, s = t.shape[:2]
    nb = s // A_BLOCK
    tp = jnp.pad(t, ((0, 0), (A_BLOCK, A_BLOCK), (0, 0), (0, 0)))
    tp = tp.reshape(b, nb + 2, A_BLOCK, *t.shape[2:])
    return jnp.concatenate([tp[:, :-2], tp[:, 1:-1], tp[:, 2:]], axis=2)


def window_gqa(h, hc, w_in, w_out, sink, cos, sin, need_ctx):
    b, s, _ = h.shape
    L = hc.shape[1]
    nb = s // A_BLOCK
    scale = A_HEAD_DIM ** -0.5

    def proj(t):
        T = t.shape[1]
        q, k, v = jnp.split(t @ w_in, [A_Q_WIDTH, A_Q_WIDTH + A_KV_WIDTH], axis=-1)
        return (q.reshape(b, T, A_HEADS, A_HEAD_DIM),
                k.reshape(b, T, A_KV_HEADS, A_HEAD_DIM),
                v.reshape(b, T, A_KV_HEADS, A_HEAD_DIM))

    q, k, v = proj(h)
    qc, kc, vc = proj(hc)
    q = apply_rope(q, cos, sin)
    k = apply_rope(k, cos, sin)
    qb = q.reshape(b, nb, A_BLOCK, A_KV_HEADS, A_GROUP, A_HEAD_DIM)
    kb, vb = _band(k), _band(v)
    qpos = jnp.arange(nb)[:, None, None] * A_BLOCK + jnp.arange(A_BLOCK)[None, :, None]
    kpos = (jnp.arange(nb)[:, None, None] - 1) * A_BLOCK + jnp.arange(3 * A_BLOCK)[None, None, :]
    valid = (jnp.abs(kpos - qpos) <= A_WINDOW) & (kpos >= 0) & (kpos < s)
    s_band = jnp.einsum('bnqkgd,bnmkd->bnkgqm', qb, kb).astype(jnp.float32) * scale
    s_band = jnp.where(valid[None, :, None, None], s_band, NEG_INF)
    s_ctx = jnp.einsum('bnqkgd,blkd->bnkgql', qb, kc).astype(jnp.float32) * scale
    sink_l = jnp.broadcast_to(sink.reshape(A_KV_HEADS, A_GROUP, 1, 1).astype(jnp.float32), s_ctx.shape[:-1] + (1,))
    p = jax.nn.softmax(jnp.concatenate([sink_l, s_ctx, s_band], axis=-1), axis=-1).astype(v.dtype)
    o = (jnp.einsum('bnkgql,blkd->bnqkgd', p[..., 1:1 + L], vc)
         + jnp.einsum('bnkgqm,bnmkd->bnqkgd', p[..., 1 + L:], vb))
    y = o.reshape(b, s, A_Q_WIDTH) @ w_out
    yc = None
    if need_ctx:
        qg = qc.reshape(b, L, A_KV_HEADS, A_GROUP, A_HEAD_DIM)
        sc = jnp.einsum('blkgd,bmkd->bkglm', qg, kc).astype(jnp.float32) * scale
        sink_c = jnp.broadcast_to(sink.reshape(A_KV_HEADS, A_GROUP, 1, 1).astype(jnp.float32), sc.shape[:-1] + (1,))
        pc = jax.nn.softmax(jnp.concatenate([sink_c, sc], axis=-1), axis=-1)[..., 1:].astype(vc.dtype)
        oc = jnp.einsum('bkglm,bmkd->blkgd', pc, vc)
        yc = oc.reshape(b, L, A_Q_WIDTH) @ w_out
    return y, yc


def chunk_mlp(t, w_in, vn_g, vn_b, w_s, b_s, w_out):
    b, T, _ = t.shape
    u, v = jnp.split(jax.nn.gelu(t @ w_in), 2, axis=-1)
    v = layer_norm(v, vn_g, vn_b)
    v = v.reshape(b, T // B_CHUNK, B_CHUNK, B_GROUPS, B_GROUP_W)
    v = jnp.einsum('gpq,bnqgc->bnpgc', w_s, v) + b_s.T[:, :, None]
    return (u * v.reshape(b, T, B_WIDTH)) @ w_out


def diff_attn(h, hc, w_in, w_out, lq1, lk1, lq2, lk2, subln_g, lam_init, cos, sin, need_ctx):
    b, s, _ = h.shape
    L = hc.shape[1]
    nb = s // C_BLOCK
    scale = C_HEAD_DIM ** -0.5
    lam = (jnp.exp(jnp.sum(lq1.astype(jnp.float32) * lk1.astype(jnp.float32)))
           - jnp.exp(jnp.sum(lq2.astype(jnp.float32) * lk2.astype(jnp.float32))) + lam_init)

    def proj(t):
        T = t.shape[1]
        q, k, v = jnp.split(t @ w_in, 3, axis=-1)
        return (q.reshape(b, T, C_HEADS, 2, C_HEAD_DIM),
                k.reshape(b, T, C_HEADS, 2, C_HEAD_DIM),
                v.reshape(b, T, C_HEADS, 2 * C_HEAD_DIM))

    def rope2(t):
        return apply_rope(t.reshape(b, s, 2 * C_HEADS, C_HEAD_DIM), cos, sin).reshape(t.shape)

    def finish(o):
        o = rms_norm(o, subln_g) * (1 - lam_init)
        return o.reshape(o.shape[0], o.shape[1], C_WIDTH) @ w_out

    q, k, v = proj(h)
    qc, kc, vc = proj(hc)
    q, k = rope2(q), rope2(k)
    qblocks = jnp.moveaxis(q.reshape(b, nb, C_BLOCK, C_HEADS, 2, C_HEAD_DIM), 1, 0)

    def block(qb):
        s_ctx = jnp.einsum('bqhcd,bkhcd->bhcqk', qb, kc).astype(jnp.float32) * scale
        s_lat = jnp.einsum('bqhcd,bkhcd->bhcqk', qb, k).astype(jnp.float32) * scale
        p = jax.nn.softmax(jnp.concatenate([s_ctx, s_lat], axis=-1), axis=-1)
        a = (p[:, :, 0] - lam * p[:, :, 1]).astype(v.dtype)
        return (jnp.einsum('bhqk,bkhe->bqhe', a[..., :L], vc)
                + jnp.einsum('bhqk,bkhe->bqhe', a[..., L:], v))

    o = lax.map(block, qblocks)
    o = jnp.moveaxis(o, 0, 1).reshape(b, s, C_HEADS, 2 * C_HEAD_DIM)
    y = finish(o)
    yc = None
    if need_ctx:
        sc = jnp.einsum('bqhcd,bkhcd->bhcqk', qc, kc).astype(jnp.float32) * scale
        pc = jax.nn.softmax(sc, axis=-1)
        ac = (pc[:, :, 0] - lam * pc[:, :, 1]).astype(vc.dtype)
        yc = finish(jnp.einsum('bhqk,bkhe->bqhe', ac, vc))
    return y, yc


def setup_inputs(seed: int = 0) -> dict:
    key = jax.random.key(seed)
    ks = jax.random.split(key, 32)
    D = D_MODEL

    def nrm(k, shape, s):
        return jax.random.normal(k, shape, jnp.float32) * s

    return {
        'x': nrm(ks[0], (BATCH, SEQ, D), 1.0),
        'c': nrm(ks[1], (BATCH, D), 1.0),
        'ctx': nrm(ks[2], (BATCH, CTX_LEN, D), 1.0),
        'c_ctx': nrm(ks[3], (D,), 1.0),
        'ada_w': nrm(ks[4], (DEPTH, D, N_MOD * D), 0.5 * D ** -0.5),
        'ada_b': nrm(ks[5], (DEPTH, N_MOD * D), 0.01),
        'norm_g': 1.0 + nrm(ks[6], (DEPTH, 6, D), 0.02),
        'ffn_w_in': nrm(ks[7], (DEPTH, 2, D, 2 * D_FF), D ** -0.5),
        'ffn_w_out': nrm(ks[8], (DEPTH, 2, D_FF, D), D_FF ** -0.5),
        'a_w_in': nrm(ks[9], (N_A, D, A_Q_WIDTH + 2 * A_KV_WIDTH), D ** -0.5),
        'a_w_out': nrm(ks[10], (N_A, A_Q_WIDTH, D), A_Q_WIDTH ** -0.5),
        'a_sink': nrm(ks[11], (N_A, A_HEADS), 1.0),
        'b_w_in': nrm(ks[12], (N_B, D, 2 * B_WIDTH), D ** -0.5),
        'b_vnorm_g': 1.0 + nrm(ks[13], (N_B, B_WIDTH), 0.02),
        'b_vnorm_b': nrm(ks[14], (N_B, B_WIDTH), 0.02),
        'b_ws': nrm(ks[15], (N_B, B_GROUPS, B_CHUNK, B_CHUNK), B_CHUNK ** -0.5),
        'b_bs': 1.0 + nrm(ks[16], (N_B, B_GROUPS, B_CHUNK), 0.1),
        'b_w_out': nrm(ks[17], (N_B, B_WIDTH, D), B_WIDTH ** -0.5),
        'c_w_in': nrm(ks[18], (N_C, D, 3 * C_WIDTH), D ** -0.5),
        'c_w_out': nrm(ks[19], (N_C, C_WIDTH, D), C_WIDTH ** -0.5),
        'c_lq1': nrm(ks[20], (N_C, C_HEAD_DIM), 0.1),
        'c_lk1': nrm(ks[21], (N_C, C_HEAD_DIM), 0.1),
        'c_lq2': nrm(ks[22], (N_C, C_HEAD_DIM), 0.1),
        'c_lk2': nrm(ks[23], (N_C, C_HEAD_DIM), 0.1),
        'c_subln_g': 1.0 + nrm(ks[24], (N_C, 2 * C_HEAD_DIM), 0.02),
    }


def reference(x, c, ctx, c_ctx, ada_w, ada_b, norm_g, ffn_w_in, ffn_w_out,
              a_w_in, a_w_out, a_sink,
              b_w_in, b_vnorm_g, b_vnorm_b, b_ws, b_bs, b_w_out,
              c_w_in, c_w_out, c_lq1, c_lk1, c_lq2, c_lk2, c_subln_g):
    b, s, d = x.shape
    cos, sin = axial_rope(s, A_HEAD_DIM)
    for i in range(DEPTH):
        kind, j = i % N_MIXERS, i // N_MIXERS
        ctx_live = i < DEPTH - 1
        ctx_read = ctx_live or kind != 1
        g = norm_g[i]
        m = (jax.nn.silu(c) @ ada_w[i] + ada_b[i]).reshape(b, 1, N_MOD, d)
        x = x + 0.5 * _post(swiglu(_pre(x, g, m, 0), ffn_w_in[i, 0], ffn_w_out[i, 0]), g, m, 0)
        hc = None
        if ctx_read:
            mc = (jax.nn.silu(c_ctx) @ ada_w[i] + ada_b[i]).reshape(1, 1, N_MOD, d)
            ctx = ctx + 0.5 * _post(swiglu(_pre(ctx, g, mc, 0), ffn_w_in[i, 0], ffn_w_out[i, 0]), g, mc, 0)
            hc = _pre(ctx, g, mc, 1)
        h = _pre(x, g, m, 1)
        if kind == 0:
            y, yc = window_gqa(h, hc, a_w_in[j], a_w_out[j], a_sink[j], cos, sin, ctx_live)
        elif kind == 1:
            y = chunk_mlp(h, b_w_in[j], b_vnorm_g[j], b_vnorm_b[j], b_ws[j], b_bs[j], b_w_out[j])
            yc = chunk_mlp(hc, b_w_in[j], b_vnorm_g[j], b_vnorm_b[j], b_ws[j], b_bs[j], b_w_out[j]) if ctx_live else None
        else:
            lam_init = 0.8 - 0.6 * math.exp(-0.3 * i)
            y, yc = diff_attn(h, hc, c_w_in[j], c_w_out[j], c_lq1[j], c_lk1[j], c_lq2[j], c_lk2[j],
                              c_subln_g[j], lam_init, cos, sin, ctx_live)
        x = x + _post(y, g, m, 1)
        x = x + 0.5 * _post(swiglu(_pre(x, g, m, 2), ffn_w_in[i, 1], ffn_w_out[i, 1]), g, m, 2)
        if ctx_live:
            ctx = ctx + _post(yc, g, mc, 1)
            ctx = ctx + 0.5 * _post(swiglu(_pre(ctx, g, mc, 2), ffn_w_in[i, 1], ffn_w_out[i, 1]), g, mc, 2)
    return x
```

```cpp
#include <hip/hip_runtime.h>
#include <cstdio>
#include <cstdint>
#include <cmath>

#ifndef MK_PER_PHASE
#define MK_PER_PHASE 1
#endif

namespace pg8 {
#define PG8_LAS __attribute__((address_space(3)))
typedef unsigned short bf16_t;
typedef short bf16x8 __attribute__((ext_vector_type(8)));
typedef float f32x4 __attribute__((ext_vector_type(4)));
typedef unsigned u32x4 __attribute__((ext_vector_type(4)));
__device__ __forceinline__ int opaque_tid() { int t = threadIdx.x; asm volatile("" : "+v"(t)); return t; }
constexpr int BM = 256, BK = 64, HALF = 128, HTB = HALF * BK * 2  , STAGE_BYTES = 8 * HTB, NXCD = 8, WGM = 8;

__host__ __device__ __forceinline__ int lds_byte(int r, int c) { const int st = (r >> 4) * 2 + (c >> 5), rr = r & 15, cc = c & 31, ob = rr * 64 + cc * 2; return st * 1024 + (ob ^ (((ob >> 9) & 1) << 5)); }
__host__ __device__ __forceinline__ void stage_rc(int b, int& R, int& C) { const int st = b / 1024, sb = b % 1024, swz = sb ^ (((sb >> 9) & 1) << 5); R = (st >> 1) * 16 + swz / 64; C = (st & 1) * 32 + (swz % 64) / 2; }
__host__ __device__ __forceinline__ int perm32(int rho) { const int n = rho >> 4, i = rho & 15; return 8 * (i >> 2) + 4 * n + (i & 3); }

struct Unit { int pm, pn; };
struct Gemm { const bf16_t* A; const bf16_t* Bt; int M, N, K, lda; };

struct StaticOrder {
    int nM, nN, nwg, G, c;
    __host__ __device__ void init(int M, int N, int G_, int c_) { nM = M / BM; nN = N / BM; nwg = nM * nN; G = G_; c = c_; }
    __host__ __device__ bool next(int i, Unit& u) const {
        const long L = (long)i * G + c; if (L >= nwg) return false;
        int wgid = (int)L; { const int q = nwg / NXCD, r = nwg % NXCD, xcd = wgid % NXCD, off = wgid / NXCD; wgid = (xcd < r ? xcd * (q + 1) : r * (q + 1) + (xcd - r) * q) + off; }
        const int nig = WGM * nN, gid = wgid / nig, fm = gid * WGM, gsz = (nM - fm) < WGM ? (nM - fm) : WGM;
        u.pm = fm + ((wgid % nig) % gsz); u.pn = (wgid % nig) / gsz; return true;
    }
    __device__ __forceinline__ void a_ready(const Unit&) const {}
    __device__ __forceinline__ void done(const Unit&) const {}
};


__device__ __forceinline__ unsigned cvt_pk_bf16(float lo, float hi) { unsigned r; asm volatile("v_cvt_pk_bf16_f32 %0, %1, %2" : "=v"(r) : "v"(lo), "v"(hi)); return r; }
__device__ __forceinline__ float sigmoid_fast(float z) { return __builtin_amdgcn_rcpf(1.0f + __builtin_amdgcn_exp2f(-1.4426950408889634f * z)); }
__device__ __forceinline__ float gelu_tanh(float x) { const float z = 1.5957691216057308f * (x + 0.044715f * x * x * x); return x * sigmoid_fast(z); }

struct EpiSwiglu {
    static constexpr bool PERM = true, AFTER_DRAIN = false;
    bf16_t* O; int ldc;
    __device__ __forceinline__ void operator()(const f32x4 (&acc)[2][2][4][2], const Unit& u, int wr, int wc, int fr, int fq) const {
        const int row0 = u.pm * BM + wr * 64 + fr, col0 = u.pn * HALF + wc * 32 + 8 * fq;
#pragma unroll
        for (int ai = 0; ai < 2; ++ai)
#pragma unroll
            for (int m = 0; m < 4; ++m) { bf16_t* rowp = O + (size_t)(row0 + ai * HALF + m * 16) * ldc + col0;
                float v[8];
#pragma unroll
                for (int n = 0; n < 2; ++n)
#pragma unroll
                    for (int j = 0; j < 4; ++j) { const float g = acc[ai][0][m][n][j], uu = acc[ai][1][m][n][j]; v[n * 4 + j] = g * sigmoid_fast(g) * uu; }
                u32x4 w; w.x = cvt_pk_bf16(v[0], v[1]); w.y = cvt_pk_bf16(v[2], v[3]); w.z = cvt_pk_bf16(v[4], v[5]); w.w = cvt_pk_bf16(v[6], v[7]);
                *(u32x4*)rowp = w; }
    }
};
struct EpiF32 {
    static constexpr bool PERM = true, AFTER_DRAIN = false;
    float* C; int ldc;
    __device__ __forceinline__ void operator()(const f32x4 (&acc)[2][2][4][2], const Unit& u, int wr, int wc, int fr, int fq) const {
        const int row0 = u.pm * BM + wr * 64 + fr, col0 = u.pn * BM + wc * 32 + 8 * fq;
#pragma unroll
        for (int ai = 0; ai < 2; ++ai)
#pragma unroll
            for (int m = 0; m < 4; ++m) { float* rowp = C + (size_t)(row0 + ai * HALF + m * 16) * ldc + col0;
#pragma unroll
                for (int bj = 0; bj < 2; ++bj) { *(f32x4*)(rowp + bj * HALF) = acc[ai][bj][m][0]; *(f32x4*)(rowp + bj * HALF + 4) = acc[ai][bj][m][1]; } }
    }
};
template <int MODE  > struct EpiBf16X {
    static constexpr bool PERM = true, AFTER_DRAIN = false;
    bf16_t* O; int ldc; const float* rope; int rope_cols;
    __device__ __forceinline__ void operator()(const f32x4 (&acc)[2][2][4][2], const Unit& u, int wr, int wc, int fr, int fq) const {
        const int row0 = u.pm * BM + wr * 64 + fr, col0 = u.pn * BM + wc * 32 + 8 * fq;
        const bool do_rope = (MODE == 0) && (u.pm < 32) && (u.pn * BM < rope_cols);
        const int p0 = 16 * wc + 4 * fq;
#pragma unroll
        for (int ai = 0; ai < 2; ++ai)
#pragma unroll
            for (int m = 0; m < 4; ++m) { const int row = row0 + ai * HALF + m * 16; bf16_t* rowp = O + (size_t)row * ldc + col0;
                f32x4 cs0 = (f32x4){1.f, 0.f, 1.f, 0.f}, cs1 = cs0;
                if (do_rope) { const float* rp = rope + ((size_t)(row & 4095) * 64 + p0) * 2; cs0 = *(const f32x4*)rp; cs1 = *(const f32x4*)(rp + 4); }
#pragma unroll
                for (int bj = 0; bj < 2; ++bj) { f32x4 v0 = acc[ai][bj][m][0], v1 = acc[ai][bj][m][1];
                    if (MODE == 1) {
#pragma unroll
                        for (int j = 0; j < 4; ++j) { v0[j] = gelu_tanh(v0[j]); v1[j] = gelu_tanh(v1[j]); } }
                    else if (do_rope) {
                        const f32x4 a = v0, b = v1;
                        v0[0] = a[0] * cs0[0] - a[1] * cs0[1]; v0[1] = a[0] * cs0[1] + a[1] * cs0[0]; v0[2] = a[2] * cs0[2] - a[3] * cs0[3]; v0[3] = a[2] * cs0[3] + a[3] * cs0[2];
                        v1[0] = b[0] * cs1[0] - b[1] * cs1[1]; v1[1] = b[0] * cs1[1] + b[1] * cs1[0]; v1[2] = b[2] * cs1[2] - b[3] * cs1[3]; v1[3] = b[2] * cs1[3] + b[3] * cs1[2]; }
                    u32x4 w; w.x = cvt_pk_bf16(v0[0], v0[1]); w.y = cvt_pk_bf16(v0[2], v0[3]); w.z = cvt_pk_bf16(v1[0], v1[1]); w.w = cvt_pk_bf16(v1[2], v1[3]);
                    *(u32x4*)(rowp + bj * HALF) = w; } }
    }
};

template <class Epi, class Sched, bool ALIGN_EPI, bool SP2, int K, int LDA>
__device__ __forceinline__ void gemm_phase(PG8_LAS unsigned char* lds, const Gemm g, const Sched& S, const Epi& E) {
    const int tid = opaque_tid(), wid = __builtin_amdgcn_readfirstlane(tid >> 6), lane = tid & 63, wr = wid >> 2, wc = wid & 3, fr = lane & 15, fq = lane >> 4;
    constexpr int nt = K / BK;
    unsigned voffA[2], voffB[2];
#pragma unroll
    for (int i = 0; i < 2; ++i) { int R, C; stage_rc(tid * 16 + i * 8192, R, C); const int Rb = Epi::PERM ? ((R & ~31) + perm32(R & 31)) : R;
        voffA[i] = (unsigned)(R * LDA + C) * 2u; voffB[i] = (unsigned)(Rb * K + C) * 2u; }
    constexpr size_t kstep = (size_t)(BK * 2);
    constexpr size_t hstepA = (size_t)HALF * LDA * 2, hstepB = (size_t)HALF * K * 2;
    constexpr size_t tstepA = 2 * hstepA, tstepB = 2 * hstepB;
    const unsigned ldsw = (unsigned)wid * 1024u;
    const int aoff = lds_byte(wr * 64 + fr, fq * 8), boff = lds_byte(wc * 32 + fr, fq * 8);
#define PG8_SA(b, h) (((b) * 2 + (h)) * HTB)
#define PG8_SB(b, h) ((4 + (b) * 2 + (h)) * HTB)
#define PG8_STAGE(bufoff, gbase, voff) do { _Pragma("unroll") for (int _i = 0; _i < 2; ++_i) \
        __builtin_amdgcn_global_load_lds((const unsigned*)((const char*)(gbase) + (voff)[_i]), (PG8_LAS unsigned*)(lds + (bufoff) + ldsw + _i * 8192), 16, 0, 0); } while (0)
#define PG8_LDA(dst, b, h) do { _Pragma("unroll") for (int m = 0; m < 4; ++m) _Pragma("unroll") for (int k = 0; k < 2; ++k) dst[m][k] = *(const PG8_LAS bf16x8*)(lds + PG8_SA(b, h) + aoff + m * 2048 + k * 1024); } while (0)
#define PG8_LDB(dst, b, h) do { _Pragma("unroll") for (int n = 0; n < 2; ++n) _Pragma("unroll") for (int k = 0; k < 2; ++k) dst[n][k] = *(const PG8_LAS bf16x8*)(lds + PG8_SB(b, h) + boff + n * 2048 + k * 1024); } while (0)
#define PG8_MMA(ai, bj, At, Bt) do { __builtin_amdgcn_s_setprio(1); _Pragma("unroll") for (int m = 0; m < 4; ++m) _Pragma("unroll") for (int n = 0; n < 2; ++n) _Pragma("unroll") for (int k = 0; k < 2; ++k) \
        acc[ai][bj][m][n] = __builtin_amdgcn_mfma_f32_16x16x32_bf16(Bt[n][k], At[m][k], acc[ai][bj][m][n], 0, 0, 0); __builtin_amdgcn_s_setprio(0); } while (0)
#define PG8_WAIT_V(n) asm volatile("s_waitcnt vmcnt(" #n ")" ::: "memory")
#define PG8_WAIT_L(n) asm volatile("s_waitcnt lgkmcnt(" #n ")" ::: "memory")
#define PG8_BAR __builtin_amdgcn_s_barrier()
#define PG8_SCHED __builtin_amdgcn_sched_barrier(0)
    Unit cur, nxt; int ui = 0;
    if (!S.next(0, cur)) return;
    f32x4 acc[2][2][4][2];
#pragma unroll
    for (int a = 0; a < 2; ++a)
#pragma unroll
        for (int b = 0; b < 2; ++b)
#pragma unroll
            for (int m = 0; m < 4; ++m)
#pragma unroll
                for (int n = 0; n < 2; ++n) acc[a][b][m][n] = (f32x4){0.f, 0.f, 0.f, 0.f};
    bf16x8 At[4][2], B0[2][2], B1[2][2];
    const char* cA = (const char*)g.A + (size_t)cur.pm * tstepA; const char* cB = (const char*)g.Bt + (size_t)cur.pn * tstepB;
    S.a_ready(cur);
    if constexpr (SP2) {
        PG8_STAGE(PG8_SB(0, 0), cB, voffB); PG8_STAGE(PG8_SB(0, 1), cB + hstepB, voffB); PG8_STAGE(PG8_SA(0, 0), cA, voffA); PG8_STAGE(PG8_SA(0, 1), cA + hstepA, voffA);
        if (wr == 1) PG8_BAR;
        PG8_WAIT_V(2); PG8_BAR;
        PG8_STAGE(PG8_SB(1, 0), cB + kstep, voffB); PG8_STAGE(PG8_SA(1, 0), cA + kstep, voffA); PG8_STAGE(PG8_SB(1, 1), cB + hstepB + kstep, voffB);
        PG8_WAIT_V(6); PG8_BAR;
    } else {
        PG8_STAGE(PG8_SB(0, 0), cB, voffB); PG8_STAGE(PG8_SA(0, 0), cA, voffA); PG8_STAGE(PG8_SB(0, 1), cB + hstepB, voffB); PG8_STAGE(PG8_SA(0, 1), cA + hstepA, voffA);
        if (wr == 1) PG8_BAR;
        PG8_WAIT_V(4); PG8_BAR;
        PG8_STAGE(PG8_SB(1, 0), cB + kstep, voffB); PG8_STAGE(PG8_SA(1, 0), cA + kstep, voffA); PG8_STAGE(PG8_SB(1, 1), cB + hstepB + kstep, voffB);
        PG8_WAIT_V(6); PG8_BAR;
    }
    for (;;) {
        const bool has_next = S.next(ui + 1, nxt);
        const char* nA = has_next ? (const char*)g.A + (size_t)nxt.pm * tstepA : cA; const char* nB = has_next ? (const char*)g.Bt + (size_t)nxt.pn * tstepB : cB;
        for (int t = 0; t < nt; t += 2) {
            const bool last = (t == nt - 2);
            const char* a1 = cA + (size_t)(t + 1) * kstep;
            const char* a2 = last ? nA : cA + (size_t)(t + 2) * kstep; const char* b2 = last ? nB : cB + (size_t)(t + 2) * kstep;
            const char* a3 = a2 + kstep; const char* b3 = b2 + kstep;
            if (last && has_next) S.a_ready(nxt);
            if constexpr (SP2) {
            PG8_LDB(B0, 0, 0); PG8_LDB(B1, 0, 1); PG8_SCHED; PG8_LDA(At, 0, 0); PG8_STAGE(PG8_SA(1, 1), a1 + hstepA, voffA);
            PG8_WAIT_V(8); PG8_WAIT_L(0); PG8_BAR; PG8_MMA(0, 0, At, B0); PG8_MMA(0, 1, At, B1); PG8_BAR; PG8_SCHED;
            PG8_LDA(At, 0, 1); PG8_STAGE(PG8_SB(0, 0), b2, voffB); PG8_STAGE(PG8_SB(0, 1), b2 + hstepB, voffB); PG8_STAGE(PG8_SA(0, 0), a2, voffA);
            PG8_WAIT_V(8); PG8_WAIT_L(0); PG8_BAR; PG8_MMA(1, 0, At, B0); PG8_MMA(1, 1, At, B1); PG8_BAR; PG8_SCHED;
            PG8_LDB(B0, 1, 0); PG8_LDB(B1, 1, 1); PG8_SCHED; PG8_LDA(At, 1, 0); PG8_STAGE(PG8_SA(0, 1), a2 + hstepA, voffA);
            PG8_WAIT_V(8); PG8_WAIT_L(0); PG8_BAR; PG8_MMA(0, 0, At, B0); PG8_MMA(0, 1, At, B1); PG8_BAR; PG8_SCHED;
            PG8_LDA(At, 1, 1); PG8_STAGE(PG8_SB(1, 0), b3, voffB); PG8_STAGE(PG8_SB(1, 1), b3 + hstepB, voffB); PG8_STAGE(PG8_SA(1, 0), a3, voffA);
            PG8_WAIT_V(8); PG8_WAIT_L(0); PG8_BAR; PG8_MMA(1, 0, At, B0); PG8_MMA(1, 1, At, B1); PG8_BAR; PG8_SCHED;
            } else {
            PG8_LDB(B0, 0, 0); PG8_SCHED; PG8_LDA(At, 0, 0); PG8_STAGE(PG8_SA(1, 1), a1 + hstepA, voffA);
            PG8_WAIT_L(8); PG8_BAR; PG8_WAIT_L(0); PG8_MMA(0, 0, At, B0); PG8_BAR; PG8_SCHED;
            PG8_LDB(B1, 0, 1); PG8_STAGE(PG8_SB(0, 0), b2, voffB);
            PG8_BAR; PG8_WAIT_L(0); PG8_MMA(0, 1, At, B1); PG8_BAR;
            PG8_LDA(At, 0, 1); PG8_STAGE(PG8_SA(0, 0), a2, voffA);
            PG8_BAR; PG8_WAIT_L(0); PG8_MMA(1, 0, At, B0); PG8_BAR; PG8_SCHED;
            PG8_STAGE(PG8_SB(0, 1), b2 + hstepB, voffB);
            PG8_WAIT_V(6); PG8_BAR; PG8_MMA(1, 1, At, B1); PG8_BAR;
            PG8_LDB(B0, 1, 0); PG8_SCHED; PG8_LDA(At, 1, 0); PG8_STAGE(PG8_SA(0, 1), a2 + hstepA, voffA);
            PG8_WAIT_L(8); PG8_BAR; PG8_WAIT_L(0); PG8_MMA(0, 0, At, B0); PG8_BAR; PG8_SCHED;
            PG8_LDB(B1, 1, 1); PG8_STAGE(PG8_SB(1, 0), b3, voffB);
            PG8_BAR; PG8_WAIT_L(0); PG8_MMA(0, 1, At, B1); PG8_BAR;
            PG8_LDA(At, 1, 1); PG8_STAGE(PG8_SA(1, 0), a3, voffA);
            PG8_BAR; PG8_WAIT_L(0); PG8_MMA(1, 0, At, B0); PG8_BAR; PG8_SCHED;
            PG8_STAGE(PG8_SB(1, 1), b3 + hstepB, voffB);
            PG8_WAIT_V(6); PG8_BAR; PG8_MMA(1, 1, At, B1); PG8_BAR;
            }
        }
        if constexpr (ALIGN_EPI) { if (wr == 0) PG8_BAR; }
        if constexpr (!Epi::AFTER_DRAIN) { E(acc, cur, wr, wc, fr, fq); S.done(cur); }
        if (!has_next) break;
#pragma unroll
        for (int a = 0; a < 2; ++a)
#pragma unroll
            for (int b = 0; b < 2; ++b)
#pragma unroll
                for (int m = 0; m < 4; ++m)
#pragma unroll
                    for (int n = 0; n < 2; ++n) acc[a][b][m][n] = (f32x4){0.f, 0.f, 0.f, 0.f};
        cur = nxt; cA = nA; cB = nB; ++ui;
        if constexpr (ALIGN_EPI) { if (wr == 1) PG8_BAR; }
    }
    PG8_WAIT_V(0);
    if constexpr (!ALIGN_EPI) { if (wr == 0) PG8_BAR; }
    PG8_BAR;
    if constexpr (Epi::AFTER_DRAIN) { E.fused(acc, cur, wr, wc, fr, fq, lds, wid, lane); S.done(cur); }
#undef PG8_SA
#undef PG8_SB
#undef PG8_STAGE
#undef PG8_LDA
#undef PG8_LDB
#undef PG8_MMA
#undef PG8_WAIT_V
#undef PG8_WAIT_L
#undef PG8_BAR
#undef PG8_SCHED
}
}

namespace att {
typedef unsigned short bf16;
using bf16x8 = __attribute__((ext_vector_type(8))) short;
using s16x4  = __attribute__((ext_vector_type(4))) short;
using f32x16 = __attribute__((ext_vector_type(16))) float;
using u32x4  = __attribute__((ext_vector_type(4))) unsigned;
constexpr int   D = 128, NW = 8, QBLK = 32, KVBLK = 64;
constexpr float SCALE = 0.088388347648318440f;
constexpr float THR = 8.f;
constexpr int SHM_V = KVBLK * D * 2, SHM_K = KVBLK * D * 2, SHM_ATTN = 2 * SHM_V + 2 * SHM_K + NW * 64 * 4;
#define KSWZ(row, colB) ((row) * 256 + ((colB) ^ (((row) & 7) << 4)))
#define SBAR() __builtin_amdgcn_sched_barrier(0)
__device__ __forceinline__ int crow(int r, int hi) { return (r & 3) + 8 * (r >> 2) + 4 * hi; }
__device__ __forceinline__ unsigned cvtpk(float lo, float hi) { unsigned r; asm volatile("v_cvt_pk_bf16_f32 %0, %1, %2" : "=v"(r) : "v"(lo), "v"(hi)); return r; }

__device__ __forceinline__ void wmask(f32x16& p0, f32x16& p1, int kpos0, int qp, int hi) {
  const bool oob = (kpos0 < 0) || (kpos0 >= 4096);
  const int base = kpos0 - qp + 128;
#pragma unroll
  for (int r = 0; r < 16; ++r) { const int c = crow(r, hi);
    if (oob || (unsigned)(base + c) > 256u) p0[r] = -1e30f;
    if (oob || (unsigned)(base + 32 + c) > 256u) p1[r] = -1e30f; }
}
__device__ __forceinline__ void partialSM(f32x16& p0, f32x16& p1, float& m_reg, float& mn, float& alpha) {
  constexpr float C = SCALE * 1.4426950408889634f;
  float pmax = p0[0];
#pragma unroll
  for (int r = 1; r < 16; ++r) pmax = fmaxf(pmax, p0[r]);
#pragma unroll
  for (int r = 0; r < 16; ++r) pmax = fmaxf(pmax, p1[r]);
  { auto rr = __builtin_amdgcn_permlane32_swap(__float_as_uint(pmax), __float_as_uint(pmax), false, false);
    pmax = fmaxf(__uint_as_float(rr[0]), __uint_as_float(rr[1])); }
  if (__builtin_expect(__all(pmax - m_reg <= THR / SCALE), 1)) { mn = m_reg; alpha = 1.f; }
  else { mn = fmaxf(m_reg, pmax); alpha = __builtin_amdgcn_exp2f((m_reg - mn) * C); m_reg = mn; }
  float mnC = -mn * C;
#pragma unroll
  for (int r = 0; r < 16; ++r) p0[r] = fmaf(p0[r], C, mnC);
#pragma unroll
  for (int r = 0; r < 16; ++r) p1[r] = fmaf(p1[r], C, mnC);
#pragma unroll
  for (int r = 0; r < 16; ++r) p0[r] = __builtin_amdgcn_exp2f(p0[r]);
}
__device__ __forceinline__ void finishSM(f32x16& p0, f32x16& p1, float alpha, float& l_reg, bf16x8& pa0, bf16x8& pa1, bf16x8& pa2, bf16x8& pa3) {
#pragma unroll
  for (int r = 0; r < 16; ++r) p1[r] = __builtin_amdgcn_exp2f(p1[r]);
  float ps = 0;
#pragma unroll
  for (int r = 0; r < 16; ++r) ps += p0[r];
#pragma unroll
  for (int r = 0; r < 16; ++r) ps += p1[r];
  { auto rr = __builtin_amdgcn_permlane32_swap(__float_as_uint(ps), __float_as_uint(ps), false, false);
    ps = __uint_as_float(rr[0]) + __uint_as_float(rr[1]); }
  l_reg = l_reg * alpha + ps;
#define PK4(P, BASE, OUT) do { unsigned a0 = cvtpk(P[BASE + 0], P[BASE + 1]), a1 = cvtpk(P[BASE + 2], P[BASE + 3]);   \
    unsigned b0 = cvtpk(P[BASE + 4], P[BASE + 5]), b1 = cvtpk(P[BASE + 6], P[BASE + 7]);                              \
    auto r0 = __builtin_amdgcn_permlane32_swap(a0, b0, false, false); auto r1 = __builtin_amdgcn_permlane32_swap(a1, b1, false, false); \
    u32x4 w = {r0[0], r1[0], r0[1], r1[1]}; OUT = *reinterpret_cast<bf16x8*>(&w); } while (0)
  PK4(p0, 0, pa0); PK4(p0, 8, pa1); PK4(p1, 0, pa2); PK4(p1, 8, pa3);
#undef PK4
}
__device__ __forceinline__ void qkt(f32x16& p0, f32x16& p1, const bf16* Ks, const bf16x8* qr, int r32, int hi) {
  p0 = f32x16{}; p1 = f32x16{};
#pragma unroll
  for (int d0 = 0; d0 < 8; ++d0) { int cb = (d0 * 16 + hi * 8) * 2;
    bf16x8 b0 = *reinterpret_cast<const bf16x8*>((const char*)Ks + KSWZ(r32, cb));
    bf16x8 b1 = *reinterpret_cast<const bf16x8*>((const char*)Ks + KSWZ(32 + r32, cb));
    p0 = __builtin_amdgcn_mfma_f32_32x32x16_bf16(b0, qr[d0], p0, 0, 0, 0);
    p1 = __builtin_amdgcn_mfma_f32_32x32x16_bf16(b1, qr[d0], p1, 0, 0, 0); }
}
__device__ __forceinline__ int v_st(int k, int c) { const int kk = (k & ~0xC) | ((k & 4) << 1) | ((k & 8) >> 1); return ((kk >> 3) * 4 + (c >> 5)) * 512 + ((kk & 7) * 32 + (c & 31)) * 2; }
__device__ __forceinline__ int v_rd_base(int lane) { return ((lane & 3) << 3) | (((lane >> 2) & 3) << 6) | (((lane >> 4) & 1) << 5) | (((lane >> 5) & 1) << 8); }
constexpr int v_rd_off(int d0, int ks, int half) { return d0 * 512 + ks * 4096 + half * 2048; }
template <int OFF> __device__ __forceinline__ s16x4 tr_read(int vb) {
  s16x4 r; asm volatile("ds_read_b64_tr_b16 %0, %1 offset:%2" : "=&v"(r) : "v"(vb), "i"(OFF) : "memory"); return r;
}
template <int D0> __device__ __forceinline__ void pv_one(f32x16& od, int vb, bf16x8 pa0, bf16x8 pa1, bf16x8 pa2, bf16x8 pa3) {
  const s16x4 l0 = tr_read<v_rd_off(D0, 0, 0)>(vb), h0 = tr_read<v_rd_off(D0, 0, 1)>(vb), l1 = tr_read<v_rd_off(D0, 1, 0)>(vb), h1 = tr_read<v_rd_off(D0, 1, 1)>(vb);
  const s16x4 l2 = tr_read<v_rd_off(D0, 2, 0)>(vb), h2 = tr_read<v_rd_off(D0, 2, 1)>(vb), l3 = tr_read<v_rd_off(D0, 3, 0)>(vb), h3 = tr_read<v_rd_off(D0, 3, 1)>(vb);
  asm volatile("s_waitcnt lgkmcnt(0)" ::: "memory"); SBAR();
#define PK(L, H) (bf16x8){L[0], L[1], L[2], L[3], H[0], H[1], H[2], H[3]}
  od = __builtin_amdgcn_mfma_f32_32x32x16_bf16(pa0, PK(l0, h0), od, 0, 0, 0);
  od = __builtin_amdgcn_mfma_f32_32x32x16_bf16(pa1, PK(l1, h1), od, 0, 0, 0);
  od = __builtin_amdgcn_mfma_f32_32x32x16_bf16(pa2, PK(l2, h2), od, 0, 0, 0);
  od = __builtin_amdgcn_mfma_f32_32x32x16_bf16(pa3, PK(l3, h3), od, 0, 0, 0);
#undef PK
}
__device__ __forceinline__ void pv_d0(f32x16* o, int vb, bf16x8 pa0, bf16x8 pa1, bf16x8 pa2, bf16x8 pa3) {
  pv_one<0>(o[0], vb, pa0, pa1, pa2, pa3); pv_one<1>(o[1], vb, pa0, pa1, pa2, pa3); pv_one<2>(o[2], vb, pa0, pa1, pa2, pa3); pv_one<3>(o[3], vb, pa0, pa1, pa2, pa3);
}

struct Args {
  const bf16* qkv; int ld;
  int qrow0, qcol, kcol, vcol;
  int ctxrow0, latrow0;
  int kstart, n0, n1;
  int qpos0;
  float sink; int has_sink;
  void* out; int ldo, ocol;
};

template <bool WINDOW, bool OUT_BF16, int LD>
__device__ __forceinline__ void attn_unit(const Args& a, char* lds) {
  const int tid = pg8::opaque_tid(), wid = tid >> 6, lane = tid & 63, r32 = lane & 31, hi = lane >> 5;
  bf16* V_lds = (bf16*)lds; bf16* K_lds = (bf16*)(lds + 2 * SHM_V);
  float* ws = (float*)(lds + 2 * SHM_V + 2 * SHM_K) + wid * 64; float* li_l = ws; float* al_l = ws + 32;
  float m_reg = a.has_sink ? a.sink * (1.0f / SCALE) : -1e30f, l_reg = a.has_sink ? 1.0f : 0.0f; f32x16 o[4] = {}; bf16x8 qr[8];
  const bf16* Qw = a.qkv + (long)(a.qrow0 + wid * QBLK + r32) * LD + a.qcol + hi * 8;
#pragma unroll
  for (int d0 = 0; d0 < 8; ++d0) qr[d0] = *reinterpret_cast<const bf16x8*>(Qw + d0 * 16);
  const int sr = tid >> 4, sc = (tid & 15) * 8, vst0 = v_st(sr, sc), vst1 = v_st(32 + sr, sc);
  const int vb0 = (int)(uintptr_t)V_lds + v_rd_base(lane);
  const int qp = a.qpos0 + wid * QBLK + r32;
  const unsigned soff0 = (unsigned)(sr * LD + sc) * 2u, soff1 = soff0 + 32u * LD * 2u;
  struct { bf16x8 vs0, vs1, ks0, ks1; } sr_[2];
#define TROW(t) ((t) < a.n0 ? a.ctxrow0 + (t) * KVBLK : a.latrow0 + min(max(a.kstart + ((t) - a.n0) * KVBLK, 0), 4096 - KVBLK))
#define SLOAD(i, t) do { const char* tb_ = (const char*)a.qkv + (size_t)TROW(t) * (LD * 2); const char* tv_ = tb_ + a.vcol * 2; const char* tk_ = tb_ + a.kcol * 2; \
    sr_[i].vs0 = *reinterpret_cast<const bf16x8*>(tv_ + soff0); sr_[i].vs1 = *reinterpret_cast<const bf16x8*>(tv_ + soff1); \
    sr_[i].ks0 = *reinterpret_cast<const bf16x8*>(tk_ + soff0); sr_[i].ks1 = *reinterpret_cast<const bf16x8*>(tk_ + soff1); } while (0)
#define SWRITE(b, i) do { *(bf16x8*)((char*)V_lds + (b) * SHM_V + vst0) = sr_[i].vs0;          \
    *(bf16x8*)((char*)V_lds + (b) * SHM_V + vst1) = sr_[i].vs1; int kc = sc * 2;               \
    *(bf16x8*)((char*)K_lds + (b) * SHM_K + KSWZ(sr, kc)) = sr_[i].ks0;                       \
    *(bf16x8*)((char*)K_lds + (b) * SHM_K + KSWZ(32 + sr, kc)) = sr_[i].ks1; } while (0)
#define SWAIT() asm volatile("s_waitcnt vmcnt(4)" ::: "memory")
#define RESC(al) do { if (__any((al) < 1.f)) { if (hi == 0) al_l[r32] = (al); asm volatile("s_waitcnt lgkmcnt(0)" ::: "memory"); \
    _Pragma("unroll") for (int d = 0; d < 4; ++d) _Pragma("unroll") for (int r = 0; r < 16; ++r) o[d][r] *= al_l[crow(r, hi)]; } } while (0)
#define WMASK(P0, P1, t) do { if (WINDOW) { if ((t) >= a.n0) wmask(P0, P1, a.kstart + ((t) - a.n0) * KVBLK, qp, hi); } } while (0)
  f32x16 pA0, pA1, pB0, pB1; float mnA, mnB, alA, alB; bf16x8 pa0, pa1, pa2, pa3; const int NT = a.n0 + a.n1;
  constexpr int SE = 0, SO = 1;
  SLOAD(SE, 0); asm volatile("s_waitcnt vmcnt(0)" ::: "memory"); SWRITE(0, SE); __syncthreads();
  qkt(pA0, pA1, K_lds, qr, r32, hi); WMASK(pA0, pA1, 0); partialSM(pA0, pA1, m_reg, mnA, alA);
  SLOAD(SO, 1); if (2 < NT) SLOAD(SE, 2);
  SWAIT(); SWRITE(1, SO); __syncthreads();
  for (int j = 1; j + 1 < NT; j += 2) {
    SBAR(); qkt(pB0, pB1, (bf16*)((char*)K_lds + SHM_K), qr, r32, hi);
    finishSM(pA0, pA1, alA, l_reg, pa0, pa1, pa2, pa3); SBAR();
    SLOAD(SO, j + 2); SBAR();
    pv_d0(o, vb0, pa0, pa1, pa2, pa3); WMASK(pB0, pB1, j); partialSM(pB0, pB1, m_reg, mnB, alB);
    __syncthreads(); SWAIT(); SWRITE(0, SE);
    RESC(alB); __syncthreads();
    SBAR(); qkt(pA0, pA1, K_lds, qr, r32, hi);
    finishSM(pB0, pB1, alB, l_reg, pa0, pa1, pa2, pa3); SBAR();
    if (j + 3 < NT) SLOAD(SE, j + 3); SBAR();
    pv_d0(o, vb0 + (int)SHM_V, pa0, pa1, pa2, pa3); WMASK(pA0, pA1, j + 1); partialSM(pA0, pA1, m_reg, mnA, alA);
    __syncthreads(); SWAIT(); SWRITE(1, SO);
    RESC(alA); __syncthreads();
  }
  SBAR(); qkt(pB0, pB1, (bf16*)((char*)K_lds + SHM_K), qr, r32, hi);
  finishSM(pA0, pA1, alA, l_reg, pa0, pa1, pa2, pa3); SBAR();
  pv_d0(o, vb0, pa0, pa1, pa2, pa3); WMASK(pB0, pB1, NT - 1); partialSM(pB0, pB1, m_reg, mnB, alB);
  __syncthreads(); RESC(alB);
  finishSM(pB0, pB1, alB, l_reg, pa0, pa1, pa2, pa3); SBAR();
  pv_d0(o, vb0 + (int)SHM_V, pa0, pa1, pa2, pa3);
  if (hi == 0) li_l[r32] = l_reg; asm volatile("s_waitcnt lgkmcnt(0)" ::: "memory");
  float rli[16];
#pragma unroll
  for (int r = 0; r < 16; ++r) rli[r] = __builtin_amdgcn_rcpf(li_l[crow(r, hi)]);
  if (OUT_BF16) {
    bf16* Ow = (bf16*)a.out + (long)(a.qrow0 + wid * QBLK) * a.ldo + a.ocol;
#pragma unroll
    for (int r = 0; r < 16; ++r) { const int orow = crow(r, hi);
#pragma unroll
      for (int d0 = 0; d0 < 4; ++d0) Ow[(long)orow * a.ldo + d0 * 32 + r32] = (bf16)(cvtpk(o[d0][r] * rli[r], 0.f) & 0xffffu); }
  } else {
    float* Ow = (float*)a.out + (long)(a.qrow0 + wid * QBLK) * a.ldo + a.ocol;
#pragma unroll
    for (int r = 0; r < 16; ++r) { const int orow = crow(r, hi);
#pragma unroll
      for (int d0 = 0; d0 < 4; ++d0) Ow[(long)orow * a.ldo + d0 * 32 + r32] = o[d0][r] * rli[r]; }
  }
  __syncthreads();
#undef TROW
#undef SLOAD
#undef SWRITE
#undef SWAIT
#undef RESC
#undef WMASK
}
#undef KSWZ
#undef SBAR
}

constexpr int NWAVES = 8;
constexpr int DM = 2048, NBATCH = 2, SEQ = 4096, MLAT = NBATCH * SEQ, CTXL = 256, MCTX = NBATCH * CTXL, MALL = MLAT + MCTX;
constexpr int DFF = 5504, NFC1 = 2 * DFF, NLAYER = 4, NMODC = 9 * DM;
constexpr int A_N = 3072, B_N = 12288, B_W = 6144, C_N = 6144;
constexpr float EPS = 1e-6f;
constexpr size_t MiB = 1u << 20;
constexpr size_t WS_CTL = 0, CTL_BYTES = 2 * MiB;
constexpr size_t WS_MODT = 2 * MiB;
constexpr size_t WS_ROPE = 3 * MiB;
constexpr size_t WS_XC = 5 * MiB;
constexpr size_t WS_STATS = 9 * MiB;
constexpr size_t WS_BSW = 10 * MiB;
constexpr size_t WS_WFC1 = 11 * MiB;
constexpr size_t WS_WFC2 = WS_WFC1 + 344 * MiB;
constexpr size_t WS_WAIN = WS_WFC2 + 172 * MiB;
constexpr size_t WS_WAOUT = WS_WAIN + 24 * MiB;
constexpr size_t WS_WBIN = WS_WAOUT + 16 * MiB;
constexpr size_t WS_WBOUT = WS_WBIN + 48 * MiB;
constexpr size_t WS_WCIN = WS_WBOUT + 24 * MiB;
constexpr size_t WS_WCOUT = WS_WCIN + 24 * MiB;
constexpr size_t WS_H = WS_WCOUT + 8 * MiB;
constexpr size_t WS_HID = WS_H + 34 * MiB;
constexpr size_t WS_Y = WS_HID + 92 * MiB;
constexpr size_t WS_QKV = WS_Y + 68 * MiB;
constexpr size_t WS_AO = WS_QKV + 204 * MiB;
constexpr size_t WS_OC = WS_AO + 34 * MiB;
constexpr size_t WS_END = WS_OC + 136 * MiB;
static_assert((size_t)8 * NFC1 * DM * 2 <= 344 * MiB && (size_t)8 * DM * DFF * 2 <= 172 * MiB && (size_t)MALL * DFF * 2 <= 92 * MiB && (size_t)MALL * B_N * 2 <= 204 * MiB, "ws map");
constexpr int CW_BAR = 4096;
constexpr int RING_BYTES = 131072, MISC_OFF = RING_BYTES + 320, LDS_BYTES = 147456;

#define GAS __attribute__((address_space(1)))
#define LAS __attribute__((address_space(3)))
typedef unsigned short bf16;
typedef unsigned v4u __attribute__((ext_vector_type(4)));
typedef unsigned v2u __attribute__((ext_vector_type(2)));
typedef float f32x4 __attribute__((ext_vector_type(4)));
typedef short bf16x8 __attribute__((ext_vector_type(8)));
typedef float f32x16 __attribute__((ext_vector_type(16)));
#define LDS_WAIT() asm volatile("s_waitcnt lgkmcnt(0)" ::: "memory")
#define VM_WAIT() asm volatile("s_waitcnt vmcnt(0)" ::: "memory")
__device__ __forceinline__ unsigned f2bf(float f) { unsigned u = __builtin_bit_cast(unsigned, f); return (u + 0x7fffu + ((u >> 16) & 1u)) >> 16; }
__device__ __forceinline__ unsigned pk2(float lo, float hi) { return f2bf(lo) | (f2bf(hi) << 16); }
__device__ __forceinline__ float bf2f(unsigned short b) { return __builtin_bit_cast(float, ((unsigned)b) << 16); }
__device__ __forceinline__ float wave_sum(float v) {
#pragma unroll
    for (int o = 1; o < 64; o <<= 1) v += __shfl_xor(v, o);
    return v;
}

#define XB_TMO      128
#define XB_XCNT(j)  (256  + 64 * (j))
#define XB_XSUB(j)  (1280 + 64 * (j))
#define XB_XGEN(j)  (2304 + 64 * (j))
#define XB_TOP      3328
#define XB_TOPGEN   3392
#define XCD_BAR_WORDS 3456
#define XB_SPIN_CAP (1u << 18)

__device__ __forceinline__ unsigned xb_ld(unsigned* p)              { return __hip_atomic_load(p, __ATOMIC_RELAXED, __HIP_MEMORY_SCOPE_AGENT); }
__device__ __forceinline__ unsigned xb_add(unsigned* p, unsigned v) { return __hip_atomic_fetch_add(p, v, __ATOMIC_RELAXED, __HIP_MEMORY_SCOPE_AGENT); }
__device__ __forceinline__ unsigned xb_xcc_id() { return (unsigned)__builtin_amdgcn_s_getreg((3 << 11) | 20) & 0xFu; }
#define XB_SPIN(cond, bar) do { unsigned _sp = 0; while (cond) { __builtin_amdgcn_s_sleep(1); \
    if ((++_sp & 255u) == 0u) { if (xb_ld(&(bar)[XB_TMO])) break; if (_sp > XB_SPIN_CAP) { atomicAdd(&(bar)[XB_TMO], 1u); break; } } } } while (0)

struct XcdBarrier {
    unsigned* bar; unsigned x;
    volatile LAS unsigned* st;
};

__device__ __forceinline__ XcdBarrier xcd_barrier_post(unsigned* bar, volatile LAS unsigned* st) {
    XcdBarrier b; b.bar = bar; b.x = xb_xcc_id(); b.st = st;
    if (threadIdx.x == 0) (void)xb_add(&bar[XB_XCNT(b.x)], 1u);
    return b;
}
__device__ __forceinline__ void xcd_barrier_complete(unsigned* bar, unsigned x, unsigned& nloc, unsigned& nx) {
    const unsigned G = gridDim.x * gridDim.y * gridDim.z;
    unsigned sum, cnt, mine, sp = 0u;
    for (;;) {
        sum = 0u; cnt = 0u; mine = 0u;
#pragma unroll
        for (unsigned j = 0; j < 16; ++j) { const unsigned c = xb_ld(&bar[XB_XCNT(j)]); sum += c; cnt += (c > 0u) ? 1u : 0u; mine = (j == x) ? c : mine; }
        if (sum == G) break;
        __builtin_amdgcn_s_sleep(1);
        if ((++sp & 255u) == 0u) { if (xb_ld(&bar[XB_TMO])) break; if (sp > XB_SPIN_CAP) { atomicAdd(&bar[XB_TMO], 1u); break; } }
    }
    nloc = mine > 0u ? mine : 1u; nx = cnt > 0u ? cnt : 1u;
}

__device__ __forceinline__ void xcd_barrier(const XcdBarrier& b) {
    asm volatile("s_waitcnt vmcnt(0)" ::: "memory");
    __syncthreads();
    if (threadIdx.x == 0) {
        unsigned* bar = b.bar;
        __builtin_amdgcn_s_waitcnt(0);
        unsigned nloc = b.st[0], nx = b.st[1];
        if (nloc == 0u) { xcd_barrier_complete(bar, b.x, nloc, nx); b.st[0] = nloc; b.st[1] = nx; }
        const unsigned old = xb_add(&bar[XB_XSUB(b.x)], 1u);
        const unsigned gen = old / nloc;
        if (old + 1u == (gen + 1u) * nloc) {
            __builtin_amdgcn_fence(__ATOMIC_RELEASE, "agent");
            asm volatile("s_waitcnt vmcnt(0)" ::: "memory");
            const unsigned og = xb_add(&bar[XB_TOP], 1u);
            const unsigned tg = og / nx;
            if (og + 1u == (tg + 1u) * nx) xb_add(&bar[XB_TOPGEN], 1u);
            else XB_SPIN(xb_ld(&bar[XB_TOPGEN]) == tg, bar);
            __builtin_amdgcn_fence(__ATOMIC_ACQUIRE, "agent");
            xb_add(&bar[XB_XGEN(b.x)], 1u);
            asm volatile("s_waitcnt vmcnt(0)" ::: "memory");
        } else {
            XB_SPIN(xb_ld(&bar[XB_XGEN(b.x)]) == gen, bar);
            __builtin_amdgcn_fence(__ATOMIC_ACQUIRE, "agent");
            asm volatile("s_waitcnt vmcnt(0)" ::: "memory");
        }
    }
    __syncthreads();
}

__device__ __forceinline__ void transpose_item(const float* W, int K, int N, bf16* WT, int fc1map, LAS float* scr, int item, int lane) {
    const int nblk = N / 32, kb = item / nblk, nb = item % nblk, k0 = 64 * kb, n0 = 32 * nb;
    int rowbase = n0;
    if (fc1map) { rowbase = (n0 < DFF) ? 256 * (n0 / 128) + (n0 % 128) : 256 * ((n0 - DFF) / 128) + 128 + ((n0 - DFF) % 128); }
#pragma unroll 8
    for (int i = 0; i < 32; ++i) { const int kk = 2 * i + (lane >> 5); scr[kk * 33 + (lane & 31)] = W[(size_t)(k0 + kk) * N + n0 + (lane & 31)]; }
    LDS_WAIT(); asm volatile("" ::: "memory");
    const int c = lane & 7;
#pragma unroll
    for (int j = 0; j < 4; ++j) { const int n = (lane >> 3) + 8 * j; const LAS float* s = scr + (8 * c) * 33 + n;
        v4u o; o.x = pk2(s[0 * 33], s[1 * 33]); o.y = pk2(s[2 * 33], s[3 * 33]); o.z = pk2(s[4 * 33], s[5 * 33]); o.w = pk2(s[6 * 33], s[7 * 33]);
        *(GAS v4u*)(WT + (size_t)(rowbase + n) * K + k0 + 8 * c) = o; }
    LDS_WAIT(); asm volatile("" ::: "memory");
}

struct KArgs { const float* in[25]; float* out; unsigned char* ws; int ph_lo, ph_hi, li; float lam_init; };

__device__ __forceinline__ float* modt(unsigned char* ws, int layer, int slot, int modrow, int which) { return (float*)(ws + WS_MODT) + ((size_t)(((layer * 3 + slot) * 3 + modrow) * 3 + which)) * DM; }

__device__ __forceinline__ void prologue_phase(const KArgs& args, LAS unsigned char* L, int bx, int G) {
    const int tid = pg8::opaque_tid(), lane = tid & 63, wave = __builtin_amdgcn_readfirstlane(tid >> 6);
    unsigned char* ws = args.ws;
    LAS float* sl = (LAS float*)L;
    for (int i = tid; i < 3 * DM; i += NWAVES * 64) { const int r = i / DM, k = i % DM; const float v = (r < 2) ? args.in[1][r * DM + k] : args.in[3][k]; sl[i] = v / (1.0f + expf(-v)); }
    __syncthreads();
    LAS float* part = (LAS float*)(L + 24576);
    for (int item = bx; item < NLAYER * 72; item += G) {
        const int layer = item / 72, n0 = (item % 72) * 256;
        const float* W = args.in[4] + ((size_t)layer * DM + wave * 256) * NMODC + n0 + lane * 4;
        const LAS float* s0 = sl + wave * 256;
        f32x4 a0 = {0.f, 0.f, 0.f, 0.f}, a1 = a0, a2 = a0;
#pragma unroll 8
        for (int kk = 0; kk < 256; ++kk) { const f32x4 w = *(const f32x4*)(W + (size_t)kk * NMODC); a0 += w * s0[kk]; a1 += w * s0[DM + kk]; a2 += w * s0[2 * DM + kk]; }
        *(LAS f32x4*)(part + (wave * 3 + 0) * 256 + lane * 4) = a0; *(LAS f32x4*)(part + (wave * 3 + 1) * 256 + lane * 4) = a1; *(LAS f32x4*)(part + (wave * 3 + 2) * 256 + lane * 4) = a2;
        __syncthreads();
        for (int idx = tid; idx < 768; idx += NWAVES * 64) { const int r = idx >> 8, cc = idx & 255, n = n0 + cc; float m = args.in[5][layer * NMODC + n];
#pragma unroll
            for (int w = 0; w < 8; ++w) m += part[(w * 3 + r) * 256 + cc];
            const int k9 = n / DM, c = n % DM, s = k9 / 3, which = k9 % 3; const float* g = args.in[6] + (size_t)layer * 6 * DM;
            if (which == 0) modt(ws, layer, s, r, 2)[c] = m;
            else if (which == 1) modt(ws, layer, s, r, 1)[c] = g[(2 * s) * DM + c] * (1.0f + m);
            else modt(ws, layer, s, r, 0)[c] = (s == 1 ? 1.0f : 0.5f) * m * g[(2 * s + 1) * DM + c]; }
        __syncthreads();
    }
    {
        LAS float* scr = (LAS float*)(L + 49152 + wave * 8448);
        const int gw = bx * NWAVES + wave, NGW = G * NWAVES;
        constexpr int I_FC1 = (DM / 64) * (NFC1 / 32), I_FC2 = (DFF / 64) * (DM / 32), I_AIN = (DM / 64) * (A_N / 32), I_SQ = (DM / 64) * (DM / 32), I_BIN = (DM / 64) * (B_N / 32), I_BOUT = (B_W / 64) * (DM / 32), I_CIN = (DM / 64) * (C_N / 32);
        constexpr int NITEMS = 8 * I_FC1 + 8 * I_FC2 + 2 * I_AIN + 2 * I_SQ + I_BIN + I_BOUT + I_CIN + I_SQ;
        for (int it = gw; it < NITEMS; it += NGW) {
            int r = it;
            if (r < 8 * I_FC1) { const int mat = r / I_FC1; transpose_item(args.in[7] + (size_t)mat * DM * NFC1, DM, NFC1, (bf16*)(ws + WS_WFC1) + (size_t)mat * NFC1 * DM, 1, scr, r % I_FC1, lane); continue; } r -= 8 * I_FC1;
            if (r < 8 * I_FC2) { const int mat = r / I_FC2; transpose_item(args.in[8] + (size_t)mat * DFF * DM, DFF, DM, (bf16*)(ws + WS_WFC2) + (size_t)mat * DM * DFF, 0, scr, r % I_FC2, lane); continue; } r -= 8 * I_FC2;
            if (r < 2 * I_AIN) { const int mat = r / I_AIN; transpose_item(args.in[9] + (size_t)mat * DM * A_N, DM, A_N, (bf16*)(ws + WS_WAIN) + (size_t)mat * A_N * DM, 0, scr, r % I_AIN, lane); continue; } r -= 2 * I_AIN;
            if (r < 2 * I_SQ) { const int mat = r / I_SQ; transpose_item(args.in[10] + (size_t)mat * DM * DM, DM, DM, (bf16*)(ws + WS_WAOUT) + (size_t)mat * DM * DM, 0, scr, r % I_SQ, lane); continue; } r -= 2 * I_SQ;
            if (r < I_BIN) { transpose_item(args.in[12], DM, B_N, (bf16*)(ws + WS_WBIN), 0, scr, r, lane); continue; } r -= I_BIN;
            if (r < I_BOUT) { transpose_item(args.in[17], B_W, DM, (bf16*)(ws + WS_WBOUT), 0, scr, r, lane); continue; } r -= I_BOUT;
            if (r < I_CIN) { transpose_item(args.in[18], DM, C_N, (bf16*)(ws + WS_WCIN), 0, scr, r, lane); continue; } r -= I_CIN;
            transpose_item(args.in[19], DM, DM, (bf16*)(ws + WS_WCOUT), 0, scr, r, lane);
        }
    }
    for (int e = bx * NWAVES * 64 + tid; e < SEQ * 64; e += G * NWAVES * 64) { const int t = e >> 6, p = e & 63, pi = p & 31;
        const float inv = (float)pow(10000.0, -(double)pi / 32.0); const float ang = (float)((p < 32) ? (t >> 6) : (t & 63)) * inv;
        float* o = (float*)(ws + WS_ROPE) + (size_t)e * 2; o[0] = (float)cos((double)ang); o[1] = (float)sin((double)ang); }
    for (int e = bx * NWAVES * 64 + tid; e < 8 * 128 * 128; e += G * NWAVES * 64) ((bf16*)(ws + WS_BSW))[e] = (bf16)f2bf(args.in[15][e]);
}

__device__ __forceinline__ void norm_phase(const float* xs_lat, const float* xs_ctx, float* xd_lat, float* xd_ctx, const float* Y, const float* postT, const float* preT, bf16* H, int nrows) {
    const int tid = pg8::opaque_tid(), lane = tid & 63, gw = blockIdx.x * NWAVES + __builtin_amdgcn_readfirstlane(tid >> 6), NGW = gridDim.x * NWAVES;
    for (int row = gw; row < nrows; row += NGW) {
        const int modrow = row < SEQ ? 0 : (row < MLAT ? 1 : 2);
        const float* xs = (row < MLAT) ? xs_lat + (size_t)row * DM : xs_ctx + (size_t)(row - MLAT) * DM;
        float* xd = (row < MLAT) ? xd_lat + (size_t)row * DM : xd_ctx + (size_t)(row - MLAT) * DM;
        f32x4 xv[8];
#pragma unroll
        for (int j = 0; j < 8; ++j) xv[j] = *(const f32x4*)(xs + 256 * j + 4 * lane);
        if (Y) {
            const float* yr = Y + (size_t)row * DM; const float* At = postT + (size_t)modrow * 3 * DM;
            f32x4 yv[8]; float ss = 0.f;
#pragma unroll
            for (int j = 0; j < 8; ++j) { yv[j] = *(const f32x4*)(yr + 256 * j + 4 * lane); ss += (yv[j].x * yv[j].x + yv[j].y * yv[j].y) + (yv[j].z * yv[j].z + yv[j].w * yv[j].w); }
            const float ry = 1.0f / sqrtf(wave_sum(ss) * (1.0f / DM) + EPS);
#pragma unroll
            for (int j = 0; j < 8; ++j) { const f32x4 a = *(const f32x4*)(At + 256 * j + 4 * lane); xv[j] += yv[j] * ry * a; }
        }
#pragma unroll
        for (int j = 0; j < 8; ++j) *(f32x4*)(xd + 256 * j + 4 * lane) = xv[j];
        if (H) {
            const float* Bt = preT + (size_t)(modrow * 3 + 1) * DM; const float* Ct = preT + (size_t)(modrow * 3 + 2) * DM;
            float ss = 0.f;
#pragma unroll
            for (int j = 0; j < 8; ++j) ss += (xv[j].x * xv[j].x + xv[j].y * xv[j].y) + (xv[j].z * xv[j].z + xv[j].w * xv[j].w);
            const float rx = 1.0f / sqrtf(wave_sum(ss) * (1.0f / DM) + EPS);
            bf16* hr = H + (size_t)row * DM;
#pragma unroll
            for (int j = 0; j < 8; ++j) { const f32x4 b = *(const f32x4*)(Bt + 256 * j + 4 * lane), c = *(const f32x4*)(Ct + 256 * j + 4 * lane); const f32x4 h = xv[j] * rx * b + c;
                v2u o; o.x = pk2(h.x, h.y); o.y = pk2(h.z, h.w); *(v2u*)(hr + 256 * j + 4 * lane) = o; }
        }
    }
}
__device__ __forceinline__ void vstats_phase(const bf16* QKV, float* stats, int nrows) {
    const int tid = pg8::opaque_tid(), lane = tid & 63, gw = blockIdx.x * NWAVES + __builtin_amdgcn_readfirstlane(tid >> 6), NGW = gridDim.x * NWAVES;
    for (int row = gw; row < nrows; row += NGW) {
        const bf16* vr = QKV + (size_t)row * B_N + B_W + lane * 8; bf16x8 raw[12]; float s = 0.f;
#pragma unroll
        for (int i = 0; i < 12; ++i) { raw[i] = *(const bf16x8*)(vr + i * 512);
#pragma unroll
            for (int e = 0; e < 8; ++e) s += bf2f((unsigned short)raw[i][e]); }
        const float mean = wave_sum(s) * (1.0f / B_W); float q = 0.f;
#pragma unroll
        for (int i = 0; i < 12; ++i)
#pragma unroll
            for (int e = 0; e < 8; ++e) { const float d = bf2f((unsigned short)raw[i][e]) - mean; q += d * d; }
        const float rstd = 1.0f / sqrtf(wave_sum(q) * (1.0f / B_W) + EPS);
        if (lane == 0) { stats[2 * row] = mean; stats[2 * row + 1] = rstd; }
    }
}
__device__ __forceinline__ void spatial_phase(bf16* QKV, const bf16* BSW, const float* stats, const float* vg, const float* vb, const float* bs, LAS unsigned char* L, int nchunks, int bx, int G) {
    const int tid = pg8::opaque_tid(), lane = tid & 63, wave = __builtin_amdgcn_readfirstlane(tid >> 6);
    constexpr int PITCH = 136;
    LAS bf16* T = (LAS bf16*)L;
    const int hi = lane >> 5, r32 = lane & 31;
    for (int u = bx; u < nchunks * 24; u += G) {
        const int third = u % 3, g = (u / 3) % 8, ch = u / 24, row0 = ch * 128, cbase = g * 768 + third * 256;
        { const int q = tid & 127, c8b = tid >> 7; const float mu = stats[2 * (row0 + q)], rs = stats[2 * (row0 + q) + 1];
          const bf16* vr = QKV + (size_t)(row0 + q) * B_N + B_W + cbase;
#pragma unroll
          for (int i = 0; i < 8; ++i) { const int c0 = (4 * i + c8b) * 8; const bf16x8 raw = *(const bf16x8*)(vr + c0);
              const f32x4 g0 = *(const f32x4*)(vg + cbase + c0), g1 = *(const f32x4*)(vg + cbase + c0 + 4), b0 = *(const f32x4*)(vb + cbase + c0), b1 = *(const f32x4*)(vb + cbase + c0 + 4);
#pragma unroll
              for (int e = 0; e < 8; ++e) { const float gm = e < 4 ? g0[e & 3] : g1[e & 3], bt = e < 4 ? b0[e & 3] : b1[e & 3];
                  T[(c0 + e) * PITCH + q] = (bf16)f2bf((bf2f((unsigned short)raw[e]) - mu) * rs * gm + bt); } } }
        __syncthreads();
        f32x16 acc[4] = {};
        const bf16* Wg = BSW + (size_t)g * 16384 + (size_t)r32 * 128 + hi * 8;
#pragma unroll
        for (int ks = 0; ks < 8; ++ks) { const bf16x8 bfr = *(const LAS bf16x8*)(T + (32 * wave + r32) * PITCH + ks * 16 + hi * 8);
#pragma unroll
            for (int mb = 0; mb < 4; ++mb) { const bf16x8 afr = *(const bf16x8*)(Wg + mb * 32 * 128 + ks * 16); acc[mb] = __builtin_amdgcn_mfma_f32_32x32x16_bf16(afr, bfr, acc[mb], 0, 0, 0); } }
        const int col = cbase + 32 * wave + r32;
#pragma unroll
        for (int mb = 0; mb < 4; ++mb)
#pragma unroll
            for (int r = 0; r < 16; ++r) { const int p = mb * 32 + (r & 3) + 8 * (r >> 2) + 4 * hi; bf16* up = QKV + (size_t)(row0 + p) * B_N + col;
                *up = (bf16)f2bf(bf2f(*up) * (acc[mb][r] + bs[g * 128 + p])); }
        __syncthreads();
    }
}
__device__ __forceinline__ void combine_phase(const float* OC, bf16* AO, const float* lq1, const float* lk1, const float* lq2, const float* lk2, const float* sg, float lam_init, int nrows) {
    const int tid = pg8::opaque_tid(), lane = tid & 63, gw = blockIdx.x * NWAVES + __builtin_amdgcn_readfirstlane(tid >> 6), NGW = gridDim.x * NWAVES;
    const float d1 = wave_sum(lq1[lane] * lk1[lane] + lq1[lane + 64] * lk1[lane + 64]), d2 = wave_sum(lq2[lane] * lk2[lane] + lq2[lane + 64] * lk2[lane + 64]);
    const float lam = expf(d1) - expf(d2) + lam_init;
    const f32x4 gv = *(const f32x4*)(sg + 4 * lane) * (1.0f - lam_init);
    for (int row = gw; row < nrows; row += NGW) {
        const float* orow = OC + (size_t)row * 4096; bf16* ar = AO + (size_t)row * DM;
#pragma unroll
        for (int h = 0; h < 8; ++h) { const f32x4 a = *(const f32x4*)(orow + (2 * h) * 256 + 4 * lane), b = *(const f32x4*)(orow + (2 * h + 1) * 256 + 4 * lane); const f32x4 o = a - lam * b;
            const float rs = 1.0f / sqrtf(wave_sum((o.x * o.x + o.y * o.y) + (o.z * o.z + o.w * o.w)) * (1.0f / 256.0f) + EPS); const f32x4 v = o * rs * gv;
            v2u w; w.x = pk2(v.x, v.y); w.y = pk2(v.z, v.w); *(v2u*)(ar + h * 256 + 4 * lane) = w; }
    }
}

__global__ void __launch_bounds__(NWAVES * 64, 2) fwd(KArgs args) {
    extern __shared__ __attribute__((aligned(16))) unsigned char lds[];
    LAS unsigned char* L = (LAS unsigned char*)lds;
    const int tid = threadIdx.x, G = gridDim.x, bx = blockIdx.x;
    unsigned char* ws = args.ws;
    for (int u = tid; u < (LDS_BYTES - RING_BYTES) / 4; u += NWAVES * 64) ((LAS unsigned*)(L + RING_BYTES))[u] = 0u;
    __syncthreads();
    const int lo = args.ph_lo, hi = args.ph_hi;
    XcdBarrier bar; bar.bar = (unsigned*)(ws + WS_CTL) + CW_BAR + args.li * XCD_BAR_WORDS; bar.x = 0; bar.st = (volatile LAS unsigned*)(L + MISC_OFF + 32);
    if (hi - lo > 1) bar = xcd_barrier_post((unsigned*)(ws + WS_CTL) + CW_BAR + args.li * XCD_BAR_WORDS, (volatile LAS unsigned*)(L + MISC_OFF + 32));
    int ph = 0;
#define PHASE_BEGIN if (ph >= lo && ph < hi) {
#define PHASE_END   if (ph + 1 < hi) xcd_barrier(bar); } ++ph;
    float* XL = args.out; float* XC = (float*)(ws + WS_XC);
    bf16* H = (bf16*)(ws + WS_H); bf16* HID = (bf16*)(ws + WS_HID); float* Y = (float*)(ws + WS_Y); bf16* QKV = (bf16*)(ws + WS_QKV); bf16* AO = (bf16*)(ws + WS_AO); float* OC = (float*)(ws + WS_OC);
    const float* ROPE = (const float*)(ws + WS_ROPE);

    PHASE_BEGIN
#ifndef OFF_PRO
    prologue_phase(args, L, bx, G);
#endif
    PHASE_END
    PHASE_BEGIN norm_phase(args.in[0], args.in[2], XL, XC, nullptr, nullptr, modt(ws, 0, 0, 0, 0), H, MALL); PHASE_END

    for (int sl = 0; sl < 3 * NLAYER; ++sl) {
        const int layer = sl / 3, typ = sl % 3, kind = layer % 3, jm = layer / 3; const bool lastl = (layer == NLAYER - 1);
        const int Mrows = (lastl && typ >= 1) ? MLAT : MALL;
        pg8::Gemm gy;
        if (typ != 1) {
            const int f = (typ == 0) ? 0 : 1;
            PHASE_BEGIN
                pg8::Gemm g{H, (const bf16*)(ws + WS_WFC1) + (size_t)(layer * 2 + f) * NFC1 * DM, Mrows, NFC1, DM, DM}; pg8::StaticOrder S; S.init(Mrows, NFC1, G, bx);
                pg8::EpiSwiglu E{HID, DFF};
                #ifndef OFF_FC1
                pg8::gemm_phase<pg8::EpiSwiglu, pg8::StaticOrder, true, true, DM, DM>(L, g, S, E);
#endif
            PHASE_END
            gy = pg8::Gemm{HID, (const bf16*)(ws + WS_WFC2) + (size_t)(layer * 2 + f) * DM * DFF, Mrows, DM, DFF, DFF};
        } else {
            if (kind != 1) {
                PHASE_BEGIN
                    const int N = (kind == 0) ? A_N : C_N;
                    pg8::Gemm g{H, (kind == 0) ? (const bf16*)(ws + WS_WAIN) + (size_t)jm * A_N * DM : (const bf16*)(ws + WS_WCIN), MALL, N, DM, DM}; pg8::StaticOrder S; S.init(MALL, N, G, bx);
                    pg8::EpiBf16X<0> E{QKV, N, ROPE, (kind == 0) ? 2560 : 4096};
                    #ifndef OFF_ROPE
                    pg8::gemm_phase<pg8::EpiBf16X<0>, pg8::StaticOrder, true, true, DM, DM>(L, g, S, E);
#endif
                PHASE_END
            } else {
                PHASE_BEGIN
                    pg8::Gemm g{H, (const bf16*)(ws + WS_WBIN), MALL, B_N, DM, DM}; pg8::StaticOrder S; S.init(MALL, B_N, G, bx);
                    pg8::EpiBf16X<1> E{QKV, B_N, nullptr, 0};
                    #ifndef OFF_GELU
                    pg8::gemm_phase<pg8::EpiBf16X<1>, pg8::StaticOrder, true, true, DM, DM>(L, g, S, E);
#endif
                PHASE_END
            }
            if (kind == 0) {
                PHASE_BEGIN
                    const int nlat = NBATCH * 16 * 16, nall = nlat + (lastl ? 0 : NBATCH * 16);
                    for (int u = bx; u < nall; u += G) {
                        att::Args a; a.qkv = QKV; a.ld = A_N; a.n0 = 4; a.has_sink = 1; a.out = AO; a.ldo = DM;
                        if (u < nlat) { const int qb = u & 15, h = (u >> 4) & 15, b = u >> 8;
                            a.qrow0 = b * SEQ + qb * 256; a.qcol = h * 128; a.kcol = 2048 + (h >> 2) * 128; a.vcol = 2560 + (h >> 2) * 128; a.ctxrow0 = MLAT + b * CTXL; a.latrow0 = b * SEQ;
                            a.kstart = qb * 256 - 128; a.n1 = 8; a.qpos0 = qb * 256; a.sink = args.in[11][jm * 16 + h]; a.ocol = h * 128; }
                        else { const int cu = u - nlat, h = cu & 15, b = cu >> 4;
                            a.qrow0 = MLAT + b * CTXL; a.qcol = h * 128; a.kcol = 2048 + (h >> 2) * 128; a.vcol = 2560 + (h >> 2) * 128; a.ctxrow0 = MLAT + b * CTXL; a.latrow0 = b * SEQ;
                            a.kstart = 0; a.n1 = 0; a.qpos0 = 0; a.sink = args.in[11][jm * 16 + h]; a.ocol = h * 128; }
                        #ifndef OFF_ATTA
                        att::attn_unit<true, true, A_N>(a, (char*)lds);
#endif
                    }
                PHASE_END
                gy = pg8::Gemm{AO, (const bf16*)(ws + WS_WAOUT) + (size_t)jm * DM * DM, Mrows, DM, DM, DM};
            } else if (kind == 1) {
                PHASE_BEGIN vstats_phase(QKV, (float*)(ws + WS_STATS), MALL); PHASE_END
                PHASE_BEGIN
#ifndef OFF_SPA
                spatial_phase(QKV, (const bf16*)(ws + WS_BSW), (const float*)(ws + WS_STATS), args.in[13], args.in[14], args.in[16], L, MALL / 128, bx, G);
#endif
                PHASE_END
                gy = pg8::Gemm{QKV, (const bf16*)(ws + WS_WBOUT), Mrows, DM, B_W, B_N};
            } else {
                PHASE_BEGIN
                    const int nlat = NBATCH * 32 * 16, nall = nlat + (lastl ? 0 : NBATCH * 32);
                    for (int u = bx; u < nall; u += G) {
                        att::Args a; a.qkv = QKV; a.ld = C_N; a.n0 = 4; a.has_sink = 0; a.sink = 0.f; a.out = OC; a.ldo = 4096; a.kstart = 0; a.qpos0 = 0;
                        int b, combo;
                        if (u < nlat) { const int qb = u & 15; combo = (u >> 4) & 31; b = u >> 9; a.qrow0 = b * SEQ + qb * 256; a.n1 = 64; }
                        else { const int cu = u - nlat; combo = cu & 31; b = cu >> 5; a.qrow0 = MLAT + b * CTXL; a.n1 = 0; }
                        const int hc = combo >> 1, vh = combo & 1;
                        a.qcol = hc * 128; a.kcol = 2048 + hc * 128; a.vcol = 4096 + (hc >> 1) * 256 + vh * 128; a.ctxrow0 = MLAT + b * CTXL; a.latrow0 = b * SEQ; a.ocol = hc * 256 + vh * 128;
                        #ifndef OFF_ATTC
                        att::attn_unit<false, false, C_N>(a, (char*)lds);
#endif
                    }
                PHASE_END
                PHASE_BEGIN combine_phase(OC, AO, args.in[20], args.in[21], args.in[22], args.in[23], args.in[24], args.lam_init, MALL); PHASE_END
                gy = pg8::Gemm{AO, (const bf16*)(ws + WS_WCOUT), Mrows, DM, DM, DM};
            }
        }
        PHASE_BEGIN
            pg8::StaticOrder S; S.init(gy.M, DM, G, bx); pg8::EpiF32 E{Y, DM};
            #ifndef OFF_GY
            if (typ != 1) pg8::gemm_phase<pg8::EpiF32, pg8::StaticOrder, true, true, DFF, DFF>(L, gy, S, E);
            else if (kind == 1) pg8::gemm_phase<pg8::EpiF32, pg8::StaticOrder, true, true, B_W, B_N>(L, gy, S, E);
            else pg8::gemm_phase<pg8::EpiF32, pg8::StaticOrder, true, true, DM, DM>(L, gy, S, E);
#endif
        PHASE_END
        PHASE_BEGIN
            const bool fin = (sl == 3 * NLAYER - 1);
            const int nl = (typ == 2) ? layer + 1 : layer, ns = (typ == 2) ? 0 : typ + 1;
            norm_phase(XL, XC, XL, XC, Y, modt(ws, layer, typ, 0, 0), fin ? nullptr : modt(ws, nl, ns, 0, 0), fin ? nullptr : H, Mrows);
        PHASE_END
    }
#undef PHASE_BEGIN
#undef PHASE_END
}

static int count_phases() { int n = 2; for (int sl = 0; sl < 3 * NLAYER; ++sl) { const int layer = sl / 3, typ = sl % 3, kind = layer % 3; n += (typ != 1) ? 3 : (kind == 0 ? 4 : 5); } return n; }
extern "C" void kernel_launch(void* const* d_in, const int* in_sizes, int n_in, void* d_out, int out_size, void* d_ws, size_t ws_size, hipStream_t stream) {
    static int grid = 0;
    if (grid == 0) {
        if (n_in != 25 || in_sizes[0] != MLAT * DM || out_size != MLAT * DM || ws_size < WS_END) { fprintf(stderr, "kernel_launch: unexpected shapes (n_in %d, in0 %d, out %d, ws %zu < %zu)\n", n_in, n_in > 0 ? in_sizes[0] : -1, out_size, ws_size, (size_t)WS_END); grid = -1; return; }
        int dev = 0, cus = 0, per_cu = 0;
        if (hipGetDevice(&dev) != hipSuccess || hipDeviceGetAttribute(&cus, hipDeviceAttributeMultiprocessorCount, dev) != hipSuccess) { grid = -1; return; }
        if (hipFuncSetAttribute((const void*)fwd, hipFuncAttributeMaxDynamicSharedMemorySize, LDS_BYTES) != hipSuccess) { fprintf(stderr, "kernel_launch: hipFuncSetAttribute failed\n"); grid = -1; return; }
        if (hipOccupancyMaxActiveBlocksPerMultiprocessor(&per_cu, (const void*)fwd, NWAVES * 64, LDS_BYTES) != hipSuccess || per_cu < 1) fprintf(stderr, "kernel_launch: occupancy query reports %d\n", per_cu);
        (void)hipGetLastError();
        grid = cus;
    }
    if (grid < 0) return;
    if (hipMemsetAsync((char*)d_ws + WS_CTL, 0, CTL_BYTES, stream) != hipSuccess) return;
    KArgs a{};
    for (int i = 0; i < 25; ++i) a.in[i] = (const float*)d_in[i];
    a.out = (float*)d_out; a.ws = (unsigned char*)d_ws; a.lam_init = (float)(0.8 - 0.6 * exp(-0.3 * 2.0));
    const int nph = count_phases();
#if MK_PER_PHASE
    for (int p = 0; p < nph; ++p) { a.ph_lo = p; a.ph_hi = p + 1; a.li = 0; hipLaunchKernelGGL(fwd, dim3(grid), dim3(NWAVES * 64), LDS_BYTES, stream, a); }
#else
    a.ph_lo = 0; a.ph_hi = nph; a.li = 0; hipLaunchKernelGGL(fwd, dim3(grid), dim3(NWAVES * 64), LDS_BYTES, stream, a);
#endif
    const hipError_t le = hipPeekAtLastError();
    if (le != hipSuccess) fprintf(stderr, "kernel_launch: launch failed: %s\n", hipGetErrorName(le));
}
```

```cpp
#include <hip/hip_runtime.h>
#include <cstdio>
#include <cstdint>
#include <cmath>

#ifndef MK_PER_PHASE
#define MK_PER_PHASE 0
#endif

namespace pg8 {
#define PG8_LAS __attribute__((address_space(3)))
typedef unsigned short bf16_t;
typedef short bf16x8 __attribute__((ext_vector_type(8)));
typedef float f32x4 __attribute__((ext_vector_type(4)));
typedef unsigned u32x4 __attribute__((ext_vector_type(4)));
__device__ __forceinline__ int opaque_tid() { int t = threadIdx.x; asm volatile("" : "+v"(t)); return t; }
constexpr int BM = 256, BK = 64, HALF = 128, HTB = HALF * BK * 2  , STAGE_BYTES = 8 * HTB, NXCD = 8, WGM = 8;

__host__ __device__ __forceinline__ int lds_byte(int r, int c) { const int st = (r >> 4) * 2 + (c >> 5), rr = r & 15, cc = c & 31, ob = rr * 64 + cc * 2; return st * 1024 + (ob ^ (((ob >> 9) & 1) << 5)); }
__host__ __device__ __forceinline__ void stage_rc(int b, int& R, int& C) { const int st = b / 1024, sb = b % 1024, swz = sb ^ (((sb >> 9) & 1) << 5); R = (st >> 1) * 16 + swz / 64; C = (st & 1) * 32 + (swz % 64) / 2; }
__host__ __device__ __forceinline__ int perm32(int rho) { const int n = rho >> 4, i = rho & 15; return 8 * (i >> 2) + 4 * n + (i & 3); }

struct Unit { int pm, pn; };
struct Gemm { const bf16_t* A; const bf16_t* Bt; int M, N, K, lda; };

struct StaticOrder {
    int nM, nN, nwg, G, c;
    __host__ __device__ void init(int M, int N, int G_, int c_) { nM = M / BM; nN = N / BM; nwg = nM * nN; G = G_; c = c_; }
    __host__ __device__ bool next(int i, Unit& u) const {
        const long L = (long)i * G + c; if (L >= nwg) return false;
        int wgid = (int)L; { const int q = nwg / NXCD, r = nwg % NXCD, xcd = wgid % NXCD, off = wgid / NXCD; wgid = (xcd < r ? xcd * (q + 1) : r * (q + 1) + (xcd - r) * q) + off; }
        const int nig = WGM * nN, gid = wgid / nig, fm = gid * WGM, gsz = (nM - fm) < WGM ? (nM - fm) : WGM;
        u.pm = fm + ((wgid % nig) % gsz); u.pn = (wgid % nig) / gsz; return true;
    }
    __device__ __forceinline__ void a_ready(const Unit&) const {}
    __device__ __forceinline__ void done(const Unit&) const {}
};


__device__ __forceinline__ unsigned cvt_pk_bf16(float lo, float hi) { unsigned r; asm volatile("v_cvt_pk_bf16_f32 %0, %1, %2" : "=v"(r) : "v"(lo), "v"(hi)); return r; }
__device__ __forceinline__ float sigmoid_fast(float z) { return __builtin_amdgcn_rcpf(1.0f + __builtin_amdgcn_exp2f(-1.4426950408889634f * z)); }
__device__ __forceinline__ float gelu_tanh(float x) { const float z = 1.5957691216057308f * (x + 0.044715f * x * x * x); return x * sigmoid_fast(z); }

struct EpiSwiglu {
    static constexpr bool PERM = true, AFTER_DRAIN = false;
    bf16_t* O; int ldc;
    __device__ __forceinline__ void operator()(const f32x4 (&acc)[2][2][4][2], const Unit& u, int wr, int wc, int fr, int fq) const {
        const int row0 = u.pm * BM + wr * 64 + fr, col0 = u.pn * HALF + wc * 32 + 8 * fq;
#pragma unroll
        for (int ai = 0; ai < 2; ++ai)
#pragma unroll
            for (int m = 0; m < 4; ++m) { bf16_t* rowp = O + (size_t)(row0 + ai * HALF + m * 16) * ldc + col0;
                float v[8];
#pragma unroll
                for (int n = 0; n < 2; ++n)
#pragma unroll
                    for (int j = 0; j < 4; ++j) { const float g = acc[ai][0][m][n][j], uu = acc[ai][1][m][n][j]; v[n * 4 + j] = g * sigmoid_fast(g) * uu; }
                u32x4 w; w.x = cvt_pk_bf16(v[0], v[1]); w.y = cvt_pk_bf16(v[2], v[3]); w.z = cvt_pk_bf16(v[4], v[5]); w.w = cvt_pk_bf16(v[6], v[7]);
                *(u32x4*)rowp = w; }
    }
};
struct EpiF32 {
    static constexpr bool PERM = true, AFTER_DRAIN = false;
    float* C; int ldc;
    __device__ __forceinline__ void operator()(const f32x4 (&acc)[2][2][4][2], const Unit& u, int wr, int wc, int fr, int fq) const {
        const int row0 = u.pm * BM + wr * 64 + fr, col0 = u.pn * BM + wc * 32 + 8 * fq;
#pragma unroll
        for (int ai = 0; ai < 2; ++ai)
#pragma unroll
            for (int m = 0; m < 4; ++m) { float* rowp = C + (size_t)(row0 + ai * HALF + m * 16) * ldc + col0;
#pragma unroll
                for (int bj = 0; bj < 2; ++bj) { *(f32x4*)(rowp + bj * HALF) = acc[ai][bj][m][0]; *(f32x4*)(rowp + bj * HALF + 4) = acc[ai][bj][m][1]; } }
    }
};
template <int MODE  > struct EpiBf16X {
    static constexpr bool PERM = true, AFTER_DRAIN = false;
    bf16_t* O; int ldc; const float* rope; int rope_cols;
    __device__ __forceinline__ void operator()(const f32x4 (&acc)[2][2][4][2], const Unit& u, int wr, int wc, int fr, int fq) const {
        const int row0 = u.pm * BM + wr * 64 + fr, col0 = u.pn * BM + wc * 32 + 8 * fq;
        const bool do_rope = (MODE == 0) && (u.pm < 32) && (u.pn * BM < rope_cols);
        const int p0 = 16 * wc + 4 * fq;
#pragma unroll
        for (int ai = 0; ai < 2; ++ai)
#pragma unroll
            for (int m = 0; m < 4; ++m) { const int row = row0 + ai * HALF + m * 16; bf16_t* rowp = O + (size_t)row * ldc + col0;
                f32x4 cs0 = (f32x4){1.f, 0.f, 1.f, 0.f}, cs1 = cs0;
                if (do_rope) { const float* rp = rope + ((size_t)(row & 4095) * 64 + p0) * 2; cs0 = *(const f32x4*)rp; cs1 = *(const f32x4*)(rp + 4); }
#pragma unroll
                for (int bj = 0; bj < 2; ++bj) { f32x4 v0 = acc[ai][bj][m][0], v1 = acc[ai][bj][m][1];
                    if (MODE == 1) {
#pragma unroll
                        for (int j = 0; j < 4; ++j) { v0[j] = gelu_tanh(v0[j]); v1[j] = gelu_tanh(v1[j]); } }
                    else if (do_rope) {
                        const f32x4 a = v0, b = v1;
                        v0[0] = a[0] * cs0[0] - a[1] * cs0[1]; v0[1] = a[0] * cs0[1] + a[1] * cs0[0]; v0[2] = a[2] * cs0[2] - a[3] * cs0[3]; v0[3] = a[2] * cs0[3] + a[3] * cs0[2];
                        v1[0] = b[0] * cs1[0] - b[1] * cs1[1]; v1[1] = b[0] * cs1[1] + b[1] * cs1[0]; v1[2] = b[2] * cs1[2] - b[3] * cs1[3]; v1[3] = b[2] * cs1[3] + b[3] * cs1[2]; }
                    u32x4 w; w.x = cvt_pk_bf16(v0[0], v0[1]); w.y = cvt_pk_bf16(v0[2], v0[3]); w.z = cvt_pk_bf16(v1[0], v1[1]); w.w = cvt_pk_bf16(v1[2], v1[3]);
                    *(u32x4*)(rowp + bj * HALF) = w; } }
    }
};

template <class Epi, class Sched, bool ALIGN_EPI, bool SP2, int K, int LDA>
__device__ __forceinline__ void gemm_phase(PG8_LAS unsigned char* lds, const Gemm g, const Sched& S, const Epi& E) {
    const int tid = opaque_tid(), wid = __builtin_amdgcn_readfirstlane(tid >> 6), lane = tid & 63, wr = wid >> 2, wc = wid & 3, fr = lane & 15, fq = lane >> 4;
    constexpr int nt = K / BK;
    unsigned voffA[2], voffB[2];
#pragma unroll
    for (int i = 0; i < 2; ++i) { int R, C; stage_rc(tid * 16 + i * 8192, R, C); const int Rb = Epi::PERM ? ((R & ~31) + perm32(R & 31)) : R;
        voffA[i] = (unsigned)(R * LDA + C) * 2u; voffB[i] = (unsigned)(Rb * K + C) * 2u; }
    constexpr size_t kstep = (size_t)(BK * 2);
    constexpr size_t hstepA = (size_t)HALF * LDA * 2, hstepB = (size_t)HALF * K * 2;
    constexpr size_t tstepA = 2 * hstepA, tstepB = 2 * hstepB;
    const unsigned ldsw = (unsigned)wid * 1024u;
    const int aoff = lds_byte(wr * 64 + fr, fq * 8), boff = lds_byte(wc * 32 + fr, fq * 8);
#define PG8_SA(b, h) (((b) * 2 + (h)) * HTB)
#define PG8_SB(b, h) ((4 + (b) * 2 + (h)) * HTB)
#define PG8_STAGE(bufoff, gbase, voff) do { _Pragma("unroll") for (int _i = 0; _i < 2; ++_i) \
        __builtin_amdgcn_global_load_lds((const unsigned*)((const char*)(gbase) + (voff)[_i]), (PG8_LAS unsigned*)(lds + (bufoff) + ldsw + _i * 8192), 16, 0, 0); } while (0)
#define PG8_LDA(dst, b, h) do { _Pragma("unroll") for (int m = 0; m < 4; ++m) _Pragma("unroll") for (int k = 0; k < 2; ++k) dst[m][k] = *(const PG8_LAS bf16x8*)(lds + PG8_SA(b, h) + aoff + m * 2048 + k * 1024); } while (0)
#define PG8_LDB(dst, b, h) do { _Pragma("unroll") for (int n = 0; n < 2; ++n) _Pragma("unroll") for (int k = 0; k < 2; ++k) dst[n][k] = *(const PG8_LAS bf16x8*)(lds + PG8_SB(b, h) + boff + n * 2048 + k * 1024); } while (0)
#define PG8_MMA(ai, bj, At, Bt) do { __builtin_amdgcn_s_setprio(1); _Pragma("unroll") for (int m = 0; m < 4; ++m) _Pragma("unroll") for (int n = 0; n < 2; ++n) _Pragma("unroll") for (int k = 0; k < 2; ++k) \
        acc[ai][bj][m][n] = __builtin_amdgcn_mfma_f32_16x16x32_bf16(Bt[n][k], At[m][k], acc[ai][bj][m][n], 0, 0, 0); __builtin_amdgcn_s_setprio(0); } while (0)
#define PG8_WAIT_V(n) asm volatile("s_waitcnt vmcnt(" #n ")" ::: "memory")
#define PG8_WAIT_L(n) asm volatile("s_waitcnt lgkmcnt(" #n ")" ::: "memory")
#define PG8_BAR __builtin_amdgcn_s_barrier()
#define PG8_SCHED __builtin_amdgcn_sched_barrier(0)
    Unit cur, nxt; int ui = 0;
    if (!S.next(0, cur)) return;
    f32x4 acc[2][2][4][2];
#pragma unroll
    for (int a = 0; a < 2; ++a)
#pragma unroll
        for (int b = 0; b < 2; ++b)
#pragma unroll
            for (int m = 0; m < 4; ++m)
#pragma unroll
                for (int n = 0; n < 2; ++n) acc[a][b][m][n] = (f32x4){0.f, 0.f, 0.f, 0.f};
    bf16x8 At[4][2], B0[2][2], B1[2][2];
    const char* cA = (const char*)g.A + (size_t)cur.pm * tstepA; const char* cB = (const char*)g.Bt + (size_t)cur.pn * tstepB;
    S.a_ready(cur);
    if constexpr (SP2) {
        PG8_STAGE(PG8_SB(0, 0), cB, voffB); PG8_STAGE(PG8_SB(0, 1), cB + hstepB, voffB); PG8_STAGE(PG8_SA(0, 0), cA, voffA); PG8_STAGE(PG8_SA(0, 1), cA + hstepA, voffA);
        if (wr == 1) PG8_BAR;
        PG8_WAIT_V(2); PG8_BAR;
        PG8_STAGE(PG8_SB(1, 0), cB + kstep, voffB); PG8_STAGE(PG8_SA(1, 0), cA + kstep, voffA); PG8_STAGE(PG8_SB(1, 1), cB + hstepB + kstep, voffB);
        PG8_WAIT_V(6); PG8_BAR;
    } else {
        PG8_STAGE(PG8_SB(0, 0), cB, voffB); PG8_STAGE(PG8_SA(0, 0), cA, voffA); PG8_STAGE(PG8_SB(0, 1), cB + hstepB, voffB); PG8_STAGE(PG8_SA(0, 1), cA + hstepA, voffA);
        if (wr == 1) PG8_BAR;
        PG8_WAIT_V(4); PG8_BAR;
        PG8_STAGE(PG8_SB(1, 0), cB + kstep, voffB); PG8_STAGE(PG8_SA(1, 0), cA + kstep, voffA); PG8_STAGE(PG8_SB(1, 1), cB + hstepB + kstep, voffB);
        PG8_WAIT_V(6); PG8_BAR;
    }
    for (;;) {
        const bool has_next = S.next(ui + 1, nxt);
        const char* nA = has_next ? (const char*)g.A + (size_t)nxt.pm * tstepA : cA; const char* nB = has_next ? (const char*)g.Bt + (size_t)nxt.pn * tstepB : cB;
        for (int t = 0; t < nt; t += 2) {
            const bool last = (t == nt - 2);
            const char* a1 = cA + (size_t)(t + 1) * kstep;
            const char* a2 = last ? nA : cA + (size_t)(t + 2) * kstep; const char* b2 = last ? nB : cB + (size_t)(t + 2) * kstep;
            const char* a3 = a2 + kstep; const char* b3 = b2 + kstep;
            if (last && has_next) S.a_ready(nxt);
            if constexpr (SP2) {
            PG8_LDB(B0, 0, 0); PG8_LDB(B1, 0, 1); PG8_SCHED; PG8_LDA(At, 0, 0); PG8_STAGE(PG8_SA(1, 1), a1 + hstepA, voffA);
            PG8_WAIT_V(8); PG8_WAIT_L(0); PG8_BAR; PG8_MMA(0, 0, At, B0); PG8_MMA(0, 1, At, B1); PG8_BAR; PG8_SCHED;
            PG8_LDA(At, 0, 1); PG8_STAGE(PG8_SB(0, 0), b2, voffB); PG8_STAGE(PG8_SB(0, 1), b2 + hstepB, voffB); PG8_STAGE(PG8_SA(0, 0), a2, voffA);
            PG8_WAIT_V(8); PG8_WAIT_L(0); PG8_BAR; PG8_MMA(1, 0, At, B0); PG8_MMA(1, 1, At, B1); PG8_BAR; PG8_SCHED;
            PG8_LDB(B0, 1, 0); PG8_LDB(B1, 1, 1); PG8_SCHED; PG8_LDA(At, 1, 0); PG8_STAGE(PG8_SA(0, 1), a2 + hstepA, voffA);
            PG8_WAIT_V(8); PG8_WAIT_L(0); PG8_BAR; PG8_MMA(0, 0, At, B0); PG8_MMA(0, 1, At, B1); PG8_BAR; PG8_SCHED;
            PG8_LDA(At, 1, 1); PG8_STAGE(PG8_SB(1, 0), b3, voffB); PG8_STAGE(PG8_SB(1, 1), b3 + hstepB, voffB); PG8_STAGE(PG8_SA(1, 0), a3, voffA);
            PG8_WAIT_V(8); PG8_WAIT_L(0); PG8_BAR; PG8_MMA(1, 0, At, B0); PG8_MMA(1, 1, At, B1); PG8_BAR; PG8_SCHED;
            } else {
            PG8_LDB(B0, 0, 0); PG8_SCHED; PG8_LDA(At, 0, 0); PG8_STAGE(PG8_SA(1, 1), a1 + hstepA, voffA);
            PG8_WAIT_L(8); PG8_BAR; PG8_WAIT_L(0); PG8_MMA(0, 0, At, B0); PG8_BAR; PG8_SCHED;
            PG8_LDB(B1, 0, 1); PG8_STAGE(PG8_SB(0, 0), b2, voffB);
            PG8_BAR; PG8_WAIT_L(0); PG8_MMA(0, 1, At, B1); PG8_BAR;
            PG8_LDA(At, 0, 1); PG8_STAGE(PG8_SA(0, 0), a2, voffA);
            PG8_BAR; PG8_WAIT_L(0); PG8_MMA(1, 0, At, B0); PG8_BAR; PG8_SCHED;
            PG8_STAGE(PG8_SB(0, 1), b2 + hstepB, voffB);
            PG8_WAIT_V(6); PG8_BAR; PG8_MMA(1, 1, At, B1); PG8_BAR;
            PG8_LDB(B0, 1, 0); PG8_SCHED; PG8_LDA(At, 1, 0); PG8_STAGE(PG8_SA(0, 1), a2 + hstepA, voffA);
            PG8_WAIT_L(8); PG8_BAR; PG8_WAIT_L(0); PG8_MMA(0, 0, At, B0); PG8_BAR; PG8_SCHED;
            PG8_LDB(B1, 1, 1); PG8_STAGE(PG8_SB(1, 0), b3, voffB);
            PG8_BAR; PG8_WAIT_L(0); PG8_MMA(0, 1, At, B1); PG8_BAR;
            PG8_LDA(At, 1, 1); PG8_STAGE(PG8_SA(1, 0), a3, voffA);
            PG8_BAR; PG8_WAIT_L(0); PG8_MMA(1, 0, At, B0); PG8_BAR; PG8_SCHED;
            PG8_STAGE(PG8_SB(1, 1), b3 + hstepB, voffB);
            PG8_WAIT_V(6); PG8_BAR; PG8_MMA(1, 1, At, B1); PG8_BAR;
            }
        }
        if constexpr (ALIGN_EPI) { if (wr == 0) PG8_BAR; }
        if constexpr (!Epi::AFTER_DRAIN) { E(acc, cur, wr, wc, fr, fq); S.done(cur); }
        if (!has_next) break;
#pragma unroll
        for (int a = 0; a < 2; ++a)
#pragma unroll
            for (int b = 0; b < 2; ++b)
#pragma unroll
                for (int m = 0; m < 4; ++m)
#pragma unroll
                    for (int n = 0; n < 2; ++n) acc[a][b][m][n] = (f32x4){0.f, 0.f, 0.f, 0.f};
        cur = nxt; cA = nA; cB = nB; ++ui;
        if constexpr (ALIGN_EPI) { if (wr == 1) PG8_BAR; }
    }
    PG8_WAIT_V(0);
    if constexpr (!ALIGN_EPI) { if (wr == 0) PG8_BAR; }
    PG8_BAR;
    if constexpr (Epi::AFTER_DRAIN) { E.fused(acc, cur, wr, wc, fr, fq, lds, wid, lane); S.done(cur); }
#undef PG8_SA
#undef PG8_SB
#undef PG8_STAGE
#undef PG8_LDA
#undef PG8_LDB
#undef PG8_MMA
#undef PG8_WAIT_V
#undef PG8_WAIT_L
#undef PG8_BAR
#undef PG8_SCHED
}
}

namespace att {
typedef unsigned short bf16;
using bf16x8 = __attribute__((ext_vector_type(8))) short;
using s16x4  = __attribute__((ext_vector_type(4))) short;
using f32x16 = __attribute__((ext_vector_type(16))) float;
using u32x4  = __attribute__((ext_vector_type(4))) unsigned;
constexpr int   D = 128, NW = 8, QBLK = 32, KVBLK = 64;
constexpr float SCALE = 0.088388347648318440f;
constexpr float THR = 8.f;
constexpr int SHM_V = KVBLK * D * 2, SHM_K = KVBLK * D * 2, SHM_ATTN = 2 * SHM_V + 2 * SHM_K + NW * 64 * 4;
#define KSWZ(row, colB) ((row) * 256 + ((colB) ^ (((row) & 7) << 4)))
#define SBAR() __builtin_amdgcn_sched_barrier(0)
__device__ __forceinline__ int crow(int r, int hi) { return (r & 3) + 8 * (r >> 2) + 4 * hi; }
__device__ __forceinline__ unsigned cvtpk(float lo, float hi) { unsigned r; asm volatile("v_cvt_pk_bf16_f32 %0, %1, %2" : "=v"(r) : "v"(lo), "v"(hi)); return r; }

__device__ __forceinline__ void wmask(f32x16& p0, f32x16& p1, int kpos0, int qp, int hi) {
  const bool oob = (kpos0 < 0) || (kpos0 >= 4096);
  const int base = kpos0 - qp + 128;
#pragma unroll
  for (int r = 0; r < 16; ++r) { const int c = crow(r, hi);
    if (oob || (unsigned)(base + c) > 256u) p0[r] = -1e30f;
    if (oob || (unsigned)(base + 32 + c) > 256u) p1[r] = -1e30f; }
}
__device__ __forceinline__ void partialSM(f32x16& p0, f32x16& p1, float& m_reg, float& mn, float& alpha) {
  constexpr float C = SCALE * 1.4426950408889634f;
  float pmax = p0[0];
#pragma unroll
  for (int r = 1; r < 16; ++r) pmax = fmaxf(pmax, p0[r]);
#pragma unroll
  for (int r = 0; r < 16; ++r) pmax = fmaxf(pmax, p1[r]);
  { auto rr = __builtin_amdgcn_permlane32_swap(__float_as_uint(pmax), __float_as_uint(pmax), false, false);
    pmax = fmaxf(__uint_as_float(rr[0]), __uint_as_float(rr[1])); }
  if (__builtin_expect(__all(pmax - m_reg <= THR / SCALE), 1)) { mn = m_reg; alpha = 1.f; }
  else { mn = fmaxf(m_reg, pmax); alpha = __builtin_amdgcn_exp2f((m_reg - mn) * C); m_reg = mn; }
  float mnC = -mn * C;
#pragma unroll
  for (int r = 0; r < 16; ++r) p0[r] = fmaf(p0[r], C, mnC);
#pragma unroll
  for (int r = 0; r < 16; ++r) p1[r] = fmaf(p1[r], C, mnC);
#pragma unroll
  for (int r = 0; r < 16; ++r) p0[r] = __builtin_amdgcn_exp2f(p0[r]);
}
__device__ __forceinline__ void finishSM(f32x16& p0, f32x16& p1, float alpha, float& l_reg, bf16x8& pa0, bf16x8& pa1, bf16x8& pa2, bf16x8& pa3) {
#pragma unroll
  for (int r = 0; r < 16; ++r) p1[r] = __builtin_amdgcn_exp2f(p1[r]);
  float ps = 0;
#pragma unroll
  for (int r = 0; r < 16; ++r) ps += p0[r];
#pragma unroll
  for (int r = 0; r < 16; ++r) ps += p1[r];
  { auto rr = __builtin_amdgcn_permlane32_swap(__float_as_uint(ps), __float_as_uint(ps), false, false);
    ps = __uint_as_float(rr[0]) + __uint_as_float(rr[1]); }
  l_reg = l_reg * alpha + ps;
#define PK4(P, BASE, OUT) do { unsigned a0 = cvtpk(P[BASE + 0], P[BASE + 1]), a1 = cvtpk(P[BASE + 2], P[BASE + 3]);   \
    unsigned b0 = cvtpk(P[BASE + 4], P[BASE + 5]), b1 = cvtpk(P[BASE + 6], P[BASE + 7]);                              \
    auto r0 = __builtin_amdgcn_permlane32_swap(a0, b0, false, false); auto r1 = __builtin_amdgcn_permlane32_swap(a1, b1, false, false); \
    u32x4 w = {r0[0], r1[0], r0[1], r1[1]}; OUT = *reinterpret_cast<bf16x8*>(&w); } while (0)
  PK4(p0, 0, pa0); PK4(p0, 8, pa1); PK4(p1, 0, pa2); PK4(p1, 8, pa3);
#undef PK4
}
__device__ __forceinline__ void qkt(f32x16& p0, f32x16& p1, const bf16* Ks, const bf16x8* qr, int r32, int hi) {
  p0 = f32x16{}; p1 = f32x16{};
#pragma unroll
  for (int d0 = 0; d0 < 8; ++d0) { int cb = (d0 * 16 + hi * 8) * 2;
    bf16x8 b0 = *reinterpret_cast<const bf16x8*>((const char*)Ks + KSWZ(r32, cb));
    bf16x8 b1 = *reinterpret_cast<const bf16x8*>((const char*)Ks + KSWZ(32 + r32, cb));
    p0 = __builtin_amdgcn_mfma_f32_32x32x16_bf16(b0, qr[d0], p0, 0, 0, 0);
    p1 = __builtin_amdgcn_mfma_f32_32x32x16_bf16(b1, qr[d0], p1, 0, 0, 0); }
}
__device__ __forceinline__ int v_st(int k, int c) { const int kk = (k & ~0xC) | ((k & 4) << 1) | ((k & 8) >> 1); return ((kk >> 3) * 4 + (c >> 5)) * 512 + ((kk & 7) * 32 + (c & 31)) * 2; }
__device__ __forceinline__ int v_rd_base(int lane) { return ((lane & 3) << 3) | (((lane >> 2) & 3) << 6) | (((lane >> 4) & 1) << 5) | (((lane >> 5) & 1) << 8); }
constexpr int v_rd_off(int d0, int ks, int half) { return d0 * 512 + ks * 4096 + half * 2048; }
template <int OFF> __device__ __forceinline__ s16x4 tr_read(int vb) {
  s16x4 r; asm volatile("ds_read_b64_tr_b16 %0, %1 offset:%2" : "=&v"(r) : "v"(vb), "i"(OFF) : "memory"); return r;
}
template <int D0> __device__ __forceinline__ void pv_one(f32x16& od, int vb, bf16x8 pa0, bf16x8 pa1, bf16x8 pa2, bf16x8 pa3) {
  const s16x4 l0 = tr_read<v_rd_off(D0, 0, 0)>(vb), h0 = tr_read<v_rd_off(D0, 0, 1)>(vb), l1 = tr_read<v_rd_off(D0, 1, 0)>(vb), h1 = tr_read<v_rd_off(D0, 1, 1)>(vb);
  const s16x4 l2 = tr_read<v_rd_off(D0, 2, 0)>(vb), h2 = tr_read<v_rd_off(D0, 2, 1)>(vb), l3 = tr_read<v_rd_off(D0, 3, 0)>(vb), h3 = tr_read<v_rd_off(D0, 3, 1)>(vb);
  asm volatile("s_waitcnt lgkmcnt(0)" ::: "memory"); SBAR();
#define PK(L, H) (bf16x8){L[0], L[1], L[2], L[3], H[0], H[1], H[2], H[3]}
  od = __builtin_amdgcn_mfma_f32_32x32x16_bf16(pa0, PK(l0, h0), od, 0, 0, 0);
  od = __builtin_amdgcn_mfma_f32_32x32x16_bf16(pa1, PK(l1, h1), od, 0, 0, 0);
  od = __builtin_amdgcn_mfma_f32_32x32x16_bf16(pa2, PK(l2, h2), od, 0, 0, 0);
  od = __builtin_amdgcn_mfma_f32_32x32x16_bf16(pa3, PK(l3, h3), od, 0, 0, 0);
#undef PK
}
__device__ __forceinline__ void pv_d0(f32x16* o, int vb, bf16x8 pa0, bf16x8 pa1, bf16x8 pa2, bf16x8 pa3) {
  pv_one<0>(o[0], vb, pa0, pa1, pa2, pa3); pv_one<1>(o[1], vb, pa0, pa1, pa2, pa3); pv_one<2>(o[2], vb, pa0, pa1, pa2, pa3); pv_one<3>(o[3], vb, pa0, pa1, pa2, pa3);
}

struct Args {
  const bf16* qkv; int ld;
  int qrow0, qcol, kcol, vcol;
  int ctxrow0, latrow0;
  int kstart, n0, n1;
  int qpos0;
  float sink; int has_sink;
  void* out; int ldo, ocol;
};

template <bool WINDOW, bool OUT_BF16, int LD>
__device__ __forceinline__ void attn_unit(const Args& a, char* lds) {
  const int tid = pg8::opaque_tid(), wid = tid >> 6, lane = tid & 63, r32 = lane & 31, hi = lane >> 5;
  bf16* V_lds = (bf16*)lds; bf16* K_lds = (bf16*)(lds + 2 * SHM_V);
  float* ws = (float*)(lds + 2 * SHM_V + 2 * SHM_K) + wid * 64; float* li_l = ws; float* al_l = ws + 32;
  float m_reg = a.has_sink ? a.sink * (1.0f / SCALE) : -1e30f, l_reg = a.has_sink ? 1.0f : 0.0f; f32x16 o[4] = {}; bf16x8 qr[8];
  const bf16* Qw = a.qkv + (long)(a.qrow0 + wid * QBLK + r32) * LD + a.qcol + hi * 8;
#pragma unroll
  for (int d0 = 0; d0 < 8; ++d0) qr[d0] = *reinterpret_cast<const bf16x8*>(Qw + d0 * 16);
  const int sr = tid >> 4, sc = (tid & 15) * 8, vst0 = v_st(sr, sc), vst1 = v_st(32 + sr, sc);
  const int vb0 = (int)(uintptr_t)V_lds + v_rd_base(lane);
  const int qp = a.qpos0 + wid * QBLK + r32;
  const unsigned soff0 = (unsigned)(sr * LD + sc) * 2u, soff1 = soff0 + 32u * LD * 2u;
  struct { bf16x8 vs0, vs1, ks0, ks1; } sr_[2];
#define TROW(t) ((t) < a.n0 ? a.ctxrow0 + (t) * KVBLK : a.latrow0 + min(max(a.kstart + ((t) - a.n0) * KVBLK, 0), 4096 - KVBLK))
#define SLOAD(i, t) do { const char* tb_ = (const char*)a.qkv + (size_t)TROW(t) * (LD * 2); const char* tv_ = tb_ + a.vcol * 2; const char* tk_ = tb_ + a.kcol * 2; \
    sr_[i].vs0 = *reinterpret_cast<const bf16x8*>(tv_ + soff0); sr_[i].vs1 = *reinterpret_cast<const bf16x8*>(tv_ + soff1); \
    sr_[i].ks0 = *reinterpret_cast<const bf16x8*>(tk_ + soff0); sr_[i].ks1 = *reinterpret_cast<const bf16x8*>(tk_ + soff1); } while (0)
#define SWRITE(b, i) do { *(bf16x8*)((char*)V_lds + (b) * SHM_V + vst0) = sr_[i].vs0;          \
    *(bf16x8*)((char*)V_lds + (b) * SHM_V + vst1) = sr_[i].vs1; int kc = sc * 2;               \
    *(bf16x8*)((char*)K_lds + (b) * SHM_K + KSWZ(sr, kc)) = sr_[i].ks0;                       \
    *(bf16x8*)((char*)K_lds + (b) * SHM_K + KSWZ(32 + sr, kc)) = sr_[i].ks1; } while (0)
#define SWAIT() asm volatile("s_waitcnt vmcnt(4)" ::: "memory")
#define RESC(al) do { if (__any((al) < 1.f)) { if (hi == 0) al_l[r32] = (al); asm volatile("s_waitcnt lgkmcnt(0)" ::: "memory"); \
    _Pragma("unroll") for (int d = 0; d < 4; ++d) _Pragma("unroll") for (int r = 0; r < 16; ++r) o[d][r] *= al_l[crow(r, hi)]; } } while (0)
#define WMASK(P0, P1, t) do { if (WINDOW) { if ((t) >= a.n0) wmask(P0, P1, a.kstart + ((t) - a.n0) * KVBLK, qp, hi); } } while (0)
  f32x16 pA0, pA1, pB0, pB1; float mnA, mnB, alA, alB; bf16x8 pa0, pa1, pa2, pa3; const int NT = a.n0 + a.n1;
  constexpr int SE = 0, SO = 1;
  SLOAD(SE, 0); asm volatile("s_waitcnt vmcnt(0)" ::: "memory"); SWRITE(0, SE); __syncthreads();
  qkt(pA0, pA1, K_lds, qr, r32, hi); WMASK(pA0, pA1, 0); partialSM(pA0, pA1, m_reg, mnA, alA);
  SLOAD(SO, 1); if (2 < NT) SLOAD(SE, 2);
  SWAIT(); SWRITE(1, SO); __syncthreads();
  for (int j = 1; j + 1 < NT; j += 2) {
    SBAR(); qkt(pB0, pB1, (bf16*)((char*)K_lds + SHM_K), qr, r32, hi);
    finishSM(pA0, pA1, alA, l_reg, pa0, pa1, pa2, pa3); SBAR();
    SLOAD(SO, j + 2); SBAR();
    pv_d0(o, vb0, pa0, pa1, pa2, pa3); WMASK(pB0, pB1, j); partialSM(pB0, pB1, m_reg, mnB, alB);
    __syncthreads(); SWAIT(); SWRITE(0, SE);
    RESC(alB); __syncthreads();
    SBAR(); qkt(pA0, pA1, K_lds, qr, r32, hi);
    finishSM(pB0, pB1, alB, l_reg, pa0, pa1, pa2, pa3); SBAR();
    if (j + 3 < NT) SLOAD(SE, j + 3); SBAR();
    pv_d0(o, vb0 + (int)SHM_V, pa0, pa1, pa2, pa3); WMASK(pA0, pA1, j + 1); partialSM(pA0, pA1, m_reg, mnA, alA);
    __syncthreads(); SWAIT(); SWRITE(1, SO);
    RESC(alA); __syncthreads();
  }
  SBAR(); qkt(pB0, pB1, (bf16*)((char*)K_lds + SHM_K), qr, r32, hi);
  finishSM(pA0, pA1, alA, l_reg, pa0, pa1, pa2, pa3); SBAR();
  pv_d0(o, vb0, pa0, pa1, pa2, pa3); WMASK(pB0, pB1, NT - 1); partialSM(pB0, pB1, m_reg, mnB, alB);
  __syncthreads(); RESC(alB);
  finishSM(pB0, pB1, alB, l_reg, pa0, pa1, pa2, pa3); SBAR();
  pv_d0(o, vb0 + (int)SHM_V, pa0, pa1, pa2, pa3);
  if (hi == 0) li_l[r32] = l_reg; asm volatile("s_waitcnt lgkmcnt(0)" ::: "memory");
  float rli[16];
#pragma unroll
  for (int r = 0; r < 16; ++r) rli[r] = __builtin_amdgcn_rcpf(li_l[crow(r, hi)]);
  if (OUT_BF16) {
    bf16* Ow = (bf16*)a.out + (long)(a.qrow0 + wid * QBLK) * a.ldo + a.ocol;
#pragma unroll
    for (int r = 0; r < 16; ++r) { const int orow = crow(r, hi);
#pragma unroll
      for (int d0 = 0; d0 < 4; ++d0) Ow[(long)orow * a.ldo + d0 * 32 + r32] = (bf16)(cvtpk(o[d0][r] * rli[r], 0.f) & 0xffffu); }
  } else {
    float* Ow = (float*)a.out + (long)(a.qrow0 + wid * QBLK) * a.ldo + a.ocol;
#pragma unroll
    for (int r = 0; r < 16; ++r) { const int orow = crow(r, hi);
#pragma unroll
      for (int d0 = 0; d0 < 4; ++d0) Ow[(long)orow * a.ldo + d0 * 32 + r32] = o[d0][r] * rli[r]; }
  }
  __syncthreads();
#undef TROW
#undef SLOAD
#undef SWRITE
#undef SWAIT
#undef RESC
#undef WMASK
}
#undef KSWZ
#undef SBAR
}

constexpr int NWAVES = 8;
constexpr int DM = 2048, NBATCH = 2, SEQ = 4096, MLAT = NBATCH * SEQ, CTXL = 256, MCTX = NBATCH * CTXL, MALL = MLAT + MCTX;
constexpr int DFF = 5504, NFC1 = 2 * DFF, NLAYER = 4, NMODC = 9 * DM;
constexpr int A_N = 3072, B_N = 12288, B_W = 6144, C_N = 6144;
constexpr float EPS = 1e-6f;
constexpr size_t MiB = 1u << 20;
constexpr size_t WS_CTL = 0, CTL_BYTES = 2 * MiB;
constexpr size_t WS_MODT = 2 * MiB;
constexpr size_t WS_ROPE = 3 * MiB;
constexpr size_t WS_XC = 5 * MiB;
constexpr size_t WS_STATS = 9 * MiB;
constexpr size_t WS_BSW = 10 * MiB;
constexpr size_t WS_WFC1 = 11 * MiB;
constexpr size_t WS_WFC2 = WS_WFC1 + 344 * MiB;
constexpr size_t WS_WAIN = WS_WFC2 + 172 * MiB;
constexpr size_t WS_WAOUT = WS_WAIN + 24 * MiB;
constexpr size_t WS_WBIN = WS_WAOUT + 16 * MiB;
constexpr size_t WS_WBOUT = WS_WBIN + 48 * MiB;
constexpr size_t WS_WCIN = WS_WBOUT + 24 * MiB;
constexpr size_t WS_WCOUT = WS_WCIN + 24 * MiB;
constexpr size_t WS_H = WS_WCOUT + 8 * MiB;
constexpr size_t WS_HID = WS_H + 34 * MiB;
constexpr size_t WS_Y = WS_HID + 92 * MiB;
constexpr size_t WS_QKV = WS_Y + 68 * MiB;
constexpr size_t WS_AO = WS_QKV + 204 * MiB;
constexpr size_t WS_OC = WS_AO + 34 * MiB;
constexpr size_t WS_END = WS_OC + 136 * MiB;
static_assert((size_t)8 * NFC1 * DM * 2 <= 344 * MiB && (size_t)8 * DM * DFF * 2 <= 172 * MiB && (size_t)MALL * DFF * 2 <= 92 * MiB && (size_t)MALL * B_N * 2 <= 204 * MiB, "ws map");
constexpr int CW_BAR = 4096;
constexpr int RING_BYTES = 131072, MISC_OFF = RING_BYTES + 320, LDS_BYTES = 147456;

#define GAS __attribute__((address_space(1)))
#define LAS __attribute__((address_space(3)))
typedef unsigned short bf16;
typedef unsigned v4u __attribute__((ext_vector_type(4)));
typedef unsigned v2u __attribute__((ext_vector_type(2)));
typedef float f32x4 __attribute__((ext_vector_type(4)));
typedef short bf16x8 __attribute__((ext_vector_type(8)));
typedef float f32x16 __attribute__((ext_vector_type(16)));
#define LDS_WAIT() asm volatile("s_waitcnt lgkmcnt(0)" ::: "memory")
#define VM_WAIT() asm volatile("s_waitcnt vmcnt(0)" ::: "memory")
__device__ __forceinline__ unsigned f2bf(float f) { unsigned u = __builtin_bit_cast(unsigned, f); return (u + 0x7fffu + ((u >> 16) & 1u)) >> 16; }
__device__ __forceinline__ unsigned pk2(float lo, float hi) { return f2bf(lo) | (f2bf(hi) << 16); }
__device__ __forceinline__ float bf2f(unsigned short b) { return __builtin_bit_cast(float, ((unsigned)b) << 16); }
__device__ __forceinline__ float wave_sum(float v) {
#pragma unroll
    for (int o = 1; o < 64; o <<= 1) v += __shfl_xor(v, o);
    return v;
}

#define XB_TMO      128
#define XB_XCNT(j)  (256  + 64 * (j))
#define XB_XSUB(j)  (1280 + 64 * (j))
#define XB_XGEN(j)  (2304 + 64 * (j))
#define XB_TOP      3328
#define XB_TOPGEN   3392
#define XCD_BAR_WORDS 3456
#define XB_SPIN_CAP (1u << 18)

__device__ __forceinline__ unsigned xb_ld(unsigned* p)              { return __hip_atomic_load(p, __ATOMIC_RELAXED, __HIP_MEMORY_SCOPE_AGENT); }
__device__ __forceinline__ unsigned xb_add(unsigned* p, unsigned v) { return __hip_atomic_fetch_add(p, v, __ATOMIC_RELAXED, __HIP_MEMORY_SCOPE_AGENT); }
__device__ __forceinline__ unsigned xb_xcc_id() { return (unsigned)__builtin_amdgcn_s_getreg((3 << 11) | 20) & 0xFu; }
#define XB_SPIN(cond, bar) do { unsigned _sp = 0; while (cond) { __builtin_amdgcn_s_sleep(1); \
    if ((++_sp & 255u) == 0u) { if (xb_ld(&(bar)[XB_TMO])) break; if (_sp > XB_SPIN_CAP) { atomicAdd(&(bar)[XB_TMO], 1u); break; } } } } while (0)

struct XcdBarrier {
    unsigned* bar; unsigned x;
    volatile LAS unsigned* st;
};

__device__ __forceinline__ XcdBarrier xcd_barrier_post(unsigned* bar, volatile LAS unsigned* st) {
    XcdBarrier b; b.bar = bar; b.x = xb_xcc_id(); b.st = st;
    if (threadIdx.x == 0) (void)xb_add(&bar[XB_XCNT(b.x)], 1u);
    return b;
}
__device__ __forceinline__ void xcd_barrier_complete(unsigned* bar, unsigned x, unsigned& nloc, unsigned& nx) {
    const unsigned G = gridDim.x * gridDim.y * gridDim.z;
    unsigned sum, cnt, mine, sp = 0u;
    for (;;) {
        sum = 0u; cnt = 0u; mine = 0u;
#pragma unroll
        for (unsigned j = 0; j < 16; ++j) { const unsigned c = xb_ld(&bar[XB_XCNT(j)]); sum += c; cnt += (c > 0u) ? 1u : 0u; mine = (j == x) ? c : mine; }
        if (sum == G) break;
        __builtin_amdgcn_s_sleep(1);
        if ((++sp & 255u) == 0u) { if (xb_ld(&bar[XB_TMO])) break; if (sp > XB_SPIN_CAP) { atomicAdd(&bar[XB_TMO], 1u); break; } }
    }
    nloc = mine > 0u ? mine : 1u; nx = cnt > 0u ? cnt : 1u;
}

__device__ __forceinline__ void xcd_barrier(const XcdBarrier& b) {
    asm volatile("s_waitcnt vmcnt(0)" ::: "memory");
    __syncthreads();
    if (threadIdx.x == 0) {
        unsigned* bar = b.bar;
        __builtin_amdgcn_s_waitcnt(0);
        unsigned nloc = b.st[0], nx = b.st[1];
        if (nloc == 0u) { xcd_barrier_complete(bar, b.x, nloc, nx); b.st[0] = nloc; b.st[1] = nx; }
        const unsigned old = xb_add(&bar[XB_XSUB(b.x)], 1u);
        const unsigned gen = old / nloc;
        if (old + 1u == (gen + 1u) * nloc) {
            __builtin_amdgcn_fence(__ATOMIC_RELEASE, "agent");
            asm volatile("s_waitcnt vmcnt(0)" ::: "memory");
            const unsigned og = xb_add(&bar[XB_TOP], 1u);
            const unsigned tg = og / nx;
            if (og + 1u == (tg + 1u) * nx) xb_add(&bar[XB_TOPGEN], 1u);
            else XB_SPIN(xb_ld(&bar[XB_TOPGEN]) == tg, bar);
            __builtin_amdgcn_fence(__ATOMIC_ACQUIRE, "agent");
            xb_add(&bar[XB_XGEN(b.x)], 1u);
            asm volatile("s_waitcnt vmcnt(0)" ::: "memory");
        } else {
            XB_SPIN(xb_ld(&bar[XB_XGEN(b.x)]) == gen, bar);
            __builtin_amdgcn_fence(__ATOMIC_ACQUIRE, "agent");
            asm volatile("s_waitcnt vmcnt(0)" ::: "memory");
        }
    }
    __syncthreads();
}

__device__ __forceinline__ void transpose_item(const float* W, int K, int N, bf16* WT, int fc1map, LAS float* scr, int item, int lane) {
    const int nblk = N / 32, kb = item / nblk, nb = item % nblk, k0 = 64 * kb, n0 = 32 * nb;
    int rowbase = n0;
    if (fc1map) { rowbase = (n0 < DFF) ? 256 * (n0 / 128) + (n0 % 128) : 256 * ((n0 - DFF) / 128) + 128 + ((n0 - DFF) % 128); }
#pragma unroll 8
    for (int i = 0; i < 32; ++i) { const int kk = 2 * i + (lane >> 5); scr[kk * 33 + (lane & 31)] = W[(size_t)(k0 + kk) * N + n0 + (lane & 31)]; }
    LDS_WAIT(); asm volatile("" ::: "memory");
    const int c = lane & 7;
#pragma unroll
    for (int j = 0; j < 4; ++j) { const int n = (lane >> 3) + 8 * j; const LAS float* s = scr + (8 * c) * 33 + n;
        v4u o; o.x = pk2(s[0 * 33], s[1 * 33]); o.y = pk2(s[2 * 33], s[3 * 33]); o.z = pk2(s[4 * 33], s[5 * 33]); o.w = pk2(s[6 * 33], s[7 * 33]);
        *(GAS v4u*)(WT + (size_t)(rowbase + n) * K + k0 + 8 * c) = o; }
    LDS_WAIT(); asm volatile("" ::: "memory");
}

struct KArgs { const float* in[25]; float* out; unsigned char* ws; int ph_lo, ph_hi, li; float lam_init; };

__device__ __forceinline__ float* modt(unsigned char* ws, int layer, int slot, int modrow, int which) { return (float*)(ws + WS_MODT) + ((size_t)(((layer * 3 + slot) * 3 + modrow) * 3 + which)) * DM; }

__device__ __forceinline__ void prologue_phase(const KArgs& args, LAS unsigned char* L, int bx, int G) {
    const int tid = pg8::opaque_tid(), lane = tid & 63, wave = __builtin_amdgcn_readfirstlane(tid >> 6);
    unsigned char* ws = args.ws;
    LAS float* sl = (LAS float*)L;
    for (int i = tid; i < 3 * DM; i += NWAVES * 64) { const int r = i / DM, k = i % DM; const float v = (r < 2) ? args.in[1][r * DM + k] : args.in[3][k]; sl[i] = v / (1.0f + expf(-v)); }
    __syncthreads();
    LAS float* part = (LAS float*)(L + 24576);
    for (int item = bx; item < NLAYER * 72; item += G) {
        const int layer = item / 72, n0 = (item % 72) * 256;
        const float* W = args.in[4] + ((size_t)layer * DM + wave * 256) * NMODC + n0 + lane * 4;
        const LAS float* s0 = sl + wave * 256;
        f32x4 a0 = {0.f, 0.f, 0.f, 0.f}, a1 = a0, a2 = a0;
#pragma unroll 8
        for (int kk = 0; kk < 256; ++kk) { const f32x4 w = *(const f32x4*)(W + (size_t)kk * NMODC); a0 += w * s0[kk]; a1 += w * s0[DM + kk]; a2 += w * s0[2 * DM + kk]; }
        *(LAS f32x4*)(part + (wave * 3 + 0) * 256 + lane * 4) = a0; *(LAS f32x4*)(part + (wave * 3 + 1) * 256 + lane * 4) = a1; *(LAS f32x4*)(part + (wave * 3 + 2) * 256 + lane * 4) = a2;
        __syncthreads();
        for (int idx = tid; idx < 768; idx += NWAVES * 64) { const int r = idx >> 8, cc = idx & 255, n = n0 + cc; float m = args.in[5][layer * NMODC + n];
#pragma unroll
            for (int w = 0; w < 8; ++w) m += part[(w * 3 + r) * 256 + cc];
            const int k9 = n / DM, c = n % DM, s = k9 / 3, which = k9 % 3; const float* g = args.in[6] + (size_t)layer * 6 * DM;
            if (which == 0) modt(ws, layer, s, r, 2)[c] = m;
            else if (which == 1) modt(ws, layer, s, r, 1)[c] = g[(2 * s) * DM + c] * (1.0f + m);
            else modt(ws, layer, s, r, 0)[c] = (s == 1 ? 1.0f : 0.5f) * m * g[(2 * s + 1) * DM + c]; }
        __syncthreads();
    }
    {
        LAS float* scr = (LAS float*)(L + 49152 + wave * 8448);
        const int gw = bx * NWAVES + wave, NGW = G * NWAVES;
        constexpr int I_FC1 = (DM / 64) * (NFC1 / 32), I_FC2 = (DFF / 64) * (DM / 32), I_AIN = (DM / 64) * (A_N / 32), I_SQ = (DM / 64) * (DM / 32), I_BIN = (DM / 64) * (B_N / 32), I_BOUT = (B_W / 64) * (DM / 32), I_CIN = (DM / 64) * (C_N / 32);
        constexpr int NITEMS = 8 * I_FC1 + 8 * I_FC2 + 2 * I_AIN + 2 * I_SQ + I_BIN + I_BOUT + I_CIN + I_SQ;
        for (int it = gw; it < NITEMS; it += NGW) {
            int r = it;
            if (r < 8 * I_FC1) { const int mat = r / I_FC1; transpose_item(args.in[7] + (size_t)mat * DM * NFC1, DM, NFC1, (bf16*)(ws + WS_WFC1) + (size_t)mat * NFC1 * DM, 1, scr, r % I_FC1, lane); continue; } r -= 8 * I_FC1;
            if (r < 8 * I_FC2) { const int mat = r / I_FC2; transpose_item(args.in[8] + (size_t)mat * DFF * DM, DFF, DM, (bf16*)(ws + WS_WFC2) + (size_t)mat * DM * DFF, 0, scr, r % I_FC2, lane); continue; } r -= 8 * I_FC2;
            if (r < 2 * I_AIN) { const int mat = r / I_AIN; transpose_item(args.in[9] + (size_t)mat * DM * A_N, DM, A_N, (bf16*)(ws + WS_WAIN) + (size_t)mat * A_N * DM, 0, scr, r % I_AIN, lane); continue; } r -= 2 * I_AIN;
            if (r < 2 * I_SQ) { const int mat = r / I_SQ; transpose_item(args.in[10] + (size_t)mat * DM * DM, DM, DM, (bf16*)(ws + WS_WAOUT) + (size_t)mat * DM * DM, 0, scr, r % I_SQ, lane); continue; } r -= 2 * I_SQ;
            if (r < I_BIN) { transpose_item(args.in[12], DM, B_N, (bf16*)(ws + WS_WBIN), 0, scr, r, lane); continue; } r -= I_BIN;
            if (r < I_BOUT) { transpose_item(args.in[17], B_W, DM, (bf16*)(ws + WS_WBOUT), 0, scr, r, lane); continue; } r -= I_BOUT;
            if (r < I_CIN) { transpose_item(args.in[18], DM, C_N, (bf16*)(ws + WS_WCIN), 0, scr, r, lane); continue; } r -= I_CIN;
            transpose_item(args.in[19], DM, DM, (bf16*)(ws + WS_WCOUT), 0, scr, r, lane);
        }
    }
    for (int e = bx * NWAVES * 64 + tid; e < SEQ * 64; e += G * NWAVES * 64) { const int t = e >> 6, p = e & 63, pi = p & 31;
        const float inv = (float)pow(10000.0, -(double)pi / 32.0); const float ang = (float)((p < 32) ? (t >> 6) : (t & 63)) * inv;
        float* o = (float*)(ws + WS_ROPE) + (size_t)e * 2; o[0] = (float)cos((double)ang); o[1] = (float)sin((double)ang); }
    for (int e = bx * NWAVES * 64 + tid; e < 8 * 128 * 128; e += G * NWAVES * 64) ((bf16*)(ws + WS_BSW))[e] = (bf16)f2bf(args.in[15][e]);
}

__device__ __forceinline__ void norm_phase(const float* xs_lat, const float* xs_ctx, float* xd_lat, float* xd_ctx, const float* Y, const float* postT, const float* preT, bf16* H, int nrows) {
    const int tid = pg8::opaque_tid(), lane = tid & 63, gw = blockIdx.x * NWAVES + __builtin_amdgcn_readfirstlane(tid >> 6), NGW = gridDim.x * NWAVES;
    for (int row = gw; row < nrows; row += NGW) {
        const int modrow = row < SEQ ? 0 : (row < MLAT ? 1 : 2);
        const float* xs = (row < MLAT) ? xs_lat + (size_t)row * DM : xs_ctx + (size_t)(row - MLAT) * DM;
        float* xd = (row < MLAT) ? xd_lat + (size_t)row * DM : xd_ctx + (size_t)(row - MLAT) * DM;
        f32x4 xv[8];
#pragma unroll
        for (int j = 0; j < 8; ++j) xv[j] = *(const f32x4*)(xs + 256 * j + 4 * lane);
        if (Y) {
            const float* yr = Y + (size_t)row * DM; const float* At = postT + (size_t)modrow * 3 * DM;
            f32x4 yv[8]; float ss = 0.f;
#pragma unroll
            for (int j = 0; j < 8; ++j) { yv[j] = *(const f32x4*)(yr + 256 * j + 4 * lane); ss += (yv[j].x * yv[j].x + yv[j].y * yv[j].y) + (yv[j].z * yv[j].z + yv[j].w * yv[j].w); }
            const float ry = 1.0f / sqrtf(wave_sum(ss) * (1.0f / DM) + EPS);
#pragma unroll
            for (int j = 0; j < 8; ++j) { const f32x4 a = *(const f32x4*)(At + 256 * j + 4 * lane); xv[j] += yv[j] * ry * a; }
        }
#pragma unroll
        for (int j = 0; j < 8; ++j) *(f32x4*)(xd + 256 * j + 4 * lane) = xv[j];
        if (H) {
            const float* Bt = preT + (size_t)(modrow * 3 + 1) * DM; const float* Ct = preT + (size_t)(modrow * 3 + 2) * DM;
            float ss = 0.f;
#pragma unroll
            for (int j = 0; j < 8; ++j) ss += (xv[j].x * xv[j].x + xv[j].y * xv[j].y) + (xv[j].z * xv[j].z + xv[j].w * xv[j].w);
            const float rx = 1.0f / sqrtf(wave_sum(ss) * (1.0f / DM) + EPS);
            bf16* hr = H + (size_t)row * DM;
#pragma unroll
            for (int j = 0; j < 8; ++j) { const f32x4 b = *(const f32x4*)(Bt + 256 * j + 4 * lane), c = *(const f32x4*)(Ct + 256 * j + 4 * lane); const f32x4 h = xv[j] * rx * b + c;
                v2u o; o.x = pk2(h.x, h.y); o.y = pk2(h.z, h.w); *(v2u*)(hr + 256 * j + 4 * lane) = o; }
        }
    }
}
__device__ __forceinline__ void vstats_phase(const bf16* QKV, float* stats, int nrows) {
    const int tid = pg8::opaque_tid(), lane = tid & 63, gw = blockIdx.x * NWAVES + __builtin_amdgcn_readfirstlane(tid >> 6), NGW = gridDim.x * NWAVES;
    for (int row = gw; row < nrows; row += NGW) {
        const bf16* vr = QKV + (size_t)row * B_N + B_W + lane * 8; bf16x8 raw[12]; float s = 0.f;
#pragma unroll
        for (int i = 0; i < 12; ++i) { raw[i] = *(const bf16x8*)(vr + i * 512);
#pragma unroll
            for (int e = 0; e < 8; ++e) s += bf2f((unsigned short)raw[i][e]); }
        const float mean = wave_sum(s) * (1.0f / B_W); float q = 0.f;
#pragma unroll
        for (int i = 0; i < 12; ++i)
#pragma unroll
            for (int e = 0; e < 8; ++e) { const float d = bf2f((unsigned short)raw[i][e]) - mean; q += d * d; }
        const float rstd = 1.0f / sqrtf(wave_sum(q) * (1.0f / B_W) + EPS);
        if (lane == 0) { stats[2 * row] = mean; stats[2 * row + 1] = rstd; }
    }
}
__device__ __forceinline__ void spatial_phase(bf16* QKV, const bf16* BSW, const float* stats, const float* vg, const float* vb, const float* bs, LAS unsigned char* L, int nchunks, int bx, int G) {
    const int tid = pg8::opaque_tid(), lane = tid & 63, wave = __builtin_amdgcn_readfirstlane(tid >> 6);
    constexpr int PITCH = 136;
    LAS bf16* T = (LAS bf16*)L;
    const int hi = lane >> 5, r32 = lane & 31;
    for (int u = bx; u < nchunks * 24; u += G) {
        const int third = u % 3, g = (u / 3) % 8, ch = u / 24, row0 = ch * 128, cbase = g * 768 + third * 256;
        { const int q = tid & 127, c8b = tid >> 7; const float mu = stats[2 * (row0 + q)], rs = stats[2 * (row0 + q) + 1];
          const bf16* vr = QKV + (size_t)(row0 + q) * B_N + B_W + cbase;
#pragma unroll
          for (int i = 0; i < 8; ++i) { const int c0 = (4 * i + c8b) * 8; const bf16x8 raw = *(const bf16x8*)(vr + c0);
              const f32x4 g0 = *(const f32x4*)(vg + cbase + c0), g1 = *(const f32x4*)(vg + cbase + c0 + 4), b0 = *(const f32x4*)(vb + cbase + c0), b1 = *(const f32x4*)(vb + cbase + c0 + 4);
#pragma unroll
              for (int e = 0; e < 8; ++e) { const float gm = e < 4 ? g0[e & 3] : g1[e & 3], bt = e < 4 ? b0[e & 3] : b1[e & 3];
                  T[(c0 + e) * PITCH + q] = (bf16)f2bf((bf2f((unsigned short)raw[e]) - mu) * rs * gm + bt); } } }
        __syncthreads();
        f32x16 acc[4] = {};
        const bf16* Wg = BSW + (size_t)g * 16384 + (size_t)r32 * 128 + hi * 8;
#pragma unroll
        for (int ks = 0; ks < 8; ++ks) { const bf16x8 bfr = *(const LAS bf16x8*)(T + (32 * wave + r32) * PITCH + ks * 16 + hi * 8);
#pragma unroll
            for (int mb = 0; mb < 4; ++mb) { const bf16x8 afr = *(const bf16x8*)(Wg + mb * 32 * 128 + ks * 16); acc[mb] = __builtin_amdgcn_mfma_f32_32x32x16_bf16(afr, bfr, acc[mb], 0, 0, 0); } }
        const int col = cbase + 32 * wave + r32;
#pragma unroll
        for (int mb = 0; mb < 4; ++mb)
#pragma unroll
            for (int r = 0; r < 16; ++r) { const int p = mb * 32 + (r & 3) + 8 * (r >> 2) + 4 * hi; bf16* up = QKV + (size_t)(row0 + p) * B_N + col;
                *up = (bf16)f2bf(bf2f(*up) * (acc[mb][r] + bs[g * 128 + p])); }
        __syncthreads();
    }
}
__device__ __forceinline__ void combine_phase(const float* OC, bf16* AO, const float* lq1, const float* lk1, const float* lq2, const float* lk2, const float* sg, float lam_init, int nrows) {
    const int tid = pg8::opaque_tid(), lane = tid & 63, gw = blockIdx.x * NWAVES + __builtin_amdgcn_readfirstlane(tid >> 6), NGW = gridDim.x * NWAVES;
    const float d1 = wave_sum(lq1[lane] * lk1[lane] + lq1[lane + 64] * lk1[lane + 64]), d2 = wave_sum(lq2[lane] * lk2[lane] + lq2[lane + 64] * lk2[lane + 64]);
    const float lam = expf(d1) - expf(d2) + lam_init;
    const f32x4 gv = *(const f32x4*)(sg + 4 * lane) * (1.0f - lam_init);
    for (int row = gw; row < nrows; row += NGW) {
        const float* orow = OC + (size_t)row * 4096; bf16* ar = AO + (size_t)row * DM;
#pragma unroll
        for (int h = 0; h < 8; ++h) { const f32x4 a = *(const f32x4*)(orow + (2 * h) * 256 + 4 * lane), b = *(const f32x4*)(orow + (2 * h + 1) * 256 + 4 * lane); const f32x4 o = a - lam * b;
            const float rs = 1.0f / sqrtf(wave_sum((o.x * o.x + o.y * o.y) + (o.z * o.z + o.w * o.w)) * (1.0f / 256.0f) + EPS); const f32x4 v = o * rs * gv;
            v2u w; w.x = pk2(v.x, v.y); w.y = pk2(v.z, v.w); *(v2u*)(ar + h * 256 + 4 * lane) = w; }
    }
}

__global__ void __launch_bounds__(NWAVES * 64, 2) fwd(KArgs args) {
    extern __shared__ __attribute__((aligned(16))) unsigned char lds[];
    LAS unsigned char* L = (LAS unsigned char*)lds;
    const int tid = threadIdx.x, G = gridDim.x, bx = blockIdx.x;
    unsigned char* ws = args.ws;
    for (int u = tid; u < (LDS_BYTES - RING_BYTES) / 4; u += NWAVES * 64) ((LAS unsigned*)(L + RING_BYTES))[u] = 0u;
    __syncthreads();
    const int lo = args.ph_lo, hi = args.ph_hi;
    XcdBarrier bar; bar.bar = (unsigned*)(ws + WS_CTL) + CW_BAR + args.li * XCD_BAR_WORDS; bar.x = 0; bar.st = (volatile LAS unsigned*)(L + MISC_OFF + 32);
    if (hi - lo > 1) bar = xcd_barrier_post((unsigned*)(ws + WS_CTL) + CW_BAR + args.li * XCD_BAR_WORDS, (volatile LAS unsigned*)(L + MISC_OFF + 32));
    int ph = 0;
#define PHASE_BEGIN if (ph >= lo && ph < hi) {
#define PHASE_END   if (ph + 1 < hi) xcd_barrier(bar); } ++ph;
    float* XL = args.out; float* XC = (float*)(ws + WS_XC);
    bf16* H = (bf16*)(ws + WS_H); bf16* HID = (bf16*)(ws + WS_HID); float* Y = (float*)(ws + WS_Y); bf16* QKV = (bf16*)(ws + WS_QKV); bf16* AO = (bf16*)(ws + WS_AO); float* OC = (float*)(ws + WS_OC);
    const float* ROPE = (const float*)(ws + WS_ROPE);

    PHASE_BEGIN
#ifndef OFF_PRO
    prologue_phase(args, L, bx, G);
#endif
    PHASE_END
    PHASE_BEGIN norm_phase(args.in[0], args.in[2], XL, XC, nullptr, nullptr, modt(ws, 0, 0, 0, 0), H, MALL); PHASE_END

    for (int sl = 0; sl < 3 * NLAYER; ++sl) {
        const int layer = sl / 3, typ = sl % 3, kind = layer % 3, jm = layer / 3; const bool lastl = (layer == NLAYER - 1);
        const int Mrows = (lastl && typ >= 1) ? MLAT : MALL;
        pg8::Gemm gy;
        if (typ != 1) {
            const int f = (typ == 0) ? 0 : 1;
            PHASE_BEGIN
                pg8::Gemm g{H, (const bf16*)(ws + WS_WFC1) + (size_t)(layer * 2 + f) * NFC1 * DM, Mrows, NFC1, DM, DM}; pg8::StaticOrder S; S.init(Mrows, NFC1, G, bx);
                pg8::EpiSwiglu E{HID, DFF};
                #ifndef OFF_FC1
                pg8::gemm_phase<pg8::EpiSwiglu, pg8::StaticOrder, true, true, DM, DM>(L, g, S, E);
#endif
            PHASE_END
            gy = pg8::Gemm{HID, (const bf16*)(ws + WS_WFC2) + (size_t)(layer * 2 + f) * DM * DFF, Mrows, DM, DFF, DFF};
        } else {
            if (kind != 1) {
                PHASE_BEGIN
                    const int N = (kind == 0) ? A_N : C_N;
                    pg8::Gemm g{H, (kind == 0) ? (const bf16*)(ws + WS_WAIN) + (size_t)jm * A_N * DM : (const bf16*)(ws + WS_WCIN), MALL, N, DM, DM}; pg8::StaticOrder S; S.init(MALL, N, G, bx);
                    pg8::EpiBf16X<0> E{QKV, N, ROPE, (kind == 0) ? 2560 : 4096};
                    #ifndef OFF_ROPE
                    pg8::gemm_phase<pg8::EpiBf16X<0>, pg8::StaticOrder, true, true, DM, DM>(L, g, S, E);
#endif
                PHASE_END
            } else {
                PHASE_BEGIN
                    pg8::Gemm g{H, (const bf16*)(ws + WS_WBIN), MALL, B_N, DM, DM}; pg8::StaticOrder S; S.init(MALL, B_N, G, bx);
                    pg8::EpiBf16X<1> E{QKV, B_N, nullptr, 0};
                    #ifndef OFF_GELU
                    pg8::gemm_phase<pg8::EpiBf16X<1>, pg8::StaticOrder, true, true, DM, DM>(L, g, S, E);
#endif
                PHASE_END
            }
            if (kind == 0) {
                PHASE_BEGIN
                    const int nlat = NBATCH * 16 * 16, nall = nlat + (lastl ? 0 : NBATCH * 16);
                    for (int u = bx; u < nall; u += G) {
                        att::Args a; a.qkv = QKV; a.ld = A_N; a.n0 = 4; a.has_sink = 1; a.out = AO; a.ldo = DM;
                        if (u < nlat) { const int qb = u & 15, h = (u >> 4) & 15, b = u >> 8;
                            a.qrow0 = b * SEQ + qb * 256; a.qcol = h * 128; a.kcol = 2048 + (h >> 2) * 128; a.vcol = 2560 + (h >> 2) * 128; a.ctxrow0 = MLAT + b * CTXL; a.latrow0 = b * SEQ;
                            a.kstart = qb * 256 - 128; a.n1 = 8; a.qpos0 = qb * 256; a.sink = args.in[11][jm * 16 + h]; a.ocol = h * 128; }
                        else { const int cu = u - nlat, h = cu & 15, b = cu >> 4;
                            a.qrow0 = MLAT + b * CTXL; a.qcol = h * 128; a.kcol = 2048 + (h >> 2) * 128; a.vcol = 2560 + (h >> 2) * 128; a.ctxrow0 = MLAT + b * CTXL; a.latrow0 = b * SEQ;
                            a.kstart = 0; a.n1 = 0; a.qpos0 = 0; a.sink = args.in[11][jm * 16 + h]; a.ocol = h * 128; }
                        #ifndef OFF_ATTA
                        att::attn_unit<true, true, A_N>(a, (char*)lds);
#endif
                    }
                PHASE_END
                gy = pg8::Gemm{AO, (const bf16*)(ws + WS_WAOUT) + (size_t)jm * DM * DM, Mrows, DM, DM, DM};
            } else if (kind == 1) {
                PHASE_BEGIN vstats_phase(QKV, (float*)(ws + WS_STATS), MALL); PHASE_END
                PHASE_BEGIN
#ifndef OFF_SPA
                spatial_phase(QKV, (const bf16*)(ws + WS_BSW), (const float*)(ws + WS_STATS), args.in[13], args.in[14], args.in[16], L, MALL / 128, bx, G);
#endif
                PHASE_END
                gy = pg8::Gemm{QKV, (const bf16*)(ws + WS_WBOUT), Mrows, DM, B_W, B_N};
            } else {
                PHASE_BEGIN
                    const int nlat = NBATCH * 32 * 16, nall = nlat + (lastl ? 0 : NBATCH * 32);
                    for (int u = bx; u < nall; u += G) {
                        att::Args a; a.qkv = QKV; a.ld = C_N; a.n0 = 4; a.has_sink = 0; a.sink = 0.f; a.out = OC; a.ldo = 4096; a.kstart = 0; a.qpos0 = 0;
                        int b, combo;
                        if (u < nlat) { const int qb = u & 15; combo = (u >> 4) & 31; b = u >> 9; a.qrow0 = b * SEQ + qb * 256; a.n1 = 64; }
                        else { const int cu = u - nlat; combo = cu & 31; b = cu >> 5; a.qrow0 = MLAT + b * CTXL; a.n1 = 0; }
                        const int hc = combo >> 1, vh = combo & 1;
                        a.qcol = hc * 128; a.kcol = 2048 + hc * 128; a.vcol = 4096 + (hc >> 1) * 256 + vh * 128; a.ctxrow0 = MLAT + b * CTXL; a.latrow0 = b * SEQ; a.ocol = hc * 256 + vh * 128;
                        #ifndef OFF_ATTC
                        att::attn_unit<false, false, C_N>(a, (char*)lds);
#endif
                    }
                PHASE_END
                PHASE_BEGIN combine_phase(OC, AO, args.in[20], args.in[21], args.in[22], args.in[23], args.in[24], args.lam_init, MALL); PHASE_END
                gy = pg8::Gemm{AO, (const bf16*)(ws + WS_WCOUT), Mrows, DM, DM, DM};
            }
        }
        PHASE_BEGIN
            pg8::StaticOrder S; S.init(gy.M, DM, G, bx); pg8::EpiF32 E{Y, DM};
            #ifndef OFF_GY
            if (typ != 1) pg8::gemm_phase<pg8::EpiF32, pg8::StaticOrder, true, true, DFF, DFF>(L, gy, S, E);
            else if (kind == 1) pg8::gemm_phase<pg8::EpiF32, pg8::StaticOrder, true, true, B_W, B_N>(L, gy, S, E);
            else pg8::gemm_phase<pg8::EpiF32, pg8::StaticOrder, true, true, DM, DM>(L, gy, S, E);
#endif
        PHASE_END
        PHASE_BEGIN
            const bool fin = (sl == 3 * NLAYER - 1);
            const int nl = (typ == 2) ? layer + 1 : layer, ns = (typ == 2) ? 0 : typ + 1;
            norm_phase(XL, XC, XL, XC, Y, modt(ws, layer, typ, 0, 0), fin ? nullptr : modt(ws, nl, ns, 0, 0), fin ? nullptr : H, Mrows);
        PHASE_END
    }
#undef PHASE_BEGIN
#undef PHASE_END
}

static int count_phases() { int n = 2; for (int sl = 0; sl < 3 * NLAYER; ++sl) { const int layer = sl / 3, typ = sl % 3, kind = layer % 3; n += (typ != 1) ? 3 : (kind == 0 ? 4 : 5); } return n; }
extern "C" void kernel_launch(void* const* d_in, const int* in_sizes, int n_in, void* d_out, int out_size, void* d_ws, size_t ws_size, hipStream_t stream) {
    static int grid = 0;
    if (grid == 0) {
        if (n_in != 25 || in_sizes[0] != MLAT * DM || out_size != MLAT * DM || ws_size < WS_END) { fprintf(stderr, "kernel_launch: unexpected shapes (n_in %d, in0 %d, out %d, ws %zu < %zu)\n", n_in, n_in > 0 ? in_sizes[0] : -1, out_size, ws_size, (size_t)WS_END); grid = -1; return; }
        int dev = 0, cus = 0, per_cu = 0;
        if (hipGetDevice(&dev) != hipSuccess || hipDeviceGetAttribute(&cus, hipDeviceAttributeMultiprocessorCount, dev) != hipSuccess) { grid = -1; return; }
        if (hipFuncSetAttribute((const void*)fwd, hipFuncAttributeMaxDynamicSharedMemorySize, LDS_BYTES) != hipSuccess) { fprintf(stderr, "kernel_launch: hipFuncSetAttribute failed\n"); grid = -1; return; }
        if (hipOccupancyMaxActiveBlocksPerMultiprocessor(&per_cu, (const void*)fwd, NWAVES * 64, LDS_BYTES) != hipSuccess || per_cu < 1) fprintf(stderr, "kernel_launch: occupancy query reports %d\n", per_cu);
        (void)hipGetLastError();
        grid = cus;
    }
    if (grid < 0) return;
    if (hipMemsetAsync((char*)d_ws + WS_CTL, 0, CTL_BYTES, stream) != hipSuccess) return;
    KArgs a{};
    for (int i = 0; i < 25; ++i) a.in[i] = (const float*)d_in[i];
    a.out = (float*)d_out; a.ws = (unsigned char*)d_ws; a.lam_init = (float)(0.8 - 0.6 * exp(-0.3 * 2.0));
    const int nph = count_phases();
#if MK_PER_PHASE
    for (int p = 0; p < nph; ++p) { a.ph_lo = p; a.ph_hi = p + 1; a.li = 0; hipLaunchKernelGGL(fwd, dim3(grid), dim3(NWAVES * 64), LDS_BYTES, stream, a); }
#else
    a.ph_lo = 0; a.ph_hi = nph; a.li = 0; hipLaunchKernelGGL(fwd, dim3(grid), dim3(NWAVES * 64), LDS_BYTES, stream, a);
#endif
    const hipError_t le = hipPeekAtLastError();
    if (le != hipSuccess) fprintf(stderr, "kernel_launch: launch failed: %s\n", hipGetErrorName(le));
}
```

```cpp
#include <hip/hip_runtime.h>
#include <cstdio>
#include <cstdint>
#include <cmath>

#ifndef PROBE_ID
#define PROBE_ID 0
#endif
#ifndef MK_PER_PHASE
#define MK_PER_PHASE 0
#endif

namespace pg8 {
#define PG8_LAS __attribute__((address_space(3)))
typedef unsigned short bf16_t;
typedef short bf16x8 __attribute__((ext_vector_type(8)));
typedef float f32x4 __attribute__((ext_vector_type(4)));
typedef unsigned u32x4 __attribute__((ext_vector_type(4)));
__device__ __forceinline__ int opaque_tid() { int t = threadIdx.x; asm volatile("" : "+v"(t)); return t; }
constexpr int BM = 256, BK = 64, HALF = 128, HTB = HALF * BK * 2  , STAGE_BYTES = 8 * HTB, NXCD = 8, WGM = 8;

__host__ __device__ __forceinline__ int lds_byte(int r, int c) { const int st = (r >> 4) * 2 + (c >> 5), rr = r & 15, cc = c & 31, ob = rr * 64 + cc * 2; return st * 1024 + (ob ^ (((ob >> 9) & 1) << 5)); }
__host__ __device__ __forceinline__ void stage_rc(int b, int& R, int& C) { const int st = b / 1024, sb = b % 1024, swz = sb ^ (((sb >> 9) & 1) << 5); R = (st >> 1) * 16 + swz / 64; C = (st & 1) * 32 + (swz % 64) / 2; }
__host__ __device__ __forceinline__ int perm32(int rho) { const int n = rho >> 4, i = rho & 15; return 8 * (i >> 2) + 4 * n + (i & 3); }

struct Unit { int pm, pn; };
struct Gemm { const bf16_t* A; const bf16_t* Bt; int M, N, K, lda; };

struct StaticOrder {
    int nM, nN, nwg, G, c;
    __host__ __device__ void init(int M, int N, int G_, int c_) { nM = M / BM; nN = N / BM; nwg = nM * nN; G = G_; c = c_; }
    __host__ __device__ bool next(int i, Unit& u) const {
        const long L = (long)i * G + c; if (L >= nwg) return false;
        int wgid = (int)L; { const int q = nwg / NXCD, r = nwg % NXCD, xcd = wgid % NXCD, off = wgid / NXCD; wgid = (xcd < r ? xcd * (q + 1) : r * (q + 1) + (xcd - r) * q) + off; }
        const int nig = WGM * nN, gid = wgid / nig, fm = gid * WGM, gsz = (nM - fm) < WGM ? (nM - fm) : WGM;
        u.pm = fm + ((wgid % nig) % gsz); u.pn = (wgid % nig) / gsz; return true;
    }
    __device__ __forceinline__ void a_ready(const Unit&) const {}
    __device__ __forceinline__ void done(const Unit&) const {}
};


__device__ __forceinline__ unsigned cvt_pk_bf16(float lo, float hi) { unsigned r; asm volatile("v_cvt_pk_bf16_f32 %0, %1, %2" : "=v"(r) : "v"(lo), "v"(hi)); return r; }
__device__ __forceinline__ float sigmoid_fast(float z) { return __builtin_amdgcn_rcpf(1.0f + __builtin_amdgcn_exp2f(-1.4426950408889634f * z)); }
__device__ __forceinline__ float gelu_tanh(float x) { const float z = 1.5957691216057308f * (x + 0.044715f * x * x * x); return x * sigmoid_fast(z); }

struct EpiSwiglu {
    static constexpr bool PERM = true, AFTER_DRAIN = false;
    bf16_t* O; int ldc;
    __device__ __forceinline__ void operator()(const f32x4 (&acc)[2][2][4][2], const Unit& u, int wr, int wc, int fr, int fq) const {
        const int row0 = u.pm * BM + wr * 64 + fr, col0 = u.pn * HALF + wc * 32 + 8 * fq;
#pragma unroll
        for (int ai = 0; ai < 2; ++ai)
#pragma unroll
            for (int m = 0; m < 4; ++m) { bf16_t* rowp = O + (size_t)(row0 + ai * HALF + m * 16) * ldc + col0;
                float v[8];
#pragma unroll
                for (int n = 0; n < 2; ++n)
#pragma unroll
                    for (int j = 0; j < 4; ++j) { const float g = acc[ai][0][m][n][j], uu = acc[ai][1][m][n][j]; v[n * 4 + j] = g * sigmoid_fast(g) * uu; }
                u32x4 w; w.x = cvt_pk_bf16(v[0], v[1]); w.y = cvt_pk_bf16(v[2], v[3]); w.z = cvt_pk_bf16(v[4], v[5]); w.w = cvt_pk_bf16(v[6], v[7]);
                *(u32x4*)rowp = w; }
    }
};
struct EpiF32 {
    static constexpr bool PERM = true, AFTER_DRAIN = false;
    float* C; int ldc;
    __device__ __forceinline__ void operator()(const f32x4 (&acc)[2][2][4][2], const Unit& u, int wr, int wc, int fr, int fq) const {
        const int row0 = u.pm * BM + wr * 64 + fr, col0 = u.pn * BM + wc * 32 + 8 * fq;
#pragma unroll
        for (int ai = 0; ai < 2; ++ai)
#pragma unroll
            for (int m = 0; m < 4; ++m) { float* rowp = C + (size_t)(row0 + ai * HALF + m * 16) * ldc + col0;
#pragma unroll
                for (int bj = 0; bj < 2; ++bj) { *(f32x4*)(rowp + bj * HALF) = acc[ai][bj][m][0]; *(f32x4*)(rowp + bj * HALF + 4) = acc[ai][bj][m][1]; } }
    }
};
template <int MODE  > struct EpiBf16X {
    static constexpr bool PERM = true, AFTER_DRAIN = false;
    bf16_t* O; int ldc; const float* rope; int rope_cols;
    __device__ __forceinline__ void operator()(const f32x4 (&acc)[2][2][4][2], const Unit& u, int wr, int wc, int fr, int fq) const {
        const int row0 = u.pm * BM + wr * 64 + fr, col0 = u.pn * BM + wc * 32 + 8 * fq;
        const bool do_rope = (MODE == 0) && (u.pm < 32) && (u.pn * BM < rope_cols);
        const int p0 = 16 * wc + 4 * fq;
#pragma unroll
        for (int ai = 0; ai < 2; ++ai)
#pragma unroll
            for (int m = 0; m < 4; ++m) { const int row = row0 + ai * HALF + m * 16; bf16_t* rowp = O + (size_t)row * ldc + col0;
                f32x4 cs0 = (f32x4){1.f, 0.f, 1.f, 0.f}, cs1 = cs0;
                if (do_rope) { const float* rp = rope + ((size_t)(row & 4095) * 64 + p0) * 2; cs0 = *(const f32x4*)rp; cs1 = *(const f32x4*)(rp + 4); }
#pragma unroll
                for (int bj = 0; bj < 2; ++bj) { f32x4 v0 = acc[ai][bj][m][0], v1 = acc[ai][bj][m][1];
                    if (MODE == 1) {
#pragma unroll
                        for (int j = 0; j < 4; ++j) { v0[j] = gelu_tanh(v0[j]); v1[j] = gelu_tanh(v1[j]); } }
                    else if (do_rope) {
                        const f32x4 a = v0, b = v1;
                        v0[0] = a[0] * cs0[0] - a[1] * cs0[1]; v0[1] = a[0] * cs0[1] + a[1] * cs0[0]; v0[2] = a[2] * cs0[2] - a[3] * cs0[3]; v0[3] = a[2] * cs0[3] + a[3] * cs0[2];
                        v1[0] = b[0] * cs1[0] - b[1] * cs1[1]; v1[1] = b[0] * cs1[1] + b[1] * cs1[0]; v1[2] = b[2] * cs1[2] - b[3] * cs1[3]; v1[3] = b[2] * cs1[3] + b[3] * cs1[2]; }
                    u32x4 w; w.x = cvt_pk_bf16(v0[0], v0[1]); w.y = cvt_pk_bf16(v0[2], v0[3]); w.z = cvt_pk_bf16(v1[0], v1[1]); w.w = cvt_pk_bf16(v1[2], v1[3]);
                    *(u32x4*)(rowp + bj * HALF) = w; } }
    }
};

template <class Epi, class Sched, bool ALIGN_EPI, bool SP2, int K, int LDA>
__device__ __forceinline__ void gemm_phase(PG8_LAS unsigned char* lds, const Gemm g, const Sched& S, const Epi& E) {
    const int tid = opaque_tid(), wid = __builtin_amdgcn_readfirstlane(tid >> 6), lane = tid & 63, wr = wid >> 2, wc = wid & 3, fr = lane & 15, fq = lane >> 4;
    constexpr int nt = K / BK;
    unsigned voffA[2], voffB[2];
#pragma unroll
    for (int i = 0; i < 2; ++i) { int R, C; stage_rc(tid * 16 + i * 8192, R, C); const int Rb = Epi::PERM ? ((R & ~31) + perm32(R & 31)) : R;
        voffA[i] = (unsigned)(R * LDA + C) * 2u; voffB[i] = (unsigned)(Rb * K + C) * 2u; }
    constexpr size_t kstep = (size_t)(BK * 2);
    constexpr size_t hstepA = (size_t)HALF * LDA * 2, hstepB = (size_t)HALF * K * 2;
    constexpr size_t tstepA = 2 * hstepA, tstepB = 2 * hstepB;
    const unsigned ldsw = (unsigned)wid * 1024u;
    const int aoff = lds_byte(wr * 64 + fr, fq * 8), boff = lds_byte(wc * 32 + fr, fq * 8);
#define PG8_SA(b, h) (((b) * 2 + (h)) * HTB)
#define PG8_SB(b, h) ((4 + (b) * 2 + (h)) * HTB)
#define PG8_STAGE(bufoff, gbase, voff) do { _Pragma("unroll") for (int _i = 0; _i < 2; ++_i) \
        __builtin_amdgcn_global_load_lds((const unsigned*)((const char*)(gbase) + (voff)[_i]), (PG8_LAS unsigned*)(lds + (bufoff) + ldsw + _i * 8192), 16, 0, 0); } while (0)
#define PG8_LDA(dst, b, h) do { _Pragma("unroll") for (int m = 0; m < 4; ++m) _Pragma("unroll") for (int k = 0; k < 2; ++k) dst[m][k] = *(const PG8_LAS bf16x8*)(lds + PG8_SA(b, h) + aoff + m * 2048 + k * 1024); } while (0)
#define PG8_LDB(dst, b, h) do { _Pragma("unroll") for (int n = 0; n < 2; ++n) _Pragma("unroll") for (int k = 0; k < 2; ++k) dst[n][k] = *(const PG8_LAS bf16x8*)(lds + PG8_SB(b, h) + boff + n * 2048 + k * 1024); } while (0)
#define PG8_MMA(ai, bj, At, Bt) do { __builtin_amdgcn_s_setprio(1); _Pragma("unroll") for (int m = 0; m < 4; ++m) _Pragma("unroll") for (int n = 0; n < 2; ++n) _Pragma("unroll") for (int k = 0; k < 2; ++k) \
        acc[ai][bj][m][n] = __builtin_amdgcn_mfma_f32_16x16x32_bf16(Bt[n][k], At[m][k], acc[ai][bj][m][n], 0, 0, 0); __builtin_amdgcn_s_setprio(0); } while (0)
#define PG8_WAIT_V(n) asm volatile("s_waitcnt vmcnt(" #n ")" ::: "memory")
#define PG8_WAIT_L(n) asm volatile("s_waitcnt lgkmcnt(" #n ")" ::: "memory")
#define PG8_BAR __builtin_amdgcn_s_barrier()
#define PG8_SCHED __builtin_amdgcn_sched_barrier(0)
    Unit cur, nxt; int ui = 0;
    if (!S.next(0, cur)) return;
    f32x4 acc[2][2][4][2];
#pragma unroll
    for (int a = 0; a < 2; ++a)
#pragma unroll
        for (int b = 0; b < 2; ++b)
#pragma unroll
            for (int m = 0; m < 4; ++m)
#pragma unroll
                for (int n = 0; n < 2; ++n) acc[a][b][m][n] = (f32x4){0.f, 0.f, 0.f, 0.f};
    bf16x8 At[4][2], B0[2][2], B1[2][2];
    const char* cA = (const char*)g.A + (size_t)cur.pm * tstepA; const char* cB = (const char*)g.Bt + (size_t)cur.pn * tstepB;
    S.a_ready(cur);
    if constexpr (SP2) {
        PG8_STAGE(PG8_SB(0, 0), cB, voffB); PG8_STAGE(PG8_SB(0, 1), cB + hstepB, voffB); PG8_STAGE(PG8_SA(0, 0), cA, voffA); PG8_STAGE(PG8_SA(0, 1), cA + hstepA, voffA);
        if (wr == 1) PG8_BAR;
        PG8_WAIT_V(2); PG8_BAR;
        PG8_STAGE(PG8_SB(1, 0), cB + kstep, voffB); PG8_STAGE(PG8_SA(1, 0), cA + kstep, voffA); PG8_STAGE(PG8_SB(1, 1), cB + hstepB + kstep, voffB);
        PG8_WAIT_V(6); PG8_BAR;
    } else {
        PG8_STAGE(PG8_SB(0, 0), cB, voffB); PG8_STAGE(PG8_SA(0, 0), cA, voffA); PG8_STAGE(PG8_SB(0, 1), cB + hstepB, voffB); PG8_STAGE(PG8_SA(0, 1), cA + hstepA, voffA);
        if (wr == 1) PG8_BAR;
        PG8_WAIT_V(4); PG8_BAR;
        PG8_STAGE(PG8_SB(1, 0), cB + kstep, voffB); PG8_STAGE(PG8_SA(1, 0), cA + kstep, voffA); PG8_STAGE(PG8_SB(1, 1), cB + hstepB + kstep, voffB);
        PG8_WAIT_V(6); PG8_BAR;
    }
    for (;;) {
        const bool has_next = S.next(ui + 1, nxt);
        const char* nA = has_next ? (const char*)g.A + (size_t)nxt.pm * tstepA : cA; const char* nB = has_next ? (const char*)g.Bt + (size_t)nxt.pn * tstepB : cB;
        for (int t = 0; t < nt; t += 2) {
            const bool last = (t == nt - 2);
            const char* a1 = cA + (size_t)(t + 1) * kstep;
            const char* a2 = last ? nA : cA + (size_t)(t + 2) * kstep; const char* b2 = last ? nB : cB + (size_t)(t + 2) * kstep;
            const char* a3 = a2 + kstep; const char* b3 = b2 + kstep;
            if (last && has_next) S.a_ready(nxt);
            if constexpr (SP2) {
            PG8_LDB(B0, 0, 0); PG8_LDB(B1, 0, 1); PG8_SCHED; PG8_LDA(At, 0, 0); PG8_STAGE(PG8_SA(1, 1), a1 + hstepA, voffA);
            PG8_WAIT_V(8); PG8_WAIT_L(0); PG8_BAR; PG8_MMA(0, 0, At, B0); PG8_MMA(0, 1, At, B1); PG8_BAR; PG8_SCHED;
            PG8_LDA(At, 0, 1); PG8_STAGE(PG8_SB(0, 0), b2, voffB); PG8_STAGE(PG8_SB(0, 1), b2 + hstepB, voffB); PG8_STAGE(PG8_SA(0, 0), a2, voffA);
            PG8_WAIT_V(8); PG8_WAIT_L(0); PG8_BAR; PG8_MMA(1, 0, At, B0); PG8_MMA(1, 1, At, B1); PG8_BAR; PG8_SCHED;
            PG8_LDB(B0, 1, 0); PG8_LDB(B1, 1, 1); PG8_SCHED; PG8_LDA(At, 1, 0); PG8_STAGE(PG8_SA(0, 1), a2 + hstepA, voffA);
            PG8_WAIT_V(8); PG8_WAIT_L(0); PG8_BAR; PG8_MMA(0, 0, At, B0); PG8_MMA(0, 1, At, B1); PG8_BAR; PG8_SCHED;
            PG8_LDA(At, 1, 1); PG8_STAGE(PG8_SB(1, 0), b3, voffB); PG8_STAGE(PG8_SB(1, 1), b3 + hstepB, voffB); PG8_STAGE(PG8_SA(1, 0), a3, voffA);
            PG8_WAIT_V(8); PG8_WAIT_L(0); PG8_BAR; PG8_MMA(1, 0, At, B0); PG8_MMA(1, 1, At, B1); PG8_BAR; PG8_SCHED;
            } else {
            PG8_LDB(B0, 0, 0); PG8_SCHED; PG8_LDA(At, 0, 0); PG8_STAGE(PG8_SA(1, 1), a1 + hstepA, voffA);
            PG8_WAIT_L(8); PG8_BAR; PG8_WAIT_L(0); PG8_MMA(0, 0, At, B0); PG8_BAR; PG8_SCHED;
            PG8_LDB(B1, 0, 1); PG8_STAGE(PG8_SB(0, 0), b2, voffB);
            PG8_BAR; PG8_WAIT_L(0); PG8_MMA(0, 1, At, B1); PG8_BAR;
            PG8_LDA(At, 0, 1); PG8_STAGE(PG8_SA(0, 0), a2, voffA);
            PG8_BAR; PG8_WAIT_L(0); PG8_MMA(1, 0, At, B0); PG8_BAR; PG8_SCHED;
            PG8_STAGE(PG8_SB(0, 1), b2 + hstepB, voffB);
            PG8_WAIT_V(6); PG8_BAR; PG8_MMA(1, 1, At, B1); PG8_BAR;
            PG8_LDB(B0, 1, 0); PG8_SCHED; PG8_LDA(At, 1, 0); PG8_STAGE(PG8_SA(0, 1), a2 + hstepA, voffA);
            PG8_WAIT_L(8); PG8_BAR; PG8_WAIT_L(0); PG8_MMA(0, 0, At, B0); PG8_BAR; PG8_SCHED;
            PG8_LDB(B1, 1, 1); PG8_STAGE(PG8_SB(1, 0), b3, voffB);
            PG8_BAR; PG8_WAIT_L(0); PG8_MMA(0, 1, At, B1); PG8_BAR;
            PG8_LDA(At, 1, 1); PG8_STAGE(PG8_SA(1, 0), a3, voffA);
            PG8_BAR; PG8_WAIT_L(0); PG8_MMA(1, 0, At, B0); PG8_BAR; PG8_SCHED;
            PG8_STAGE(PG8_SB(1, 1), b3 + hstepB, voffB);
            PG8_WAIT_V(6); PG8_BAR; PG8_MMA(1, 1, At, B1); PG8_BAR;
            }
        }
        if constexpr (ALIGN_EPI) { if (wr == 0) PG8_BAR; }
        if constexpr (!Epi::AFTER_DRAIN) { E(acc, cur, wr, wc, fr, fq); S.done(cur); }
        if (!has_next) break;
#pragma unroll
        for (int a = 0; a < 2; ++a)
#pragma unroll
            for (int b = 0; b < 2; ++b)
#pragma unroll
                for (int m = 0; m < 4; ++m)
#pragma unroll
                    for (int n = 0; n < 2; ++n) acc[a][b][m][n] = (f32x4){0.f, 0.f, 0.f, 0.f};
        cur = nxt; cA = nA; cB = nB; ++ui;
        if constexpr (ALIGN_EPI) { if (wr == 1) PG8_BAR; }
    }
    PG8_WAIT_V(0);
    if constexpr (!ALIGN_EPI) { if (wr == 0) PG8_BAR; }
    PG8_BAR;
    if constexpr (Epi::AFTER_DRAIN) { E.fused(acc, cur, wr, wc, fr, fq, lds, wid, lane); S.done(cur); }
#undef PG8_SA
#undef PG8_SB
#undef PG8_STAGE
#undef PG8_LDA
#undef PG8_LDB
#undef PG8_MMA
#undef PG8_WAIT_V
#undef PG8_WAIT_L
#undef PG8_BAR
#undef PG8_SCHED
}
}

namespace att {
typedef unsigned short bf16;
using bf16x8 = __attribute__((ext_vector_type(8))) short;
using s16x4  = __attribute__((ext_vector_type(4))) short;
using f32x16 = __attribute__((ext_vector_type(16))) float;
using u32x4  = __attribute__((ext_vector_type(4))) unsigned;
constexpr int   D = 128, NW = 8, QBLK = 32, KVBLK = 64;
constexpr float SCALE = 0.088388347648318440f;
constexpr float THR = 8.f;
constexpr int SHM_V = KVBLK * D * 2, SHM_K = KVBLK * D * 2, SHM_ATTN = 2 * SHM_V + 2 * SHM_K + NW * 64 * 4;
#define KSWZ(row, colB) ((row) * 256 + ((colB) ^ (((row) & 7) << 4)))
#define SBAR() __builtin_amdgcn_sched_barrier(0)
__device__ __forceinline__ int crow(int r, int hi) { return (r & 3) + 8 * (r >> 2) + 4 * hi; }
__device__ __forceinline__ unsigned cvtpk(float lo, float hi) { unsigned r; asm volatile("v_cvt_pk_bf16_f32 %0, %1, %2" : "=v"(r) : "v"(lo), "v"(hi)); return r; }

__device__ __forceinline__ void wmask(f32x16& p0, f32x16& p1, int kpos0, int qp, int hi) {
  const bool oob = (kpos0 < 0) || (kpos0 >= 4096);
  const int base = kpos0 - qp + 128;
#pragma unroll
  for (int r = 0; r < 16; ++r) { const int c = crow(r, hi);
    if (oob || (unsigned)(base + c) > 256u) p0[r] = -1e30f;
    if (oob || (unsigned)(base + 32 + c) > 256u) p1[r] = -1e30f; }
}
__device__ __forceinline__ void partialSM(f32x16& p0, f32x16& p1, float& m_reg, float& mn, float& alpha) {
  constexpr float C = SCALE * 1.4426950408889634f;
  float pmax = p0[0];
#pragma unroll
  for (int r = 1; r < 16; ++r) pmax = fmaxf(pmax, p0[r]);
#pragma unroll
  for (int r = 0; r < 16; ++r) pmax = fmaxf(pmax, p1[r]);
  { auto rr = __builtin_amdgcn_permlane32_swap(__float_as_uint(pmax), __float_as_uint(pmax), false, false);
    pmax = fmaxf(__uint_as_float(rr[0]), __uint_as_float(rr[1])); }
  if (__builtin_expect(__all(pmax - m_reg <= THR / SCALE), 1)) { mn = m_reg; alpha = 1.f; }
  else { mn = fmaxf(m_reg, pmax); alpha = __builtin_amdgcn_exp2f((m_reg - mn) * C); m_reg = mn; }
  float mnC = -mn * C;
#pragma unroll
  for (int r = 0; r < 16; ++r) p0[r] = fmaf(p0[r], C, mnC);
#pragma unroll
  for (int r = 0; r < 16; ++r) p1[r] = fmaf(p1[r], C, mnC);
#pragma unroll
  for (int r = 0; r < 16; ++r) p0[r] = __builtin_amdgcn_exp2f(p0[r]);
}
__device__ __forceinline__ void finishSM(f32x16& p0, f32x16& p1, float alpha, float& l_reg, bf16x8& pa0, bf16x8& pa1, bf16x8& pa2, bf16x8& pa3) {
#pragma unroll
  for (int r = 0; r < 16; ++r) p1[r] = __builtin_amdgcn_exp2f(p1[r]);
  float ps = 0;
#pragma unroll
  for (int r = 0; r < 16; ++r) ps += p0[r];
#pragma unroll
  for (int r = 0; r < 16; ++r) ps += p1[r];
  { auto rr = __builtin_amdgcn_permlane32_swap(__float_as_uint(ps), __float_as_uint(ps), false, false);
    ps = __uint_as_float(rr[0]) + __uint_as_float(rr[1]); }
  l_reg = l_reg * alpha + ps;
#define PK4(P, BASE, OUT) do { unsigned a0 = cvtpk(P[BASE + 0], P[BASE + 1]), a1 = cvtpk(P[BASE + 2], P[BASE + 3]);   \
    unsigned b0 = cvtpk(P[BASE + 4], P[BASE + 5]), b1 = cvtpk(P[BASE + 6], P[BASE + 7]);                              \
    auto r0 = __builtin_amdgcn_permlane32_swap(a0, b0, false, false); auto r1 = __builtin_amdgcn_permlane32_swap(a1, b1, false, false); \
    u32x4 w = {r0[0], r1[0], r0[1], r1[1]}; OUT = *reinterpret_cast<bf16x8*>(&w); } while (0)
  PK4(p0, 0, pa0); PK4(p0, 8, pa1); PK4(p1, 0, pa2); PK4(p1, 8, pa3);
#undef PK4
}
__device__ __forceinline__ void qkt(f32x16& p0, f32x16& p1, const bf16* Ks, const bf16x8* qr, int r32, int hi) {
  p0 = f32x16{}; p1 = f32x16{};
#pragma unroll
  for (int d0 = 0; d0 < 8; ++d0) { int cb = (d0 * 16 + hi * 8) * 2;
    bf16x8 b0 = *reinterpret_cast<const bf16x8*>((const char*)Ks + KSWZ(r32, cb));
    bf16x8 b1 = *reinterpret_cast<const bf16x8*>((const char*)Ks + KSWZ(32 + r32, cb));
    p0 = __builtin_amdgcn_mfma_f32_32x32x16_bf16(b0, qr[d0], p0, 0, 0, 0);
    p1 = __builtin_amdgcn_mfma_f32_32x32x16_bf16(b1, qr[d0], p1, 0, 0, 0); }
}
__device__ __forceinline__ int v_st(int k, int c) { const int kk = (k & ~0xC) | ((k & 4) << 1) | ((k & 8) >> 1); return ((kk >> 3) * 4 + (c >> 5)) * 512 + ((kk & 7) * 32 + (c & 31)) * 2; }
__device__ __forceinline__ int v_rd_base(int lane) { return ((lane & 3) << 3) | (((lane >> 2) & 3) << 6) | (((lane >> 4) & 1) << 5) | (((lane >> 5) & 1) << 8); }
constexpr int v_rd_off(int d0, int ks, int half) { return d0 * 512 + ks * 4096 + half * 2048; }
template <int OFF> __device__ __forceinline__ s16x4 tr_read(int vb) {
  s16x4 r; asm volatile("ds_read_b64_tr_b16 %0, %1 offset:%2" : "=&v"(r) : "v"(vb), "i"(OFF) : "memory"); return r;
}
template <int D0> __device__ __forceinline__ void pv_one(f32x16& od, int vb, bf16x8 pa0, bf16x8 pa1, bf16x8 pa2, bf16x8 pa3) {
  const s16x4 l0 = tr_read<v_rd_off(D0, 0, 0)>(vb), h0 = tr_read<v_rd_off(D0, 0, 1)>(vb), l1 = tr_read<v_rd_off(D0, 1, 0)>(vb), h1 = tr_read<v_rd_off(D0, 1, 1)>(vb);
  const s16x4 l2 = tr_read<v_rd_off(D0, 2, 0)>(vb), h2 = tr_read<v_rd_off(D0, 2, 1)>(vb), l3 = tr_read<v_rd_off(D0, 3, 0)>(vb), h3 = tr_read<v_rd_off(D0, 3, 1)>(vb);
  asm volatile("s_waitcnt lgkmcnt(0)" ::: "memory"); SBAR();
#define PK(L, H) (bf16x8){L[0], L[1], L[2], L[3], H[0], H[1], H[2], H[3]}
  od = __builtin_amdgcn_mfma_f32_32x32x16_bf16(pa0, PK(l0, h0), od, 0, 0, 0);
  od = __builtin_amdgcn_mfma_f32_32x32x16_bf16(pa1, PK(l1, h1), od, 0, 0, 0);
  od = __builtin_amdgcn_mfma_f32_32x32x16_bf16(pa2, PK(l2, h2), od, 0, 0, 0);
  od = __builtin_amdgcn_mfma_f32_32x32x16_bf16(pa3, PK(l3, h3), od, 0, 0, 0);
#undef PK
}
__device__ __forceinline__ void pv_d0(f32x16* o, int vb, bf16x8 pa0, bf16x8 pa1, bf16x8 pa2, bf16x8 pa3) {
  pv_one<0>(o[0], vb, pa0, pa1, pa2, pa3); pv_one<1>(o[1], vb, pa0, pa1, pa2, pa3); pv_one<2>(o[2], vb, pa0, pa1, pa2, pa3); pv_one<3>(o[3], vb, pa0, pa1, pa2, pa3);
}

struct Args {
  const bf16* qkv; int ld;
  int qrow0, qcol, kcol, vcol;
  int ctxrow0, latrow0;
  int kstart, n0, n1;
  int qpos0;
  float sink; int has_sink;
  void* out; int ldo, ocol;
};

template <bool WINDOW, bool OUT_BF16, int LD>
__device__ __forceinline__ void attn_unit(const Args& a, char* lds) {
  const int tid = pg8::opaque_tid(), wid = tid >> 6, lane = tid & 63, r32 = lane & 31, hi = lane >> 5;
  bf16* V_lds = (bf16*)lds; bf16* K_lds = (bf16*)(lds + 2 * SHM_V);
  float* ws = (float*)(lds + 2 * SHM_V + 2 * SHM_K) + wid * 64; float* li_l = ws; float* al_l = ws + 32;
  float m_reg = a.has_sink ? a.sink * (1.0f / SCALE) : -1e30f, l_reg = a.has_sink ? 1.0f : 0.0f; f32x16 o[4] = {}; bf16x8 qr[8];
  const bf16* Qw = a.qkv + (long)(a.qrow0 + wid * QBLK + r32) * LD + a.qcol + hi * 8;
#pragma unroll
  for (int d0 = 0; d0 < 8; ++d0) qr[d0] = *reinterpret_cast<const bf16x8*>(Qw + d0 * 16);
  const int sr = tid >> 4, sc = (tid & 15) * 8, vst0 = v_st(sr, sc), vst1 = v_st(32 + sr, sc);
  const int vb0 = (int)(uintptr_t)V_lds + v_rd_base(lane);
  const int qp = a.qpos0 + wid * QBLK + r32;
  const unsigned soff0 = (unsigned)(sr * LD + sc) * 2u, soff1 = soff0 + 32u * LD * 2u;
  struct { bf16x8 vs0, vs1, ks0, ks1; } sr_[2];
#define TROW(t) ((t) < a.n0 ? a.ctxrow0 + (t) * KVBLK : a.latrow0 + min(max(a.kstart + ((t) - a.n0) * KVBLK, 0), 4096 - KVBLK))
#define SLOAD(i, t) do { const char* tb_ = (const char*)a.qkv + (size_t)TROW(t) * (LD * 2); const char* tv_ = tb_ + a.vcol * 2; const char* tk_ = tb_ + a.kcol * 2; \
    sr_[i].vs0 = *reinterpret_cast<const bf16x8*>(tv_ + soff0); sr_[i].vs1 = *reinterpret_cast<const bf16x8*>(tv_ + soff1); \
    sr_[i].ks0 = *reinterpret_cast<const bf16x8*>(tk_ + soff0); sr_[i].ks1 = *reinterpret_cast<const bf16x8*>(tk_ + soff1); } while (0)
#define SWRITE(b, i) do { *(bf16x8*)((char*)V_lds + (b) * SHM_V + vst0) = sr_[i].vs0;          \
    *(bf16x8*)((char*)V_lds + (b) * SHM_V + vst1) = sr_[i].vs1; int kc = sc * 2;               \
    *(bf16x8*)((char*)K_lds + (b) * SHM_K + KSWZ(sr, kc)) = sr_[i].ks0;                       \
    *(bf16x8*)((char*)K_lds + (b) * SHM_K + KSWZ(32 + sr, kc)) = sr_[i].ks1; } while (0)
#define SWAIT() asm volatile("s_waitcnt vmcnt(4)" ::: "memory")
#define RESC(al) do { if (__any((al) < 1.f)) { if (hi == 0) al_l[r32] = (al); asm volatile("s_waitcnt lgkmcnt(0)" ::: "memory"); \
    _Pragma("unroll") for (int d = 0; d < 4; ++d) _Pragma("unroll") for (int r = 0; r < 16; ++r) o[d][r] *= al_l[crow(r, hi)]; } } while (0)
#define WMASK(P0, P1, t) do { if (WINDOW) { if ((t) >= a.n0) wmask(P0, P1, a.kstart + ((t) - a.n0) * KVBLK, qp, hi); } } while (0)
  f32x16 pA0, pA1, pB0, pB1; float mnA, mnB, alA, alB; bf16x8 pa0, pa1, pa2, pa3; const int NT = a.n0 + a.n1;
  constexpr int SE = 0, SO = 1;
  SLOAD(SE, 0); asm volatile("s_waitcnt vmcnt(0)" ::: "memory"); SWRITE(0, SE); __syncthreads();
  qkt(pA0, pA1, K_lds, qr, r32, hi); WMASK(pA0, pA1, 0); partialSM(pA0, pA1, m_reg, mnA, alA);
  SLOAD(SO, 1); if (2 < NT) SLOAD(SE, 2);
  SWAIT(); SWRITE(1, SO); __syncthreads();
  for (int j = 1; j + 1 < NT; j += 2) {
    SBAR(); qkt(pB0, pB1, (bf16*)((char*)K_lds + SHM_K), qr, r32, hi);
    finishSM(pA0, pA1, alA, l_reg, pa0, pa1, pa2, pa3); SBAR();
    SLOAD(SO, j + 2); SBAR();
    pv_d0(o, vb0, pa0, pa1, pa2, pa3); WMASK(pB0, pB1, j); partialSM(pB0, pB1, m_reg, mnB, alB);
    __syncthreads(); SWAIT(); SWRITE(0, SE);
    RESC(alB); __syncthreads();
    SBAR(); qkt(pA0, pA1, K_lds, qr, r32, hi);
    finishSM(pB0, pB1, alB, l_reg, pa0, pa1, pa2, pa3); SBAR();
    if (j + 3 < NT) SLOAD(SE, j + 3); SBAR();
    pv_d0(o, vb0 + (int)SHM_V, pa0, pa1, pa2, pa3); WMASK(pA0, pA1, j + 1); partialSM(pA0, pA1, m_reg, mnA, alA);
    __syncthreads(); SWAIT(); SWRITE(1, SO);
    RESC(alA); __syncthreads();
  }
  SBAR(); qkt(pB0, pB1, (bf16*)((char*)K_lds + SHM_K), qr, r32, hi);
  finishSM(pA0, pA1, alA, l_reg, pa0, pa1, pa2, pa3); SBAR();
  pv_d0(o, vb0, pa0, pa1, pa2, pa3); WMASK(pB0, pB1, NT - 1); partialSM(pB0, pB1, m_reg, mnB, alB);
  __syncthreads(); RESC(alB);
  finishSM(pB0, pB1, alB, l_reg, pa0, pa1, pa2, pa3); SBAR();
  pv_d0(o, vb0 + (int)SHM_V, pa0, pa1, pa2, pa3);
  if (hi == 0) li_l[r32] = l_reg; asm volatile("s_waitcnt lgkmcnt(0)" ::: "memory");
  float rli[16];
#pragma unroll
  for (int r = 0; r < 16; ++r) rli[r] = __builtin_amdgcn_rcpf(li_l[crow(r, hi)]);
  if (OUT_BF16) {
    bf16* Ow = (bf16*)a.out + (long)(a.qrow0 + wid * QBLK) * a.ldo + a.ocol;
#pragma unroll
    for (int r = 0; r < 16; ++r) { const int orow = crow(r, hi);
#pragma unroll
      for (int d0 = 0; d0 < 4; ++d0) Ow[(long)orow * a.ldo + d0 * 32 + r32] = (bf16)(cvtpk(o[d0][r] * rli[r], 0.f) & 0xffffu); }
  } else {
    float* Ow = (float*)a.out + (long)(a.qrow0 + wid * QBLK) * a.ldo + a.ocol;
#pragma unroll
    for (int r = 0; r < 16; ++r) { const int orow = crow(r, hi);
#pragma unroll
      for (int d0 = 0; d0 < 4; ++d0) Ow[(long)orow * a.ldo + d0 * 32 + r32] = o[d0][r] * rli[r]; }
  }
  __syncthreads();
#undef TROW
#undef SLOAD
#undef SWRITE
#undef SWAIT
#undef RESC
#undef WMASK
}
#undef KSWZ
#undef SBAR
}

constexpr int NWAVES = 8;
constexpr int DM = 2048, NBATCH = 2, SEQ = 4096, MLAT = NBATCH * SEQ, CTXL = 256, MCTX = NBATCH * CTXL, MALL = MLAT + MCTX;
constexpr int DFF = 5504, NFC1 = 2 * DFF, NLAYER = 4, NMODC = 9 * DM;
constexpr int A_N = 3072, B_N = 12288, B_W = 6144, C_N = 6144;
constexpr float EPS = 1e-6f;
constexpr size_t MiB = 1u << 20;
constexpr size_t WS_CTL = 0, CTL_BYTES = 2 * MiB;
constexpr size_t WS_MODT = 2 * MiB;
constexpr size_t WS_ROPE = 3 * MiB;
constexpr size_t WS_XC = 5 * MiB;
constexpr size_t WS_STATS = 9 * MiB;
constexpr size_t WS_BSW = 10 * MiB;
constexpr size_t WS_SMALL = 10 * MiB + 512 * 1024;
constexpr int SM_SINK = 0, SM_VNG = 64, SM_VNB = SM_VNG + 6144, SM_BS = SM_VNB + 6144, SM_LQ1 = SM_BS + 1024, SM_LK1 = SM_LQ1 + 128, SM_LQ2 = SM_LK1 + 128, SM_LK2 = SM_LQ2 + 128, SM_SUBG = SM_LK2 + 128, SM_END = SM_SUBG + 256;
constexpr size_t WS_WFC1 = 11 * MiB;
constexpr size_t WS_WFC2 = WS_WFC1 + 344 * MiB;
constexpr size_t WS_WAIN = WS_WFC2 + 172 * MiB;
constexpr size_t WS_WAOUT = WS_WAIN + 24 * MiB;
constexpr size_t WS_WBIN = WS_WAOUT + 16 * MiB;
constexpr size_t WS_WBOUT = WS_WBIN + 48 * MiB;
constexpr size_t WS_WCIN = WS_WBOUT + 24 * MiB;
constexpr size_t WS_WCOUT = WS_WCIN + 24 * MiB;
constexpr size_t WS_H = WS_WCOUT + 8 * MiB;
constexpr size_t WS_HID = WS_H + 34 * MiB;
constexpr size_t WS_Y = WS_HID + 92 * MiB;
constexpr size_t WS_QKV = WS_Y + 68 * MiB;
constexpr size_t WS_AO = WS_QKV + 204 * MiB;
constexpr size_t WS_OC = WS_AO + 34 * MiB;
constexpr size_t WS_END = WS_OC + 136 * MiB;
static_assert((size_t)8 * NFC1 * DM * 2 <= 344 * MiB && (size_t)8 * DM * DFF * 2 <= 172 * MiB && (size_t)MALL * DFF * 2 <= 92 * MiB && (size_t)MALL * B_N * 2 <= 204 * MiB, "ws map");
constexpr int CW_BAR = 4096;
constexpr int RING_BYTES = 131072, MISC_OFF = RING_BYTES + 320, LDS_BYTES = 147456;

#define GAS __attribute__((address_space(1)))
#define LAS __attribute__((address_space(3)))
typedef unsigned short bf16;
typedef unsigned v4u __attribute__((ext_vector_type(4)));
typedef unsigned v2u __attribute__((ext_vector_type(2)));
typedef float f32x4 __attribute__((ext_vector_type(4)));
typedef short bf16x8 __attribute__((ext_vector_type(8)));
typedef float f32x16 __attribute__((ext_vector_type(16)));
#define LDS_WAIT() asm volatile("s_waitcnt lgkmcnt(0)" ::: "memory")
#define VM_WAIT() asm volatile("s_waitcnt vmcnt(0)" ::: "memory")
__device__ __forceinline__ unsigned f2bf(float f) { unsigned u = __builtin_bit_cast(unsigned, f); return (u + 0x7fffu + ((u >> 16) & 1u)) >> 16; }
__device__ __forceinline__ unsigned pk2(float lo, float hi) { return f2bf(lo) | (f2bf(hi) << 16); }
__device__ __forceinline__ float bf2f(unsigned short b) { return __builtin_bit_cast(float, ((unsigned)b) << 16); }
__device__ __forceinline__ float wave_sum(float v) {
#pragma unroll
    for (int o = 1; o < 64; o <<= 1) v += __shfl_xor(v, o);
    return v;
}

#define XB_TMO      128
#define XB_XCNT(j)  (256  + 64 * (j))
#define XB_XSUB(j)  (1280 + 64 * (j))
#define XB_XGEN(j)  (2304 + 64 * (j))
#define XB_TOP      3328
#define XB_TOPGEN   3392
#define XCD_BAR_WORDS 3456
#define XB_SPIN_CAP (1u << 18)

__device__ __forceinline__ unsigned xb_ld(unsigned* p)              { return __hip_atomic_load(p, __ATOMIC_RELAXED, __HIP_MEMORY_SCOPE_AGENT); }
__device__ __forceinline__ unsigned xb_add(unsigned* p, unsigned v) { return __hip_atomic_fetch_add(p, v, __ATOMIC_RELAXED, __HIP_MEMORY_SCOPE_AGENT); }
__device__ __forceinline__ unsigned xb_xcc_id() { return (unsigned)__builtin_amdgcn_s_getreg((3 << 11) | 20) & 0xFu; }
#define XB_SPIN(cond, bar) do { unsigned _sp = 0; while (cond) { __builtin_amdgcn_s_sleep(1); \
    if ((++_sp & 255u) == 0u) { if (xb_ld(&(bar)[XB_TMO])) break; if (_sp > XB_SPIN_CAP) { atomicAdd(&(bar)[XB_TMO], 1u); break; } } } } while (0)

struct XcdBarrier {
    unsigned* bar; unsigned x;
    volatile LAS unsigned* st;
};

__device__ __forceinline__ XcdBarrier xcd_barrier_post(unsigned* bar, volatile LAS unsigned* st) {
    XcdBarrier b; b.bar = bar; b.x = xb_xcc_id(); b.st = st;
    if (threadIdx.x == 0) (void)xb_add(&bar[XB_XCNT(b.x)], 1u);
    return b;
}
__device__ __forceinline__ void xcd_barrier_complete(unsigned* bar, unsigned x, unsigned& nloc, unsigned& nx) {
    const unsigned G = gridDim.x * gridDim.y * gridDim.z;
    unsigned sum, cnt, mine, sp = 0u;
    for (;;) {
        sum = 0u; cnt = 0u; mine = 0u;
#pragma unroll
        for (unsigned j = 0; j < 16; ++j) { const unsigned c = xb_ld(&bar[XB_XCNT(j)]); sum += c; cnt += (c > 0u) ? 1u : 0u; mine = (j == x) ? c : mine; }
        if (sum == G) break;
        __builtin_amdgcn_s_sleep(1);
        if ((++sp & 255u) == 0u) { if (xb_ld(&bar[XB_TMO])) break; if (sp > XB_SPIN_CAP) { atomicAdd(&bar[XB_TMO], 1u); break; } }
    }
    nloc = mine > 0u ? mine : 1u; nx = cnt > 0u ? cnt : 1u;
}

__device__ __forceinline__ void xcd_barrier(const XcdBarrier& b) {
    asm volatile("s_waitcnt vmcnt(0)" ::: "memory");
    __syncthreads();
    if (threadIdx.x == 0) {
        unsigned* bar = b.bar;
        __builtin_amdgcn_s_waitcnt(0);
        unsigned nloc = b.st[0], nx = b.st[1];
        if (nloc == 0u) { xcd_barrier_complete(bar, b.x, nloc, nx); b.st[0] = nloc; b.st[1] = nx; }
        const unsigned old = xb_add(&bar[XB_XSUB(b.x)], 1u);
        const unsigned gen = old / nloc;
        if (old + 1u == (gen + 1u) * nloc) {
            __builtin_amdgcn_fence(__ATOMIC_RELEASE, "agent");
            asm volatile("s_waitcnt vmcnt(0)" ::: "memory");
            const unsigned og = xb_add(&bar[XB_TOP], 1u);
            const unsigned tg = og / nx;
            if (og + 1u == (tg + 1u) * nx) xb_add(&bar[XB_TOPGEN], 1u);
            else XB_SPIN(xb_ld(&bar[XB_TOPGEN]) == tg, bar);
            __builtin_amdgcn_fence(__ATOMIC_ACQUIRE, "agent");
            xb_add(&bar[XB_XGEN(b.x)], 1u);
            asm volatile("s_waitcnt vmcnt(0)" ::: "memory");
        } else {
            XB_SPIN(xb_ld(&bar[XB_XGEN(b.x)]) == gen, bar);
            __builtin_amdgcn_fence(__ATOMIC_ACQUIRE, "agent");
            asm volatile("s_waitcnt vmcnt(0)" ::: "memory");
        }
    }
    __syncthreads();
}

__device__ __forceinline__ void transpose_item(const float* W, int K, int N, bf16* WT, int fc1map, LAS float* scr, int item, int lane) {
    const int nblk = N / 32, kb = item / nblk, nb = item % nblk, k0 = 64 * kb, n0 = 32 * nb;
    int rowbase = n0;
    if (fc1map) { rowbase = (n0 < DFF) ? 256 * (n0 / 128) + (n0 % 128) : 256 * ((n0 - DFF) / 128) + 128 + ((n0 - DFF) % 128); }
    float tv[32];
#pragma unroll
    for (int i = 0; i < 32; ++i) tv[i] = W[(size_t)(k0 + 2 * i + (lane >> 5)) * N + n0 + (lane & 31)];
#pragma unroll
    for (int i = 0; i < 32; ++i) scr[(2 * i + (lane >> 5)) * 33 + (lane & 31)] = tv[i];
    LDS_WAIT(); asm volatile("" ::: "memory");
    const int c = lane & 7;
#pragma unroll
    for (int j = 0; j < 4; ++j) { const int n = (lane >> 3) + 8 * j; const LAS float* s = scr + (8 * c) * 33 + n;
        v4u o; o.x = pk2(s[0 * 33], s[1 * 33]); o.y = pk2(s[2 * 33], s[3 * 33]); o.z = pk2(s[4 * 33], s[5 * 33]); o.w = pk2(s[6 * 33], s[7 * 33]);
        *(GAS v4u*)(WT + (size_t)(rowbase + n) * K + k0 + 8 * c) = o; }
    LDS_WAIT(); asm volatile("" ::: "memory");
}

struct KArgs { const float* in[25]; float* out; unsigned char* ws; int ph_lo, ph_hi, li; float lam_init; };

__device__ __forceinline__ float* modt(unsigned char* ws, int layer, int slot, int modrow, int which) { return (float*)(ws + WS_MODT) + ((size_t)(((layer * 3 + slot) * 3 + modrow) * 3 + which)) * DM; }

__device__ __forceinline__ void prologue_phase(const KArgs& args, LAS unsigned char* L, int bx, int G) {
    const int tid = pg8::opaque_tid(), lane = tid & 63, wave = __builtin_amdgcn_readfirstlane(tid >> 6);
    unsigned char* ws = args.ws;
    LAS float* sl = (LAS float*)L;
    for (int i = tid; i < 3 * DM; i += NWAVES * 64) { const int r = i / DM, k = i % DM; const float v = (r < 2) ? args.in[1][r * DM + k] : args.in[3][k]; sl[i] = v / (1.0f + expf(-v)); }
    __syncthreads();
    LAS float* part = (LAS float*)(L + 24576);
    for (int item = bx; item < NLAYER * 72; item += G) {
        const int layer = item / 72, n0 = (item % 72) * 256;
        const float* W = args.in[4] + ((size_t)layer * DM + wave * 256) * NMODC + n0 + lane * 4;
        const LAS float* s0 = sl + wave * 256;
        f32x4 a0 = {0.f, 0.f, 0.f, 0.f}, a1 = a0, a2 = a0;
#pragma unroll 8
        for (int kk = 0; kk < 256; ++kk) { const f32x4 w = *(const f32x4*)(W + (size_t)kk * NMODC); a0 += w * s0[kk]; a1 += w * s0[DM + kk]; a2 += w * s0[2 * DM + kk]; }
        *(LAS f32x4*)(part + (wave * 3 + 0) * 256 + lane * 4) = a0; *(LAS f32x4*)(part + (wave * 3 + 1) * 256 + lane * 4) = a1; *(LAS f32x4*)(part + (wave * 3 + 2) * 256 + lane * 4) = a2;
        __syncthreads();
        for (int idx = tid; idx < 768; idx += NWAVES * 64) { const int r = idx >> 8, cc = idx & 255, n = n0 + cc; float m = args.in[5][layer * NMODC + n];
#pragma unroll
            for (int w = 0; w < 8; ++w) m += part[(w * 3 + r) * 256 + cc];
            const int k9 = n / DM, c = n % DM, s = k9 / 3, which = k9 % 3; const float* g = args.in[6] + (size_t)layer * 6 * DM;
            if (which == 0) modt(ws, layer, s, r, 2)[c] = m;
            else if (which == 1) modt(ws, layer, s, r, 1)[c] = g[(2 * s) * DM + c] * (1.0f + m);
            else modt(ws, layer, s, r, 0)[c] = (s == 1 ? 1.0f : 0.5f) * m * g[(2 * s + 1) * DM + c]; }
        __syncthreads();
    }
    {
        LAS float* scr = (LAS float*)(L + 49152 + wave * 8448);
        const int gw = bx * NWAVES + wave, NGW = G * NWAVES;
        constexpr int I_FC1 = (DM / 64) * (NFC1 / 32), I_FC2 = (DFF / 64) * (DM / 32), I_AIN = (DM / 64) * (A_N / 32), I_SQ = (DM / 64) * (DM / 32), I_BIN = (DM / 64) * (B_N / 32), I_BOUT = (B_W / 64) * (DM / 32), I_CIN = (DM / 64) * (C_N / 32);
        constexpr int NITEMS = 8 * I_FC1 + 8 * I_FC2 + 2 * I_AIN + 2 * I_SQ + I_BIN + I_BOUT + I_CIN + I_SQ;
        for (int it = gw; it < NITEMS; it += NGW) {
            int r = it;
            if (r < 8 * I_FC1) { const int mat = r / I_FC1; transpose_item(args.in[7] + (size_t)mat * DM * NFC1, DM, NFC1, (bf16*)(ws + WS_WFC1) + (size_t)mat * NFC1 * DM, 1, scr, r % I_FC1, lane); continue; } r -= 8 * I_FC1;
            if (r < 8 * I_FC2) { const int mat = r / I_FC2; transpose_item(args.in[8] + (size_t)mat * DFF * DM, DFF, DM, (bf16*)(ws + WS_WFC2) + (size_t)mat * DM * DFF, 0, scr, r % I_FC2, lane); continue; } r -= 8 * I_FC2;
            if (r < 2 * I_AIN) { const int mat = r / I_AIN; transpose_item(args.in[9] + (size_t)mat * DM * A_N, DM, A_N, (bf16*)(ws + WS_WAIN) + (size_t)mat * A_N * DM, 0, scr, r % I_AIN, lane); continue; } r -= 2 * I_AIN;
            if (r < 2 * I_SQ) { const int mat = r / I_SQ; transpose_item(args.in[10] + (size_t)mat * DM * DM, DM, DM, (bf16*)(ws + WS_WAOUT) + (size_t)mat * DM * DM, 0, scr, r % I_SQ, lane); continue; } r -= 2 * I_SQ;
            if (r < I_BIN) { transpose_item(args.in[12], DM, B_N, (bf16*)(ws + WS_WBIN), 0, scr, r, lane); continue; } r -= I_BIN;
            if (r < I_BOUT) { transpose_item(args.in[17], B_W, DM, (bf16*)(ws + WS_WBOUT), 0, scr, r, lane); continue; } r -= I_BOUT;
            if (r < I_CIN) { transpose_item(args.in[18], DM, C_N, (bf16*)(ws + WS_WCIN), 0, scr, r, lane); continue; } r -= I_CIN;
            transpose_item(args.in[19], DM, DM, (bf16*)(ws + WS_WCOUT), 0, scr, r, lane);
        }
    }
    for (int e = bx * NWAVES * 64 + tid; e < SEQ * 64; e += G * NWAVES * 64) { const int t = e >> 6, p = e & 63, pi = p & 31;
        const float inv = (float)pow(10000.0, -(double)pi / 32.0); const float ang = (float)((p < 32) ? (t >> 6) : (t & 63)) * inv;
        float* o = (float*)(ws + WS_ROPE) + (size_t)e * 2; o[0] = (float)cos((double)ang); o[1] = (float)sin((double)ang); }
    for (int e = bx * NWAVES * 64 + tid; e < 8 * 128 * 128; e += G * NWAVES * 64) ((bf16*)(ws + WS_BSW))[e] = (bf16)f2bf(args.in[15][e]);
    if (bx == 0) { float* sm = (float*)(ws + WS_SMALL);
        for (int e = tid; e < SM_END; e += NWAVES * 64) { float v = 0.f;
            if (e < SM_VNG) { if (e < 32) v = args.in[11][e]; }
            else if (e < SM_VNB) v = args.in[13][e - SM_VNG];
            else if (e < SM_BS) v = args.in[14][e - SM_VNB];
            else if (e < SM_LQ1) v = args.in[16][e - SM_BS];
            else if (e < SM_LK1) v = args.in[20][e - SM_LQ1];
            else if (e < SM_LQ2) v = args.in[21][e - SM_LK1];
            else if (e < SM_LK2) v = args.in[22][e - SM_LQ2];
            else if (e < SM_SUBG) v = args.in[23][e - SM_LK2];
            else v = args.in[24][e - SM_SUBG];
            sm[e] = v; } }
}

__device__ __forceinline__ void norm_phase(const float* xs_lat, const float* xs_ctx, float* xd_lat, float* xd_ctx, const bf16* Y, const float* postT, const float* preT, bf16* H, int nrows) {
    const int tid = pg8::opaque_tid(), lane = tid & 63, gw = blockIdx.x * NWAVES + __builtin_amdgcn_readfirstlane(tid >> 6), NGW = gridDim.x * NWAVES;
    for (int row = gw; row < nrows; row += NGW) {
        const int modrow = row < SEQ ? 0 : (row < MLAT ? 1 : 2);
        const float* xs = (row < MLAT) ? xs_lat + (size_t)row * DM : xs_ctx + (size_t)(row - MLAT) * DM;
        float* xd = (row < MLAT) ? xd_lat + (size_t)row * DM : xd_ctx + (size_t)(row - MLAT) * DM;
        f32x4 xv[8];
#pragma unroll
        for (int j = 0; j < 8; ++j) xv[j] = *(const f32x4*)(xs + 256 * j + 4 * lane);
        if (Y) {
            const bf16* yr = Y + (size_t)row * DM; const float* At = postT + (size_t)modrow * 3 * DM;
            f32x4 yv[8]; float ss = 0.f;
#pragma unroll
            for (int j = 0; j < 8; ++j) { const v2u raw = *(const v2u*)(yr + 256 * j + 4 * lane);
                yv[j].x = __builtin_bit_cast(float, raw.x << 16); yv[j].y = __builtin_bit_cast(float, raw.x & 0xffff0000u); yv[j].z = __builtin_bit_cast(float, raw.y << 16); yv[j].w = __builtin_bit_cast(float, raw.y & 0xffff0000u);
                ss += (yv[j].x * yv[j].x + yv[j].y * yv[j].y) + (yv[j].z * yv[j].z + yv[j].w * yv[j].w); }
            const float ry = 1.0f / sqrtf(wave_sum(ss) * (1.0f / DM) + EPS);
#pragma unroll
            for (int j = 0; j < 8; ++j) { const f32x4 a = *(const f32x4*)(At + 256 * j + 4 * lane); xv[j] += yv[j] * ry * a; }
        }
#pragma unroll
        for (int j = 0; j < 8; ++j) *(f32x4*)(xd + 256 * j + 4 * lane) = xv[j];
        if (H) {
            const float* Bt = preT + (size_t)(modrow * 3 + 1) * DM; const float* Ct = preT + (size_t)(modrow * 3 + 2) * DM;
            float ss = 0.f;
#pragma unroll
            for (int j = 0; j < 8; ++j) ss += (xv[j].x * xv[j].x + xv[j].y * xv[j].y) + (xv[j].z * xv[j].z + xv[j].w * xv[j].w);
            const float rx = 1.0f / sqrtf(wave_sum(ss) * (1.0f / DM) + EPS);
            bf16* hr = H + (size_t)row * DM;
#pragma unroll
            for (int j = 0; j < 8; ++j) { const f32x4 b = *(const f32x4*)(Bt + 256 * j + 4 * lane), c = *(const f32x4*)(Ct + 256 * j + 4 * lane); const f32x4 h = xv[j] * rx * b + c;
                v2u o; o.x = pk2(h.x, h.y); o.y = pk2(h.z, h.w); *(v2u*)(hr + 256 * j + 4 * lane) = o; }
        }
    }
}
__device__ __forceinline__ void vstats_phase(const bf16* QKV, float* stats, int nrows) {
    const int tid = pg8::opaque_tid(), lane = tid & 63, gw = blockIdx.x * NWAVES + __builtin_amdgcn_readfirstlane(tid >> 6), NGW = gridDim.x * NWAVES;
    for (int row = gw; row < nrows; row += NGW) {
        const bf16* vr = QKV + (size_t)row * B_N + B_W + lane * 8; bf16x8 raw[12]; float s = 0.f;
#pragma unroll
        for (int i = 0; i < 12; ++i) { raw[i] = *(const bf16x8*)(vr + i * 512);
#pragma unroll
            for (int e = 0; e < 8; ++e) s += bf2f((unsigned short)raw[i][e]); }
        const float mean = wave_sum(s) * (1.0f / B_W); float q = 0.f;
#pragma unroll
        for (int i = 0; i < 12; ++i)
#pragma unroll
            for (int e = 0; e < 8; ++e) { const float d = bf2f((unsigned short)raw[i][e]) - mean; q += d * d; }
        const float rstd = 1.0f / sqrtf(wave_sum(q) * (1.0f / B_W) + EPS);
        if (lane == 0) { stats[2 * row] = mean; stats[2 * row + 1] = rstd; }
    }
}
__device__ __forceinline__ void spatial_phase(bf16* QKV, const bf16* BSW, const float* stats, const float* vg, const float* vb, const float* bs, LAS unsigned char* L, int nchunks, int bx, int G) {
    const int tid = pg8::opaque_tid(), lane = tid & 63, wave = __builtin_amdgcn_readfirstlane(tid >> 6);
    constexpr int PITCH = 136;
    LAS bf16* T = (LAS bf16*)L;
    const int hi = lane >> 5, r32 = lane & 31;
    for (int u = bx; u < nchunks * 24; u += G) {
        const int third = u % 3, g = (u / 3) % 8, ch = u / 24, row0 = ch * 128, cbase = g * 768 + third * 256;
        { const int q = tid & 127, c8b = tid >> 7; const float mu = stats[2 * (row0 + q)], rs = stats[2 * (row0 + q) + 1];
          const bf16* vr = QKV + (size_t)(row0 + q) * B_N + B_W + cbase;
#pragma unroll
          for (int i = 0; i < 8; ++i) { const int c0 = (4 * i + c8b) * 8; const bf16x8 raw = *(const bf16x8*)(vr + c0);
              const f32x4 g0 = *(const f32x4*)(vg + cbase + c0), g1 = *(const f32x4*)(vg + cbase + c0 + 4), b0 = *(const f32x4*)(vb + cbase + c0), b1 = *(const f32x4*)(vb + cbase + c0 + 4);
#pragma unroll
              for (int e = 0; e < 8; ++e) { const float gm = e < 4 ? g0[e & 3] : g1[e & 3], bt = e < 4 ? b0[e & 3] : b1[e & 3];
                  T[(c0 + e) * PITCH + q] = (bf16)f2bf((bf2f((unsigned short)raw[e]) - mu) * rs * gm + bt); } } }
        __syncthreads();
        f32x16 acc[4] = {};
        const bf16* Wg = BSW + (size_t)g * 16384 + (size_t)r32 * 128 + hi * 8;
#pragma unroll
        for (int ks = 0; ks < 8; ++ks) { const bf16x8 bfr = *(const LAS bf16x8*)(T + (32 * wave + r32) * PITCH + ks * 16 + hi * 8);
#pragma unroll
            for (int mb = 0; mb < 4; ++mb) { const bf16x8 afr = *(const bf16x8*)(Wg + mb * 32 * 128 + ks * 16); acc[mb] = __builtin_amdgcn_mfma_f32_32x32x16_bf16(afr, bfr, acc[mb], 0, 0, 0); } }
        const int col = cbase + 32 * wave + r32;
#pragma unroll
        for (int mb = 0; mb < 4; ++mb)
#pragma unroll
            for (int r = 0; r < 16; ++r) { const int p = mb * 32 + (r & 3) + 8 * (r >> 2) + 4 * hi; bf16* up = QKV + (size_t)(row0 + p) * B_N + col;
                *up = (bf16)f2bf(bf2f(*up) * (acc[mb][r] + bs[g * 128 + p])); }
        __syncthreads();
    }
}
__device__ __forceinline__ void combine_phase(const float* OC, bf16* AO, const float* lq1, const float* lk1, const float* lq2, const float* lk2, const float* sg, float lam_init, int nrows) {
    const int tid = pg8::opaque_tid(), lane = tid & 63, gw = blockIdx.x * NWAVES + __builtin_amdgcn_readfirstlane(tid >> 6), NGW = gridDim.x * NWAVES;
    const float d1 = wave_sum(lq1[lane] * lk1[lane] + lq1[lane + 64] * lk1[lane + 64]), d2 = wave_sum(lq2[lane] * lk2[lane] + lq2[lane + 64] * lk2[lane + 64]);
    const float lam = expf(d1) - expf(d2) + lam_init;
    const f32x4 gv = *(const f32x4*)(sg + 4 * lane) * (1.0f - lam_init);
    for (int row = gw; row < nrows; row += NGW) {
        const float* orow = OC + (size_t)row * 4096; bf16* ar = AO + (size_t)row * DM;
#pragma unroll
        for (int h = 0; h < 8; ++h) { const f32x4 a = *(const f32x4*)(orow + (2 * h) * 256 + 4 * lane), b = *(const f32x4*)(orow + (2 * h + 1) * 256 + 4 * lane); const f32x4 o = a - lam * b;
            const float rs = 1.0f / sqrtf(wave_sum((o.x * o.x + o.y * o.y) + (o.z * o.z + o.w * o.w)) * (1.0f / 256.0f) + EPS); const f32x4 v = o * rs * gv;
            v2u w; w.x = pk2(v.x, v.y); w.y = pk2(v.z, v.w); *(v2u*)(ar + h * 256 + 4 * lane) = w; }
    }
}

template <int K, int LDA>
__device__ __forceinline__ void ctx_tile(const bf16* A, const bf16* Bt, bf16* Yc, int tile, LAS unsigned char* L) {
    const int tid = pg8::opaque_tid(), lane = tid & 63, wave = __builtin_amdgcn_readfirstlane(tid >> 6), r32 = lane & 31, hi = lane >> 5;
    const int row0 = (tile >> 5) * 64, col0 = (tile & 31) * 64;
    constexpr int NB = K / 64;
    static_assert(K % 64 == 0, "K must be a multiple of 64");
    LAS unsigned char* W = L + wave * 16384;
    const int lr = lane >> 3, lc = lane & 7;
    const bf16* ag = A + (size_t)(row0 + lr) * LDA + lc * 8;
    const bf16* bg = Bt + (size_t)(col0 + lr) * K + lc * 8;
    const int wofs = lr * 128 + ((lc ^ (lr & 7)) << 4);
    const int rofs = r32 * 128;
    f32x16 acc00 = {}, acc01 = {}, acc10 = {}, acc11 = {};
    bf16x8 ga[8], gb[8];
    int kb = wave;
    if (kb < NB) {
#pragma unroll
        for (int i = 0; i < 8; ++i) { ga[i] = *(const bf16x8*)(ag + (size_t)(8 * i) * LDA + kb * 64); gb[i] = *(const bf16x8*)(bg + (size_t)(8 * i) * K + kb * 64); }
    }
    for (; kb < NB; kb += 8) {
#pragma unroll
        for (int i = 0; i < 8; ++i) { *(LAS bf16x8*)(W + i * 1024 + wofs) = ga[i]; *(LAS bf16x8*)(W + 8192 + i * 1024 + wofs) = gb[i]; }
        if (kb + 8 < NB) {
#pragma unroll
            for (int i = 0; i < 8; ++i) { ga[i] = *(const bf16x8*)(ag + (size_t)(8 * i) * LDA + (kb + 8) * 64); gb[i] = *(const bf16x8*)(bg + (size_t)(8 * i) * K + (kb + 8) * 64); }
        }
#pragma unroll
        for (int s = 0; s < 4; ++s) { const int ch = (((2 * s + hi) ^ (r32 & 7)) << 4);
            const bf16x8 a0 = *(const LAS bf16x8*)(W + rofs + ch), a1 = *(const LAS bf16x8*)(W + 4096 + rofs + ch), b0 = *(const LAS bf16x8*)(W + 8192 + rofs + ch), b1 = *(const LAS bf16x8*)(W + 12288 + rofs + ch);
            acc00 = __builtin_amdgcn_mfma_f32_32x32x16_bf16(a0, b0, acc00, 0, 0, 0); acc01 = __builtin_amdgcn_mfma_f32_32x32x16_bf16(a0, b1, acc01, 0, 0, 0);
            acc10 = __builtin_amdgcn_mfma_f32_32x32x16_bf16(a1, b0, acc10, 0, 0, 0); acc11 = __builtin_amdgcn_mfma_f32_32x32x16_bf16(a1, b1, acc11, 0, 0, 0); }
    }
    LDS_WAIT(); asm volatile("" ::: "memory");
    LAS float* red = (LAS float*)L + wave * 4096;
#pragma unroll
    for (int r = 0; r < 16; ++r) { const int m = (r & 3) + 8 * (r >> 2) + 4 * hi;
        red[m * 64 + r32] = acc00[r]; red[m * 64 + 32 + r32] = acc01[r]; red[(32 + m) * 64 + r32] = acc10[r]; red[(32 + m) * 64 + 32 + r32] = acc11[r]; }
    __syncthreads();
    { const int o = tid * 8, m = o >> 6, n = o & 63; f32x4 s0 = {0.f, 0.f, 0.f, 0.f}, s1 = s0;
#pragma unroll
      for (int w = 0; w < 8; ++w) { s0 += *(const LAS f32x4*)((LAS float*)L + w * 4096 + o); s1 += *(const LAS f32x4*)((LAS float*)L + w * 4096 + o + 4); }
      v4u w4; w4.x = pk2(s0.x, s0.y); w4.y = pk2(s0.z, s0.w); w4.z = pk2(s1.x, s1.y); w4.w = pk2(s1.z, s1.w);
      *(v4u*)(Yc + (size_t)(row0 + m) * DM + col0 + n) = w4; }
    __syncthreads();
}

__global__ void __launch_bounds__(NWAVES * 64, 2) fwd(KArgs args) {
    extern __shared__ __attribute__((aligned(16))) unsigned char lds[];
    LAS unsigned char* L = (LAS unsigned char*)lds;
    const int tid = threadIdx.x, G = gridDim.x, bx = blockIdx.x;
    unsigned char* ws0 = args.ws;
    for (int u = tid; u < (LDS_BYTES - RING_BYTES) / 4; u += NWAVES * 64) ((LAS unsigned*)(L + RING_BYTES))[u] = 0u;
    __syncthreads();
    const int lo = args.ph_lo, hi = args.ph_hi;
    XcdBarrier bar; bar.bar = (unsigned*)(ws0 + WS_CTL) + CW_BAR + args.li * XCD_BAR_WORDS; bar.x = 0; bar.st = (volatile LAS unsigned*)(L + MISC_OFF + 32);
    if (hi - lo > 1) bar = xcd_barrier_post((unsigned*)(ws0 + WS_CTL) + CW_BAR + args.li * XCD_BAR_WORDS, (volatile LAS unsigned*)(L + MISC_OFF + 32));
    int ph = 0;
#define PHASE_BEGIN if (ph >= lo && ph < hi) {
#define PHASE_END   if (ph + 1 < hi) xcd_barrier(bar); } ++ph;
#define SETUP_PTRS() unsigned char* ws = args.ws; asm volatile("" : "+s"(ws)); float* XL = args.out; asm volatile("" : "+s"(XL)); float* XC = (float*)(ws + WS_XC); \
    bf16* H = (bf16*)(ws + WS_H); bf16* HID = (bf16*)(ws + WS_HID); bf16* Y = (bf16*)(ws + WS_Y); bf16* QKV = (bf16*)(ws + WS_QKV); bf16* AO = (bf16*)(ws + WS_AO); float* OC = (float*)(ws + WS_OC); \
    const float* ROPE = (const float*)(ws + WS_ROPE); const float* SM = (const float*)(ws + WS_SMALL); (void)XC; (void)HID; (void)Y; (void)QKV; (void)AO; (void)OC; (void)ROPE; (void)SM; (void)H

    { SETUP_PTRS();
    PHASE_BEGIN
#ifndef OFF_PRO
    for (int rep_ = 0; rep_ < (PROBE_ID == 1 ? 2 : 1); ++rep_) { prologue_phase(args, L, bx, G); }
#endif
    PHASE_END
    PHASE_BEGIN norm_phase(args.in[0], args.in[2], XL, XC, nullptr, nullptr, modt(ws, 0, 0, 0, 0), H, MALL); PHASE_END }

    for (int sl = 0; sl < 3 * NLAYER; ++sl) {
        SETUP_PTRS();
        const int layer = sl / 3, typ = sl % 3, kind = layer % 3, jm = layer / 3; const bool lastl = (layer == NLAYER - 1);
        const int Mrows = (lastl && typ >= 1) ? MLAT : MALL;
        pg8::Gemm gy;
        if (typ != 1) {
            const int f = (typ == 0) ? 0 : 1;
            PHASE_BEGIN
                pg8::Gemm g{H, (const bf16*)(ws + WS_WFC1) + (size_t)(layer * 2 + f) * NFC1 * DM, Mrows, NFC1, DM, DM}; pg8::StaticOrder S; S.init(Mrows, NFC1, G, bx);
                pg8::EpiSwiglu E{HID, DFF};
                #ifndef OFF_FC1
                for (int rep_ = 0; rep_ < (PROBE_ID == 2 ? 2 : 1); ++rep_) { pg8::gemm_phase<pg8::EpiSwiglu, pg8::StaticOrder, true, true, DM, DM>(L, g, S, E); }
#endif
            PHASE_END
            gy = pg8::Gemm{HID, (const bf16*)(ws + WS_WFC2) + (size_t)(layer * 2 + f) * DM * DFF, Mrows, DM, DFF, DFF};
        } else {
            if (kind != 1) {
                PHASE_BEGIN
                    const int N = (kind == 0) ? A_N : C_N;
                    pg8::Gemm g{H, (kind == 0) ? (const bf16*)(ws + WS_WAIN) + (size_t)jm * A_N * DM : (const bf16*)(ws + WS_WCIN), MALL, N, DM, DM}; pg8::StaticOrder S; S.init(MALL, N, G, bx);
                    pg8::EpiBf16X<0> E{QKV, N, ROPE, (kind == 0) ? 2560 : 4096};
                    #ifndef OFF_ROPE
                    for (int rep_ = 0; rep_ < (PROBE_ID == 8 ? 2 : 1); ++rep_) { pg8::gemm_phase<pg8::EpiBf16X<0>, pg8::StaticOrder, true, true, DM, DM>(L, g, S, E); }
#endif
                PHASE_END
            } else {
                PHASE_BEGIN
                    pg8::Gemm g{H, (const bf16*)(ws + WS_WBIN), MALL, B_N, DM, DM}; pg8::StaticOrder S; S.init(MALL, B_N, G, bx);
                    pg8::EpiBf16X<1> E{QKV, B_N, nullptr, 0};
                    #ifndef OFF_GELU
                    for (int rep_ = 0; rep_ < (PROBE_ID == 9 ? 2 : 1); ++rep_) { pg8::gemm_phase<pg8::EpiBf16X<1>, pg8::StaticOrder, true, true, DM, DM>(L, g, S, E); }
#endif
                PHASE_END
            }
            if (kind == 0) {
                PHASE_BEGIN
                    const int nlat = NBATCH * 16 * 16, nall = nlat + (lastl ? 0 : NBATCH * 16);
                    for (int u = bx; u < nall; u += G) {
                        att::Args a; a.qkv = QKV; a.ld = A_N; a.n0 = 4; a.has_sink = 1; a.out = AO; a.ldo = DM;
                        if (u < nlat) { const int qb = u & 15, h = (u >> 4) & 15, b = u >> 8;
                            a.qrow0 = b * SEQ + qb * 256; a.qcol = h * 128; a.kcol = 2048 + (h >> 2) * 128; a.vcol = 2560 + (h >> 2) * 128; a.ctxrow0 = MLAT + b * CTXL; a.latrow0 = b * SEQ;
                            a.kstart = qb * 256 - 128; a.n1 = 8; a.qpos0 = qb * 256; a.sink = SM[SM_SINK + jm * 16 + h]; a.ocol = h * 128; }
                        else { const int cu = u - nlat, h = cu & 15, b = cu >> 4;
                            a.qrow0 = MLAT + b * CTXL; a.qcol = h * 128; a.kcol = 2048 + (h >> 2) * 128; a.vcol = 2560 + (h >> 2) * 128; a.ctxrow0 = MLAT + b * CTXL; a.latrow0 = b * SEQ;
                            a.kstart = 0; a.n1 = 0; a.qpos0 = 0; a.sink = SM[SM_SINK + jm * 16 + h]; a.ocol = h * 128; }
                        #ifndef OFF_ATTA
                        for (int rep_ = 0; rep_ < (PROBE_ID == 7 ? 2 : 1); ++rep_) { att::attn_unit<true, true, A_N>(a, (char*)lds); }
#endif
                    }
                PHASE_END
                gy = pg8::Gemm{AO, (const bf16*)(ws + WS_WAOUT) + (size_t)jm * DM * DM, Mrows, DM, DM, DM};
            } else if (kind == 1) {
                PHASE_BEGIN vstats_phase(QKV, (float*)(ws + WS_STATS), MALL); PHASE_END
                PHASE_BEGIN
#ifndef OFF_SPA
                spatial_phase(QKV, (const bf16*)(ws + WS_BSW), (const float*)(ws + WS_STATS), SM + SM_VNG, SM + SM_VNB, SM + SM_BS, L, MALL / 128, bx, G);
#endif
                PHASE_END
                gy = pg8::Gemm{QKV, (const bf16*)(ws + WS_WBOUT), Mrows, DM, B_W, B_N};
            } else {
                PHASE_BEGIN
                    const int nlat = NBATCH * 32 * 16, nall = nlat + (lastl ? 0 : NBATCH * 32);
                    for (int u = bx; u < nall; u += G) {
                        att::Args a; a.qkv = QKV; a.ld = C_N; a.n0 = 4; a.has_sink = 0; a.sink = 0.f; a.out = OC; a.ldo = 4096; a.kstart = 0; a.qpos0 = 0;
                        int b, combo;
                        if (u < nlat) { const int qb = u & 15; combo = (u >> 4) & 31; b = u >> 9; a.qrow0 = b * SEQ + qb * 256; a.n1 = 64; }
                        else { const int cu = u - nlat; combo = cu & 31; b = cu >> 5; a.qrow0 = MLAT + b * CTXL; a.n1 = 0; }
                        const int hc = combo >> 1, vh = combo & 1;
                        a.qcol = hc * 128; a.kcol = 2048 + hc * 128; a.vcol = 4096 + (hc >> 1) * 256 + vh * 128; a.ctxrow0 = MLAT + b * CTXL; a.latrow0 = b * SEQ; a.ocol = hc * 256 + vh * 128;
                        #ifndef OFF_ATTC
                        for (int rep_ = 0; rep_ < (PROBE_ID == 6 ? 2 : 1); ++rep_) { att::attn_unit<false, false, C_N>(a, (char*)lds); }
#endif
                    }
                PHASE_END
                PHASE_BEGIN combine_phase(OC, AO, SM + SM_LQ1, SM + SM_LK1, SM + SM_LQ2, SM + SM_LK2, SM + SM_SUBG, args.lam_init, MALL); PHASE_END
                gy = pg8::Gemm{AO, (const bf16*)(ws + WS_WCOUT), Mrows, DM, DM, DM};
            }
        }
        PHASE_BEGIN
            const bool hasctx = (gy.M == MALL); gy.M = MLAT;
            pg8::StaticOrder S; S.init(MLAT, DM, G, bx); pg8::EpiBf16X<2> E{Y, DM, nullptr, 0};
            bf16* Yc = Y + (size_t)MLAT * DM;
            if (typ != 1) { for (int rep_ = 0; rep_ < (PROBE_ID == 3 ? 2 : 1); ++rep_) { pg8::gemm_phase<pg8::EpiBf16X<2>, pg8::StaticOrder, true, true, DFF, DFF>(L, gy, S, E); }
                for (int rep_ = 0; rep_ < (PROBE_ID == 4 ? 2 : 1); ++rep_) { if (hasctx) for (int t = bx; t < 256; t += G) ctx_tile<DFF, DFF>(gy.A + (size_t)MLAT * DFF, gy.Bt, Yc, t, L); } }
            else if (kind == 1) { pg8::gemm_phase<pg8::EpiBf16X<2>, pg8::StaticOrder, true, true, B_W, B_N>(L, gy, S, E);
                if (hasctx) for (int t = bx; t < 256; t += G) ctx_tile<B_W, B_N>(gy.A + (size_t)MLAT * B_N, gy.Bt, Yc, t, L); }
            else { pg8::gemm_phase<pg8::EpiBf16X<2>, pg8::StaticOrder, true, true, DM, DM>(L, gy, S, E);
                if (hasctx) for (int t = bx; t < 256; t += G) ctx_tile<DM, DM>(gy.A + (size_t)MLAT * DM, gy.Bt, Yc, t, L); }
        PHASE_END
        PHASE_BEGIN
            const bool fin = (sl == 3 * NLAYER - 1);
            const int nl = (typ == 2) ? layer + 1 : layer, ns = (typ == 2) ? 0 : typ + 1;
            if (PROBE_ID == 5) norm_phase(XL, XC, (float*)(ws + WS_END), (float*)(ws + WS_END + 64 * MiB), Y, modt(ws, layer, typ, 0, 0), fin ? nullptr : modt(ws, nl, ns, 0, 0), fin ? nullptr : (bf16*)(ws + WS_END + 72 * MiB), Mrows);
            norm_phase(XL, XC, XL, XC, Y, modt(ws, layer, typ, 0, 0), fin ? nullptr : modt(ws, nl, ns, 0, 0), fin ? nullptr : H, Mrows);
        PHASE_END
    }
#undef PHASE_BEGIN
#undef PHASE_END
}

static int count_phases() { int n = 2; for (int sl = 0; sl < 3 * NLAYER; ++sl) { const int layer = sl / 3, typ = sl % 3, kind = layer % 3; n += (typ != 1) ? 3 : (kind == 0 ? 4 : 5); } return n; }
extern "C" void kernel_launch(void* const* d_in, const int* in_sizes, int n_in, void* d_out, int out_size, void* d_ws, size_t ws_size, hipStream_t stream) {
    static int grid = 0;
    if (grid == 0) {
        if (n_in != 25 || in_sizes[0] != MLAT * DM || out_size != MLAT * DM || ws_size < WS_END) { fprintf(stderr, "kernel_launch: unexpected shapes (n_in %d, in0 %d, out %d, ws %zu < %zu)\n", n_in, n_in > 0 ? in_sizes[0] : -1, out_size, ws_size, (size_t)WS_END); grid = -1; return; }
        int dev = 0, cus = 0, per_cu = 0;
        if (hipGetDevice(&dev) != hipSuccess || hipDeviceGetAttribute(&cus, hipDeviceAttributeMultiprocessorCount, dev) != hipSuccess) { grid = -1; return; }
        if (hipFuncSetAttribute((const void*)fwd, hipFuncAttributeMaxDynamicSharedMemorySize, LDS_BYTES) != hipSuccess) { fprintf(stderr, "kernel_launch: hipFuncSetAttribute failed\n"); grid = -1; return; }
        if (hipOccupancyMaxActiveBlocksPerMultiprocessor(&per_cu, (const void*)fwd, NWAVES * 64, LDS_BYTES) != hipSuccess || per_cu < 1) fprintf(stderr, "kernel_launch: occupancy query reports %d\n", per_cu);
        (void)hipGetLastError();
        grid = cus;
    }
    if (grid < 0) return;
    if (hipMemsetAsync((char*)d_ws + WS_CTL, 0, CTL_BYTES, stream) != hipSuccess) return;
    KArgs a{};
    for (int i = 0; i < 25; ++i) a.in[i] = (const float*)d_in[i];
    a.out = (float*)d_out; a.ws = (unsigned char*)d_ws; a.lam_init = (float)(0.8 - 0.6 * exp(-0.3 * 2.0));
    const int nph = count_phases();
#if MK_PER_PHASE
    for (int p = 0; p < nph; ++p) { a.ph_lo = p; a.ph_hi = p + 1; a.li = 0; hipLaunchKernelGGL(fwd, dim3(grid), dim3(NWAVES * 64), LDS_BYTES, stream, a); }
#else
    a.ph_lo = 0; a.ph_hi = nph; a.li = 0; hipLaunchKernelGGL(fwd, dim3(grid), dim3(NWAVES * 64), LDS_BYTES, stream, a);
#endif
    const hipError_t le = hipPeekAtLastError();
    if (le != hipSuccess) fprintf(stderr, "kernel_launch: launch failed: %s\n", hipGetErrorName(le));
}
```

```cpp
#include <hip/hip_runtime.h>
#include <cstdio>
#include <cstdint>
#include <cmath>

#ifndef PROBE_ID
#define PROBE_ID 0
#endif
#ifndef MK_PER_PHASE
#define MK_PER_PHASE 0
#endif

namespace pg8 {
#define PG8_LAS __attribute__((address_space(3)))
typedef unsigned short bf16_t;
typedef short bf16x8 __attribute__((ext_vector_type(8)));
typedef float f32x4 __attribute__((ext_vector_type(4)));
typedef unsigned u32x4 __attribute__((ext_vector_type(4)));
__device__ __forceinline__ int opaque_tid() { int t = threadIdx.x; asm volatile("" : "+v"(t)); return t; }
constexpr int BM = 256, BK = 64, HALF = 128, HTB = HALF * BK * 2  , STAGE_BYTES = 8 * HTB, NXCD = 8, WGM = 8;

__host__ __device__ __forceinline__ int lds_byte(int r, int c) { const int st = (r >> 4) * 2 + (c >> 5), rr = r & 15, cc = c & 31, ob = rr * 64 + cc * 2; return st * 1024 + (ob ^ (((ob >> 9) & 1) << 5)); }
__host__ __device__ __forceinline__ void stage_rc(int b, int& R, int& C) { const int st = b / 1024, sb = b % 1024, swz = sb ^ (((sb >> 9) & 1) << 5); R = (st >> 1) * 16 + swz / 64; C = (st & 1) * 32 + (swz % 64) / 2; }
__host__ __device__ __forceinline__ int perm32(int rho) { const int n = rho >> 4, i = rho & 15; return 8 * (i >> 2) + 4 * n + (i & 3); }

struct Unit { int pm, pn; };
struct Gemm { const bf16_t* A; const bf16_t* Bt; int M, N, K, lda; };

struct StaticOrder {
    int nM, nN, nwg, G, c;
    __host__ __device__ void init(int M, int N, int G_, int c_) { nM = M / BM; nN = N / BM; nwg = nM * nN; G = G_; c = c_; }
    __host__ __device__ bool next(int i, Unit& u) const {
        const long L = (long)i * G + c; if (L >= nwg) return false;
        int wgid = (int)L; { const int q = nwg / NXCD, r = nwg % NXCD, xcd = wgid % NXCD, off = wgid / NXCD; wgid = (xcd < r ? xcd * (q + 1) : r * (q + 1) + (xcd - r) * q) + off; }
        const int nig = WGM * nN, gid = wgid / nig, fm = gid * WGM, gsz = (nM - fm) < WGM ? (nM - fm) : WGM;
        u.pm = fm + ((wgid % nig) % gsz); u.pn = (wgid % nig) / gsz; return true;
    }
    __device__ __forceinline__ void a_ready(const Unit&) const {}
    __device__ __forceinline__ void done(const Unit&) const {}
};


__device__ __forceinline__ unsigned cvt_pk_bf16(float lo, float hi) { unsigned r; asm volatile("v_cvt_pk_bf16_f32 %0, %1, %2" : "=v"(r) : "v"(lo), "v"(hi)); return r; }
__device__ __forceinline__ float sigmoid_fast(float z) { return __builtin_amdgcn_rcpf(1.0f + __builtin_amdgcn_exp2f(-1.4426950408889634f * z)); }
__device__ __forceinline__ float gelu_tanh(float x) { const float z = 1.5957691216057308f * (x + 0.044715f * x * x * x); return x * sigmoid_fast(z); }

struct EpiSwiglu {
    static constexpr bool PERM = true, AFTER_DRAIN = false;
    bf16_t* O; int ldc;
    __device__ __forceinline__ void operator()(const f32x4 (&acc)[2][2][4][2], const Unit& u, int wr, int wc, int fr, int fq) const {
        const int row0 = u.pm * BM + wr * 64 + fr, col0 = u.pn * HALF + wc * 32 + 8 * fq;
#pragma unroll
        for (int ai = 0; ai < 2; ++ai)
#pragma unroll
            for (int m = 0; m < 4; ++m) { bf16_t* rowp = O + (size_t)(row0 + ai * HALF + m * 16) * ldc + col0;
                float v[8];
#pragma unroll
                for (int n = 0; n < 2; ++n)
#pragma unroll
                    for (int j = 0; j < 4; ++j) { const float g = acc[ai][0][m][n][j], uu = acc[ai][1][m][n][j]; v[n * 4 + j] = g * sigmoid_fast(g) * uu; }
                u32x4 w; w.x = cvt_pk_bf16(v[0], v[1]); w.y = cvt_pk_bf16(v[2], v[3]); w.z = cvt_pk_bf16(v[4], v[5]); w.w = cvt_pk_bf16(v[6], v[7]);
                *(u32x4*)rowp = w; }
    }
};
struct EpiF32 {
    static constexpr bool PERM = true, AFTER_DRAIN = false;
    float* C; int ldc;
    __device__ __forceinline__ void operator()(const f32x4 (&acc)[2][2][4][2], const Unit& u, int wr, int wc, int fr, int fq) const {
        const int row0 = u.pm * BM + wr * 64 + fr, col0 = u.pn * BM + wc * 32 + 8 * fq;
#pragma unroll
        for (int ai = 0; ai < 2; ++ai)
#pragma unroll
            for (int m = 0; m < 4; ++m) { float* rowp = C + (size_t)(row0 + ai * HALF + m * 16) * ldc + col0;
#pragma unroll
                for (int bj = 0; bj < 2; ++bj) { *(f32x4*)(rowp + bj * HALF) = acc[ai][bj][m][0]; *(f32x4*)(rowp + bj * HALF + 4) = acc[ai][bj][m][1]; } }
    }
};
template <int MODE  > struct EpiBf16X {
    static constexpr bool PERM = true, AFTER_DRAIN = false;
    bf16_t* O; int ldc; const float* rope; int rope_cols;
    __device__ __forceinline__ void operator()(const f32x4 (&acc)[2][2][4][2], const Unit& u, int wr, int wc, int fr, int fq) const {
        const int row0 = u.pm * BM + wr * 64 + fr, col0 = u.pn * BM + wc * 32 + 8 * fq;
        const bool do_rope = (MODE == 0) && (u.pm < 32) && (u.pn * BM < rope_cols);
        const int p0 = 16 * wc + 4 * fq;
#pragma unroll
        for (int ai = 0; ai < 2; ++ai)
#pragma unroll
            for (int m = 0; m < 4; ++m) { const int row = row0 + ai * HALF + m * 16; bf16_t* rowp = O + (size_t)row * ldc + col0;
                f32x4 cs0 = (f32x4){1.f, 0.f, 1.f, 0.f}, cs1 = cs0;
                if (do_rope) { const float* rp = rope + ((size_t)(row & 4095) * 64 + p0) * 2; cs0 = *(const f32x4*)rp; cs1 = *(const f32x4*)(rp + 4); }
#pragma unroll
                for (int bj = 0; bj < 2; ++bj) { f32x4 v0 = acc[ai][bj][m][0], v1 = acc[ai][bj][m][1];
                    if (MODE == 1) {
#pragma unroll
                        for (int j = 0; j < 4; ++j) { v0[j] = gelu_tanh(v0[j]); v1[j] = gelu_tanh(v1[j]); } }
                    else if (do_rope) {
                        const f32x4 a = v0, b = v1;
                        v0[0] = a[0] * cs0[0] - a[1] * cs0[1]; v0[1] = a[0] * cs0[1] + a[1] * cs0[0]; v0[2] = a[2] * cs0[2] - a[3] * cs0[3]; v0[3] = a[2] * cs0[3] + a[3] * cs0[2];
                        v1[0] = b[0] * cs1[0] - b[1] * cs1[1]; v1[1] = b[0] * cs1[1] + b[1] * cs1[0]; v1[2] = b[2] * cs1[2] - b[3] * cs1[3]; v1[3] = b[2] * cs1[3] + b[3] * cs1[2]; }
                    u32x4 w; w.x = cvt_pk_bf16(v0[0], v0[1]); w.y = cvt_pk_bf16(v0[2], v0[3]); w.z = cvt_pk_bf16(v1[0], v1[1]); w.w = cvt_pk_bf16(v1[2], v1[3]);
                    *(u32x4*)(rowp + bj * HALF) = w; } }
    }
};

template <class Epi, class Sched, bool ALIGN_EPI, bool SP2, int K, int LDA>
__device__ __forceinline__ void gemm_phase(PG8_LAS unsigned char* lds, const Gemm g, const Sched& S, const Epi& E) {
    const int tid = opaque_tid(), wid = __builtin_amdgcn_readfirstlane(tid >> 6), lane = tid & 63, wr = wid >> 2, wc = wid & 3, fr = lane & 15, fq = lane >> 4;
    constexpr int nt = K / BK;
    unsigned voffA[2], voffB[2];
#pragma unroll
    for (int i = 0; i < 2; ++i) { int R, C; stage_rc(tid * 16 + i * 8192, R, C); const int Rb = Epi::PERM ? ((R & ~31) + perm32(R & 31)) : R;
        voffA[i] = (unsigned)(R * LDA + C) * 2u; voffB[i] = (unsigned)(Rb * K + C) * 2u; }
    constexpr size_t kstep = (size_t)(BK * 2);
    constexpr size_t hstepA = (size_t)HALF * LDA * 2, hstepB = (size_t)HALF * K * 2;
    constexpr size_t tstepA = 2 * hstepA, tstepB = 2 * hstepB;
    const unsigned ldsw = (unsigned)wid * 1024u;
    const int aoff = lds_byte(wr * 64 + fr, fq * 8), boff = lds_byte(wc * 32 + fr, fq * 8);
#define PG8_SA(b, h) (((b) * 2 + (h)) * HTB)
#define PG8_SB(b, h) ((4 + (b) * 2 + (h)) * HTB)
#define PG8_STAGE(bufoff, gbase, voff) do { _Pragma("unroll") for (int _i = 0; _i < 2; ++_i) \
        __builtin_amdgcn_global_load_lds((const unsigned*)((const char*)(gbase) + (voff)[_i]), (PG8_LAS unsigned*)(lds + (bufoff) + ldsw + _i * 8192), 16, 0, 0); } while (0)
#define PG8_LDA(dst, b, h) do { _Pragma("unroll") for (int m = 0; m < 4; ++m) _Pragma("unroll") for (int k = 0; k < 2; ++k) dst[m][k] = *(const PG8_LAS bf16x8*)(lds + PG8_SA(b, h) + aoff + m * 2048 + k * 1024); } while (0)
#define PG8_LDB(dst, b, h) do { _Pragma("unroll") for (int n = 0; n < 2; ++n) _Pragma("unroll") for (int k = 0; k < 2; ++k) dst[n][k] = *(const PG8_LAS bf16x8*)(lds + PG8_SB(b, h) + boff + n * 2048 + k * 1024); } while (0)
#define PG8_MMA(ai, bj, At, Bt) do { __builtin_amdgcn_s_setprio(1); _Pragma("unroll") for (int m = 0; m < 4; ++m) _Pragma("unroll") for (int n = 0; n < 2; ++n) _Pragma("unroll") for (int k = 0; k < 2; ++k) \
        acc[ai][bj][m][n] = __builtin_amdgcn_mfma_f32_16x16x32_bf16(Bt[n][k], At[m][k], acc[ai][bj][m][n], 0, 0, 0); __builtin_amdgcn_s_setprio(0); } while (0)
#define PG8_WAIT_V(n) asm volatile("s_waitcnt vmcnt(" #n ")" ::: "memory")
#define PG8_WAIT_L(n) asm volatile("s_waitcnt lgkmcnt(" #n ")" ::: "memory")
#define PG8_BAR __builtin_amdgcn_s_barrier()
#define PG8_SCHED __builtin_amdgcn_sched_barrier(0)
    Unit cur, nxt; int ui = 0;
    if (!S.next(0, cur)) return;
    f32x4 acc[2][2][4][2];
#pragma unroll
    for (int a = 0; a < 2; ++a)
#pragma unroll
        for (int b = 0; b < 2; ++b)
#pragma unroll
            for (int m = 0; m < 4; ++m)
#pragma unroll
                for (int n = 0; n < 2; ++n) acc[a][b][m][n] = (f32x4){0.f, 0.f, 0.f, 0.f};
    bf16x8 At[4][2], B0[2][2], B1[2][2];
    const char* cA = (const char*)g.A + (size_t)cur.pm * tstepA; const char* cB = (const char*)g.Bt + (size_t)cur.pn * tstepB;
    S.a_ready(cur);
    if constexpr (SP2) {
        PG8_STAGE(PG8_SB(0, 0), cB, voffB); PG8_STAGE(PG8_SB(0, 1), cB + hstepB, voffB); PG8_STAGE(PG8_SA(0, 0), cA, voffA); PG8_STAGE(PG8_SA(0, 1), cA + hstepA, voffA);
        if (wr == 1) PG8_BAR;
        PG8_WAIT_V(2); PG8_BAR;
        PG8_STAGE(PG8_SB(1, 0), cB + kstep, voffB); PG8_STAGE(PG8_SA(1, 0), cA + kstep, voffA); PG8_STAGE(PG8_SB(1, 1), cB + hstepB + kstep, voffB);
        PG8_WAIT_V(6); PG8_BAR;
    } else {
        PG8_STAGE(PG8_SB(0, 0), cB, voffB); PG8_STAGE(PG8_SA(0, 0), cA, voffA); PG8_STAGE(PG8_SB(0, 1), cB + hstepB, voffB); PG8_STAGE(PG8_SA(0, 1), cA + hstepA, voffA);
        if (wr == 1) PG8_BAR;
        PG8_WAIT_V(4); PG8_BAR;
        PG8_STAGE(PG8_SB(1, 0), cB + kstep, voffB); PG8_STAGE(PG8_SA(1, 0), cA + kstep, voffA); PG8_STAGE(PG8_SB(1, 1), cB + hstepB + kstep, voffB);
        PG8_WAIT_V(6); PG8_BAR;
    }
    for (;;) {
        const bool has_next = S.next(ui + 1, nxt);
        const char* nA = has_next ? (const char*)g.A + (size_t)nxt.pm * tstepA : cA; const char* nB = has_next ? (const char*)g.Bt + (size_t)nxt.pn * tstepB : cB;
        for (int t = 0; t < nt; t += 2) {
            const bool last = (t == nt - 2);
            const char* a1 = cA + (size_t)(t + 1) * kstep;
            const char* a2 = last ? nA : cA + (size_t)(t + 2) * kstep; const char* b2 = last ? nB : cB + (size_t)(t + 2) * kstep;
            const char* a3 = a2 + kstep; const char* b3 = b2 + kstep;
            if (last && has_next) S.a_ready(nxt);
            if constexpr (SP2) {
            PG8_LDB(B0, 0, 0); PG8_LDB(B1, 0, 1); PG8_SCHED; PG8_LDA(At, 0, 0); PG8_STAGE(PG8_SA(1, 1), a1 + hstepA, voffA);
            PG8_WAIT_V(8); PG8_WAIT_L(0); PG8_BAR; PG8_MMA(0, 0, At, B0); PG8_MMA(0, 1, At, B1); PG8_BAR; PG8_SCHED;
            PG8_LDA(At, 0, 1); PG8_STAGE(PG8_SB(0, 0), b2, voffB); PG8_STAGE(PG8_SB(0, 1), b2 + hstepB, voffB); PG8_STAGE(PG8_SA(0, 0), a2, voffA);
            PG8_WAIT_V(8); PG8_WAIT_L(0); PG8_BAR; PG8_MMA(1, 0, At, B0); PG8_MMA(1, 1, At, B1); PG8_BAR; PG8_SCHED;
            PG8_LDB(B0, 1, 0); PG8_LDB(B1, 1, 1); PG8_SCHED; PG8_LDA(At, 1, 0); PG8_STAGE(PG8_SA(0, 1), a2 + hstepA, voffA);
            PG8_WAIT_V(8); PG8_WAIT_L(0); PG8_BAR; PG8_MMA(0, 0, At, B0); PG8_MMA(0, 1, At, B1); PG8_BAR; PG8_SCHED;
            PG8_LDA(At, 1, 1); PG8_STAGE(PG8_SB(1, 0), b3, voffB); PG8_STAGE(PG8_SB(1, 1), b3 + hstepB, voffB); PG8_STAGE(PG8_SA(1, 0), a3, voffA);
            PG8_WAIT_V(8); PG8_WAIT_L(0); PG8_BAR; PG8_MMA(1, 0, At, B0); PG8_MMA(1, 1, At, B1); PG8_BAR; PG8_SCHED;
            } else {
            PG8_LDB(B0, 0, 0); PG8_SCHED; PG8_LDA(At, 0, 0); PG8_STAGE(PG8_SA(1, 1), a1 + hstepA, voffA);
            PG8_WAIT_L(8); PG8_BAR; PG8_WAIT_L(0); PG8_MMA(0, 0, At, B0); PG8_BAR; PG8_SCHED;
            PG8_LDB(B1, 0, 1); PG8_STAGE(PG8_SB(0, 0), b2, voffB);
            PG8_BAR; PG8_WAIT_L(0); PG8_MMA(0, 1, At, B1); PG8_BAR;
            PG8_LDA(At, 0, 1); PG8_STAGE(PG8_SA(0, 0), a2, voffA);
            PG8_BAR; PG8_WAIT_L(0); PG8_MMA(1, 0, At, B0); PG8_BAR; PG8_SCHED;
            PG8_STAGE(PG8_SB(0, 1), b2 + hstepB, voffB);
            PG8_WAIT_V(6); PG8_BAR; PG8_MMA(1, 1, At, B1); PG8_BAR;
            PG8_LDB(B0, 1, 0); PG8_SCHED; PG8_LDA(At, 1, 0); PG8_STAGE(PG8_SA(0, 1), a2 + hstepA, voffA);
            PG8_WAIT_L(8); PG8_BAR; PG8_WAIT_L(0); PG8_MMA(0, 0, At, B0); PG8_BAR; PG8_SCHED;
            PG8_LDB(B1, 1, 1); PG8_STAGE(PG8_SB(1, 0), b3, voffB);
            PG8_BAR; PG8_WAIT_L(0); PG8_MMA(0, 1, At, B1); PG8_BAR;
            PG8_LDA(At, 1, 1); PG8_STAGE(PG8_SA(1, 0), a3, voffA);
            PG8_BAR; PG8_WAIT_L(0); PG8_MMA(1, 0, At, B0); PG8_BAR; PG8_SCHED;
            PG8_STAGE(PG8_SB(1, 1), b3 + hstepB, voffB);
            PG8_WAIT_V(6); PG8_BAR; PG8_MMA(1, 1, At, B1); PG8_BAR;
            }
        }
        if constexpr (ALIGN_EPI) { if (wr == 0) PG8_BAR; }
        if constexpr (!Epi::AFTER_DRAIN) { E(acc, cur, wr, wc, fr, fq); S.done(cur); }
        if (!has_next) break;
#pragma unroll
        for (int a = 0; a < 2; ++a)
#pragma unroll
            for (int b = 0; b < 2; ++b)
#pragma unroll
                for (int m = 0; m < 4; ++m)
#pragma unroll
                    for (int n = 0; n < 2; ++n) acc[a][b][m][n] = (f32x4){0.f, 0.f, 0.f, 0.f};
        cur = nxt; cA = nA; cB = nB; ++ui;
        if constexpr (ALIGN_EPI) { if (wr == 1) PG8_BAR; }
    }
    PG8_WAIT_V(0);
    if constexpr (!ALIGN_EPI) { if (wr == 0) PG8_BAR; }
    PG8_BAR;
    if constexpr (Epi::AFTER_DRAIN) { E.fused(acc, cur, wr, wc, fr, fq, lds, wid, lane); S.done(cur); }
#undef PG8_SA
#undef PG8_SB
#undef PG8_STAGE
#undef PG8_LDA
#undef PG8_LDB
#undef PG8_MMA
#undef PG8_WAIT_V
#undef PG8_WAIT_L
#undef PG8_BAR
#undef PG8_SCHED
}
}

namespace att {
typedef unsigned short bf16;
using bf16x8 = __attribute__((ext_vector_type(8))) short;
using s16x4  = __attribute__((ext_vector_type(4))) short;
using f32x16 = __attribute__((ext_vector_type(16))) float;
using u32x4  = __attribute__((ext_vector_type(4))) unsigned;
constexpr int   D = 128, NW = 8, QBLK = 32, KVBLK = 64;
constexpr float SCALE = 0.088388347648318440f;
constexpr float THR = 8.f;
constexpr int SHM_V = KVBLK * D * 2, SHM_K = KVBLK * D * 2, SHM_ATTN = 2 * SHM_V + 2 * SHM_K + NW * 64 * 4;
#define KSWZ(row, colB) ((row) * 256 + ((colB) ^ (((row) & 7) << 4)))
#define SBAR() __builtin_amdgcn_sched_barrier(0)
__device__ __forceinline__ int crow(int r, int hi) { return (r & 3) + 8 * (r >> 2) + 4 * hi; }
__device__ __forceinline__ unsigned cvtpk(float lo, float hi) { unsigned r; asm volatile("v_cvt_pk_bf16_f32 %0, %1, %2" : "=v"(r) : "v"(lo), "v"(hi)); return r; }

__device__ __forceinline__ void wmask(f32x16& p0, f32x16& p1, int kpos0, int qp, int hi) {
  const bool oob = (kpos0 < 0) || (kpos0 >= 4096);
  const int base = kpos0 - qp + 128;
#pragma unroll
  for (int r = 0; r < 16; ++r) { const int c = crow(r, hi);
    if (oob || (unsigned)(base + c) > 256u) p0[r] = -1e30f;
    if (oob || (unsigned)(base + 32 + c) > 256u) p1[r] = -1e30f; }
}
__device__ __forceinline__ void partialSM(f32x16& p0, f32x16& p1, float& m_reg, float& mn, float& alpha) {
  constexpr float C = SCALE * 1.4426950408889634f;
  float pmax = p0[0];
#pragma unroll
  for (int r = 1; r < 16; ++r) pmax = fmaxf(pmax, p0[r]);
#pragma unroll
  for (int r = 0; r < 16; ++r) pmax = fmaxf(pmax, p1[r]);
  { auto rr = __builtin_amdgcn_permlane32_swap(__float_as_uint(pmax), __float_as_uint(pmax), false, false);
    pmax = fmaxf(__uint_as_float(rr[0]), __uint_as_float(rr[1])); }
  if (__builtin_expect(__all(pmax - m_reg <= THR / SCALE), 1)) { mn = m_reg; alpha = 1.f; }
  else { mn = fmaxf(m_reg, pmax); alpha = __builtin_amdgcn_exp2f((m_reg - mn) * C); m_reg = mn; }
  float mnC = -mn * C;
#pragma unroll
  for (int r = 0; r < 16; ++r) p0[r] = fmaf(p0[r], C, mnC);
#pragma unroll
  for (int r = 0; r < 16; ++r) p1[r] = fmaf(p1[r], C, mnC);
#pragma unroll
  for (int r = 0; r < 16; ++r) p0[r] = __builtin_amdgcn_exp2f(p0[r]);
}
__device__ __forceinline__ void finishSM(f32x16& p0, f32x16& p1, float alpha, float& l_reg, bf16x8& pa0, bf16x8& pa1, bf16x8& pa2, bf16x8& pa3) {
#pragma unroll
  for (int r = 0; r < 16; ++r) p1[r] = __builtin_amdgcn_exp2f(p1[r]);
  float ps = 0;
#pragma unroll
  for (int r = 0; r < 16; ++r) ps += p0[r];
#pragma unroll
  for (int r = 0; r < 16; ++r) ps += p1[r];
  { auto rr = __builtin_amdgcn_permlane32_swap(__float_as_uint(ps), __float_as_uint(ps), false, false);
    ps = __uint_as_float(rr[0]) + __uint_as_float(rr[1]); }
  l_reg = l_reg * alpha + ps;
#define PK4(P, BASE, OUT) do { unsigned a0 = cvtpk(P[BASE + 0], P[BASE + 1]), a1 = cvtpk(P[BASE + 2], P[BASE + 3]);   \
    unsigned b0 = cvtpk(P[BASE + 4], P[BASE + 5]), b1 = cvtpk(P[BASE + 6], P[BASE + 7]);                              \
    auto r0 = __builtin_amdgcn_permlane32_swap(a0, b0, false, false); auto r1 = __builtin_amdgcn_permlane32_swap(a1, b1, false, false); \
    u32x4 w = {r0[0], r1[0], r0[1], r1[1]}; OUT = *reinterpret_cast<bf16x8*>(&w); } while (0)
  PK4(p0, 0, pa0); PK4(p0, 8, pa1); PK4(p1, 0, pa2); PK4(p1, 8, pa3);
#undef PK4
}
__device__ __forceinline__ void qkt(f32x16& p0, f32x16& p1, const bf16* Ks, const bf16x8* qr, int r32, int hi) {
  p0 = f32x16{}; p1 = f32x16{};
#pragma unroll
  for (int d0 = 0; d0 < 8; ++d0) { int cb = (d0 * 16 + hi * 8) * 2;
    bf16x8 b0 = *reinterpret_cast<const bf16x8*>((const char*)Ks + KSWZ(r32, cb));
    bf16x8 b1 = *reinterpret_cast<const bf16x8*>((const char*)Ks + KSWZ(32 + r32, cb));
    p0 = __builtin_amdgcn_mfma_f32_32x32x16_bf16(b0, qr[d0], p0, 0, 0, 0);
    p1 = __builtin_amdgcn_mfma_f32_32x32x16_bf16(b1, qr[d0], p1, 0, 0, 0); }
}
__device__ __forceinline__ int v_st(int k, int c) { const int kk = (k & ~0xC) | ((k & 4) << 1) | ((k & 8) >> 1); return ((kk >> 3) * 4 + (c >> 5)) * 512 + ((kk & 7) * 32 + (c & 31)) * 2; }
__device__ __forceinline__ int v_rd_base(int lane) { return ((lane & 3) << 3) | (((lane >> 2) & 3) << 6) | (((lane >> 4) & 1) << 5) | (((lane >> 5) & 1) << 8); }
constexpr int v_rd_off(int d0, int ks, int half) { return d0 * 512 + ks * 4096 + half * 2048; }
template <int OFF> __device__ __forceinline__ s16x4 tr_read(int vb) {
  s16x4 r; asm volatile("ds_read_b64_tr_b16 %0, %1 offset:%2" : "=&v"(r) : "v"(vb), "i"(OFF) : "memory"); return r;
}
template <int D0> __device__ __forceinline__ void pv_one(f32x16& od, int vb, bf16x8 pa0, bf16x8 pa1, bf16x8 pa2, bf16x8 pa3) {
  const s16x4 l0 = tr_read<v_rd_off(D0, 0, 0)>(vb), h0 = tr_read<v_rd_off(D0, 0, 1)>(vb), l1 = tr_read<v_rd_off(D0, 1, 0)>(vb), h1 = tr_read<v_rd_off(D0, 1, 1)>(vb);
  const s16x4 l2 = tr_read<v_rd_off(D0, 2, 0)>(vb), h2 = tr_read<v_rd_off(D0, 2, 1)>(vb), l3 = tr_read<v_rd_off(D0, 3, 0)>(vb), h3 = tr_read<v_rd_off(D0, 3, 1)>(vb);
  asm volatile("s_waitcnt lgkmcnt(0)" ::: "memory"); SBAR();
#define PK(L, H) (bf16x8){L[0], L[1], L[2], L[3], H[0], H[1], H[2], H[3]}
  od = __builtin_amdgcn_mfma_f32_32x32x16_bf16(pa0, PK(l0, h0), od, 0, 0, 0);
  od = __builtin_amdgcn_mfma_f32_32x32x16_bf16(pa1, PK(l1, h1), od, 0, 0, 0);
  od = __builtin_amdgcn_mfma_f32_32x32x16_bf16(pa2, PK(l2, h2), od, 0, 0, 0);
  od = __builtin_amdgcn_mfma_f32_32x32x16_bf16(pa3, PK(l3, h3), od, 0, 0, 0);
#undef PK
}
__device__ __forceinline__ void pv_d0(f32x16* o, int vb, bf16x8 pa0, bf16x8 pa1, bf16x8 pa2, bf16x8 pa3) {
  pv_one<0>(o[0], vb, pa0, pa1, pa2, pa3); pv_one<1>(o[1], vb, pa0, pa1, pa2, pa3); pv_one<2>(o[2], vb, pa0, pa1, pa2, pa3); pv_one<3>(o[3], vb, pa0, pa1, pa2, pa3);
}

struct Args {
  const bf16* qkv; int ld;
  int qrow0, qcol, kcol, vcol;
  int ctxrow0, latrow0;
  int kstart, n0, n1;
  int qpos0;
  float sink; int has_sink;
  void* out; int ldo, ocol;
};

template <bool WINDOW, bool OUT_BF16, int LD>
__device__ __forceinline__ void attn_unit(const Args& a, char* lds) {
  const int tid = pg8::opaque_tid(), wid = tid >> 6, lane = tid & 63, r32 = lane & 31, hi = lane >> 5;
  bf16* V_lds = (bf16*)lds; bf16* K_lds = (bf16*)(lds + 2 * SHM_V);
  float* ws = (float*)(lds + 2 * SHM_V + 2 * SHM_K) + wid * 64; float* li_l = ws; float* al_l = ws + 32;
  float m_reg = a.has_sink ? a.sink * (1.0f / SCALE) : -1e30f, l_reg = a.has_sink ? 1.0f : 0.0f; f32x16 o[4] = {}; bf16x8 qr[8];
  const bf16* Qw = a.qkv + (long)(a.qrow0 + wid * QBLK + r32) * LD + a.qcol + hi * 8;
#pragma unroll
  for (int d0 = 0; d0 < 8; ++d0) qr[d0] = *reinterpret_cast<const bf16x8*>(Qw + d0 * 16);
  const int sr = tid >> 4, sc = (tid & 15) * 8, vst0 = v_st(sr, sc), vst1 = v_st(32 + sr, sc);
  const int vb0 = (int)(uintptr_t)V_lds + v_rd_base(lane);
  const int qp = a.qpos0 + wid * QBLK + r32;
  const unsigned soff0 = (unsigned)(sr * LD + sc) * 2u, soff1 = soff0 + 32u * LD * 2u;
  struct { bf16x8 vs0, vs1, ks0, ks1; } sr_[2];
#define TROW(t) ((t) < a.n0 ? a.ctxrow0 + (t) * KVBLK : a.latrow0 + min(max(a.kstart + ((t) - a.n0) * KVBLK, 0), 4096 - KVBLK))
#define SLOAD(i, t) do { const char* tb_ = (const char*)a.qkv + (size_t)TROW(t) * (LD * 2); const char* tv_ = tb_ + a.vcol * 2; const char* tk_ = tb_ + a.kcol * 2; \
    sr_[i].vs0 = *reinterpret_cast<const bf16x8*>(tv_ + soff0); sr_[i].vs1 = *reinterpret_cast<const bf16x8*>(tv_ + soff1); \
    sr_[i].ks0 = *reinterpret_cast<const bf16x8*>(tk_ + soff0); sr_[i].ks1 = *reinterpret_cast<const bf16x8*>(tk_ + soff1); } while (0)
#define SWRITE(b, i) do { *(bf16x8*)((char*)V_lds + (b) * SHM_V + vst0) = sr_[i].vs0;          \
    *(bf16x8*)((char*)V_lds + (b) * SHM_V + vst1) = sr_[i].vs1; int kc = sc * 2;               \
    *(bf16x8*)((char*)K_lds + (b) * SHM_K + KSWZ(sr, kc)) = sr_[i].ks0;                       \
    *(bf16x8*)((char*)K_lds + (b) * SHM_K + KSWZ(32 + sr, kc)) = sr_[i].ks1; } while (0)
#define SWAIT() asm volatile("s_waitcnt vmcnt(4)" ::: "memory")
#define RESC(al) do { if (__any((al) < 1.f)) { if (hi == 0) al_l[r32] = (al); asm volatile("s_waitcnt lgkmcnt(0)" ::: "memory"); \
    _Pragma("unroll") for (int d = 0; d < 4; ++d) _Pragma("unroll") for (int r = 0; r < 16; ++r) o[d][r] *= al_l[crow(r, hi)]; } } while (0)
#define WMASK(P0, P1, t) do { if (WINDOW) { if ((t) >= a.n0) wmask(P0, P1, a.kstart + ((t) - a.n0) * KVBLK, qp, hi); } } while (0)
  f32x16 pA0, pA1, pB0, pB1; float mnA, mnB, alA, alB; bf16x8 pa0, pa1, pa2, pa3; const int NT = a.n0 + a.n1;
  constexpr int SE = 0, SO = 1;
  SLOAD(SE, 0); asm volatile("s_waitcnt vmcnt(0)" ::: "memory"); SWRITE(0, SE); __syncthreads();
  qkt(pA0, pA1, K_lds, qr, r32, hi); WMASK(pA0, pA1, 0); partialSM(pA0, pA1, m_reg, mnA, alA);
  SLOAD(SO, 1); if (2 < NT) SLOAD(SE, 2);
  SWAIT(); SWRITE(1, SO); __syncthreads();
  for (int j = 1; j + 1 < NT; j += 2) {
    SBAR(); qkt(pB0, pB1, (bf16*)((char*)K_lds + SHM_K), qr, r32, hi);
    finishSM(pA0, pA1, alA, l_reg, pa0, pa1, pa2, pa3); SBAR();
    SLOAD(SO, j + 2); SBAR();
    pv_d0(o, vb0, pa0, pa1, pa2, pa3); WMASK(pB0, pB1, j); partialSM(pB0, pB1, m_reg, mnB, alB);
    __syncthreads(); SWAIT(); SWRITE(0, SE);
    RESC(alB); __syncthreads();
    SBAR(); qkt(pA0, pA1, K_lds, qr, r32, hi);
    finishSM(pB0, pB1, alB, l_reg, pa0, pa1, pa2, pa3); SBAR();
    if (j + 3 < NT) SLOAD(SE, j + 3); SBAR();
    pv_d0(o, vb0 + (int)SHM_V, pa0, pa1, pa2, pa3); WMASK(pA0, pA1, j + 1); partialSM(pA0, pA1, m_reg, mnA, alA);
    __syncthreads(); SWAIT(); SWRITE(1, SO);
    RESC(alA); __syncthreads();
  }
  SBAR(); qkt(pB0, pB1, (bf16*)((char*)K_lds + SHM_K), qr, r32, hi);
  finishSM(pA0, pA1, alA, l_reg, pa0, pa1, pa2, pa3); SBAR();
  pv_d0(o, vb0, pa0, pa1, pa2, pa3); WMASK(pB0, pB1, NT - 1); partialSM(pB0, pB1, m_reg, mnB, alB);
  __syncthreads(); RESC(alB);
  finishSM(pB0, pB1, alB, l_reg, pa0, pa1, pa2, pa3); SBAR();
  pv_d0(o, vb0 + (int)SHM_V, pa0, pa1, pa2, pa3);
  if (hi == 0) li_l[r32] = l_reg; asm volatile("s_waitcnt lgkmcnt(0)" ::: "memory");
  float rli[16];
#pragma unroll
  for (int r = 0; r < 16; ++r) rli[r] = __builtin_amdgcn_rcpf(li_l[crow(r, hi)]);
  if (OUT_BF16) {
    bf16* Ow = (bf16*)a.out + (long)(a.qrow0 + wid * QBLK) * a.ldo + a.ocol;
#pragma unroll
    for (int r = 0; r < 16; ++r) { const int orow = crow(r, hi);
#pragma unroll
      for (int d0 = 0; d0 < 4; ++d0) Ow[(long)orow * a.ldo + d0 * 32 + r32] = (bf16)(cvtpk(o[d0][r] * rli[r], 0.f) & 0xffffu); }
  } else {
    float* Ow = (float*)a.out + (long)(a.qrow0 + wid * QBLK) * a.ldo + a.ocol;
#pragma unroll
    for (int r = 0; r < 16; ++r) { const int orow = crow(r, hi);
#pragma unroll
      for (int d0 = 0; d0 < 4; ++d0) Ow[(long)orow * a.ldo + d0 * 32 + r32] = o[d0][r] * rli[r]; }
  }
  __syncthreads();
#undef TROW
#undef SLOAD
#undef SWRITE
#undef SWAIT
#undef RESC
#undef WMASK
}
#undef KSWZ
#undef SBAR
}

constexpr int NWAVES = 8;
constexpr int DM = 2048, NBATCH = 2, SEQ = 4096, MLAT = NBATCH * SEQ, CTXL = 256, MCTX = NBATCH * CTXL, MALL = MLAT + MCTX;
constexpr int DFF = 5504, NFC1 = 2 * DFF, NLAYER = 4, NMODC = 9 * DM;
constexpr int A_N = 3072, B_N = 12288, B_W = 6144, C_N = 6144;
constexpr float EPS = 1e-6f;
constexpr size_t MiB = 1u << 20;
constexpr size_t WS_CTL = 0, CTL_BYTES = 2 * MiB;
constexpr size_t WS_MODT = 2 * MiB;
constexpr size_t WS_ROPE = 3 * MiB;
constexpr size_t WS_XC = 5 * MiB;
constexpr size_t WS_STATS = 9 * MiB;
constexpr size_t WS_BSW = 10 * MiB;
constexpr size_t WS_SMALL = 10 * MiB + 512 * 1024;
constexpr int SM_SINK = 0, SM_VNG = 64, SM_VNB = SM_VNG + 6144, SM_BS = SM_VNB + 6144, SM_LQ1 = SM_BS + 1024, SM_LK1 = SM_LQ1 + 128, SM_LQ2 = SM_LK1 + 128, SM_LK2 = SM_LQ2 + 128, SM_SUBG = SM_LK2 + 128, SM_END = SM_SUBG + 256;
constexpr size_t WS_WFC1 = 11 * MiB;
constexpr size_t WS_WFC2 = WS_WFC1 + 344 * MiB;
constexpr size_t WS_WAIN = WS_WFC2 + 172 * MiB;
constexpr size_t WS_WAOUT = WS_WAIN + 24 * MiB;
constexpr size_t WS_WBIN = WS_WAOUT + 16 * MiB;
constexpr size_t WS_WBOUT = WS_WBIN + 48 * MiB;
constexpr size_t WS_WCIN = WS_WBOUT + 24 * MiB;
constexpr size_t WS_WCOUT = WS_WCIN + 24 * MiB;
constexpr size_t WS_H = WS_WCOUT + 8 * MiB;
constexpr size_t WS_HID = WS_H + 34 * MiB;
constexpr size_t WS_Y = WS_HID + 92 * MiB;
constexpr size_t WS_QKV = WS_Y + 68 * MiB;
constexpr size_t WS_AO = WS_QKV + 204 * MiB;
constexpr size_t WS_OC = WS_AO + 34 * MiB;
constexpr size_t WS_END = WS_OC + 136 * MiB;
static_assert((size_t)8 * NFC1 * DM * 2 <= 344 * MiB && (size_t)8 * DM * DFF * 2 <= 172 * MiB && (size_t)MALL * DFF * 2 <= 92 * MiB && (size_t)MALL * B_N * 2 <= 204 * MiB, "ws map");
constexpr int CW_BAR = 4096;
constexpr int RING_BYTES = 131072, MISC_OFF = RING_BYTES + 320, LDS_BYTES = 147456;

#define GAS __attribute__((address_space(1)))
#define LAS __attribute__((address_space(3)))
typedef unsigned short bf16;
typedef unsigned v4u __attribute__((ext_vector_type(4)));
typedef unsigned v2u __attribute__((ext_vector_type(2)));
typedef float f32x4 __attribute__((ext_vector_type(4)));
typedef short bf16x8 __attribute__((ext_vector_type(8)));
typedef float f32x16 __attribute__((ext_vector_type(16)));
#define LDS_WAIT() asm volatile("s_waitcnt lgkmcnt(0)" ::: "memory")
#define VM_WAIT() asm volatile("s_waitcnt vmcnt(0)" ::: "memory")
__device__ __forceinline__ unsigned f2bf(float f) { unsigned u = __builtin_bit_cast(unsigned, f); return (u + 0x7fffu + ((u >> 16) & 1u)) >> 16; }
__device__ __forceinline__ unsigned pk2(float lo, float hi) { return f2bf(lo) | (f2bf(hi) << 16); }
__device__ __forceinline__ float bf2f(unsigned short b) { return __builtin_bit_cast(float, ((unsigned)b) << 16); }
__device__ __forceinline__ float wave_sum(float v) {
#pragma unroll
    for (int o = 1; o < 64; o <<= 1) v += __shfl_xor(v, o);
    return v;
}

#define XB_TMO      128
#define XB_XCNT(j)  (256  + 64 * (j))
#define XB_XSUB(j)  (1280 + 64 * (j))
#define XB_XGEN(j)  (2304 + 64 * (j))
#define XB_TOP      3328
#define XB_TOPGEN   3392
#define XCD_BAR_WORDS 3456
#define XB_SPIN_CAP (1u << 18)

__device__ __forceinline__ unsigned xb_ld(unsigned* p)              { return __hip_atomic_load(p, __ATOMIC_RELAXED, __HIP_MEMORY_SCOPE_AGENT); }
__device__ __forceinline__ unsigned xb_add(unsigned* p, unsigned v) { return __hip_atomic_fetch_add(p, v, __ATOMIC_RELAXED, __HIP_MEMORY_SCOPE_AGENT); }
__device__ __forceinline__ unsigned xb_xcc_id() { return (unsigned)__builtin_amdgcn_s_getreg((3 << 11) | 20) & 0xFu; }
#define XB_SPIN(cond, bar) do { unsigned _sp = 0; while (cond) { __builtin_amdgcn_s_sleep(1); \
    if ((++_sp & 255u) == 0u) { if (xb_ld(&(bar)[XB_TMO])) break; if (_sp > XB_SPIN_CAP) { atomicAdd(&(bar)[XB_TMO], 1u); break; } } } } while (0)

struct XcdBarrier {
    unsigned* bar; unsigned x;
    volatile LAS unsigned* st;
};

__device__ __forceinline__ XcdBarrier xcd_barrier_post(unsigned* bar, volatile LAS unsigned* st) {
    XcdBarrier b; b.bar = bar; b.x = xb_xcc_id(); b.st = st;
    if (threadIdx.x == 0) (void)xb_add(&bar[XB_XCNT(b.x)], 1u);
    return b;
}
__device__ __forceinline__ void xcd_barrier_complete(unsigned* bar, unsigned x, unsigned& nloc, unsigned& nx) {
    const unsigned G = gridDim.x * gridDim.y * gridDim.z;
    unsigned sum, cnt, mine, sp = 0u;
    for (;;) {
        sum = 0u; cnt = 0u; mine = 0u;
#pragma unroll
        for (unsigned j = 0; j < 16; ++j) { const unsigned c = xb_ld(&bar[XB_XCNT(j)]); sum += c; cnt += (c > 0u) ? 1u : 0u; mine = (j == x) ? c : mine; }
        if (sum == G) break;
        __builtin_amdgcn_s_sleep(1);
        if ((++sp & 255u) == 0u) { if (xb_ld(&bar[XB_TMO])) break; if (sp > XB_SPIN_CAP) { atomicAdd(&bar[XB_TMO], 1u); break; } }
    }
    nloc = mine > 0u ? mine : 1u; nx = cnt > 0u ? cnt : 1u;
}

__device__ __forceinline__ void xcd_barrier(const XcdBarrier& b) {
    asm volatile("s_waitcnt vmcnt(0)" ::: "memory");
    __syncthreads();
    if (threadIdx.x == 0) {
        unsigned* bar = b.bar;
        __builtin_amdgcn_s_waitcnt(0);
        unsigned nloc = b.st[0], nx = b.st[1];
        if (nloc == 0u) { xcd_barrier_complete(bar, b.x, nloc, nx); b.st[0] = nloc; b.st[1] = nx; }
        const unsigned old = xb_add(&bar[XB_XSUB(b.x)], 1u);
        const unsigned gen = old / nloc;
        if (old + 1u == (gen + 1u) * nloc) {
            __builtin_amdgcn_fence(__ATOMIC_RELEASE, "agent");
            asm volatile("s_waitcnt vmcnt(0)" ::: "memory");
            const unsigned og = xb_add(&bar[XB_TOP], 1u);
            const unsigned tg = og / nx;
            if (og + 1u == (tg + 1u) * nx) xb_add(&bar[XB_TOPGEN], 1u);
            else XB_SPIN(xb_ld(&bar[XB_TOPGEN]) == tg, bar);
            __builtin_amdgcn_fence(__ATOMIC_ACQUIRE, "agent");
            xb_add(&bar[XB_XGEN(b.x)], 1u);
            asm volatile("s_waitcnt vmcnt(0)" ::: "memory");
        } else {
            XB_SPIN(xb_ld(&bar[XB_XGEN(b.x)]) == gen, bar);
            __builtin_amdgcn_fence(__ATOMIC_ACQUIRE, "agent");
            asm volatile("s_waitcnt vmcnt(0)" ::: "memory");
        }
    }
    __syncthreads();
}

__device__ __forceinline__ void transpose_item(const float* W, int K, int N, bf16* WT, int fc1map, LAS float* scr, int item, int lane) {
    const int nblk = N / 32, kb = item / nblk, nb = item % nblk, k0 = 64 * kb, n0 = 32 * nb;
    int rowbase = n0;
    if (fc1map) { rowbase = (n0 < DFF) ? 256 * (n0 / 128) + (n0 % 128) : 256 * ((n0 - DFF) / 128) + 128 + ((n0 - DFF) % 128); }
    float tv[32];
#pragma unroll
    for (int i = 0; i < 32; ++i) tv[i] = W[(size_t)(k0 + 2 * i + (lane >> 5)) * N + n0 + (lane & 31)];
#pragma unroll
    for (int i = 0; i < 32; ++i) scr[(2 * i + (lane >> 5)) * 33 + (lane & 31)] = tv[i];
    LDS_WAIT(); asm volatile("" ::: "memory");
    const int c = lane & 7;
#pragma unroll
    for (int j = 0; j < 4; ++j) { const int n = (lane >> 3) + 8 * j; const LAS float* s = scr + (8 * c) * 33 + n;
        v4u o; o.x = pk2(s[0 * 33], s[1 * 33]); o.y = pk2(s[2 * 33], s[3 * 33]); o.z = pk2(s[4 * 33], s[5 * 33]); o.w = pk2(s[6 * 33], s[7 * 33]);
        *(GAS v4u*)(WT + (size_t)(rowbase + n) * K + k0 + 8 * c) = o; }
    LDS_WAIT(); asm volatile("" ::: "memory");
}

struct KArgs { const float* in[25]; float* out; unsigned char* ws; int ph_lo, ph_hi, li; float lam_init; };

__device__ __forceinline__ float* modt(unsigned char* ws, int layer, int slot, int modrow, int which) { return (float*)(ws + WS_MODT) + ((size_t)(((layer * 3 + slot) * 3 + modrow) * 3 + which)) * DM; }

__device__ __forceinline__ void prologue_phase(const KArgs& args, LAS unsigned char* L, int bx, int G) {
    const int tid = pg8::opaque_tid(), lane = tid & 63, wave = __builtin_amdgcn_readfirstlane(tid >> 6);
    unsigned char* ws = args.ws;
    LAS float* sl = (LAS float*)L;
    for (int i = tid; i < 3 * DM; i += NWAVES * 64) { const int r = i / DM, k = i % DM; const float v = (r < 2) ? args.in[1][r * DM + k] : args.in[3][k]; sl[i] = v / (1.0f + expf(-v)); }
    __syncthreads();
    LAS float* part = (LAS float*)(L + 24576);
    for (int rep_ = 0; rep_ < (PROBE_ID == 11 ? 2 : 1); ++rep_)
    for (int item = bx; item < NLAYER * 72; item += G) {
        const int layer = item / 72, n0 = (item % 72) * 256;
        const float* W = args.in[4] + ((size_t)layer * DM + wave * 256) * NMODC + n0 + lane * 4;
        const LAS float* s0 = sl + wave * 256;
        f32x4 a0 = {0.f, 0.f, 0.f, 0.f}, a1 = a0, a2 = a0;
#pragma unroll 8
        for (int kk = 0; kk < 256; ++kk) { const f32x4 w = *(const f32x4*)(W + (size_t)kk * NMODC); a0 += w * s0[kk]; a1 += w * s0[DM + kk]; a2 += w * s0[2 * DM + kk]; }
        *(LAS f32x4*)(part + (wave * 3 + 0) * 256 + lane * 4) = a0; *(LAS f32x4*)(part + (wave * 3 + 1) * 256 + lane * 4) = a1; *(LAS f32x4*)(part + (wave * 3 + 2) * 256 + lane * 4) = a2;
        __syncthreads();
        for (int idx = tid; idx < 768; idx += NWAVES * 64) { const int r = idx >> 8, cc = idx & 255, n = n0 + cc; float m = args.in[5][layer * NMODC + n];
#pragma unroll
            for (int w = 0; w < 8; ++w) m += part[(w * 3 + r) * 256 + cc];
            const int k9 = n / DM, c = n % DM, s = k9 / 3, which = k9 % 3; const float* g = args.in[6] + (size_t)layer * 6 * DM;
            if (which == 0) modt(ws, layer, s, r, 2)[c] = m;
            else if (which == 1) modt(ws, layer, s, r, 1)[c] = g[(2 * s) * DM + c] * (1.0f + m);
            else modt(ws, layer, s, r, 0)[c] = (s == 1 ? 1.0f : 0.5f) * m * g[(2 * s + 1) * DM + c]; }
        __syncthreads();
    }
    {
        LAS float* scr = (LAS float*)(L + 49152 + wave * 8448);
        const int gw = bx * NWAVES + wave, NGW = G * NWAVES;
        constexpr int I_FC1 = (DM / 64) * (NFC1 / 32), I_FC2 = (DFF / 64) * (DM / 32), I_AIN = (DM / 64) * (A_N / 32), I_SQ = (DM / 64) * (DM / 32), I_BIN = (DM / 64) * (B_N / 32), I_BOUT = (B_W / 64) * (DM / 32), I_CIN = (DM / 64) * (C_N / 32);
        constexpr int NITEMS = 8 * I_FC1 + 8 * I_FC2 + 2 * I_AIN + 2 * I_SQ + I_BIN + I_BOUT + I_CIN + I_SQ;
        for (int rep_ = 0; rep_ < (PROBE_ID == 12 ? 2 : 1); ++rep_)
        for (int it = gw; it < NITEMS; it += NGW) {
            int r = it;
            if (r < 8 * I_FC1) { const int mat = r / I_FC1; transpose_item(args.in[7] + (size_t)mat * DM * NFC1, DM, NFC1, (bf16*)(ws + WS_WFC1) + (size_t)mat * NFC1 * DM, 1, scr, r % I_FC1, lane); continue; } r -= 8 * I_FC1;
            if (r < 8 * I_FC2) { const int mat = r / I_FC2; transpose_item(args.in[8] + (size_t)mat * DFF * DM, DFF, DM, (bf16*)(ws + WS_WFC2) + (size_t)mat * DM * DFF, 0, scr, r % I_FC2, lane); continue; } r -= 8 * I_FC2;
            if (r < 2 * I_AIN) { const int mat = r / I_AIN; transpose_item(args.in[9] + (size_t)mat * DM * A_N, DM, A_N, (bf16*)(ws + WS_WAIN) + (size_t)mat * A_N * DM, 0, scr, r % I_AIN, lane); continue; } r -= 2 * I_AIN;
            if (r < 2 * I_SQ) { const int mat = r / I_SQ; transpose_item(args.in[10] + (size_t)mat * DM * DM, DM, DM, (bf16*)(ws + WS_WAOUT) + (size_t)mat * DM * DM, 0, scr, r % I_SQ, lane); continue; } r -= 2 * I_SQ;
            if (r < I_BIN) { transpose_item(args.in[12], DM, B_N, (bf16*)(ws + WS_WBIN), 0, scr, r, lane); continue; } r -= I_BIN;
            if (r < I_BOUT) { transpose_item(args.in[17], B_W, DM, (bf16*)(ws + WS_WBOUT), 0, scr, r, lane); continue; } r -= I_BOUT;
            if (r < I_CIN) { transpose_item(args.in[18], DM, C_N, (bf16*)(ws + WS_WCIN), 0, scr, r, lane); continue; } r -= I_CIN;
            transpose_item(args.in[19], DM, DM, (bf16*)(ws + WS_WCOUT), 0, scr, r, lane);
        }
    }
    for (int rep_ = 0; rep_ < (PROBE_ID == 13 ? 2 : 1); ++rep_)
    for (int e = bx * NWAVES * 64 + tid; e < SEQ * 64; e += G * NWAVES * 64) { const int t = e >> 6, p = e & 63, pi = p & 31;
        const float inv = (float)pow(10000.0, -(double)pi / 32.0); const float ang = (float)((p < 32) ? (t >> 6) : (t & 63)) * inv;
        float* o = (float*)(ws + WS_ROPE) + (size_t)e * 2; o[0] = (float)cos((double)ang); o[1] = (float)sin((double)ang); }
    for (int e = bx * NWAVES * 64 + tid; e < 8 * 128 * 128; e += G * NWAVES * 64) ((bf16*)(ws + WS_BSW))[e] = (bf16)f2bf(args.in[15][e]);
    if (bx == 0) { float* sm = (float*)(ws + WS_SMALL);
        for (int e = tid; e < SM_END; e += NWAVES * 64) { float v = 0.f;
            if (e < SM_VNG) { if (e < 32) v = args.in[11][e]; }
            else if (e < SM_VNB) v = args.in[13][e - SM_VNG];
            else if (e < SM_BS) v = args.in[14][e - SM_VNB];
            else if (e < SM_LQ1) v = args.in[16][e - SM_BS];
            else if (e < SM_LK1) v = args.in[20][e - SM_LQ1];
            else if (e < SM_LQ2) v = args.in[21][e - SM_LK1];
            else if (e < SM_LK2) v = args.in[22][e - SM_LQ2];
            else if (e < SM_SUBG) v = args.in[23][e - SM_LK2];
            else v = args.in[24][e - SM_SUBG];
            sm[e] = v; } }
}

__device__ __forceinline__ void norm_phase(const float* xs_lat, const float* xs_ctx, float* xd_lat, float* xd_ctx, const bf16* Y, const float* postT, const float* preT, bf16* H, int nrows) {
    const int tid = pg8::opaque_tid(), lane = tid & 63, gw = blockIdx.x * NWAVES + __builtin_amdgcn_readfirstlane(tid >> 6), NGW = gridDim.x * NWAVES;
    for (int row = gw; row < nrows; row += NGW) {
        const int modrow = row < SEQ ? 0 : (row < MLAT ? 1 : 2);
        const float* xs = (row < MLAT) ? xs_lat + (size_t)row * DM : xs_ctx + (size_t)(row - MLAT) * DM;
        float* xd = (row < MLAT) ? xd_lat + (size_t)row * DM : xd_ctx + (size_t)(row - MLAT) * DM;
        f32x4 xv[8];
#pragma unroll
        for (int j = 0; j < 8; ++j) xv[j] = *(const f32x4*)(xs + 256 * j + 4 * lane);
        if (Y) {
            const bf16* yr = Y + (size_t)row * DM; const float* At = postT + (size_t)modrow * 3 * DM;
            f32x4 yv[8]; float ss = 0.f;
#pragma unroll
            for (int j = 0; j < 8; ++j) { const v2u raw = *(const v2u*)(yr + 256 * j + 4 * lane);
                yv[j].x = __builtin_bit_cast(float, raw.x << 16); yv[j].y = __builtin_bit_cast(float, raw.x & 0xffff0000u); yv[j].z = __builtin_bit_cast(float, raw.y << 16); yv[j].w = __builtin_bit_cast(float, raw.y & 0xffff0000u);
                ss += (yv[j].x * yv[j].x + yv[j].y * yv[j].y) + (yv[j].z * yv[j].z + yv[j].w * yv[j].w); }
            const float ry = 1.0f / sqrtf(wave_sum(ss) * (1.0f / DM) + EPS);
#pragma unroll
            for (int j = 0; j < 8; ++j) { const f32x4 a = *(const f32x4*)(At + 256 * j + 4 * lane); xv[j] += yv[j] * ry * a; }
        }
#pragma unroll
        for (int j = 0; j < 8; ++j) *(f32x4*)(xd + 256 * j + 4 * lane) = xv[j];
        if (H) {
            const float* Bt = preT + (size_t)(modrow * 3 + 1) * DM; const float* Ct = preT + (size_t)(modrow * 3 + 2) * DM;
            float ss = 0.f;
#pragma unroll
            for (int j = 0; j < 8; ++j) ss += (xv[j].x * xv[j].x + xv[j].y * xv[j].y) + (xv[j].z * xv[j].z + xv[j].w * xv[j].w);
            const float rx = 1.0f / sqrtf(wave_sum(ss) * (1.0f / DM) + EPS);
            bf16* hr = H + (size_t)row * DM;
#pragma unroll
            for (int j = 0; j < 8; ++j) { const f32x4 b = *(const f32x4*)(Bt + 256 * j + 4 * lane), c = *(const f32x4*)(Ct + 256 * j + 4 * lane); const f32x4 h = xv[j] * rx * b + c;
                v2u o; o.x = pk2(h.x, h.y); o.y = pk2(h.z, h.w); *(v2u*)(hr + 256 * j + 4 * lane) = o; }
        }
    }
}
__device__ __forceinline__ void vstats_phase(const bf16* QKV, float* stats, int nrows) {
    const int tid = pg8::opaque_tid(), lane = tid & 63, gw = blockIdx.x * NWAVES + __builtin_amdgcn_readfirstlane(tid >> 6), NGW = gridDim.x * NWAVES;
    for (int row = gw; row < nrows; row += NGW) {
        const bf16* vr = QKV + (size_t)row * B_N + B_W + lane * 8; bf16x8 raw[12]; float s = 0.f;
#pragma unroll
        for (int i = 0; i < 12; ++i) { raw[i] = *(const bf16x8*)(vr + i * 512);
#pragma unroll
            for (int e = 0; e < 8; ++e) s += bf2f((unsigned short)raw[i][e]); }
        const float mean = wave_sum(s) * (1.0f / B_W); float q = 0.f;
#pragma unroll
        for (int i = 0; i < 12; ++i)
#pragma unroll
            for (int e = 0; e < 8; ++e) { const float d = bf2f((unsigned short)raw[i][e]) - mean; q += d * d; }
        const float rstd = 1.0f / sqrtf(wave_sum(q) * (1.0f / B_W) + EPS);
        if (lane == 0) { stats[2 * row] = mean; stats[2 * row + 1] = rstd; }
    }
}
__device__ __forceinline__ void spatial_phase(const bf16* QKV, bf16* Gout, const bf16* BSW, const float* stats, const float* vg, const float* vb, const float* bs, char* lds, int nchunks, int bx, int G) {
    const int tid = pg8::opaque_tid(), lane = tid & 63, wave = __builtin_amdgcn_readfirstlane(tid >> 6), r32 = lane & 31, hi = lane >> 5;
    constexpr int OP = 132;
    float* Ob = (float*)(lds + 32768);
    const int sr = tid >> 4, sc = (tid & 15) * 8, pb = wave & 3, dh = wave >> 2;
    for (int u = bx; u < nchunks * 48; u += G) {
        const int cb = u % 6, g = (u / 6) & 7, ch = u / 48, row0 = ch * 128, c0 = g * 768 + cb * 128;
        bf16x8 ureg[4];
#pragma unroll
        for (int i = 0; i < 4; ++i) ureg[i] = *(const bf16x8*)(QKV + (size_t)(row0 + sr + 32 * i) * B_N + c0 + sc);
        { const f32x4 g0 = *(const f32x4*)(vg + c0 + sc), g1 = *(const f32x4*)(vg + c0 + sc + 4), b0 = *(const f32x4*)(vb + c0 + sc), b1 = *(const f32x4*)(vb + c0 + sc + 4);
#pragma unroll
          for (int i = 0; i < 4; ++i) { const int q = sr + 32 * i; const bf16x8 raw = *(const bf16x8*)(QKV + (size_t)(row0 + q) * B_N + B_W + c0 + sc);
              const float mu = stats[2 * (row0 + q)], rs = stats[2 * (row0 + q) + 1]; float t[8];
#pragma unroll
              for (int e = 0; e < 8; ++e) t[e] = (bf2f((unsigned short)raw[e]) - mu) * rs * (e < 4 ? g0[e & 3] : g1[e & 3]) + (e < 4 ? b0[e & 3] : b1[e & 3]);
              v4u w; w.x = pk2(t[0], t[1]); w.y = pk2(t[2], t[3]); w.z = pk2(t[4], t[5]); w.w = pk2(t[6], t[7]);
              *(v4u*)(lds + (i >> 1) * 16384 + att::v_st(sr + 32 * (i & 1), sc)) = w; } }
        __syncthreads();
        bf16x8 pa[2][4];
        { const bf16* Wg = BSW + (size_t)g * 16384 + (size_t)(pb * 32 + r32) * 128 + hi * 8;
#pragma unroll
          for (int kt = 0; kt < 2; ++kt)
#pragma unroll
              for (int kk = 0; kk < 4; ++kk) pa[kt][kk] = *(const bf16x8*)(Wg + kt * 64 + kk * 16); }
        f32x16 o0 = {}, o1 = {};
#pragma unroll
        for (int kt = 0; kt < 2; ++kt) { const int vbase = (int)(uintptr_t)(lds + kt * 16384) + att::v_rd_base(lane);
            if (dh == 0) { att::pv_one<0>(o0, vbase, pa[kt][0], pa[kt][1], pa[kt][2], pa[kt][3]); att::pv_one<1>(o1, vbase, pa[kt][0], pa[kt][1], pa[kt][2], pa[kt][3]); }
            else { att::pv_one<2>(o0, vbase, pa[kt][0], pa[kt][1], pa[kt][2], pa[kt][3]); att::pv_one<3>(o1, vbase, pa[kt][0], pa[kt][1], pa[kt][2], pa[kt][3]); } }
#pragma unroll
        for (int r = 0; r < 16; ++r) { const int p = pb * 32 + (r & 3) + 8 * (r >> 2) + 4 * hi; Ob[p * OP + dh * 64 + r32] = o0[r]; Ob[p * OP + dh * 64 + 32 + r32] = o1[r]; }
        __syncthreads();
#pragma unroll
        for (int i = 0; i < 4; ++i) { const int p = sr + 32 * i; const float bias = bs[g * 128 + p];
            const f32x4 x0 = *(const f32x4*)(Ob + p * OP + sc), x1 = *(const f32x4*)(Ob + p * OP + sc + 4); float t[8];
#pragma unroll
            for (int e = 0; e < 8; ++e) t[e] = bf2f((unsigned short)ureg[i][e]) * ((e < 4 ? x0[e & 3] : x1[e & 3]) + bias);
            v4u w; w.x = pk2(t[0], t[1]); w.y = pk2(t[2], t[3]); w.z = pk2(t[4], t[5]); w.w = pk2(t[6], t[7]);
            *(v4u*)(Gout + (size_t)(row0 + p) * B_W + c0 + sc) = w; }
        __syncthreads();
    }
}
__device__ __forceinline__ void combine_phase(const float* OC, bf16* AO, const float* lq1, const float* lk1, const float* lq2, const float* lk2, const float* sg, float lam_init, int nrows) {
    const int tid = pg8::opaque_tid(), lane = tid & 63, gw = blockIdx.x * NWAVES + __builtin_amdgcn_readfirstlane(tid >> 6), NGW = gridDim.x * NWAVES;
    const float d1 = wave_sum(lq1[lane] * lk1[lane] + lq1[lane + 64] * lk1[lane + 64]), d2 = wave_sum(lq2[lane] * lk2[lane] + lq2[lane + 64] * lk2[lane + 64]);
    const float lam = expf(d1) - expf(d2) + lam_init;
    const f32x4 gv = *(const f32x4*)(sg + 4 * lane) * (1.0f - lam_init);
    for (int row = gw; row < nrows; row += NGW) {
        const float* orow = OC + (size_t)row * 4096; bf16* ar = AO + (size_t)row * DM;
#pragma unroll
        for (int h = 0; h < 8; ++h) { const f32x4 a = *(const f32x4*)(orow + (2 * h) * 256 + 4 * lane), b = *(const f32x4*)(orow + (2 * h + 1) * 256 + 4 * lane); const f32x4 o = a - lam * b;
            const float rs = 1.0f / sqrtf(wave_sum((o.x * o.x + o.y * o.y) + (o.z * o.z + o.w * o.w)) * (1.0f / 256.0f) + EPS); const f32x4 v = o * rs * gv;
            v2u w; w.x = pk2(v.x, v.y); w.y = pk2(v.z, v.w); *(v2u*)(ar + h * 256 + 4 * lane) = w; }
    }
}

template <int K, int LDA>
__device__ __forceinline__ void ctx_tile(const bf16* A, const bf16* Bt, bf16* Yc, int tile, LAS unsigned char* L) {
    const int tid = pg8::opaque_tid(), lane = tid & 63, wave = __builtin_amdgcn_readfirstlane(tid >> 6), r32 = lane & 31, hi = lane >> 5;
    const int row0 = (tile >> 5) * 64, col0 = (tile & 31) * 64;
    constexpr int NB = K / 64;
    static_assert(K % 64 == 0, "K must be a multiple of 64");
    LAS unsigned char* W = L + wave * 16384;
    const int lr = lane >> 3, lc = lane & 7;
    const bf16* ag = A + (size_t)(row0 + lr) * LDA + lc * 8;
    const bf16* bg = Bt + (size_t)(col0 + lr) * K + lc * 8;
    const int wofs = lr * 128 + ((lc ^ (lr & 7)) << 4);
    const int rofs = r32 * 128;
    f32x16 acc00 = {}, acc01 = {}, acc10 = {}, acc11 = {};
    bf16x8 ga[8], gb[8];
    int kb = wave;
    if (kb < NB) {
#pragma unroll
        for (int i = 0; i < 8; ++i) { ga[i] = *(const bf16x8*)(ag + (size_t)(8 * i) * LDA + kb * 64); gb[i] = *(const bf16x8*)(bg + (size_t)(8 * i) * K + kb * 64); }
    }
    for (; kb < NB; kb += 8) {
#pragma unroll
        for (int i = 0; i < 8; ++i) { *(LAS bf16x8*)(W + i * 1024 + wofs) = ga[i]; *(LAS bf16x8*)(W + 8192 + i * 1024 + wofs) = gb[i]; }
        if (kb + 8 < NB) {
#pragma unroll
            for (int i = 0; i < 8; ++i) { ga[i] = *(const bf16x8*)(ag + (size_t)(8 * i) * LDA + (kb + 8) * 64); gb[i] = *(const bf16x8*)(bg + (size_t)(8 * i) * K + (kb + 8) * 64); }
        }
#pragma unroll
        for (int s = 0; s < 4; ++s) { const int ch = (((2 * s + hi) ^ (r32 & 7)) << 4);
            const bf16x8 a0 = *(const LAS bf16x8*)(W + rofs + ch), a1 = *(const LAS bf16x8*)(W + 4096 + rofs + ch), b0 = *(const LAS bf16x8*)(W + 8192 + rofs + ch), b1 = *(const LAS bf16x8*)(W + 12288 + rofs + ch);
            acc00 = __builtin_amdgcn_mfma_f32_32x32x16_bf16(a0, b0, acc00, 0, 0, 0); acc01 = __builtin_amdgcn_mfma_f32_32x32x16_bf16(a0, b1, acc01, 0, 0, 0);
            acc10 = __builtin_amdgcn_mfma_f32_32x32x16_bf16(a1, b0, acc10, 0, 0, 0); acc11 = __builtin_amdgcn_mfma_f32_32x32x16_bf16(a1, b1, acc11, 0, 0, 0); }
    }
    LDS_WAIT(); asm volatile("" ::: "memory");
    LAS float* red = (LAS float*)L + wave * 4096;
#pragma unroll
    for (int r = 0; r < 16; ++r) { const int m = (r & 3) + 8 * (r >> 2) + 4 * hi;
        red[m * 64 + r32] = acc00[r]; red[m * 64 + 32 + r32] = acc01[r]; red[(32 + m) * 64 + r32] = acc10[r]; red[(32 + m) * 64 + 32 + r32] = acc11[r]; }
    __syncthreads();
    { const int o = tid * 8, m = o >> 6, n = o & 63; f32x4 s0 = {0.f, 0.f, 0.f, 0.f}, s1 = s0;
#pragma unroll
      for (int w = 0; w < 8; ++w) { s0 += *(const LAS f32x4*)((LAS float*)L + w * 4096 + o); s1 += *(const LAS f32x4*)((LAS float*)L + w * 4096 + o + 4); }
      v4u w4; w4.x = pk2(s0.x, s0.y); w4.y = pk2(s0.z, s0.w); w4.z = pk2(s1.x, s1.y); w4.w = pk2(s1.z, s1.w);
      *(v4u*)(Yc + (size_t)(row0 + m) * DM + col0 + n) = w4; }
    __syncthreads();
}

__global__ void __launch_bounds__(NWAVES * 64, 2) fwd(KArgs args) {
    extern __shared__ __attribute__((aligned(16))) unsigned char lds[];
    LAS unsigned char* L = (LAS unsigned char*)lds;
    const int tid = threadIdx.x, G = gridDim.x, bx = blockIdx.x;
    unsigned char* ws0 = args.ws;
    for (int u = tid; u < (LDS_BYTES - RING_BYTES) / 4; u += NWAVES * 64) ((LAS unsigned*)(L + RING_BYTES))[u] = 0u;
    __syncthreads();
    const int lo = args.ph_lo, hi = args.ph_hi;
    XcdBarrier bar; bar.bar = (unsigned*)(ws0 + WS_CTL) + CW_BAR + args.li * XCD_BAR_WORDS; bar.x = 0; bar.st = (volatile LAS unsigned*)(L + MISC_OFF + 32);
    if (hi - lo > 1) bar = xcd_barrier_post((unsigned*)(ws0 + WS_CTL) + CW_BAR + args.li * XCD_BAR_WORDS, (volatile LAS unsigned*)(L + MISC_OFF + 32));
    int ph = 0;
#define PHASE_BEGIN if (ph >= lo && ph < hi) {
#define PHASE_END   if (ph + 1 < hi) xcd_barrier(bar); } ++ph;
#define SETUP_PTRS() GAS unsigned char* wsg_ = (GAS unsigned char*)args.ws; asm volatile("" : "+s"(wsg_)); unsigned char* ws = (unsigned char*)wsg_; \
    GAS float* xlg_ = (GAS float*)args.out; asm volatile("" : "+s"(xlg_)); float* XL = (float*)xlg_; float* XC = (float*)(ws + WS_XC); \
    bf16* H = (bf16*)(ws + WS_H); bf16* HID = (bf16*)(ws + WS_HID); bf16* Y = (bf16*)(ws + WS_Y); bf16* QKV = (bf16*)(ws + WS_QKV); bf16* AO = (bf16*)(ws + WS_AO); float* OC = (float*)(ws + WS_OC); \
    const float* ROPE = (const float*)(ws + WS_ROPE); const float* SM = (const float*)(ws + WS_SMALL); (void)XC; (void)HID; (void)Y; (void)QKV; (void)AO; (void)OC; (void)ROPE; (void)SM; (void)H

    { SETUP_PTRS();
    PHASE_BEGIN
#ifndef OFF_PRO
    prologue_phase(args, L, bx, G);
#endif
    PHASE_END
    PHASE_BEGIN norm_phase(args.in[0], args.in[2], XL, XC, nullptr, nullptr, modt(ws, 0, 0, 0, 0), H, MALL); PHASE_END }

    for (int sl = 0; sl < 3 * NLAYER; ++sl) {
        SETUP_PTRS();
        const int layer = sl / 3, typ = sl % 3, kind = layer % 3, jm = layer / 3; const bool lastl = (layer == NLAYER - 1);
        const int Mrows = (lastl && typ >= 1) ? MLAT : MALL;
        pg8::Gemm gy;
        if (typ != 1) {
            const int f = (typ == 0) ? 0 : 1;
            PHASE_BEGIN
                pg8::Gemm g{H, (const bf16*)(ws + WS_WFC1) + (size_t)(layer * 2 + f) * NFC1 * DM, Mrows, NFC1, DM, DM}; pg8::StaticOrder S; S.init(Mrows, NFC1, G, bx);
                pg8::EpiSwiglu E{HID, DFF};
                #ifndef OFF_FC1
                for (int rep_ = 0; rep_ < (PROBE_ID == 2 ? 2 : 1); ++rep_) { pg8::gemm_phase<pg8::EpiSwiglu, pg8::StaticOrder, true, true, DM, DM>(L, g, S, E); }
#endif
            PHASE_END
            gy = pg8::Gemm{HID, (const bf16*)(ws + WS_WFC2) + (size_t)(layer * 2 + f) * DM * DFF, Mrows, DM, DFF, DFF};
        } else {
            if (kind != 1) {
                PHASE_BEGIN
                    const int N = (kind == 0) ? A_N : C_N;
                    pg8::Gemm g{H, (kind == 0) ? (const bf16*)(ws + WS_WAIN) + (size_t)jm * A_N * DM : (const bf16*)(ws + WS_WCIN), MALL, N, DM, DM}; pg8::StaticOrder S; S.init(MALL, N, G, bx);
                    pg8::EpiBf16X<0> E{QKV, N, ROPE, (kind == 0) ? 2560 : 4096};
                    #ifndef OFF_ROPE
                    for (int rep_ = 0; rep_ < (PROBE_ID == 8 ? 2 : 1); ++rep_) { pg8::gemm_phase<pg8::EpiBf16X<0>, pg8::StaticOrder, true, true, DM, DM>(L, g, S, E); }
#endif
                PHASE_END
            } else {
                PHASE_BEGIN
                    pg8::Gemm g{H, (const bf16*)(ws + WS_WBIN), MALL, B_N, DM, DM}; pg8::StaticOrder S; S.init(MALL, B_N, G, bx);
                    pg8::EpiBf16X<1> E{QKV, B_N, nullptr, 0};
                    #ifndef OFF_GELU
                    for (int rep_ = 0; rep_ < (PROBE_ID == 9 ? 2 : 1); ++rep_) { pg8::gemm_phase<pg8::EpiBf16X<1>, pg8::StaticOrder, true, true, DM, DM>(L, g, S, E); }
#endif
                PHASE_END
            }
            if (kind == 0) {
                PHASE_BEGIN
                    const int nlat = NBATCH * 16 * 16, nall = nlat + (lastl ? 0 : NBATCH * 16);
                    for (int u = bx; u < nall; u += G) {
                        att::Args a; a.qkv = QKV; a.ld = A_N; a.n0 = 4; a.has_sink = 1; a.out = AO; a.ldo = DM;
                        if (u < nlat) { const int qb = u & 15, h = (u >> 4) & 15, b = u >> 8;
                            a.qrow0 = b * SEQ + qb * 256; a.qcol = h * 128; a.kcol = 2048 + (h >> 2) * 128; a.vcol = 2560 + (h >> 2) * 128; a.ctxrow0 = MLAT + b * CTXL; a.latrow0 = b * SEQ;
                            a.kstart = qb * 256 - 128; a.n1 = 8; a.qpos0 = qb * 256; a.sink = SM[SM_SINK + jm * 16 + h]; a.ocol = h * 128; }
                        else { const int cu = u - nlat, h = cu & 15, b = cu >> 4;
                            a.qrow0 = MLAT + b * CTXL; a.qcol = h * 128; a.kcol = 2048 + (h >> 2) * 128; a.vcol = 2560 + (h >> 2) * 128; a.ctxrow0 = MLAT + b * CTXL; a.latrow0 = b * SEQ;
                            a.kstart = 0; a.n1 = 0; a.qpos0 = 0; a.sink = SM[SM_SINK + jm * 16 + h]; a.ocol = h * 128; }
                        #ifndef OFF_ATTA
                        for (int rep_ = 0; rep_ < (PROBE_ID == 7 ? 2 : 1); ++rep_) { att::attn_unit<true, true, A_N>(a, (char*)lds); }
#endif
                    }
                PHASE_END
                gy = pg8::Gemm{AO, (const bf16*)(ws + WS_WAOUT) + (size_t)jm * DM * DM, Mrows, DM, DM, DM};
            } else if (kind == 1) {
                PHASE_BEGIN vstats_phase(QKV, (float*)(ws + WS_STATS), MALL); PHASE_END
                PHASE_BEGIN
spatial_phase(QKV, (bf16*)OC, (const bf16*)(ws + WS_BSW), (const float*)(ws + WS_STATS), SM + SM_VNG, SM + SM_VNB, SM + SM_BS, (char*)lds, MALL / 128, bx, G);
                PHASE_END
                gy = pg8::Gemm{(const bf16*)OC, (const bf16*)(ws + WS_WBOUT), Mrows, DM, B_W, B_W};
            } else {
                PHASE_BEGIN
                    const int nlat = NBATCH * 32 * 16, nall = nlat + (lastl ? 0 : NBATCH * 32);
                    for (int u = bx; u < nall; u += G) {
                        att::Args a; a.qkv = QKV; a.ld = C_N; a.n0 = 4; a.has_sink = 0; a.sink = 0.f; a.out = OC; a.ldo = 4096; a.kstart = 0; a.qpos0 = 0;
                        int b, combo;
                        if (u < nlat) { const int qb = u & 15; combo = (u >> 4) & 31; b = u >> 9; a.qrow0 = b * SEQ + qb * 256; a.n1 = 64; }
                        else { const int cu = u - nlat; combo = cu & 31; b = cu >> 5; a.qrow0 = MLAT + b * CTXL; a.n1 = 0; }
                        const int hc = combo >> 1, vh = combo & 1;
                        a.qcol = hc * 128; a.kcol = 2048 + hc * 128; a.vcol = 4096 + (hc >> 1) * 256 + vh * 128; a.ctxrow0 = MLAT + b * CTXL; a.latrow0 = b * SEQ; a.ocol = hc * 256 + vh * 128;
                        #ifndef OFF_ATTC
                        for (int rep_ = 0; rep_ < (PROBE_ID == 6 ? 2 : 1); ++rep_) { att::attn_unit<false, false, C_N>(a, (char*)lds); }
#endif
                    }
                PHASE_END
                PHASE_BEGIN combine_phase(OC, AO, SM + SM_LQ1, SM + SM_LK1, SM + SM_LQ2, SM + SM_LK2, SM + SM_SUBG, args.lam_init, MALL); PHASE_END
                gy = pg8::Gemm{AO, (const bf16*)(ws + WS_WCOUT), Mrows, DM, DM, DM};
            }
        }
        PHASE_BEGIN
            const bool hasctx = (gy.M == MALL); gy.M = MLAT;
            pg8::StaticOrder S; S.init(MLAT, DM, G, bx); pg8::EpiBf16X<2> E{Y, DM, nullptr, 0};
            bf16* Yc = Y + (size_t)MLAT * DM;
            if (typ != 1) { for (int rep_ = 0; rep_ < (PROBE_ID == 3 ? 2 : 1); ++rep_) { pg8::gemm_phase<pg8::EpiBf16X<2>, pg8::StaticOrder, true, true, DFF, DFF>(L, gy, S, E); }
                for (int rep_ = 0; rep_ < (PROBE_ID == 4 ? 2 : 1); ++rep_) { if (hasctx) for (int t = bx; t < 256; t += G) ctx_tile<DFF, DFF>(gy.A + (size_t)MLAT * DFF, gy.Bt, Yc, t, L); } }
            else if (kind == 1) { pg8::gemm_phase<pg8::EpiBf16X<2>, pg8::StaticOrder, true, true, B_W, B_W>(L, gy, S, E);
                if (hasctx) for (int t = bx; t < 256; t += G) ctx_tile<B_W, B_W>(gy.A + (size_t)MLAT * B_W, gy.Bt, Yc, t, L); }
            else { pg8::gemm_phase<pg8::EpiBf16X<2>, pg8::StaticOrder, true, true, DM, DM>(L, gy, S, E);
                if (hasctx) for (int t = bx; t < 256; t += G) ctx_tile<DM, DM>(gy.A + (size_t)MLAT * DM, gy.Bt, Yc, t, L); }
        PHASE_END
        PHASE_BEGIN
            const bool fin = (sl == 3 * NLAYER - 1);
            const int nl = (typ == 2) ? layer + 1 : layer, ns = (typ == 2) ? 0 : typ + 1;
            if (PROBE_ID == 5) norm_phase(XL, XC, (float*)(ws + WS_END), (float*)(ws + WS_END + 64 * MiB), Y, modt(ws, layer, typ, 0, 0), fin ? nullptr : modt(ws, nl, ns, 0, 0), fin ? nullptr : (bf16*)(ws + WS_END + 72 * MiB), Mrows);
            norm_phase(XL, XC, XL, XC, Y, modt(ws, layer, typ, 0, 0), fin ? nullptr : modt(ws, nl, ns, 0, 0), fin ? nullptr : H, Mrows);
        PHASE_END
    }
#undef PHASE_BEGIN
#undef PHASE_END
}

static int count_phases() { int n = 2; for (int sl = 0; sl < 3 * NLAYER; ++sl) { const int layer = sl / 3, typ = sl % 3, kind = layer % 3; n += (typ != 1) ? 3 : (kind == 0 ? 4 : 5); } return n; }
extern "C" void kernel_launch(void* const* d_in, const int* in_sizes, int n_in, void* d_out, int out_size, void* d_ws, size_t ws_size, hipStream_t stream) {
    static int grid = 0;
    if (grid == 0) {
        if (n_in != 25 || in_sizes[0] != MLAT * DM || out_size != MLAT * DM || ws_size < WS_END) { fprintf(stderr, "kernel_launch: unexpected shapes (n_in %d, in0 %d, out %d, ws %zu < %zu)\n", n_in, n_in > 0 ? in_sizes[0] : -1, out_size, ws_size, (size_t)WS_END); grid = -1; return; }
        int dev = 0, cus = 0, per_cu = 0;
        if (hipGetDevice(&dev) != hipSuccess || hipDeviceGetAttribute(&cus, hipDeviceAttributeMultiprocessorCount, dev) != hipSuccess) { grid = -1; return; }
        if (hipFuncSetAttribute((const void*)fwd, hipFuncAttributeMaxDynamicSharedMemorySize, LDS_BYTES) != hipSuccess) { fprintf(stderr, "kernel_launch: hipFuncSetAttribute failed\n"); grid = -1; return; }
        if (hipOccupancyMaxActiveBlocksPerMultiprocessor(&per_cu, (const void*)fwd, NWAVES * 64, LDS_BYTES) != hipSuccess || per_cu < 1) fprintf(stderr, "kernel_launch: occupancy query reports %d\n", per_cu);
        (void)hipGetLastError();
        grid = cus;
    }
    if (grid < 0) return;
    if (hipMemsetAsync((char*)d_ws + WS_CTL, 0, CTL_BYTES, stream) != hipSuccess) return;
    KArgs a{};
    for (int i = 0; i < 25; ++i) a.in[i] = (const float*)d_in[i];
    a.out = (float*)d_out; a.ws = (unsigned char*)d_ws; a.lam_init = (float)(0.8 - 0.6 * exp(-0.3 * 2.0));
    const int nph = count_phases();
#if MK_PER_PHASE
    for (int p = 0; p < nph; ++p) { a.ph_lo = p; a.ph_hi = p + 1; a.li = 0; hipLaunchKernelGGL(fwd, dim3(grid), dim3(NWAVES * 64), LDS_BYTES, stream, a); }
#else
    a.ph_lo = 0; a.ph_hi = nph; a.li = 0; hipLaunchKernelGGL(fwd, dim3(grid), dim3(NWAVES * 64), LDS_BYTES, stream, a);
#endif
    const hipError_t le = hipPeekAtLastError();
    if (le != hipSuccess) fprintf(stderr, "kernel_launch: launch failed: %s\n", hipGetErrorName(le));
}
```

```cpp
#include <hip/hip_runtime.h>
#include <cstdio>
#include <cstdint>
#include <cmath>

#ifndef PROBE_ID
#define PROBE_ID 4
#endif
#ifndef PROBE_BLK
#define PROBE_BLK 0
#endif
#ifndef MK_PER_PHASE
#define MK_PER_PHASE 0
#endif

namespace pg8 {
#define PG8_LAS __attribute__((address_space(3)))
typedef unsigned short bf16_t;
typedef short bf16x8 __attribute__((ext_vector_type(8)));
typedef float f32x4 __attribute__((ext_vector_type(4)));
typedef unsigned u32x4 __attribute__((ext_vector_type(4)));
__device__ __forceinline__ int opaque_tid() { int t = threadIdx.x; asm volatile("" : "+v"(t)); return t; }
constexpr int BM = 256, BK = 64, HALF = 128, HTB = HALF * BK * 2  , STAGE_BYTES = 8 * HTB, NXCD = 8, WGM = 8;

__host__ __device__ __forceinline__ int lds_byte(int r, int c) { const int st = (r >> 4) * 2 + (c >> 5), rr = r & 15, cc = c & 31, ob = rr * 64 + cc * 2; return st * 1024 + (ob ^ (((ob >> 9) & 1) << 5)); }
__host__ __device__ __forceinline__ void stage_rc(int b, int& R, int& C) { const int st = b / 1024, sb = b % 1024, swz = sb ^ (((sb >> 9) & 1) << 5); R = (st >> 1) * 16 + swz / 64; C = (st & 1) * 32 + (swz % 64) / 2; }
__host__ __device__ __forceinline__ int perm32(int rho) { const int n = rho >> 4, i = rho & 15; return 8 * (i >> 2) + 4 * n + (i & 3); }

struct Unit { int pm, pn; };
struct Gemm { const bf16_t* A; const bf16_t* Bt; int M, N, K, lda; };

struct StaticOrder {
    int nM, nN, nwg, G, c;
    __host__ __device__ void init(int M, int N, int G_, int c_) { nM = M / BM; nN = N / BM; nwg = nM * nN; G = G_; c = c_; }
    __host__ __device__ bool next(int i, Unit& u) const {
        const long L = (long)i * G + c; if (L >= nwg) return false;
        int wgid = (int)L; { const int q = nwg / NXCD, r = nwg % NXCD, xcd = wgid % NXCD, off = wgid / NXCD; wgid = (xcd < r ? xcd * (q + 1) : r * (q + 1) + (xcd - r) * q) + off; }
        const int nig = WGM * nN, gid = wgid / nig, fm = gid * WGM, gsz = (nM - fm) < WGM ? (nM - fm) : WGM;
        u.pm = fm + ((wgid % nig) % gsz); u.pn = (wgid % nig) / gsz; return true;
    }
    __device__ __forceinline__ void a_ready(const Unit&) const {}
    __device__ __forceinline__ void done(const Unit&) const {}
};


__device__ __forceinline__ unsigned cvt_pk_bf16(float lo, float hi) { unsigned r; asm volatile("v_cvt_pk_bf16_f32 %0, %1, %2" : "=v"(r) : "v"(lo), "v"(hi)); return r; }
__device__ __forceinline__ float sigmoid_fast(float z) { return __builtin_amdgcn_rcpf(1.0f + __builtin_amdgcn_exp2f(-1.4426950408889634f * z)); }
__device__ __forceinline__ float gelu_tanh(float x) { const float z = 1.5957691216057308f * (x + 0.044715f * x * x * x); return x * sigmoid_fast(z); }

struct EpiSwiglu {
    static constexpr bool PERM = true, AFTER_DRAIN = false;
    bf16_t* O; int ldc;
    __device__ __forceinline__ void operator()(const f32x4 (&acc)[2][2][4][2], const Unit& u, int wr, int wc, int fr, int fq) const {
        const int row0 = u.pm * BM + wr * 64 + fr, col0 = u.pn * HALF + wc * 32 + 8 * fq;
#pragma unroll
        for (int ai = 0; ai < 2; ++ai)
#pragma unroll
            for (int m = 0; m < 4; ++m) { bf16_t* rowp = O + (size_t)(row0 + ai * HALF + m * 16) * ldc + col0;
                float v[8];
#pragma unroll
                for (int n = 0; n < 2; ++n)
#pragma unroll
                    for (int j = 0; j < 4; ++j) { const float g = acc[ai][0][m][n][j], uu = acc[ai][1][m][n][j]; v[n * 4 + j] = g * sigmoid_fast(g) * uu; }
                u32x4 w; w.x = cvt_pk_bf16(v[0], v[1]); w.y = cvt_pk_bf16(v[2], v[3]); w.z = cvt_pk_bf16(v[4], v[5]); w.w = cvt_pk_bf16(v[6], v[7]);
                *(u32x4*)rowp = w; }
    }
};
struct EpiF32 {
    static constexpr bool PERM = true, AFTER_DRAIN = false;
    float* C; int ldc;
    __device__ __forceinline__ void operator()(const f32x4 (&acc)[2][2][4][2], const Unit& u, int wr, int wc, int fr, int fq) const {
        const int row0 = u.pm * BM + wr * 64 + fr, col0 = u.pn * BM + wc * 32 + 8 * fq;
#pragma unroll
        for (int ai = 0; ai < 2; ++ai)
#pragma unroll
            for (int m = 0; m < 4; ++m) { float* rowp = C + (size_t)(row0 + ai * HALF + m * 16) * ldc + col0;
#pragma unroll
                for (int bj = 0; bj < 2; ++bj) { *(f32x4*)(rowp + bj * HALF) = acc[ai][bj][m][0]; *(f32x4*)(rowp + bj * HALF + 4) = acc[ai][bj][m][1]; } }
    }
};
template <int MODE  > struct EpiBf16X {
    static constexpr bool PERM = true, AFTER_DRAIN = false;
    bf16_t* O; int ldc; const float* rope; int rope_cols;
    __device__ __forceinline__ void operator()(const f32x4 (&acc)[2][2][4][2], const Unit& u, int wr, int wc, int fr, int fq) const {
        const int row0 = u.pm * BM + wr * 64 + fr, col0 = u.pn * BM + wc * 32 + 8 * fq;
        const bool do_rope = (MODE == 0) && (u.pm < 32) && (u.pn * BM < rope_cols);
        const int p0 = 16 * wc + 4 * fq;
#pragma unroll
        for (int ai = 0; ai < 2; ++ai)
#pragma unroll
            for (int m = 0; m < 4; ++m) { const int row = row0 + ai * HALF + m * 16; bf16_t* rowp = O + (size_t)row * ldc + col0;
                f32x4 cs0 = (f32x4){1.f, 0.f, 1.f, 0.f}, cs1 = cs0;
                if (do_rope) { const float* rp = rope + ((size_t)(row & 4095) * 64 + p0) * 2; cs0 = *(const f32x4*)rp; cs1 = *(const f32x4*)(rp + 4); }
#pragma unroll
                for (int bj = 0; bj < 2; ++bj) { f32x4 v0 = acc[ai][bj][m][0], v1 = acc[ai][bj][m][1];
                    if (MODE == 1) {
#pragma unroll
                        for (int j = 0; j < 4; ++j) { v0[j] = gelu_tanh(v0[j]); v1[j] = gelu_tanh(v1[j]); } }
                    else if (do_rope) {
                        const f32x4 a = v0, b = v1;
                        v0[0] = a[0] * cs0[0] - a[1] * cs0[1]; v0[1] = a[0] * cs0[1] + a[1] * cs0[0]; v0[2] = a[2] * cs0[2] - a[3] * cs0[3]; v0[3] = a[2] * cs0[3] + a[3] * cs0[2];
                        v1[0] = b[0] * cs1[0] - b[1] * cs1[1]; v1[1] = b[0] * cs1[1] + b[1] * cs1[0]; v1[2] = b[2] * cs1[2] - b[3] * cs1[3]; v1[3] = b[2] * cs1[3] + b[3] * cs1[2]; }
                    u32x4 w; w.x = cvt_pk_bf16(v0[0], v0[1]); w.y = cvt_pk_bf16(v0[2], v0[3]); w.z = cvt_pk_bf16(v1[0], v1[1]); w.w = cvt_pk_bf16(v1[2], v1[3]);
                    *(u32x4*)(rowp + bj * HALF) = w; } }
    }
};

template <class Epi, class Sched, bool ALIGN_EPI, bool SP2, int K, int LDA>
__device__ __forceinline__ void gemm_phase(PG8_LAS unsigned char* lds, const Gemm g, const Sched& S, const Epi& E) {
    const int tid = opaque_tid(), wid = __builtin_amdgcn_readfirstlane(tid >> 6), lane = tid & 63, wr = wid >> 2, wc = wid & 3, fr = lane & 15, fq = lane >> 4;
    constexpr int nt = K / BK;
    unsigned voffA[2], voffB[2];
#pragma unroll
    for (int i = 0; i < 2; ++i) { int R, C; stage_rc(tid * 16 + i * 8192, R, C); const int Rb = Epi::PERM ? ((R & ~31) + perm32(R & 31)) : R;
        voffA[i] = (unsigned)(R * LDA + C) * 2u; voffB[i] = (unsigned)(Rb * K + C) * 2u; }
    constexpr size_t kstep = (size_t)(BK * 2);
    constexpr size_t hstepA = (size_t)HALF * LDA * 2, hstepB = (size_t)HALF * K * 2;
    constexpr size_t tstepA = 2 * hstepA, tstepB = 2 * hstepB;
    const unsigned ldsw = (unsigned)wid * 1024u;
    const int aoff = lds_byte(wr * 64 + fr, fq * 8), boff = lds_byte(wc * 32 + fr, fq * 8);
#define PG8_SA(b, h) (((b) * 2 + (h)) * HTB)
#define PG8_SB(b, h) ((4 + (b) * 2 + (h)) * HTB)
#define PG8_STAGE(bufoff, gbase, voff) do { _Pragma("unroll") for (int _i = 0; _i < 2; ++_i) \
        __builtin_amdgcn_global_load_lds((const unsigned*)((const char*)(gbase) + (voff)[_i]), (PG8_LAS unsigned*)(lds + (bufoff) + ldsw + _i * 8192), 16, 0, 0); } while (0)
#define PG8_LDA(dst, b, h) do { _Pragma("unroll") for (int m = 0; m < 4; ++m) _Pragma("unroll") for (int k = 0; k < 2; ++k) dst[m][k] = *(const PG8_LAS bf16x8*)(lds + PG8_SA(b, h) + aoff + m * 2048 + k * 1024); } while (0)
#define PG8_LDB(dst, b, h) do { _Pragma("unroll") for (int n = 0; n < 2; ++n) _Pragma("unroll") for (int k = 0; k < 2; ++k) dst[n][k] = *(const PG8_LAS bf16x8*)(lds + PG8_SB(b, h) + boff + n * 2048 + k * 1024); } while (0)
#define PG8_MMA(ai, bj, At, Bt) do { __builtin_amdgcn_s_setprio(1); _Pragma("unroll") for (int m = 0; m < 4; ++m) _Pragma("unroll") for (int n = 0; n < 2; ++n) _Pragma("unroll") for (int k = 0; k < 2; ++k) \
        acc[ai][bj][m][n] = __builtin_amdgcn_mfma_f32_16x16x32_bf16(Bt[n][k], At[m][k], acc[ai][bj][m][n], 0, 0, 0); __builtin_amdgcn_s_setprio(0); } while (0)
#define PG8_WAIT_V(n) asm volatile("s_waitcnt vmcnt(" #n ")" ::: "memory")
#define PG8_WAIT_L(n) asm volatile("s_waitcnt lgkmcnt(" #n ")" ::: "memory")
#define PG8_BAR __builtin_amdgcn_s_barrier()
#define PG8_SCHED __builtin_amdgcn_sched_barrier(0)
    Unit cur, nxt; int ui = 0;
    if (!S.next(0, cur)) return;
    f32x4 acc[2][2][4][2];
#pragma unroll
    for (int a = 0; a < 2; ++a)
#pragma unroll
        for (int b = 0; b < 2; ++b)
#pragma unroll
            for (int m = 0; m < 4; ++m)
#pragma unroll
                for (int n = 0; n < 2; ++n) acc[a][b][m][n] = (f32x4){0.f, 0.f, 0.f, 0.f};
    bf16x8 At[4][2], B0[2][2], B1[2][2];
    const char* cA = (const char*)g.A + (size_t)cur.pm * tstepA; const char* cB = (const char*)g.Bt + (size_t)cur.pn * tstepB;
    S.a_ready(cur);
    if constexpr (SP2) {
        PG8_STAGE(PG8_SB(0, 0), cB, voffB); PG8_STAGE(PG8_SB(0, 1), cB + hstepB, voffB); PG8_STAGE(PG8_SA(0, 0), cA, voffA); PG8_STAGE(PG8_SA(0, 1), cA + hstepA, voffA);
        if (wr == 1) PG8_BAR;
        PG8_WAIT_V(2); PG8_BAR;
        PG8_STAGE(PG8_SB(1, 0), cB + kstep, voffB); PG8_STAGE(PG8_SA(1, 0), cA + kstep, voffA); PG8_STAGE(PG8_SB(1, 1), cB + hstepB + kstep, voffB);
        PG8_WAIT_V(6); PG8_BAR;
    } else {
        PG8_STAGE(PG8_SB(0, 0), cB, voffB); PG8_STAGE(PG8_SA(0, 0), cA, voffA); PG8_STAGE(PG8_SB(0, 1), cB + hstepB, voffB); PG8_STAGE(PG8_SA(0, 1), cA + hstepA, voffA);
        if (wr == 1) PG8_BAR;
        PG8_WAIT_V(4); PG8_BAR;
        PG8_STAGE(PG8_SB(1, 0), cB + kstep, voffB); PG8_STAGE(PG8_SA(1, 0), cA + kstep, voffA); PG8_STAGE(PG8_SB(1, 1), cB + hstepB + kstep, voffB);
        PG8_WAIT_V(6); PG8_BAR;
    }
    for (;;) {
        const bool has_next = S.next(ui + 1, nxt);
        const char* nA = has_next ? (const char*)g.A + (size_t)nxt.pm * tstepA : cA; const char* nB = has_next ? (const char*)g.Bt + (size_t)nxt.pn * tstepB : cB;
        for (int t = 0; t < nt; t += 2) {
            const bool last = (t == nt - 2);
            const char* a1 = cA + (size_t)(t + 1) * kstep;
            const char* a2 = last ? nA : cA + (size_t)(t + 2) * kstep; const char* b2 = last ? nB : cB + (size_t)(t + 2) * kstep;
            const char* a3 = a2 + kstep; const char* b3 = b2 + kstep;
            if (last && has_next) S.a_ready(nxt);
            if constexpr (SP2) {
            PG8_LDB(B0, 0, 0); PG8_LDB(B1, 0, 1); PG8_SCHED; PG8_LDA(At, 0, 0); PG8_STAGE(PG8_SA(1, 1), a1 + hstepA, voffA);
            PG8_WAIT_V(8); PG8_WAIT_L(0); PG8_BAR; PG8_MMA(0, 0, At, B0); PG8_MMA(0, 1, At, B1); PG8_BAR; PG8_SCHED;
            PG8_LDA(At, 0, 1); PG8_STAGE(PG8_SB(0, 0), b2, voffB); PG8_STAGE(PG8_SB(0, 1), b2 + hstepB, voffB); PG8_STAGE(PG8_SA(0, 0), a2, voffA);
            PG8_WAIT_V(8); PG8_WAIT_L(0); PG8_BAR; PG8_MMA(1, 0, At, B0); PG8_MMA(1, 1, At, B1); PG8_BAR; PG8_SCHED;
            PG8_LDB(B0, 1, 0); PG8_LDB(B1, 1, 1); PG8_SCHED; PG8_LDA(At, 1, 0); PG8_STAGE(PG8_SA(0, 1), a2 + hstepA, voffA);
            PG8_WAIT_V(8); PG8_WAIT_L(0); PG8_BAR; PG8_MMA(0, 0, At, B0); PG8_MMA(0, 1, At, B1); PG8_BAR; PG8_SCHED;
            PG8_LDA(At, 1, 1); PG8_STAGE(PG8_SB(1, 0), b3, voffB); PG8_STAGE(PG8_SB(1, 1), b3 + hstepB, voffB); PG8_STAGE(PG8_SA(1, 0), a3, voffA);
            PG8_WAIT_V(8); PG8_WAIT_L(0); PG8_BAR; PG8_MMA(1, 0, At, B0); PG8_MMA(1, 1, At, B1); PG8_BAR; PG8_SCHED;
            } else {
            PG8_LDB(B0, 0, 0); PG8_SCHED; PG8_LDA(At, 0, 0); PG8_STAGE(PG8_SA(1, 1), a1 + hstepA, voffA);
            PG8_WAIT_L(8); PG8_BAR; PG8_WAIT_L(0); PG8_MMA(0, 0, At, B0); PG8_BAR; PG8_SCHED;
            PG8_LDB(B1, 0, 1); PG8_STAGE(PG8_SB(0, 0), b2, voffB);
            PG8_BAR; PG8_WAIT_L(0); PG8_MMA(0, 1, At, B1); PG8_BAR;
            PG8_LDA(At, 0, 1); PG8_STAGE(PG8_SA(0, 0), a2, voffA);
            PG8_BAR; PG8_WAIT_L(0); PG8_MMA(1, 0, At, B0); PG8_BAR; PG8_SCHED;
            PG8_STAGE(PG8_SB(0, 1), b2 + hstepB, voffB);
            PG8_WAIT_V(6); PG8_BAR; PG8_MMA(1, 1, At, B1); PG8_BAR;
            PG8_LDB(B0, 1, 0); PG8_SCHED; PG8_LDA(At, 1, 0); PG8_STAGE(PG8_SA(0, 1), a2 + hstepA, voffA);
            PG8_WAIT_L(8); PG8_BAR; PG8_WAIT_L(0); PG8_MMA(0, 0, At, B0); PG8_BAR; PG8_SCHED;
            PG8_LDB(B1, 1, 1); PG8_STAGE(PG8_SB(1, 0), b3, voffB);
            PG8_BAR; PG8_WAIT_L(0); PG8_MMA(0, 1, At, B1); PG8_BAR;
            PG8_LDA(At, 1, 1); PG8_STAGE(PG8_SA(1, 0), a3, voffA);
            PG8_BAR; PG8_WAIT_L(0); PG8_MMA(1, 0, At, B0); PG8_BAR; PG8_SCHED;
            PG8_STAGE(PG8_SB(1, 1), b3 + hstepB, voffB);
            PG8_WAIT_V(6); PG8_BAR; PG8_MMA(1, 1, At, B1); PG8_BAR;
            }
        }
        if constexpr (ALIGN_EPI) { if (wr == 0) PG8_BAR; }
        if constexpr (!Epi::AFTER_DRAIN) { E(acc, cur, wr, wc, fr, fq); S.done(cur); }
        if (!has_next) break;
#pragma unroll
        for (int a = 0; a < 2; ++a)
#pragma unroll
            for (int b = 0; b < 2; ++b)
#pragma unroll
                for (int m = 0; m < 4; ++m)
#pragma unroll
                    for (int n = 0; n < 2; ++n) acc[a][b][m][n] = (f32x4){0.f, 0.f, 0.f, 0.f};
        cur = nxt; cA = nA; cB = nB; ++ui;
        if constexpr (ALIGN_EPI) { if (wr == 1) PG8_BAR; }
    }
    PG8_WAIT_V(0);
    if constexpr (!ALIGN_EPI) { if (wr == 0) PG8_BAR; }
    PG8_BAR;
    if constexpr (Epi::AFTER_DRAIN) { E.fused(acc, cur, wr, wc, fr, fq, lds, wid, lane); S.done(cur); }
#undef PG8_SA
#undef PG8_SB
#undef PG8_STAGE
#undef PG8_LDA
#undef PG8_LDB
#undef PG8_MMA
#undef PG8_WAIT_V
#undef PG8_WAIT_L
#undef PG8_BAR
#undef PG8_SCHED
}
}

namespace att {
typedef unsigned short bf16;
using bf16x8 = __attribute__((ext_vector_type(8))) short;
using s16x4  = __attribute__((ext_vector_type(4))) short;
using f32x16 = __attribute__((ext_vector_type(16))) float;
using u32x4  = __attribute__((ext_vector_type(4))) unsigned;
constexpr int   D = 128, NW = 8, QBLK = 32, KVBLK = 64;
constexpr float SCALE = 0.088388347648318440f;
constexpr float THR = 8.f;
constexpr int SHM_V = KVBLK * D * 2, SHM_K = KVBLK * D * 2, SHM_ATTN = 2 * SHM_V + 2 * SHM_K + NW * 64 * 4;
#define KSWZ(row, colB) ((row) * 256 + ((colB) ^ (((row) & 7) << 4)))
#define SBAR() __builtin_amdgcn_sched_barrier(0)
__device__ __forceinline__ int crow(int r, int hi) { return (r & 3) + 8 * (r >> 2) + 4 * hi; }
__device__ __forceinline__ unsigned cvtpk(float lo, float hi) { unsigned r; asm volatile("v_cvt_pk_bf16_f32 %0, %1, %2" : "=v"(r) : "v"(lo), "v"(hi)); return r; }

__device__ __forceinline__ void wmask(f32x16& p0, f32x16& p1, int kpos0, int qp, int hi) {
  const bool oob = (kpos0 < 0) || (kpos0 >= 4096);
  const int base = kpos0 - qp + 128;
#pragma unroll
  for (int r = 0; r < 16; ++r) { const int c = crow(r, hi);
    if (oob || (unsigned)(base + c) > 256u) p0[r] = -1e30f;
    if (oob || (unsigned)(base + 32 + c) > 256u) p1[r] = -1e30f; }
}
__device__ __forceinline__ void partialSM(f32x16& p0, f32x16& p1, float& m_reg, float& mn, float& alpha) {
  constexpr float C = SCALE * 1.4426950408889634f;
  float pmax = p0[0];
#pragma unroll
  for (int r = 1; r < 16; ++r) pmax = fmaxf(pmax, p0[r]);
#pragma unroll
  for (int r = 0; r < 16; ++r) pmax = fmaxf(pmax, p1[r]);
  { auto rr = __builtin_amdgcn_permlane32_swap(__float_as_uint(pmax), __float_as_uint(pmax), false, false);
    pmax = fmaxf(__uint_as_float(rr[0]), __uint_as_float(rr[1])); }
  if (__builtin_expect(__all(pmax - m_reg <= THR / SCALE), 1)) { mn = m_reg; alpha = 1.f; }
  else { mn = fmaxf(m_reg, pmax); alpha = __builtin_amdgcn_exp2f((m_reg - mn) * C); m_reg = mn; }
  float mnC = -mn * C;
#pragma unroll
  for (int r = 0; r < 16; ++r) p0[r] = fmaf(p0[r], C, mnC);
#pragma unroll
  for (int r = 0; r < 16; ++r) p1[r] = fmaf(p1[r], C, mnC);
#pragma unroll
  for (int r = 0; r < 16; ++r) p0[r] = __builtin_amdgcn_exp2f(p0[r]);
}
__device__ __forceinline__ void finishSM(f32x16& p0, f32x16& p1, float alpha, float& l_reg, bf16x8& pa0, bf16x8& pa1, bf16x8& pa2, bf16x8& pa3) {
#pragma unroll
  for (int r = 0; r < 16; ++r) p1[r] = __builtin_amdgcn_exp2f(p1[r]);
  float ps = 0;
#pragma unroll
  for (int r = 0; r < 16; ++r) ps += p0[r];
#pragma unroll
  for (int r = 0; r < 16; ++r) ps += p1[r];
  { auto rr = __builtin_amdgcn_permlane32_swap(__float_as_uint(ps), __float_as_uint(ps), false, false);
    ps = __uint_as_float(rr[0]) + __uint_as_float(rr[1]); }
  l_reg = l_reg * alpha + ps;
#define PK4(P, BASE, OUT) do { unsigned a0 = cvtpk(P[BASE + 0], P[BASE + 1]), a1 = cvtpk(P[BASE + 2], P[BASE + 3]);   \
    unsigned b0 = cvtpk(P[BASE + 4], P[BASE + 5]), b1 = cvtpk(P[BASE + 6], P[BASE + 7]);                              \
    auto r0 = __builtin_amdgcn_permlane32_swap(a0, b0, false, false); auto r1 = __builtin_amdgcn_permlane32_swap(a1, b1, false, false); \
    u32x4 w = {r0[0], r1[0], r0[1], r1[1]}; OUT = *reinterpret_cast<bf16x8*>(&w); } while (0)
  PK4(p0, 0, pa0); PK4(p0, 8, pa1); PK4(p1, 0, pa2); PK4(p1, 8, pa3);
#undef PK4
}
__device__ __forceinline__ void qkt(f32x16& p0, f32x16& p1, const bf16* Ks, const bf16x8* qr, int r32, int hi) {
  p0 = f32x16{}; p1 = f32x16{};
#pragma unroll
  for (int d0 = 0; d0 < 8; ++d0) { int cb = (d0 * 16 + hi * 8) * 2;
    bf16x8 b0 = *reinterpret_cast<const bf16x8*>((const char*)Ks + KSWZ(r32, cb));
    bf16x8 b1 = *reinterpret_cast<const bf16x8*>((const char*)Ks + KSWZ(32 + r32, cb));
    p0 = __builtin_amdgcn_mfma_f32_32x32x16_bf16(b0, qr[d0], p0, 0, 0, 0);
    p1 = __builtin_amdgcn_mfma_f32_32x32x16_bf16(b1, qr[d0], p1, 0, 0, 0); }
}
__device__ __forceinline__ int v_st(int k, int c) { const int kk = (k & ~0xC) | ((k & 4) << 1) | ((k & 8) >> 1); return ((kk >> 3) * 4 + (c >> 5)) * 512 + ((kk & 7) * 32 + (c & 31)) * 2; }
__device__ __forceinline__ int v_rd_base(int lane) { return ((lane & 3) << 3) | (((lane >> 2) & 3) << 6) | (((lane >> 4) & 1) << 5) | (((lane >> 5) & 1) << 8); }
constexpr int v_rd_off(int d0, int ks, int half) { return d0 * 512 + ks * 4096 + half * 2048; }
template <int OFF> __device__ __forceinline__ s16x4 tr_read(int vb) {
  s16x4 r; asm volatile("ds_read_b64_tr_b16 %0, %1 offset:%2" : "=&v"(r) : "v"(vb), "i"(OFF) : "memory"); return r;
}
template <int D0> __device__ __forceinline__ void pv_one(f32x16& od, int vb, bf16x8 pa0, bf16x8 pa1, bf16x8 pa2, bf16x8 pa3) {
  const s16x4 l0 = tr_read<v_rd_off(D0, 0, 0)>(vb), h0 = tr_read<v_rd_off(D0, 0, 1)>(vb), l1 = tr_read<v_rd_off(D0, 1, 0)>(vb), h1 = tr_read<v_rd_off(D0, 1, 1)>(vb);
  const s16x4 l2 = tr_read<v_rd_off(D0, 2, 0)>(vb), h2 = tr_read<v_rd_off(D0, 2, 1)>(vb), l3 = tr_read<v_rd_off(D0, 3, 0)>(vb), h3 = tr_read<v_rd_off(D0, 3, 1)>(vb);
  asm volatile("s_waitcnt lgkmcnt(0)" ::: "memory"); SBAR();
#define PK(L, H) (bf16x8){L[0], L[1], L[2], L[3], H[0], H[1], H[2], H[3]}
  od = __builtin_amdgcn_mfma_f32_32x32x16_bf16(pa0, PK(l0, h0), od, 0, 0, 0);
  od = __builtin_amdgcn_mfma_f32_32x32x16_bf16(pa1, PK(l1, h1), od, 0, 0, 0);
  od = __builtin_amdgcn_mfma_f32_32x32x16_bf16(pa2, PK(l2, h2), od, 0, 0, 0);
  od = __builtin_amdgcn_mfma_f32_32x32x16_bf16(pa3, PK(l3, h3), od, 0, 0, 0);
#undef PK
}
__device__ __forceinline__ void pv_d0(f32x16* o, int vb, bf16x8 pa0, bf16x8 pa1, bf16x8 pa2, bf16x8 pa3) {
  pv_one<0>(o[0], vb, pa0, pa1, pa2, pa3); pv_one<1>(o[1], vb, pa0, pa1, pa2, pa3); pv_one<2>(o[2], vb, pa0, pa1, pa2, pa3); pv_one<3>(o[3], vb, pa0, pa1, pa2, pa3);
}

struct Args {
  const bf16* qkv; int ld;
  int qrow0, qcol, kcol, vcol;
  int ctxrow0, latrow0;
  int kstart, n0, n1;
  int qpos0;
  float sink; int has_sink;
  void* out; int ldo, ocol;
};

template <bool WINDOW, bool OUT_BF16, int LD>
__device__ __forceinline__ void attn_unit(const Args& a, char* lds) {
  const int tid = pg8::opaque_tid(), wid = tid >> 6, lane = tid & 63, r32 = lane & 31, hi = lane >> 5;
  bf16* V_lds = (bf16*)lds; bf16* K_lds = (bf16*)(lds + 2 * SHM_V);
  float* ws = (float*)(lds + 2 * SHM_V + 2 * SHM_K) + wid * 64; float* li_l = ws; float* al_l = ws + 32;
  float m_reg = a.has_sink ? a.sink * (1.0f / SCALE) : -1e30f, l_reg = a.has_sink ? 1.0f : 0.0f; f32x16 o[4] = {}; bf16x8 qr[8];
  const bf16* Qw = a.qkv + (long)(a.qrow0 + wid * QBLK + r32) * LD + a.qcol + hi * 8;
#pragma unroll
  for (int d0 = 0; d0 < 8; ++d0) qr[d0] = *reinterpret_cast<const bf16x8*>(Qw + d0 * 16);
  const int sr = tid >> 4, sc = (tid & 15) * 8, vst0 = v_st(sr, sc), vst1 = v_st(32 + sr, sc);
  const int vb0 = (int)(uintptr_t)V_lds + v_rd_base(lane);
  const int qp = a.qpos0 + wid * QBLK + r32;
  const unsigned soff0 = (unsigned)(sr * LD + sc) * 2u, soff1 = soff0 + 32u * LD * 2u;
  struct { bf16x8 vs0, vs1, ks0, ks1; } sr_[2];
#define TROW(t) ((t) < a.n0 ? a.ctxrow0 + (t) * KVBLK : a.latrow0 + min(max(a.kstart + ((t) - a.n0) * KVBLK, 0), 4096 - KVBLK))
#define SLOAD(i, t) do { const char* tb_ = (const char*)a.qkv + (size_t)TROW(t) * (LD * 2); const char* tv_ = tb_ + a.vcol * 2; const char* tk_ = tb_ + a.kcol * 2; \
    sr_[i].vs0 = *reinterpret_cast<const bf16x8*>(tv_ + soff0); sr_[i].vs1 = *reinterpret_cast<const bf16x8*>(tv_ + soff1); \
    sr_[i].ks0 = *reinterpret_cast<const bf16x8*>(tk_ + soff0); sr_[i].ks1 = *reinterpret_cast<const bf16x8*>(tk_ + soff1); } while (0)
#define SWRITE(b, i) do { *(bf16x8*)((char*)V_lds + (b) * SHM_V + vst0) = sr_[i].vs0;          \
    *(bf16x8*)((char*)V_lds + (b) * SHM_V + vst1) = sr_[i].vs1; int kc = sc * 2;               \
    *(bf16x8*)((char*)K_lds + (b) * SHM_K + KSWZ(sr, kc)) = sr_[i].ks0;                       \
    *(bf16x8*)((char*)K_lds + (b) * SHM_K + KSWZ(32 + sr, kc)) = sr_[i].ks1; } while (0)
#define SWAIT() asm volatile("s_waitcnt vmcnt(4)" ::: "memory")
#define RESC(al) do { if (__any((al) < 1.f)) { if (hi == 0) al_l[r32] = (al); asm volatile("s_waitcnt lgkmcnt(0)" ::: "memory"); \
    _Pragma("unroll") for (int d = 0; d < 4; ++d) _Pragma("unroll") for (int r = 0; r < 16; ++r) o[d][r] *= al_l[crow(r, hi)]; } } while (0)
#define WMASK(P0, P1, t) do { if (WINDOW) { if ((t) >= a.n0) wmask(P0, P1, a.kstart + ((t) - a.n0) * KVBLK, qp, hi); } } while (0)
  f32x16 pA0, pA1, pB0, pB1; float mnA, mnB, alA, alB; bf16x8 pa0, pa1, pa2, pa3; const int NT = a.n0 + a.n1;
  constexpr int SE = 0, SO = 1;
  SLOAD(SE, 0); asm volatile("s_waitcnt vmcnt(0)" ::: "memory"); SWRITE(0, SE); __syncthreads();
  qkt(pA0, pA1, K_lds, qr, r32, hi); WMASK(pA0, pA1, 0); partialSM(pA0, pA1, m_reg, mnA, alA);
  SLOAD(SO, 1); if (2 < NT) SLOAD(SE, 2);
  SWAIT(); SWRITE(1, SO); __syncthreads();
  for (int j = 1; j + 1 < NT; j += 2) {
    SBAR(); qkt(pB0, pB1, (bf16*)((char*)K_lds + SHM_K), qr, r32, hi);
    finishSM(pA0, pA1, alA, l_reg, pa0, pa1, pa2, pa3); SBAR();
    SLOAD(SO, j + 2); SBAR();
    pv_d0(o, vb0, pa0, pa1, pa2, pa3); WMASK(pB0, pB1, j); partialSM(pB0, pB1, m_reg, mnB, alB);
    __syncthreads(); SWAIT(); SWRITE(0, SE);
    RESC(alB); __syncthreads();
    SBAR(); qkt(pA0, pA1, K_lds, qr, r32, hi);
    finishSM(pB0, pB1, alB, l_reg, pa0, pa1, pa2, pa3); SBAR();
    if (j + 3 < NT) SLOAD(SE, j + 3); SBAR();
    pv_d0(o, vb0 + (int)SHM_V, pa0, pa1, pa2, pa3); WMASK(pA0, pA1, j + 1); partialSM(pA0, pA1, m_reg, mnA, alA);
    __syncthreads(); SWAIT(); SWRITE(1, SO);
    RESC(alA); __syncthreads();
  }
  SBAR(); qkt(pB0, pB1, (bf16*)((char*)K_lds + SHM_K), qr, r32, hi);
  finishSM(pA0, pA1, alA, l_reg, pa0, pa1, pa2, pa3); SBAR();
  pv_d0(o, vb0, pa0, pa1, pa2, pa3); WMASK(pB0, pB1, NT - 1); partialSM(pB0, pB1, m_reg, mnB, alB);
  __syncthreads(); RESC(alB);
  finishSM(pB0, pB1, alB, l_reg, pa0, pa1, pa2, pa3); SBAR();
  pv_d0(o, vb0 + (int)SHM_V, pa0, pa1, pa2, pa3);
  if (hi == 0) li_l[r32] = l_reg; asm volatile("s_waitcnt lgkmcnt(0)" ::: "memory");
  float rli[16];
#pragma unroll
  for (int r = 0; r < 16; ++r) rli[r] = __builtin_amdgcn_rcpf(li_l[crow(r, hi)]);
  if (OUT_BF16) {
    bf16* Ow = (bf16*)a.out + (long)(a.qrow0 + wid * QBLK) * a.ldo + a.ocol;
#pragma unroll
    for (int r = 0; r < 16; ++r) { const int orow = crow(r, hi);
#pragma unroll
      for (int d0 = 0; d0 < 4; ++d0) Ow[(long)orow * a.ldo + d0 * 32 + r32] = (bf16)(cvtpk(o[d0][r] * rli[r], 0.f) & 0xffffu); }
  } else {
    float* Ow = (float*)a.out + (long)(a.qrow0 + wid * QBLK) * a.ldo + a.ocol;
#pragma unroll
    for (int r = 0; r < 16; ++r) { const int orow = crow(r, hi);
#pragma unroll
      for (int d0 = 0; d0 < 4; ++d0) Ow[(long)orow * a.ldo + d0 * 32 + r32] = o[d0][r] * rli[r]; }
  }
  __syncthreads();
#undef TROW
#undef SLOAD
#undef SWRITE
#undef SWAIT
#undef RESC
#undef WMASK
}

template <int LD>
__device__ __forceinline__ void dattn_unit(const bf16* qkv, int qrow0, int h, int ctxrow0, int latrow0, int n0, int n1, float lam, float gscale, const float* subg, bf16* AO,
                                           __attribute__((address_space(3))) unsigned char* L, char* lds) {
  typedef __attribute__((address_space(3))) unsigned char lds_b;
  const int tid = pg8::opaque_tid(), wid = __builtin_amdgcn_readfirstlane(tid >> 6), lane = tid & 63, r32 = lane & 31, hi = lane >> 5, g = wid & 3, c = wid >> 2;
  float* wsc = (float*)(lds + 132096 + wid * 256); float* li_l = wsc; float* al_l = wsc + 32;
  float m_reg = -1e30f, l_reg = 0.f; f32x16 o[8] = {}; bf16x8 qr[8];
  { const bf16* Qw = qkv + (long)(qrow0 + g * 32 + r32) * LD + (2 * h + c) * 128 + hi * 8;
#pragma unroll
    for (int d0 = 0; d0 < 8; ++d0) qr[d0] = *reinterpret_cast<const bf16x8*>(Qw + d0 * 16); }
  unsigned voK[2][2], voV[4];
#pragma unroll
  for (int cc = 0; cc < 2; ++cc)
#pragma unroll
    for (int i = 0; i < 2; ++i) { const int gi = i * 512 + tid, row = gi >> 4, cb = ((gi & 15) << 4) ^ ((row & 7) << 4); voK[cc][i] = (unsigned)((row * LD + 2048 + (2 * h + cc) * 128) * 2 + cb); }
#pragma unroll
  for (int i = 0; i < 4; ++i) { const int gi = i * 512 + tid, img = gi >> 10, o2 = (gi & 1023) << 4, st = o2 >> 9, e = (o2 & 511) >> 1, kk = (st >> 2) * 8 + (e >> 5);
    const int k = (kk & ~0xC) | ((kk & 4) << 1) | ((kk & 8) >> 1), col = (st & 3) * 32 + (e & 31); voV[i] = (unsigned)((k * LD + 4096 + h * 256 + img * 128 + col) * 2); }
  const int NT = n0 + n1;
#define DT_ROW(t) ((t) < n0 ? ctxrow0 + (t) * KVBLK : latrow0 + ((t) - n0) * KVBLK)
#define DT_DMA(t, b) do { const char* tb_ = (const char*)qkv + (size_t)DT_ROW(t) * (LD * 2); \
    _Pragma("unroll") for (int cc = 0; cc < 2; ++cc) _Pragma("unroll") for (int i = 0; i < 2; ++i) \
      __builtin_amdgcn_global_load_lds((const unsigned*)(tb_ + voK[cc][i]), (__attribute__((address_space(3))) unsigned*)(L + (b) * 32768 + cc * 16384 + i * 8192 + wid * 1024), 16, 0, 0); \
    _Pragma("unroll") for (int i = 0; i < 4; ++i) \
      __builtin_amdgcn_global_load_lds((const unsigned*)(tb_ + voV[i]), (__attribute__((address_space(3))) unsigned*)(L + 65536 + (b) * 32768 + i * 8192 + wid * 1024), 16, 0, 0); } while (0)
  DT_DMA(0, 0);
  if (1 < NT) DT_DMA(1, 1);
  if (1 < NT) asm volatile("s_waitcnt vmcnt(8)" ::: "memory"); else asm volatile("s_waitcnt vmcnt(0)" ::: "memory");
  __builtin_amdgcn_s_barrier(); asm volatile("" ::: "memory");
  for (int t = 0; t < NT; ++t) {
    const int b = t & 1;
    const bf16* Kt = (const bf16*)(lds + b * 32768 + c * 16384);
    const int vb = (int)(uintptr_t)(lds + 65536 + b * 32768) + v_rd_base(lane);
    f32x16 p0, p1; float mn, alpha; bf16x8 pa0, pa1, pa2, pa3;
    qkt(p0, p1, Kt, qr, r32, hi);
    partialSM(p0, p1, m_reg, mn, alpha);
    if (__any(alpha < 1.f)) { if (hi == 0) al_l[r32] = alpha; asm volatile("s_waitcnt lgkmcnt(0)" ::: "memory");
#pragma unroll
      for (int d = 0; d < 8; ++d)
#pragma unroll
        for (int r = 0; r < 16; ++r) o[d][r] *= al_l[crow(r, hi)]; }
    finishSM(p0, p1, alpha, l_reg, pa0, pa1, pa2, pa3);
    pv_one<0>(o[0], vb, pa0, pa1, pa2, pa3); pv_one<1>(o[1], vb, pa0, pa1, pa2, pa3); pv_one<2>(o[2], vb, pa0, pa1, pa2, pa3); pv_one<3>(o[3], vb, pa0, pa1, pa2, pa3);
    pv_one<0>(o[4], vb + 16384, pa0, pa1, pa2, pa3); pv_one<1>(o[5], vb + 16384, pa0, pa1, pa2, pa3); pv_one<2>(o[6], vb + 16384, pa0, pa1, pa2, pa3); pv_one<3>(o[7], vb + 16384, pa0, pa1, pa2, pa3);
    asm volatile("s_waitcnt lgkmcnt(0)" ::: "memory"); __builtin_amdgcn_s_barrier(); asm volatile("" ::: "memory");
    if (t + 2 < NT) { DT_DMA(t + 2, b); asm volatile("s_waitcnt vmcnt(8)" ::: "memory"); } else asm volatile("s_waitcnt vmcnt(0)" ::: "memory");
    __builtin_amdgcn_s_barrier(); asm volatile("" ::: "memory");
  }
#undef DT_ROW
#undef DT_DMA
  if (hi == 0) li_l[r32] = l_reg; asm volatile("s_waitcnt lgkmcnt(0)" ::: "memory");
#pragma unroll
  for (int r = 0; r < 16; ++r) { const float rl = __builtin_amdgcn_rcpf(li_l[crow(r, hi)]);
#pragma unroll
    for (int d = 0; d < 8; ++d) o[d][r] *= rl; }
  float* xch = (float*)(lds + g * 32768);
  if (c == 1) {
#pragma unroll
    for (int d = 0; d < 8; ++d)
#pragma unroll
      for (int r = 0; r < 16; ++r) xch[(d * 16 + r) * 64 + lane] = o[d][r]; }
  asm volatile("s_waitcnt lgkmcnt(0)" ::: "memory"); __builtin_amdgcn_s_barrier(); asm volatile("" ::: "memory");
  if (c == 0) {
    float gv[8];
#pragma unroll
    for (int d = 0; d < 8; ++d) gv[d] = subg[d * 32 + r32] * gscale;
#pragma unroll
    for (int r = 0; r < 16; ++r) { float s = 0.f;
#pragma unroll
      for (int d = 0; d < 8; ++d) { o[d][r] -= lam * xch[(d * 16 + r) * 64 + lane]; s += o[d][r] * o[d][r]; }
      for (int m_ = 1; m_ < 32; m_ <<= 1) s += __builtin_bit_cast(float, __builtin_amdgcn_ds_bpermute((lane ^ m_) << 2, __builtin_bit_cast(int, s)));
      const float rs = 1.0f / sqrtf(s * (1.0f / 256.0f) + 1e-6f);
      bf16* orow = AO + (long)(qrow0 + g * 32 + crow(r, hi)) * 2048 + h * 256 + r32;
#pragma unroll
      for (int d = 0; d < 8; ++d) orow[d * 32] = (bf16)(cvtpk(o[d][r] * rs * gv[d], 0.f) & 0xffffu); }
  }
  asm volatile("s_waitcnt vmcnt(0) lgkmcnt(0)" ::: "memory"); __builtin_amdgcn_s_barrier(); asm volatile("" ::: "memory");
}
#undef KSWZ
#undef SBAR
}

constexpr int NWAVES = 8;
constexpr int DM = 2048, NBATCH = 2, SEQ = 4096, MLAT = NBATCH * SEQ, CTXL = 256, MCTX = NBATCH * CTXL, MALL = MLAT + MCTX;
constexpr int DFF = 5504, NFC1 = 2 * DFF, NLAYER = 4, NMODC = 9 * DM;
constexpr int A_N = 3072, B_N = 12288, B_W = 6144, C_N = 6144;
constexpr float EPS = 1e-6f;
constexpr size_t MiB = 1u << 20;
constexpr size_t WS_CTL = 0, CTL_BYTES = 2 * MiB;
constexpr size_t WS_MODT = 2 * MiB;
constexpr size_t WS_ROPE = 3 * MiB;
constexpr size_t WS_XC = 5 * MiB;
constexpr size_t WS_STATS = 9 * MiB;
constexpr size_t WS_BSW = 10 * MiB;
constexpr size_t WS_SMALL = 10 * MiB + 512 * 1024;
constexpr int SM_SINK = 0, SM_VNG = 64, SM_VNB = SM_VNG + 6144, SM_BS = SM_VNB + 6144, SM_LQ1 = SM_BS + 1024, SM_LK1 = SM_LQ1 + 128, SM_LQ2 = SM_LK1 + 128, SM_LK2 = SM_LQ2 + 128, SM_SUBG = SM_LK2 + 128, SM_END = SM_SUBG + 256;
constexpr size_t WS_WFC1 = 11 * MiB;
constexpr size_t WS_WFC2 = WS_WFC1 + 344 * MiB;
constexpr size_t WS_WAIN = WS_WFC2 + 172 * MiB;
constexpr size_t WS_WAOUT = WS_WAIN + 24 * MiB;
constexpr size_t WS_WBIN = WS_WAOUT + 16 * MiB;
constexpr size_t WS_WBOUT = WS_WBIN + 48 * MiB;
constexpr size_t WS_WCIN = WS_WBOUT + 24 * MiB;
constexpr size_t WS_WCOUT = WS_WCIN + 24 * MiB;
constexpr size_t WS_H = WS_WCOUT + 8 * MiB;
constexpr size_t WS_HID = WS_H + 34 * MiB;
constexpr size_t WS_Y = WS_HID + 92 * MiB;
constexpr size_t WS_QKV = WS_Y + 68 * MiB;
constexpr size_t WS_AO = WS_QKV + 204 * MiB;
constexpr size_t WS_OC = WS_AO + 34 * MiB;
constexpr size_t WS_END = WS_OC + 136 * MiB;
static_assert((size_t)8 * NFC1 * DM * 2 <= 344 * MiB && (size_t)8 * DM * DFF * 2 <= 172 * MiB && (size_t)MALL * DFF * 2 <= 92 * MiB && (size_t)MALL * B_N * 2 <= 204 * MiB, "ws map");
constexpr int CW_PQ = 1024;
constexpr int CW_BAR = 4096;
constexpr int RING_BYTES = 131072, MISC_OFF = RING_BYTES + 320, LDS_BYTES = 147456;

#define GAS __attribute__((address_space(1)))
#define LAS __attribute__((address_space(3)))
typedef unsigned short bf16;
typedef unsigned v4u __attribute__((ext_vector_type(4)));
typedef unsigned v2u __attribute__((ext_vector_type(2)));
typedef float f32x4 __attribute__((ext_vector_type(4)));
typedef short bf16x8 __attribute__((ext_vector_type(8)));
typedef float f32x16 __attribute__((ext_vector_type(16)));
#define LDS_WAIT() asm volatile("s_waitcnt lgkmcnt(0)" ::: "memory")
#define VM_WAIT() asm volatile("s_waitcnt vmcnt(0)" ::: "memory")
__device__ __forceinline__ unsigned f2bf(float f) { unsigned u = __builtin_bit_cast(unsigned, f); return (u + 0x7fffu + ((u >> 16) & 1u)) >> 16; }
__device__ __forceinline__ unsigned pk2(float lo, float hi) { return f2bf(lo) | (f2bf(hi) << 16); }
__device__ __forceinline__ float bf2f(unsigned short b) { return __builtin_bit_cast(float, ((unsigned)b) << 16); }
__device__ __forceinline__ float lane_xor(float v, int lane, int mask) { return __builtin_bit_cast(float, __builtin_amdgcn_ds_bpermute((lane ^ mask) << 2, __builtin_bit_cast(int, v))); }
__device__ __forceinline__ float wave_sum(float v, int lane) {
#pragma unroll
    for (int o = 1; o < 64; o <<= 1) v += lane_xor(v, lane, o);
    return v;
}

#define XB_TMO      128
#define XB_XCNT(j)  (256  + 64 * (j))
#define XB_XSUB(j)  (1280 + 64 * (j))
#define XB_XGEN(j)  (2304 + 64 * (j))
#define XB_TOP      3328
#define XB_TOPGEN   3392
#define XCD_BAR_WORDS 3456
#define XB_SPIN_CAP (1u << 18)

__device__ __forceinline__ unsigned xb_ld(unsigned* p)              { return __hip_atomic_load(p, __ATOMIC_RELAXED, __HIP_MEMORY_SCOPE_AGENT); }
__device__ __forceinline__ unsigned xb_add(unsigned* p, unsigned v) { return __hip_atomic_fetch_add(p, v, __ATOMIC_RELAXED, __HIP_MEMORY_SCOPE_AGENT); }
__device__ __forceinline__ unsigned xb_xcc_id() { return (unsigned)__builtin_amdgcn_s_getreg((3 << 11) | 20) & 0xFu; }
#define XB_SPIN(cond, bar) do { unsigned _sp = 0; while (cond) { __builtin_amdgcn_s_sleep(1); \
    if ((++_sp & 255u) == 0u) { if (xb_ld(&(bar)[XB_TMO])) break; if (_sp > XB_SPIN_CAP) { atomicAdd(&(bar)[XB_TMO], 1u); break; } } } } while (0)

struct XcdBarrier {
    unsigned* bar; unsigned x;
    volatile LAS unsigned* st;
};

__device__ __forceinline__ XcdBarrier xcd_barrier_post(unsigned* bar, volatile LAS unsigned* st) {
    XcdBarrier b; b.bar = bar; b.x = xb_xcc_id(); b.st = st;
    if (threadIdx.x == 0) (void)xb_add(&bar[XB_XCNT(b.x)], 1u);
    return b;
}
__device__ __forceinline__ void xcd_barrier_complete(unsigned* bar, unsigned x, unsigned& nloc, unsigned& nx) {
    const unsigned G = gridDim.x * gridDim.y * gridDim.z;
    unsigned sum, cnt, mine, sp = 0u;
    for (;;) {
        sum = 0u; cnt = 0u; mine = 0u;
#pragma unroll
        for (unsigned j = 0; j < 16; ++j) { const unsigned c = xb_ld(&bar[XB_XCNT(j)]); sum += c; cnt += (c > 0u) ? 1u : 0u; mine = (j == x) ? c : mine; }
        if (sum == G) break;
        __builtin_amdgcn_s_sleep(1);
        if ((++sp & 255u) == 0u) { if (xb_ld(&bar[XB_TMO])) break; if (sp > XB_SPIN_CAP) { atomicAdd(&bar[XB_TMO], 1u); break; } }
    }
    nloc = mine > 0u ? mine : 1u; nx = cnt > 0u ? cnt : 1u;
}

__device__ __forceinline__ void xcd_barrier(const XcdBarrier& b) {
    asm volatile("s_waitcnt vmcnt(0)" ::: "memory");
    __syncthreads();
    if (threadIdx.x == 0) {
        unsigned* bar = b.bar;
        __builtin_amdgcn_s_waitcnt(0);
        unsigned nloc = b.st[0], nx = b.st[1];
        if (nloc == 0u) { xcd_barrier_complete(bar, b.x, nloc, nx); b.st[0] = nloc; b.st[1] = nx; }
        const unsigned old = xb_add(&bar[XB_XSUB(b.x)], 1u);
        const unsigned gen = old / nloc;
        if (old + 1u == (gen + 1u) * nloc) {
            __builtin_amdgcn_fence(__ATOMIC_RELEASE, "agent");
            asm volatile("s_waitcnt vmcnt(0)" ::: "memory");
            const unsigned og = xb_add(&bar[XB_TOP], 1u);
            const unsigned tg = og / nx;
            if (og + 1u == (tg + 1u) * nx) xb_add(&bar[XB_TOPGEN], 1u);
            else XB_SPIN(xb_ld(&bar[XB_TOPGEN]) == tg, bar);
            __builtin_amdgcn_fence(__ATOMIC_ACQUIRE, "agent");
            xb_add(&bar[XB_XGEN(b.x)], 1u);
            asm volatile("s_waitcnt vmcnt(0)" ::: "memory");
        } else {
            XB_SPIN(xb_ld(&bar[XB_XGEN(b.x)]) == gen, bar);
            __builtin_amdgcn_fence(__ATOMIC_ACQUIRE, "agent");
            asm volatile("s_waitcnt vmcnt(0)" ::: "memory");
        }
    }
    __syncthreads();
}

__device__ __forceinline__ void transpose_item(const float* W, int K, int N, bf16* WT, int fc1map, LAS float* scr, int item, int lane) {
    const int nblk = N / 32, kb = item / nblk, nb = item % nblk, k0 = 64 * kb, n0 = 32 * nb;
    int rowbase = n0;
    if (fc1map) { rowbase = (n0 < DFF) ? 256 * (n0 / 128) + (n0 % 128) : 256 * ((n0 - DFF) / 128) + 128 + ((n0 - DFF) % 128); }
    float tv[32];
#pragma unroll
    for (int i = 0; i < 32; ++i) tv[i] = W[(size_t)(k0 + 2 * i + (lane >> 5)) * N + n0 + (lane & 31)];
#pragma unroll
    for (int i = 0; i < 32; ++i) scr[(2 * i + (lane >> 5)) * 33 + (lane & 31)] = tv[i];
    LDS_WAIT(); asm volatile("" ::: "memory");
    const int c = lane & 7;
#pragma unroll
    for (int j = 0; j < 4; ++j) { const int n = (lane >> 3) + 8 * j; const LAS float* s = scr + (8 * c) * 33 + n;
        v4u o; o.x = pk2(s[0 * 33], s[1 * 33]); o.y = pk2(s[2 * 33], s[3 * 33]); o.z = pk2(s[4 * 33], s[5 * 33]); o.w = pk2(s[6 * 33], s[7 * 33]);
        *(GAS v4u*)(WT + (size_t)(rowbase + n) * K + k0 + 8 * c) = o; }
    LDS_WAIT(); asm volatile("" ::: "memory");
}

struct KArgs { const float* in[25]; float* out; unsigned char* ws; int ph_lo, ph_hi, li; float lam_init; float gscale; int pad0, pad1, pad2; };

__device__ __forceinline__ float* modt(unsigned char* ws, int layer, int slot, int modrow, int which) { return (float*)(ws + WS_MODT) + ((size_t)(((layer * 3 + slot) * 3 + modrow) * 3 + which)) * DM; }

__device__ __forceinline__ void prologue_phase(const KArgs& args, LAS unsigned char* L, int bx, int G) {
    const int tid = pg8::opaque_tid(), lane = tid & 63, wave = __builtin_amdgcn_readfirstlane(tid >> 6);
    unsigned char* ws = args.ws;
    LAS float* sl = (LAS float*)L;
    for (int i = tid; i < 3 * DM; i += NWAVES * 64) { const int r = i / DM, k = i % DM; const float v = (r < 2) ? args.in[1][r * DM + k] : args.in[3][k]; sl[i] = v / (1.0f + expf(-v)); }
    __syncthreads();
    LAS float* part = (LAS float*)(L + 24576);
    for (int rep_ = 0; rep_ < (PROBE_ID == 11 ? 2 : 1); ++rep_)
    for (int item = bx; item < NLAYER * 72; item += G) {
        const int layer = item / 72, n0 = (item % 72) * 256;
        const float* W = args.in[4] + ((size_t)layer * DM + wave * 256) * NMODC + n0 + lane * 4;
        const LAS float* s0 = sl + wave * 256;
        f32x4 a0 = {0.f, 0.f, 0.f, 0.f}, a1 = a0, a2 = a0;
#pragma unroll 8
        for (int kk = 0; kk < 256; ++kk) { const f32x4 w = *(const f32x4*)(W + (size_t)kk * NMODC); a0 += w * s0[kk]; a1 += w * s0[DM + kk]; a2 += w * s0[2 * DM + kk]; }
        *(LAS f32x4*)(part + (wave * 3 + 0) * 256 + lane * 4) = a0; *(LAS f32x4*)(part + (wave * 3 + 1) * 256 + lane * 4) = a1; *(LAS f32x4*)(part + (wave * 3 + 2) * 256 + lane * 4) = a2;
        __syncthreads();
        for (int idx = tid; idx < 768; idx += NWAVES * 64) { const int r = idx >> 8, cc = idx & 255, n = n0 + cc; float m = args.in[5][layer * NMODC + n];
#pragma unroll
            for (int w = 0; w < 8; ++w) m += part[(w * 3 + r) * 256 + cc];
            const int k9 = n / DM, c = n % DM, s = k9 / 3, which = k9 % 3; const float* g = args.in[6] + (size_t)layer * 6 * DM;
            if (which == 0) modt(ws, layer, s, r, 2)[c] = m;
            else if (which == 1) modt(ws, layer, s, r, 1)[c] = g[(2 * s) * DM + c] * (1.0f + m);
            else modt(ws, layer, s, r, 0)[c] = (s == 1 ? 1.0f : 0.5f) * m * g[(2 * s + 1) * DM + c]; }
        __syncthreads();
    }
    {
        LAS float* scr = (LAS float*)(L + 49152 + wave * 8448);
        const int gw = bx * NWAVES + wave, NGW = G * NWAVES;
        constexpr int I_FC1 = (DM / 64) * (NFC1 / 32), I_FC2 = (DFF / 64) * (DM / 32), I_AIN = (DM / 64) * (A_N / 32), I_SQ = (DM / 64) * (DM / 32), I_BIN = (DM / 64) * (B_N / 32), I_BOUT = (B_W / 64) * (DM / 32), I_CIN = (DM / 64) * (C_N / 32);
        constexpr int NITEMS = 8 * I_FC1 + 8 * I_FC2 + 2 * I_AIN + 2 * I_SQ + I_BIN + I_BOUT + I_CIN + I_SQ;
        for (int rep_ = 0; rep_ < (PROBE_ID == 12 ? 2 : 1); ++rep_)
        for (int it = gw; it < NITEMS; it += NGW) {
            int r = it;
            if (r < 8 * I_FC1) { const int mat = r / I_FC1; transpose_item(args.in[7] + (size_t)mat * DM * NFC1, DM, NFC1, (bf16*)(ws + WS_WFC1) + (size_t)mat * NFC1 * DM, 1, scr, r % I_FC1, lane); continue; } r -= 8 * I_FC1;
            if (r < 8 * I_FC2) { const int mat = r / I_FC2; transpose_item(args.in[8] + (size_t)mat * DFF * DM, DFF, DM, (bf16*)(ws + WS_WFC2) + (size_t)mat * DM * DFF, 0, scr, r % I_FC2, lane); continue; } r -= 8 * I_FC2;
            if (r < 2 * I_AIN) { const int mat = r / I_AIN; transpose_item(args.in[9] + (size_t)mat * DM * A_N, DM, A_N, (bf16*)(ws + WS_WAIN) + (size_t)mat * A_N * DM, 0, scr, r % I_AIN, lane); continue; } r -= 2 * I_AIN;
            if (r < 2 * I_SQ) { const int mat = r / I_SQ; transpose_item(args.in[10] + (size_t)mat * DM * DM, DM, DM, (bf16*)(ws + WS_WAOUT) + (size_t)mat * DM * DM, 0, scr, r % I_SQ, lane); continue; } r -= 2 * I_SQ;
            if (r < I_BIN) { transpose_item(args.in[12], DM, B_N, (bf16*)(ws + WS_WBIN), 0, scr, r, lane); continue; } r -= I_BIN;
            if (r < I_BOUT) { transpose_item(args.in[17], B_W, DM, (bf16*)(ws + WS_WBOUT), 0, scr, r, lane); continue; } r -= I_BOUT;
            if (r < I_CIN) { transpose_item(args.in[18], DM, C_N, (bf16*)(ws + WS_WCIN), 0, scr, r, lane); continue; } r -= I_CIN;
            transpose_item(args.in[19], DM, DM, (bf16*)(ws + WS_WCOUT), 0, scr, r, lane);
        }
    }
    for (int rep_ = 0; rep_ < (PROBE_ID == 13 ? 2 : 1); ++rep_)
    for (int e = bx * NWAVES * 64 + tid; e < SEQ * 64; e += G * NWAVES * 64) { const int t = e >> 6, p = e & 63, pi = p & 31;
        const float inv = (float)pow(10000.0, -(double)pi / 32.0); const float ang = (float)((p < 32) ? (t >> 6) : (t & 63)) * inv;
        float* o = (float*)(ws + WS_ROPE) + (size_t)e * 2; o[0] = (float)cos((double)ang); o[1] = (float)sin((double)ang); }
    for (int e = bx * NWAVES * 64 + tid; e < 8 * 128 * 128; e += G * NWAVES * 64) ((bf16*)(ws + WS_BSW))[e] = (bf16)f2bf(args.in[15][e]);
    if (bx == 0) { float* sm = (float*)(ws + WS_SMALL);
        for (int e = tid; e < SM_END; e += NWAVES * 64) { float v = 0.f;
            if (e < SM_VNG) { if (e < 32) v = args.in[11][e]; }
            else if (e < SM_VNB) v = args.in[13][e - SM_VNG];
            else if (e < SM_BS) v = args.in[14][e - SM_VNB];
            else if (e < SM_LQ1) v = args.in[16][e - SM_BS];
            else if (e < SM_LK1) v = args.in[20][e - SM_LQ1];
            else if (e < SM_LQ2) v = args.in[21][e - SM_LK1];
            else if (e < SM_LK2) v = args.in[22][e - SM_LQ2];
            else if (e < SM_SUBG) v = args.in[23][e - SM_LK2];
            else v = args.in[24][e - SM_SUBG];
            sm[e] = v; } }
}

__device__ __forceinline__ void norm_phase(const float* xs_lat, const float* xs_ctx, float* xd_lat, float* xd_ctx, const bf16* Y, const float* postT, const float* preT, bf16* H, int nrows, float oscale = 1.0f) {
    const int tid = pg8::opaque_tid(), lane = tid & 63, gw = blockIdx.x * NWAVES + __builtin_amdgcn_readfirstlane(tid >> 6), NGW = gridDim.x * NWAVES;
    for (int row = gw; row < nrows; row += NGW) {
        const int modrow = row < SEQ ? 0 : (row < MLAT ? 1 : 2);
        const float* xs = (row < MLAT) ? xs_lat + (size_t)row * DM : xs_ctx + (size_t)(row - MLAT) * DM;
        float* xd = (row < MLAT) ? xd_lat + (size_t)row * DM : xd_ctx + (size_t)(row - MLAT) * DM;
        f32x4 xv[8];
#pragma unroll
        for (int j = 0; j < 8; ++j) xv[j] = *(const f32x4*)(xs + 256 * j + 4 * lane);
        if (Y) {
            const bf16* yr = Y + (size_t)row * DM; const float* At = postT + (size_t)modrow * 3 * DM;
            f32x4 yv[8]; float ss = 0.f;
#pragma unroll
            for (int j = 0; j < 8; ++j) { const v2u raw = *(const v2u*)(yr + 256 * j + 4 * lane);
                yv[j].x = __builtin_bit_cast(float, raw.x << 16); yv[j].y = __builtin_bit_cast(float, raw.x & 0xffff0000u); yv[j].z = __builtin_bit_cast(float, raw.y << 16); yv[j].w = __builtin_bit_cast(float, raw.y & 0xffff0000u);
                ss += (yv[j].x * yv[j].x + yv[j].y * yv[j].y) + (yv[j].z * yv[j].z + yv[j].w * yv[j].w); }
            const float ry = 1.0f / sqrtf(wave_sum(ss, lane) * (1.0f / DM) + EPS);
#pragma unroll
            for (int j = 0; j < 8; ++j) { const f32x4 a = *(const f32x4*)(At + 256 * j + 4 * lane); xv[j] += yv[j] * ry * a; }
        }
#pragma unroll
        for (int j = 0; j < 8; ++j) *(f32x4*)(xd + 256 * j + 4 * lane) = (PROBE_ID >= 20) ? xv[j] * oscale : xv[j];
        if (H) {
            const float* Bt = preT + (size_t)(modrow * 3 + 1) * DM; const float* Ct = preT + (size_t)(modrow * 3 + 2) * DM;
            float ss = 0.f;
#pragma unroll
            for (int j = 0; j < 8; ++j) ss += (xv[j].x * xv[j].x + xv[j].y * xv[j].y) + (xv[j].z * xv[j].z + xv[j].w * xv[j].w);
            const float rx = 1.0f / sqrtf(wave_sum(ss, lane) * (1.0f / DM) + EPS);
            bf16* hr = H + (size_t)row * DM;
#pragma unroll
            for (int j = 0; j < 8; ++j) { const f32x4 b = *(const f32x4*)(Bt + 256 * j + 4 * lane), c = *(const f32x4*)(Ct + 256 * j + 4 * lane); const f32x4 h = xv[j] * rx * b + c;
                v2u o; o.x = pk2(h.x, h.y); o.y = pk2(h.z, h.w); *(v2u*)(hr + 256 * j + 4 * lane) = o; }
        }
    }
}
__device__ __forceinline__ void vstats_phase(const bf16* QKV, float* stats, int nrows) {
    const int tid = pg8::opaque_tid(), lane = tid & 63, gw = blockIdx.x * NWAVES + __builtin_amdgcn_readfirstlane(tid >> 6), NGW = gridDim.x * NWAVES;
    for (int row = gw; row < nrows; row += NGW) {
        const bf16* vr = QKV + (size_t)row * B_N + B_W + lane * 8; bf16x8 raw[12]; float s = 0.f;
#pragma unroll
        for (int i = 0; i < 12; ++i) { raw[i] = *(const bf16x8*)(vr + i * 512);
#pragma unroll
            for (int e = 0; e < 8; ++e) s += bf2f((unsigned short)raw[i][e]); }
        const float mean = wave_sum(s, lane) * (1.0f / B_W); float q = 0.f;
#pragma unroll
        for (int i = 0; i < 12; ++i)
#pragma unroll
            for (int e = 0; e < 8; ++e) { const float d = bf2f((unsigned short)raw[i][e]) - mean; q += d * d; }
        const float rstd = 1.0f / sqrtf(wave_sum(q, lane) * (1.0f / B_W) + EPS);
        if (lane == 0) { stats[2 * row] = mean; stats[2 * row + 1] = rstd; }
    }
}
__device__ __forceinline__ void spatial_phase(const bf16* QKV, bf16* Gout, const bf16* BSW, const float* stats, const float* vg, const float* vb, const float* bs, char* lds, int nchunks, int bx, int G) {
    const int tid = pg8::opaque_tid(), lane = tid & 63, wave = __builtin_amdgcn_readfirstlane(tid >> 6), r32 = lane & 31, hi = lane >> 5;
    constexpr int OP = 132;
    float* Ob = (float*)(lds + 32768);
    const int sr = tid >> 4, sc = (tid & 15) * 8, pb = wave & 3, dh = wave >> 2;
    for (int u = bx; u < nchunks * 48; u += G) {
        const int cb = u % 6, g = (u / 6) & 7, ch = u / 48, row0 = ch * 128, c0 = g * 768 + cb * 128;
        bf16x8 ureg[4];
#pragma unroll
        for (int i = 0; i < 4; ++i) ureg[i] = *(const bf16x8*)(QKV + (size_t)(row0 + sr + 32 * i) * B_N + c0 + sc);
        { const f32x4 g0 = *(const f32x4*)(vg + c0 + sc), g1 = *(const f32x4*)(vg + c0 + sc + 4), b0 = *(const f32x4*)(vb + c0 + sc), b1 = *(const f32x4*)(vb + c0 + sc + 4);
#pragma unroll
          for (int i = 0; i < 4; ++i) { const int q = sr + 32 * i; const bf16x8 raw = *(const bf16x8*)(QKV + (size_t)(row0 + q) * B_N + B_W + c0 + sc);
              const float mu = stats[2 * (row0 + q)], rs = stats[2 * (row0 + q) + 1]; float t[8];
#pragma unroll
              for (int e = 0; e < 8; ++e) t[e] = (bf2f((unsigned short)raw[e]) - mu) * rs * (e < 4 ? g0[e & 3] : g1[e & 3]) + (e < 4 ? b0[e & 3] : b1[e & 3]);
              v4u w; w.x = pk2(t[0], t[1]); w.y = pk2(t[2], t[3]); w.z = pk2(t[4], t[5]); w.w = pk2(t[6], t[7]);
              *(v4u*)(lds + (i >> 1) * 16384 + att::v_st(sr + 32 * (i & 1), sc)) = w; } }
        __syncthreads();
        bf16x8 pa[2][4];
        { const bf16* Wg = BSW + (size_t)g * 16384 + (size_t)(pb * 32 + r32) * 128 + hi * 8;
#pragma unroll
          for (int kt = 0; kt < 2; ++kt)
#pragma unroll
              for (int kk = 0; kk < 4; ++kk) pa[kt][kk] = *(const bf16x8*)(Wg + kt * 64 + kk * 16); }
        f32x16 o0 = {}, o1 = {};
#pragma unroll
        for (int kt = 0; kt < 2; ++kt) { const int vbase = (int)(uintptr_t)(lds + kt * 16384) + att::v_rd_base(lane);
            if (dh == 0) { att::pv_one<0>(o0, vbase, pa[kt][0], pa[kt][1], pa[kt][2], pa[kt][3]); att::pv_one<1>(o1, vbase, pa[kt][0], pa[kt][1], pa[kt][2], pa[kt][3]); }
            else { att::pv_one<2>(o0, vbase, pa[kt][0], pa[kt][1], pa[kt][2], pa[kt][3]); att::pv_one<3>(o1, vbase, pa[kt][0], pa[kt][1], pa[kt][2], pa[kt][3]); } }
#pragma unroll
        for (int r = 0; r < 16; ++r) { const int p = pb * 32 + (r & 3) + 8 * (r >> 2) + 4 * hi; Ob[p * OP + dh * 64 + r32] = o0[r]; Ob[p * OP + dh * 64 + 32 + r32] = o1[r]; }
        __syncthreads();
#pragma unroll
        for (int i = 0; i < 4; ++i) { const int p = sr + 32 * i; const float bias = bs[g * 128 + p];
            const f32x4 x0 = *(const f32x4*)(Ob + p * OP + sc), x1 = *(const f32x4*)(Ob + p * OP + sc + 4); float t[8];
#pragma unroll
            for (int e = 0; e < 8; ++e) t[e] = bf2f((unsigned short)ureg[i][e]) * ((e < 4 ? x0[e & 3] : x1[e & 3]) + bias);
            v4u w; w.x = pk2(t[0], t[1]); w.y = pk2(t[2], t[3]); w.z = pk2(t[4], t[5]); w.w = pk2(t[6], t[7]);
            *(v4u*)(Gout + (size_t)(row0 + p) * B_W + c0 + sc) = w; }
        __syncthreads();
    }
}
__device__ __forceinline__ void combine_phase(const float* OC, bf16* AO, const float* lq1, const float* lk1, const float* lq2, const float* lk2, const float* sg, float lam_init, int nrows) {
    const int tid = pg8::opaque_tid(), lane = tid & 63, gw = blockIdx.x * NWAVES + __builtin_amdgcn_readfirstlane(tid >> 6), NGW = gridDim.x * NWAVES;
    const float d1 = wave_sum(lq1[lane] * lk1[lane] + lq1[lane + 64] * lk1[lane + 64], lane), d2 = wave_sum(lq2[lane] * lk2[lane] + lq2[lane + 64] * lk2[lane + 64], lane);
    const float lam = expf(d1) - expf(d2) + lam_init;
    const f32x4 gv = *(const f32x4*)(sg + 4 * lane) * (1.0f - lam_init);
    for (int row = gw; row < nrows; row += NGW) {
        const float* orow = OC + (size_t)row * 4096; bf16* ar = AO + (size_t)row * DM;
#pragma unroll
        for (int h = 0; h < 8; ++h) { const f32x4 a = *(const f32x4*)(orow + (2 * h) * 256 + 4 * lane), b = *(const f32x4*)(orow + (2 * h + 1) * 256 + 4 * lane); const f32x4 o = a - lam * b;
            const float rs = 1.0f / sqrtf(wave_sum((o.x * o.x + o.y * o.y) + (o.z * o.z + o.w * o.w), lane) * (1.0f / 256.0f) + EPS); const f32x4 v = o * rs * gv;
            v2u w; w.x = pk2(v.x, v.y); w.y = pk2(v.z, v.w); *(v2u*)(ar + h * 256 + 4 * lane) = w; }
    }
}

template <int K, int LDA, int EPI>
__device__ __forceinline__ void ctx_tile(const bf16* A, const bf16* Bt, bf16* out, int ldc, int ntn, int tile, LAS unsigned char* L) {
    const int tid = pg8::opaque_tid(), lane = tid & 63, wave = __builtin_amdgcn_readfirstlane(tid >> 6), r32 = lane & 31, hi = lane >> 5;
    const int tm = tile / ntn, row0 = tm * 64, col0 = (tile - tm * ntn) * 64;
    constexpr int NB = K / 64;
    static_assert(K % 64 == 0, "K must be a multiple of 64");
    LAS unsigned char* W = L + wave * 16384;
    const int lr = lane >> 3, lc = lane & 7;
    const bf16* ag = A + (size_t)(row0 + lr) * LDA + lc * 8;
    const bf16* bg = Bt + (size_t)(col0 + lr) * K + lc * 8;
    const int wofs = lr * 128 + ((lc ^ (lr & 7)) << 4);
    const int rofs = r32 * 128;
    f32x16 acc00 = {}, acc01 = {}, acc10 = {}, acc11 = {};
    bf16x8 ga0[8], gb0[8], ga1[8], gb1[8];
#define CT_LOAD(GA, GB, kb_) do { _Pragma("unroll") for (int i = 0; i < 8; ++i) { GA[i] = *(const bf16x8*)(ag + (size_t)(8 * i) * LDA + (kb_) * 64); GB[i] = *(const bf16x8*)(bg + (size_t)(8 * i) * K + (kb_) * 64); } } while (0)
#define CT_STORE(GA, GB) do { _Pragma("unroll") for (int i = 0; i < 8; ++i) { *(LAS bf16x8*)(W + i * 1024 + wofs) = GA[i]; *(LAS bf16x8*)(W + 8192 + i * 1024 + wofs) = GB[i]; } } while (0)
#define CT_MMA() do { _Pragma("unroll") for (int s = 0; s < 4; ++s) { const int ch = (((2 * s + hi) ^ (r32 & 7)) << 4); \
        const bf16x8 a0 = *(const LAS bf16x8*)(W + rofs + ch), a1 = *(const LAS bf16x8*)(W + 4096 + rofs + ch), b0 = *(const LAS bf16x8*)(W + 8192 + rofs + ch), b1 = *(const LAS bf16x8*)(W + 12288 + rofs + ch); \
        acc00 = __builtin_amdgcn_mfma_f32_32x32x16_bf16(a0, b0, acc00, 0, 0, 0); acc01 = __builtin_amdgcn_mfma_f32_32x32x16_bf16(a0, b1, acc01, 0, 0, 0); \
        acc10 = __builtin_amdgcn_mfma_f32_32x32x16_bf16(a1, b0, acc10, 0, 0, 0); acc11 = __builtin_amdgcn_mfma_f32_32x32x16_bf16(a1, b1, acc11, 0, 0, 0); } } while (0)
    int kb = wave;
    if (kb < NB) CT_LOAD(ga0, gb0, kb);
    if (kb + 8 < NB) CT_LOAD(ga1, gb1, kb + 8);
    for (; kb < NB; kb += 16) {
        CT_STORE(ga0, gb0);
        if (kb + 16 < NB) CT_LOAD(ga0, gb0, kb + 16);
        CT_MMA();
        if (kb + 8 < NB) {
            CT_STORE(ga1, gb1);
            if (kb + 24 < NB) CT_LOAD(ga1, gb1, kb + 24);
            CT_MMA();
        }
    }
#undef CT_LOAD
#undef CT_STORE
#undef CT_MMA
    LDS_WAIT(); asm volatile("" ::: "memory");
    LAS float* red = (LAS float*)L + wave * 4096;
#pragma unroll
    for (int r = 0; r < 16; ++r) { const int m = (r & 3) + 8 * (r >> 2) + 4 * hi;
        red[m * 64 + r32] = acc00[r]; red[m * 64 + 32 + r32] = acc01[r]; red[(32 + m) * 64 + r32] = acc10[r]; red[(32 + m) * 64 + 32 + r32] = acc11[r]; }
    __syncthreads();
    { const int o = tid * 8, m = o >> 6, n = o & 63; f32x4 s0 = {0.f, 0.f, 0.f, 0.f}, s1 = s0;
#pragma unroll
      for (int w = 0; w < 8; ++w) { s0 += *(const LAS f32x4*)((LAS float*)L + w * 4096 + o); s1 += *(const LAS f32x4*)((LAS float*)L + w * 4096 + o + 4); }
      if (EPI == 1) {
#pragma unroll
          for (int j = 0; j < 4; ++j) { s0[j] = pg8::gelu_tanh(s0[j]); s1[j] = pg8::gelu_tanh(s1[j]); } }
      v4u w4; w4.x = pk2(s0.x, s0.y); w4.y = pk2(s0.z, s0.w); w4.z = pk2(s1.x, s1.y); w4.w = pk2(s1.z, s1.w);
      *(v4u*)(out + (size_t)(row0 + m) * ldc + col0 + n) = w4; }
    __syncthreads();
}

__global__ void __launch_bounds__(NWAVES * 64, 2) fwd(KArgs args) {
    extern __shared__ __attribute__((aligned(16))) unsigned char lds[];
    LAS unsigned char* L = (LAS unsigned char*)lds;
    const int tid = threadIdx.x, G = gridDim.x, bx = blockIdx.x;
    unsigned char* ws0 = args.ws;
    for (int u = tid; u < (LDS_BYTES - RING_BYTES) / 4; u += NWAVES * 64) ((LAS unsigned*)(L + RING_BYTES))[u] = 0u;
    __syncthreads();
    const int lo = args.ph_lo, hi = args.ph_hi;
    XcdBarrier bar; bar.bar = (unsigned*)(ws0 + WS_CTL) + CW_BAR + args.li * XCD_BAR_WORDS; bar.x = 0; bar.st = (volatile LAS unsigned*)(L + MISC_OFF + 32);
    if (hi - lo > 1) bar = xcd_barrier_post((unsigned*)(ws0 + WS_CTL) + CW_BAR + args.li * XCD_BAR_WORDS, (volatile LAS unsigned*)(L + MISC_OFF + 32));
    int ph = 0; unsigned long long bacc_ = 0; (void)bacc_;
#define PHASE_BEGIN if (ph >= lo && ph < hi) {
#define PHASE_END   if (ph + 1 < hi) { unsigned long long br0_ = 0; if (PROBE_ID == 21) br0_ = wall_clock64(); xcd_barrier(bar); if (PROBE_ID == 21) bacc_ += wall_clock64() - br0_; } } ++ph;
#define SETUP_PTRS() GAS unsigned char* wsg_ = (GAS unsigned char*)args.ws; asm volatile("" : "+s"(wsg_)); unsigned char* ws = (unsigned char*)wsg_; \
    GAS float* xlg_ = (GAS float*)args.out; asm volatile("" : "+s"(xlg_)); float* XL = (float*)xlg_; float* XC = (float*)(ws + WS_XC); \
    bf16* H = (bf16*)(ws + WS_H); bf16* HID = (bf16*)(ws + WS_HID); bf16* Y = (bf16*)(ws + WS_Y); bf16* QKV = (bf16*)(ws + WS_QKV); bf16* AO = (bf16*)(ws + WS_AO); float* OC = (float*)(ws + WS_OC); \
    const float* ROPE = (const float*)(ws + WS_ROPE); const float* SM = (const float*)(ws + WS_SMALL); (void)XC; (void)HID; (void)Y; (void)QKV; (void)AO; (void)OC; (void)ROPE; (void)SM; (void)H

    { SETUP_PTRS();
    PHASE_BEGIN
#ifndef OFF_PRO
    prologue_phase(args, L, bx, G);
#endif
    PHASE_END
    PHASE_BEGIN norm_phase(args.in[0], args.in[2], XL, XC, nullptr, nullptr, modt(ws, 0, 0, 0, 0), H, MALL); PHASE_END }

    for (int sl = 0; sl < 3 * NLAYER; ++sl) {
        SETUP_PTRS();
        const int layer = sl / 3, typ = sl % 3, kind = layer % 3, jm = layer / 3; const bool lastl = (layer == NLAYER - 1);
        const int Mrows = (lastl && typ >= 1) ? MLAT : MALL;
        pg8::Gemm gy;
        if (typ != 1) {
            const int f = (typ == 0) ? 0 : 1;
            PHASE_BEGIN
                pg8::Gemm g{H, (const bf16*)(ws + WS_WFC1) + (size_t)(layer * 2 + f) * NFC1 * DM, Mrows, NFC1, DM, DM}; pg8::StaticOrder S; S.init(Mrows, NFC1, G, bx);
                pg8::EpiSwiglu E{HID, DFF};
                #ifndef OFF_FC1
                unsigned long long pt0_ = 0, pr0_ = 0; if (PROBE_ID == 20 && sl == 3 && bx == 0) { pt0_ = clock64(); pr0_ = wall_clock64(); }
                for (int rep_ = 0; rep_ < (PROBE_ID == 2 ? 2 : 1); ++rep_) { pg8::gemm_phase<pg8::EpiSwiglu, pg8::StaticOrder, true, true, DM, DM>(L, g, S, E); }
                if (PROBE_ID == 20 && sl == 3 && bx == 0 && threadIdx.x == 0) { const unsigned long long t1_ = clock64(), r1_ = wall_clock64();
                    __hip_atomic_store((float*)(ws + WS_SMALL) + SM_END, floorf((float)(t1_ - pt0_) / ((float)(r1_ - pr0_) * 10.0f) * 4.0f + 0.5f) * 0.02f, __ATOMIC_RELAXED, __HIP_MEMORY_SCOPE_AGENT); }
#endif
            PHASE_END
            gy = pg8::Gemm{HID, (const bf16*)(ws + WS_WFC2) + (size_t)(layer * 2 + f) * DM * DFF, Mrows, DM, DFF, DFF};
        } else {
            if (kind != 1) {
                PHASE_BEGIN
                    const int N = (kind == 0) ? A_N : C_N, Min = (kind == 0) ? MALL : MLAT;
                    pg8::Gemm g{H, (kind == 0) ? (const bf16*)(ws + WS_WAIN) + (size_t)jm * A_N * DM : (const bf16*)(ws + WS_WCIN), Min, N, DM, DM}; pg8::StaticOrder S; S.init(Min, N, G, bx);
                    pg8::EpiBf16X<0> E{QKV, N, ROPE, (kind == 0) ? 2560 : 4096};
                    #ifndef OFF_ROPE
                    for (int rep_ = 0; rep_ < (PROBE_ID == 8 ? 2 : 1); ++rep_) { pg8::gemm_phase<pg8::EpiBf16X<0>, pg8::StaticOrder, true, true, DM, DM>(L, g, S, E); }
                    if (kind == 2) for (int t = bx; t < 8 * (C_N / 64); t += G) ctx_tile<DM, DM, 0>(H + (size_t)MLAT * DM, g.Bt, QKV + (size_t)MLAT * C_N, C_N, C_N / 64, t, L);
#endif
                PHASE_END
            } else {
                PHASE_BEGIN
                    pg8::Gemm g{H, (const bf16*)(ws + WS_WBIN), MLAT, B_N, DM, DM}; pg8::StaticOrder S; S.init(MLAT, B_N, G, bx);
                    pg8::EpiBf16X<1> E{QKV, B_N, nullptr, 0};
                    #ifndef OFF_GELU
                    for (int rep_ = 0; rep_ < (PROBE_ID == 9 ? 2 : 1); ++rep_) { pg8::gemm_phase<pg8::EpiBf16X<1>, pg8::StaticOrder, true, true, DM, DM>(L, g, S, E); }
                    for (int t = bx; t < 8 * (B_N / 64); t += G) ctx_tile<DM, DM, 1>(H + (size_t)MLAT * DM, g.Bt, QKV + (size_t)MLAT * B_N, B_N, B_N / 64, t, L);
#endif
                PHASE_END
            }
            if (kind == 0) {
                PHASE_BEGIN
                    const int nlat = NBATCH * 16 * 16, nall = nlat + (lastl ? 0 : NBATCH * 16);
                    for (int u = bx; u < nall; u += G) {
                        att::Args a; a.qkv = QKV; a.ld = A_N; a.n0 = 4; a.has_sink = 1; a.out = AO; a.ldo = DM;
                        if (u < nlat) { const int qb = u & 15, h = (u >> 4) & 15, b = u >> 8;
                            a.qrow0 = b * SEQ + qb * 256; a.qcol = h * 128; a.kcol = 2048 + (h >> 2) * 128; a.vcol = 2560 + (h >> 2) * 128; a.ctxrow0 = MLAT + b * CTXL; a.latrow0 = b * SEQ;
                            a.kstart = qb * 256 - 128; a.n1 = 8; a.qpos0 = qb * 256; a.sink = SM[SM_SINK + jm * 16 + h]; a.ocol = h * 128; }
                        else { const int cu = u - nlat, h = cu & 15, b = cu >> 4;
                            a.qrow0 = MLAT + b * CTXL; a.qcol = h * 128; a.kcol = 2048 + (h >> 2) * 128; a.vcol = 2560 + (h >> 2) * 128; a.ctxrow0 = MLAT + b * CTXL; a.latrow0 = b * SEQ;
                            a.kstart = 0; a.n1 = 0; a.qpos0 = 0; a.sink = SM[SM_SINK + jm * 16 + h]; a.ocol = h * 128; }
                        #ifndef OFF_ATTA
                        for (int rep_ = 0; rep_ < (PROBE_ID == 7 ? 2 : 1); ++rep_) { att::attn_unit<true, true, A_N>(a, (char*)lds); }
#endif
                    }
                PHASE_END
                gy = pg8::Gemm{AO, (const bf16*)(ws + WS_WAOUT) + (size_t)jm * DM * DM, Mrows, DM, DM, DM};
            } else if (kind == 1) {
                PHASE_BEGIN vstats_phase(QKV, (float*)(ws + WS_STATS), MALL); PHASE_END
                PHASE_BEGIN
spatial_phase(QKV, (bf16*)OC, (const bf16*)(ws + WS_BSW), (const float*)(ws + WS_STATS), SM + SM_VNG, SM + SM_VNB, SM + SM_BS, (char*)lds, MALL / 128, bx, G);
                PHASE_END
                gy = pg8::Gemm{(const bf16*)OC, (const bf16*)(ws + WS_WBOUT), Mrows, DM, B_W, B_W};
            } else {
                PHASE_BEGIN
                    const int nlat = NBATCH * 8 * 32, nall = nlat + (lastl ? 0 : NBATCH * 8 * 2);
                    float lam;
                    { const int ln_ = pg8::opaque_tid() & 63; const float* q1 = SM + SM_LQ1; const float* k1 = SM + SM_LK1; const float* q2 = SM + SM_LQ2; const float* k2 = SM + SM_LK2;
                      const float d1 = wave_sum(q1[ln_] * k1[ln_] + q1[ln_ + 64] * k1[ln_ + 64], ln_), d2 = wave_sum(q2[ln_] * k2[ln_] + q2[ln_ + 64] * k2[ln_ + 64], ln_);
                      lam = expf(d1) - expf(d2) + args.lam_init; }
                    for (int u = bx; u < nall; u += G) {
                        int qrow0, hh, b, n1;
                        if (u < nlat) { const int qb = u & 31; hh = (u >> 5) & 7; b = u >> 8; qrow0 = b * SEQ + qb * 128; n1 = 64; }
                        else { const int cu = u - nlat, qb = cu & 1; hh = (cu >> 1) & 7; b = cu >> 4; qrow0 = MLAT + b * CTXL + qb * 128; n1 = 0; }
                        for (int rep_ = 0; rep_ < (PROBE_ID == 6 ? 2 : 1); ++rep_) { att::dattn_unit<C_N>(QKV, qrow0, hh, MLAT + b * CTXL, b * SEQ, 4, n1, lam, args.gscale, SM + SM_SUBG, AO, L, (char*)lds); }
                    }
                PHASE_END
                gy = pg8::Gemm{AO, (const bf16*)(ws + WS_WCOUT), Mrows, DM, DM, DM};
            }
        }
        PHASE_BEGIN
            const bool hasctx = (gy.M == MALL); gy.M = MLAT;
            pg8::StaticOrder S; S.init(MLAT, DM, G, bx); pg8::EpiBf16X<2> E{Y, DM, nullptr, 0};
            bf16* Yc = Y + (size_t)MLAT * DM;
            if (typ != 1) { for (int rep_ = 0; rep_ < (PROBE_ID == 3 ? 2 : 1); ++rep_) { pg8::gemm_phase<pg8::EpiBf16X<2>, pg8::StaticOrder, true, true, DFF, DFF>(L, gy, S, E); }
                for (int rep_ = 0; rep_ < (PROBE_ID == 4 ? 2 : 1); ++rep_) { if (hasctx) for (int t = bx; t < 256; t += G) ctx_tile<DFF, DFF, 0>(gy.A + (size_t)MLAT * DFF, gy.Bt, Yc, DM, 32, t, L); } }
            else if (kind == 1) { pg8::gemm_phase<pg8::EpiBf16X<2>, pg8::StaticOrder, true, true, B_W, B_W>(L, gy, S, E);
                if (hasctx) for (int t = bx; t < 256; t += G) ctx_tile<B_W, B_W, 0>(gy.A + (size_t)MLAT * B_W, gy.Bt, Yc, DM, 32, t, L); }
            else { pg8::gemm_phase<pg8::EpiBf16X<2>, pg8::StaticOrder, true, true, DM, DM>(L, gy, S, E);
                if (hasctx) for (int t = bx; t < 256; t += G) ctx_tile<DM, DM, 0>(gy.A + (size_t)MLAT * DM, gy.Bt, Yc, DM, 32, t, L); }
        PHASE_END
        if (PROBE_ID == 21 && sl == 3 * NLAYER - 2 && bx == PROBE_BLK && threadIdx.x == 0) __hip_atomic_store((float*)(ws + WS_SMALL) + SM_END, floorf((float)bacc_ * 0.01f / 500.0f + 0.5f) * 0.02f, __ATOMIC_RELAXED, __HIP_MEMORY_SCOPE_AGENT);
        PHASE_BEGIN
            const bool fin = (sl == 3 * NLAYER - 1);
            const int nl = (typ == 2) ? layer + 1 : layer, ns = (typ == 2) ? 0 : typ + 1;
            if (PROBE_ID == 5) norm_phase(XL, XC, (float*)(ws + WS_END), (float*)(ws + WS_END + 64 * MiB), Y, modt(ws, layer, typ, 0, 0), fin ? nullptr : modt(ws, nl, ns, 0, 0), fin ? nullptr : (bf16*)(ws + WS_END + 72 * MiB), Mrows);
            norm_phase(XL, XC, XL, XC, Y, modt(ws, layer, typ, 0, 0), fin ? nullptr : modt(ws, nl, ns, 0, 0), fin ? nullptr : H, Mrows, (PROBE_ID >= 20 && fin) ? 1.0f + __hip_atomic_load((float*)(ws + WS_SMALL) + SM_END, __ATOMIC_RELAXED, __HIP_MEMORY_SCOPE_AGENT) : 1.0f);
        PHASE_END
    }
#undef PHASE_BEGIN
#undef PHASE_END
}

static int count_phases() { int n = 2; for (int sl = 0; sl < 3 * NLAYER; ++sl) { const int layer = sl / 3, typ = sl % 3, kind = layer % 3; n += (typ != 1) ? 3 : (kind == 1 ? 5 : 4); } return n; }
extern "C" void kernel_launch(void* const* d_in, const int* in_sizes, int n_in, void* d_out, int out_size, void* d_ws, size_t ws_size, hipStream_t stream) {
    static int grid = 0;
    if (grid == 0) {
        if (n_in != 25 || in_sizes[0] != MLAT * DM || out_size != MLAT * DM || ws_size < WS_END) { fprintf(stderr, "kernel_launch: unexpected shapes (n_in %d, in0 %d, out %d, ws %zu < %zu)\n", n_in, n_in > 0 ? in_sizes[0] : -1, out_size, ws_size, (size_t)WS_END); grid = -1; return; }
        int dev = 0, cus = 0, per_cu = 0;
        if (hipGetDevice(&dev) != hipSuccess || hipDeviceGetAttribute(&cus, hipDeviceAttributeMultiprocessorCount, dev) != hipSuccess) { grid = -1; return; }
        if (hipFuncSetAttribute((const void*)fwd, hipFuncAttributeMaxDynamicSharedMemorySize, LDS_BYTES) != hipSuccess) { fprintf(stderr, "kernel_launch: hipFuncSetAttribute failed\n"); grid = -1; return; }
        if (hipOccupancyMaxActiveBlocksPerMultiprocessor(&per_cu, (const void*)fwd, NWAVES * 64, LDS_BYTES) != hipSuccess || per_cu < 1) fprintf(stderr, "kernel_launch: occupancy query reports %d\n", per_cu);
        (void)hipGetLastError();
        grid = cus;
    }
    if (grid < 0) return;
    if (hipMemsetAsync((char*)d_ws + WS_CTL, 0, CTL_BYTES, stream) != hipSuccess) return;
    KArgs a{};
    for (int i = 0; i < 25; ++i) a.in[i] = (const float*)d_in[i];
    a.out = (float*)d_out; a.ws = (unsigned char*)d_ws; a.lam_init = (float)(0.8 - 0.6 * exp(-0.3 * 2.0)); a.gscale = 1.0f - a.lam_init;
    const int nph = count_phases();
#if MK_PER_PHASE
    for (int p = 0; p < nph; ++p) { a.ph_lo = p; a.ph_hi = p + 1; a.li = 0; hipLaunchKernelGGL(fwd, dim3(grid), dim3(NWAVES * 64), LDS_BYTES, stream, a); }
#else
    a.ph_lo = 0; a.ph_hi = nph; a.li = 0; hipLaunchKernelGGL(fwd, dim3(grid), dim3(NWAVES * 64), LDS_BYTES, stream, a);
#endif
    const hipError_t le = hipPeekAtLastError();
    if (le != hipSuccess) fprintf(stderr, "kernel_launch: launch failed: %s\n", hipGetErrorName(le));
}
```

```cpp
#include <hip/hip_runtime.h>
#include <cstdio>
#include <cstdint>
#include <cmath>

#ifndef PROBE_ID
#define PROBE_ID 0
#endif
#ifndef PROBE_BLK
#define PROBE_BLK 0
#endif
#ifndef MK_PER_PHASE
#define MK_PER_PHASE 0
#endif

namespace pg8 {
#define PG8_LAS __attribute__((address_space(3)))
typedef unsigned short bf16_t;
typedef short bf16x8 __attribute__((ext_vector_type(8)));
typedef float f32x4 __attribute__((ext_vector_type(4)));
typedef unsigned u32x4 __attribute__((ext_vector_type(4)));
__device__ __forceinline__ int opaque_tid() { int t = threadIdx.x; asm volatile("" : "+v"(t)); return t; }
constexpr int BM = 256, BK = 64, HALF = 128, HTB = HALF * BK * 2  , STAGE_BYTES = 8 * HTB, NXCD = 8, WGM = 8;

__host__ __device__ __forceinline__ int lds_byte(int r, int c) { const int st = (r >> 4) * 2 + (c >> 5), rr = r & 15, cc = c & 31, ob = rr * 64 + cc * 2; return st * 1024 + (ob ^ (((ob >> 9) & 1) << 5)); }
__host__ __device__ __forceinline__ void stage_rc(int b, int& R, int& C) { const int st = b / 1024, sb = b % 1024, swz = sb ^ (((sb >> 9) & 1) << 5); R = (st >> 1) * 16 + swz / 64; C = (st & 1) * 32 + (swz % 64) / 2; }
__host__ __device__ __forceinline__ int perm32(int rho) { const int n = rho >> 4, i = rho & 15; return 8 * (i >> 2) + 4 * n + (i & 3); }

struct Unit { int pm, pn; };
struct Gemm { const bf16_t* A; const bf16_t* Bt; int M, N, K, lda; };

struct StaticOrder {
    int nM, nN, nwg, G, c;
    __host__ __device__ void init(int M, int N, int G_, int c_) { nM = M / BM; nN = N / BM; nwg = nM * nN; G = G_; c = c_; }
    __host__ __device__ bool next(int i, Unit& u) const {
        const long L = (long)i * G + c; if (L >= nwg) return false;
        int wgid = (int)L; { const int q = nwg / NXCD, r = nwg % NXCD, xcd = wgid % NXCD, off = wgid / NXCD; wgid = (xcd < r ? xcd * (q + 1) : r * (q + 1) + (xcd - r) * q) + off; }
        const int nig = WGM * nN, gid = wgid / nig, fm = gid * WGM, gsz = (nM - fm) < WGM ? (nM - fm) : WGM;
        u.pm = fm + ((wgid % nig) % gsz); u.pn = (wgid % nig) / gsz; return true;
    }
    __device__ __forceinline__ void a_ready(const Unit&) const {}
    __device__ __forceinline__ void done(const Unit&) const {}
};


__device__ __forceinline__ unsigned cvt_pk_bf16(float lo, float hi) { unsigned r; asm volatile("v_cvt_pk_bf16_f32 %0, %1, %2" : "=v"(r) : "v"(lo), "v"(hi)); return r; }
__device__ __forceinline__ float sigmoid_fast(float z) { return __builtin_amdgcn_rcpf(1.0f + __builtin_amdgcn_exp2f(-1.4426950408889634f * z)); }
__device__ __forceinline__ float gelu_tanh(float x) { const float z = 1.5957691216057308f * (x + 0.044715f * x * x * x); return x * sigmoid_fast(z); }

struct EpiSwiglu {
    static constexpr bool PERM = true, AFTER_DRAIN = false;
    bf16_t* O; int ldc;
    __device__ __forceinline__ void operator()(const f32x4 (&acc)[2][2][4][2], const Unit& u, int wr, int wc, int fr, int fq) const {
        const int row0 = u.pm * BM + wr * 64 + fr, col0 = u.pn * HALF + wc * 32 + 8 * fq;
#pragma unroll
        for (int ai = 0; ai < 2; ++ai)
#pragma unroll
            for (int m = 0; m < 4; ++m) { bf16_t* rowp = O + (size_t)(row0 + ai * HALF + m * 16) * ldc + col0;
                float v[8];
#pragma unroll
                for (int n = 0; n < 2; ++n)
#pragma unroll
                    for (int j = 0; j < 4; ++j) { const float g = acc[ai][0][m][n][j], uu = acc[ai][1][m][n][j]; v[n * 4 + j] = g * sigmoid_fast(g) * uu; }
                u32x4 w; w.x = cvt_pk_bf16(v[0], v[1]); w.y = cvt_pk_bf16(v[2], v[3]); w.z = cvt_pk_bf16(v[4], v[5]); w.w = cvt_pk_bf16(v[6], v[7]);
                *(u32x4*)rowp = w; }
    }
};
struct EpiF32 {
    static constexpr bool PERM = true, AFTER_DRAIN = false;
    float* C; int ldc;
    __device__ __forceinline__ void operator()(const f32x4 (&acc)[2][2][4][2], const Unit& u, int wr, int wc, int fr, int fq) const {
        const int row0 = u.pm * BM + wr * 64 + fr, col0 = u.pn * BM + wc * 32 + 8 * fq;
#pragma unroll
        for (int ai = 0; ai < 2; ++ai)
#pragma unroll
            for (int m = 0; m < 4; ++m) { float* rowp = C + (size_t)(row0 + ai * HALF + m * 16) * ldc + col0;
#pragma unroll
                for (int bj = 0; bj < 2; ++bj) { *(f32x4*)(rowp + bj * HALF) = acc[ai][bj][m][0]; *(f32x4*)(rowp + bj * HALF + 4) = acc[ai][bj][m][1]; } }
    }
};
template <int MODE  > struct EpiBf16X {
    static constexpr bool PERM = true, AFTER_DRAIN = false;
    bf16_t* O; int ldc; const float* rope; int rope_cols;
    __device__ __forceinline__ void operator()(const f32x4 (&acc)[2][2][4][2], const Unit& u, int wr, int wc, int fr, int fq) const {
        const int row0 = u.pm * BM + wr * 64 + fr, col0 = u.pn * BM + wc * 32 + 8 * fq;
        const bool do_rope = (MODE == 0) && (u.pm < 32) && (u.pn * BM < rope_cols);
        const int p0 = 16 * wc + 4 * fq;
#pragma unroll
        for (int ai = 0; ai < 2; ++ai)
#pragma unroll
            for (int m = 0; m < 4; ++m) { const int row = row0 + ai * HALF + m * 16; bf16_t* rowp = O + (size_t)row * ldc + col0;
                f32x4 cs0 = (f32x4){1.f, 0.f, 1.f, 0.f}, cs1 = cs0;
                if (do_rope) { const float* rp = rope + ((size_t)(row & 4095) * 64 + p0) * 2; cs0 = *(const f32x4*)rp; cs1 = *(const f32x4*)(rp + 4); }
#pragma unroll
                for (int bj = 0; bj < 2; ++bj) { f32x4 v0 = acc[ai][bj][m][0], v1 = acc[ai][bj][m][1];
                    if (MODE == 1) {
#pragma unroll
                        for (int j = 0; j < 4; ++j) { v0[j] = gelu_tanh(v0[j]); v1[j] = gelu_tanh(v1[j]); } }
                    else if (do_rope) {
                        const f32x4 a = v0, b = v1;
                        v0[0] = a[0] * cs0[0] - a[1] * cs0[1]; v0[1] = a[0] * cs0[1] + a[1] * cs0[0]; v0[2] = a[2] * cs0[2] - a[3] * cs0[3]; v0[3] = a[2] * cs0[3] + a[3] * cs0[2];
                        v1[0] = b[0] * cs1[0] - b[1] * cs1[1]; v1[1] = b[0] * cs1[1] + b[1] * cs1[0]; v1[2] = b[2] * cs1[2] - b[3] * cs1[3]; v1[3] = b[2] * cs1[3] + b[3] * cs1[2]; }
                    u32x4 w; w.x = cvt_pk_bf16(v0[0], v0[1]); w.y = cvt_pk_bf16(v0[2], v0[3]); w.z = cvt_pk_bf16(v1[0], v1[1]); w.w = cvt_pk_bf16(v1[2], v1[3]);
                    *(u32x4*)(rowp + bj * HALF) = w; } }
    }
};

template <class Epi, class Sched, bool ALIGN_EPI, bool SP2, int K, int LDA>
__device__ __forceinline__ void gemm_phase(PG8_LAS unsigned char* lds, const Gemm g, const Sched& S, const Epi& E) {
    const int tid = opaque_tid(), wid = __builtin_amdgcn_readfirstlane(tid >> 6), lane = tid & 63, wr = wid >> 2, wc = wid & 3, fr = lane & 15, fq = lane >> 4;
    constexpr int nt = K / BK;
    unsigned voffA[2], voffB[2];
#pragma unroll
    for (int i = 0; i < 2; ++i) { int R, C; stage_rc(tid * 16 + i * 8192, R, C); const int Rb = Epi::PERM ? ((R & ~31) + perm32(R & 31)) : R;
        voffA[i] = (unsigned)(R * LDA + C) * 2u; voffB[i] = (unsigned)(Rb * K + C) * 2u; }
    constexpr size_t kstep = (size_t)(BK * 2);
    constexpr size_t hstepA = (size_t)HALF * LDA * 2, hstepB = (size_t)HALF * K * 2;
    constexpr size_t tstepA = 2 * hstepA, tstepB = 2 * hstepB;
    const unsigned ldsw = (unsigned)wid * 1024u;
    const int aoff = lds_byte(wr * 64 + fr, fq * 8), boff = lds_byte(wc * 32 + fr, fq * 8);
#define PG8_SA(b, h) (((b) * 2 + (h)) * HTB)
#define PG8_SB(b, h) ((4 + (b) * 2 + (h)) * HTB)
#define PG8_STAGE(bufoff, gbase, voff) do { _Pragma("unroll") for (int _i = 0; _i < 2; ++_i) \
        __builtin_amdgcn_global_load_lds((const unsigned*)((const char*)(gbase) + (voff)[_i]), (PG8_LAS unsigned*)(lds + (bufoff) + ldsw + _i * 8192), 16, 0, 0); } while (0)
#define PG8_LDA(dst, b, h) do { _Pragma("unroll") for (int m = 0; m < 4; ++m) _Pragma("unroll") for (int k = 0; k < 2; ++k) dst[m][k] = *(const PG8_LAS bf16x8*)(lds + PG8_SA(b, h) + aoff + m * 2048 + k * 1024); } while (0)
#define PG8_LDB(dst, b, h) do { _Pragma("unroll") for (int n = 0; n < 2; ++n) _Pragma("unroll") for (int k = 0; k < 2; ++k) dst[n][k] = *(const PG8_LAS bf16x8*)(lds + PG8_SB(b, h) + boff + n * 2048 + k * 1024); } while (0)
#define PG8_MMA(ai, bj, At, Bt) do { __builtin_amdgcn_s_setprio(1); _Pragma("unroll") for (int m = 0; m < 4; ++m) _Pragma("unroll") for (int n = 0; n < 2; ++n) _Pragma("unroll") for (int k = 0; k < 2; ++k) \
        acc[ai][bj][m][n] = __builtin_amdgcn_mfma_f32_16x16x32_bf16(Bt[n][k], At[m][k], acc[ai][bj][m][n], 0, 0, 0); __builtin_amdgcn_s_setprio(0); } while (0)
#define PG8_WAIT_V(n) asm volatile("s_waitcnt vmcnt(" #n ")" ::: "memory")
#define PG8_WAIT_L(n) asm volatile("s_waitcnt lgkmcnt(" #n ")" ::: "memory")
#define PG8_BAR __builtin_amdgcn_s_barrier()
#define PG8_SCHED __builtin_amdgcn_sched_barrier(0)
    Unit cur, nxt; int ui = 0;
    if (!S.next(0, cur)) return;
    f32x4 acc[2][2][4][2];
#pragma unroll
    for (int a = 0; a < 2; ++a)
#pragma unroll
        for (int b = 0; b < 2; ++b)
#pragma unroll
            for (int m = 0; m < 4; ++m)
#pragma unroll
                for (int n = 0; n < 2; ++n) acc[a][b][m][n] = (f32x4){0.f, 0.f, 0.f, 0.f};
    bf16x8 At[4][2], B0[2][2], B1[2][2];
    const char* cA = (const char*)g.A + (size_t)cur.pm * tstepA; const char* cB = (const char*)g.Bt + (size_t)cur.pn * tstepB;
    S.a_ready(cur);
    if constexpr (SP2) {
        PG8_STAGE(PG8_SB(0, 0), cB, voffB); PG8_STAGE(PG8_SB(0, 1), cB + hstepB, voffB); PG8_STAGE(PG8_SA(0, 0), cA, voffA); PG8_STAGE(PG8_SA(0, 1), cA + hstepA, voffA);
        if (wr == 1) PG8_BAR;
        PG8_WAIT_V(2); PG8_BAR;
        PG8_STAGE(PG8_SB(1, 0), cB + kstep, voffB); PG8_STAGE(PG8_SA(1, 0), cA + kstep, voffA); PG8_STAGE(PG8_SB(1, 1), cB + hstepB + kstep, voffB);
        PG8_WAIT_V(6); PG8_BAR;
    } else {
        PG8_STAGE(PG8_SB(0, 0), cB, voffB); PG8_STAGE(PG8_SA(0, 0), cA, voffA); PG8_STAGE(PG8_SB(0, 1), cB + hstepB, voffB); PG8_STAGE(PG8_SA(0, 1), cA + hstepA, voffA);
        if (wr == 1) PG8_BAR;
        PG8_WAIT_V(4); PG8_BAR;
        PG8_STAGE(PG8_SB(1, 0), cB + kstep, voffB); PG8_STAGE(PG8_SA(1, 0), cA + kstep, voffA); PG8_STAGE(PG8_SB(1, 1), cB + hstepB + kstep, voffB);
        PG8_WAIT_V(6); PG8_BAR;
    }
    for (;;) {
        const bool has_next = S.next(ui + 1, nxt);
        const char* nA = has_next ? (const char*)g.A + (size_t)nxt.pm * tstepA : cA; const char* nB = has_next ? (const char*)g.Bt + (size_t)nxt.pn * tstepB : cB;
        for (int t = 0; t < nt; t += 2) {
            const bool last = (t == nt - 2);
            const char* a1 = cA + (size_t)(t + 1) * kstep;
            const char* a2 = last ? nA : cA + (size_t)(t + 2) * kstep; const char* b2 = last ? nB : cB + (size_t)(t + 2) * kstep;
            const char* a3 = a2 + kstep; const char* b3 = b2 + kstep;
            if (last && has_next) S.a_ready(nxt);
            if constexpr (SP2) {
            PG8_LDB(B0, 0, 0); PG8_LDB(B1, 0, 1); PG8_SCHED; PG8_LDA(At, 0, 0); PG8_STAGE(PG8_SA(1, 1), a1 + hstepA, voffA);
            PG8_WAIT_V(8); PG8_WAIT_L(0); PG8_BAR; PG8_MMA(0, 0, At, B0); PG8_MMA(0, 1, At, B1); PG8_BAR; PG8_SCHED;
            PG8_LDA(At, 0, 1); PG8_STAGE(PG8_SB(0, 0), b2, voffB); PG8_STAGE(PG8_SB(0, 1), b2 + hstepB, voffB); PG8_STAGE(PG8_SA(0, 0), a2, voffA);
            PG8_WAIT_V(8); PG8_WAIT_L(0); PG8_BAR; PG8_MMA(1, 0, At, B0); PG8_MMA(1, 1, At, B1); PG8_BAR; PG8_SCHED;
            PG8_LDB(B0, 1, 0); PG8_LDB(B1, 1, 1); PG8_SCHED; PG8_LDA(At, 1, 0); PG8_STAGE(PG8_SA(0, 1), a2 + hstepA, voffA);
            PG8_WAIT_V(8); PG8_WAIT_L(0); PG8_BAR; PG8_MMA(0, 0, At, B0); PG8_MMA(0, 1, At, B1); PG8_BAR; PG8_SCHED;
            PG8_LDA(At, 1, 1); PG8_STAGE(PG8_SB(1, 0), b3, voffB); PG8_STAGE(PG8_SB(1, 1), b3 + hstepB, voffB); PG8_STAGE(PG8_SA(1, 0), a3, voffA);
            PG8_WAIT_V(8); PG8_WAIT_L(0); PG8_BAR; PG8_MMA(1, 0, At, B0); PG8_MMA(1, 1, At, B1); PG8_BAR; PG8_SCHED;
            } else {
            PG8_LDB(B0, 0, 0); PG8_SCHED; PG8_LDA(At, 0, 0); PG8_STAGE(PG8_SA(1, 1), a1 + hstepA, voffA);
            PG8_WAIT_L(8); PG8_BAR; PG8_WAIT_L(0); PG8_MMA(0, 0, At, B0); PG8_BAR; PG8_SCHED;
            PG8_LDB(B1, 0, 1); PG8_STAGE(PG8_SB(0, 0), b2, voffB);
            PG8_BAR; PG8_WAIT_L(0); PG8_MMA(0, 1, At, B1); PG8_BAR;
            PG8_LDA(At, 0, 1); PG8_STAGE(PG8_SA(0, 0), a2, voffA);
            PG8_BAR; PG8_WAIT_L(0); PG8_MMA(1, 0, At, B0); PG8_BAR; PG8_SCHED;
            PG8_STAGE(PG8_SB(0, 1), b2 + hstepB, voffB);
            PG8_WAIT_V(6); PG8_BAR; PG8_MMA(1, 1, At, B1); PG8_BAR;
            PG8_LDB(B0, 1, 0); PG8_SCHED; PG8_LDA(At, 1, 0); PG8_STAGE(PG8_SA(0, 1), a2 + hstepA, voffA);
            PG8_WAIT_L(8); PG8_BAR; PG8_WAIT_L(0); PG8_MMA(0, 0, At, B0); PG8_BAR; PG8_SCHED;
            PG8_LDB(B1, 1, 1); PG8_STAGE(PG8_SB(1, 0), b3, voffB);
            PG8_BAR; PG8_WAIT_L(0); PG8_MMA(0, 1, At, B1); PG8_BAR;
            PG8_LDA(At, 1, 1); PG8_STAGE(PG8_SA(1, 0), a3, voffA);
            PG8_BAR; PG8_WAIT_L(0); PG8_MMA(1, 0, At, B0); PG8_BAR; PG8_SCHED;
            PG8_STAGE(PG8_SB(1, 1), b3 + hstepB, voffB);
            PG8_WAIT_V(6); PG8_BAR; PG8_MMA(1, 1, At, B1); PG8_BAR;
            }
        }
        if constexpr (ALIGN_EPI) { if (wr == 0) PG8_BAR; }
        if constexpr (!Epi::AFTER_DRAIN) { E(acc, cur, wr, wc, fr, fq); S.done(cur); }
        if (!has_next) break;
#pragma unroll
        for (int a = 0; a < 2; ++a)
#pragma unroll
            for (int b = 0; b < 2; ++b)
#pragma unroll
                for (int m = 0; m < 4; ++m)
#pragma unroll
                    for (int n = 0; n < 2; ++n) acc[a][b][m][n] = (f32x4){0.f, 0.f, 0.f, 0.f};
        cur = nxt; cA = nA; cB = nB; ++ui;
        if constexpr (ALIGN_EPI) { if (wr == 1) PG8_BAR; }
    }
    PG8_WAIT_V(0);
    if constexpr (!ALIGN_EPI) { if (wr == 0) PG8_BAR; }
    PG8_BAR;
    if constexpr (Epi::AFTER_DRAIN) { E.fused(acc, cur, wr, wc, fr, fq, lds, wid, lane); S.done(cur); }
#undef PG8_SA
#undef PG8_SB
#undef PG8_STAGE
#undef PG8_LDA
#undef PG8_LDB
#undef PG8_MMA
#undef PG8_WAIT_V
#undef PG8_WAIT_L
#undef PG8_BAR
#undef PG8_SCHED
}
}

namespace att {
typedef unsigned short bf16;
using bf16x8 = __attribute__((ext_vector_type(8))) short;
using s16x4  = __attribute__((ext_vector_type(4))) short;
using f32x16 = __attribute__((ext_vector_type(16))) float;
using u32x4  = __attribute__((ext_vector_type(4))) unsigned;
constexpr int   D = 128, NW = 8, QBLK = 32, KVBLK = 64;
constexpr float SCALE = 0.088388347648318440f;
constexpr float THR = 8.f;
constexpr int SHM_V = KVBLK * D * 2, SHM_K = KVBLK * D * 2, SHM_ATTN = 2 * SHM_V + 2 * SHM_K + NW * 64 * 4;
#define KSWZ(row, colB) ((row) * 256 + ((colB) ^ (((row) & 7) << 4)))
#define SBAR() __builtin_amdgcn_sched_barrier(0)
__device__ __forceinline__ int crow(int r, int hi) { return (r & 3) + 8 * (r >> 2) + 4 * hi; }
__device__ __forceinline__ unsigned cvtpk(float lo, float hi) { unsigned r; asm volatile("v_cvt_pk_bf16_f32 %0, %1, %2" : "=v"(r) : "v"(lo), "v"(hi)); return r; }

__device__ __forceinline__ void wmask(f32x16& p0, f32x16& p1, int kpos0, int qp, int hi) {
  const bool oob = (kpos0 < 0) || (kpos0 >= 4096);
  const int base = kpos0 - qp + 128;
#pragma unroll
  for (int r = 0; r < 16; ++r) { const int c = crow(r, hi);
    if (oob || (unsigned)(base + c) > 256u) p0[r] = -1e30f;
    if (oob || (unsigned)(base + 32 + c) > 256u) p1[r] = -1e30f; }
}
__device__ __forceinline__ void partialSM(f32x16& p0, f32x16& p1, float& m_reg, float& mn, float& alpha) {
  constexpr float C = SCALE * 1.4426950408889634f;
  float pmax = p0[0];
#pragma unroll
  for (int r = 1; r < 16; ++r) pmax = fmaxf(pmax, p0[r]);
#pragma unroll
  for (int r = 0; r < 16; ++r) pmax = fmaxf(pmax, p1[r]);
  { auto rr = __builtin_amdgcn_permlane32_swap(__float_as_uint(pmax), __float_as_uint(pmax), false, false);
    pmax = fmaxf(__uint_as_float(rr[0]), __uint_as_float(rr[1])); }
  if (__builtin_expect(__all(pmax - m_reg <= THR / SCALE), 1)) { mn = m_reg; alpha = 1.f; }
  else { mn = fmaxf(m_reg, pmax); alpha = __builtin_amdgcn_exp2f((m_reg - mn) * C); m_reg = mn; }
  float mnC = -mn * C;
#pragma unroll
  for (int r = 0; r < 16; ++r) p0[r] = fmaf(p0[r], C, mnC);
#pragma unroll
  for (int r = 0; r < 16; ++r) p1[r] = fmaf(p1[r], C, mnC);
#pragma unroll
  for (int r = 0; r < 16; ++r) p0[r] = __builtin_amdgcn_exp2f(p0[r]);
}
__device__ __forceinline__ void finishSM(f32x16& p0, f32x16& p1, float alpha, float& l_reg, bf16x8& pa0, bf16x8& pa1, bf16x8& pa2, bf16x8& pa3) {
#pragma unroll
  for (int r = 0; r < 16; ++r) p1[r] = __builtin_amdgcn_exp2f(p1[r]);
  float ps = 0;
#pragma unroll
  for (int r = 0; r < 16; ++r) ps += p0[r];
#pragma unroll
  for (int r = 0; r < 16; ++r) ps += p1[r];
  { auto rr = __builtin_amdgcn_permlane32_swap(__float_as_uint(ps), __float_as_uint(ps), false, false);
    ps = __uint_as_float(rr[0]) + __uint_as_float(rr[1]); }
  l_reg = l_reg * alpha + ps;
#define PK4(P, BASE, OUT) do { unsigned a0 = cvtpk(P[BASE + 0], P[BASE + 1]), a1 = cvtpk(P[BASE + 2], P[BASE + 3]);   \
    unsigned b0 = cvtpk(P[BASE + 4], P[BASE + 5]), b1 = cvtpk(P[BASE + 6], P[BASE + 7]);                              \
    auto r0 = __builtin_amdgcn_permlane32_swap(a0, b0, false, false); auto r1 = __builtin_amdgcn_permlane32_swap(a1, b1, false, false); \
    u32x4 w = {r0[0], r1[0], r0[1], r1[1]}; OUT = *reinterpret_cast<bf16x8*>(&w); } while (0)
  PK4(p0, 0, pa0); PK4(p0, 8, pa1); PK4(p1, 0, pa2); PK4(p1, 8, pa3);
#undef PK4
}
__device__ __forceinline__ void qkt(f32x16& p0, f32x16& p1, const bf16* Ks, const bf16x8* qr, int r32, int hi) {
  p0 = f32x16{}; p1 = f32x16{};
#pragma unroll
  for (int d0 = 0; d0 < 8; ++d0) { int cb = (d0 * 16 + hi * 8) * 2;
    bf16x8 b0 = *reinterpret_cast<const bf16x8*>((const char*)Ks + KSWZ(r32, cb));
    bf16x8 b1 = *reinterpret_cast<const bf16x8*>((const char*)Ks + KSWZ(32 + r32, cb));
    p0 = __builtin_amdgcn_mfma_f32_32x32x16_bf16(b0, qr[d0], p0, 0, 0, 0);
    p1 = __builtin_amdgcn_mfma_f32_32x32x16_bf16(b1, qr[d0], p1, 0, 0, 0); }
}
__device__ __forceinline__ int v_st(int k, int c) { const int kk = (k & ~0xC) | ((k & 4) << 1) | ((k & 8) >> 1); return ((kk >> 3) * 4 + (c >> 5)) * 512 + ((kk & 7) * 32 + (c & 31)) * 2; }
__device__ __forceinline__ int v_rd_base(int lane) { return ((lane & 3) << 3) | (((lane >> 2) & 3) << 6) | (((lane >> 4) & 1) << 5) | (((lane >> 5) & 1) << 8); }
constexpr int v_rd_off(int d0, int ks, int half) { return d0 * 512 + ks * 4096 + half * 2048; }
template <int OFF> __device__ __forceinline__ s16x4 tr_read(int vb) {
  s16x4 r; asm volatile("ds_read_b64_tr_b16 %0, %1 offset:%2" : "=&v"(r) : "v"(vb), "i"(OFF) : "memory"); return r;
}
template <int D0> __device__ __forceinline__ void pv_one(f32x16& od, int vb, bf16x8 pa0, bf16x8 pa1, bf16x8 pa2, bf16x8 pa3) {
  const s16x4 l0 = tr_read<v_rd_off(D0, 0, 0)>(vb), h0 = tr_read<v_rd_off(D0, 0, 1)>(vb), l1 = tr_read<v_rd_off(D0, 1, 0)>(vb), h1 = tr_read<v_rd_off(D0, 1, 1)>(vb);
  const s16x4 l2 = tr_read<v_rd_off(D0, 2, 0)>(vb), h2 = tr_read<v_rd_off(D0, 2, 1)>(vb), l3 = tr_read<v_rd_off(D0, 3, 0)>(vb), h3 = tr_read<v_rd_off(D0, 3, 1)>(vb);
  asm volatile("s_waitcnt lgkmcnt(0)" ::: "memory"); SBAR();
#define PK(L, H) (bf16x8){L[0], L[1], L[2], L[3], H[0], H[1], H[2], H[3]}
  od = __builtin_amdgcn_mfma_f32_32x32x16_bf16(pa0, PK(l0, h0), od, 0, 0, 0);
  od = __builtin_amdgcn_mfma_f32_32x32x16_bf16(pa1, PK(l1, h1), od, 0, 0, 0);
  od = __builtin_amdgcn_mfma_f32_32x32x16_bf16(pa2, PK(l2, h2), od, 0, 0, 0);
  od = __builtin_amdgcn_mfma_f32_32x32x16_bf16(pa3, PK(l3, h3), od, 0, 0, 0);
#undef PK
}
__device__ __forceinline__ void pv_d0(f32x16* o, int vb, bf16x8 pa0, bf16x8 pa1, bf16x8 pa2, bf16x8 pa3) {
  pv_one<0>(o[0], vb, pa0, pa1, pa2, pa3); pv_one<1>(o[1], vb, pa0, pa1, pa2, pa3); pv_one<2>(o[2], vb, pa0, pa1, pa2, pa3); pv_one<3>(o[3], vb, pa0, pa1, pa2, pa3);
}

struct Args {
  const bf16* qkv; int ld;
  int qrow0, qcol, kcol, vcol;
  int ctxrow0, latrow0;
  int kstart, n0, n1;
  int qpos0;
  float sink; int has_sink;
  void* out; int ldo, ocol;
};

template <bool WINDOW, bool OUT_BF16, int LD>
__device__ __forceinline__ void attn_unit(const Args& a, char* lds) {
  const int tid = pg8::opaque_tid(), wid = tid >> 6, lane = tid & 63, r32 = lane & 31, hi = lane >> 5;
  bf16* V_lds = (bf16*)lds; bf16* K_lds = (bf16*)(lds + 2 * SHM_V);
  float* ws = (float*)(lds + 2 * SHM_V + 2 * SHM_K) + wid * 64; float* li_l = ws; float* al_l = ws + 32;
  float m_reg = a.has_sink ? a.sink * (1.0f / SCALE) : -1e30f, l_reg = a.has_sink ? 1.0f : 0.0f; f32x16 o[4] = {}; bf16x8 qr[8];
  const bf16* Qw = a.qkv + (long)(a.qrow0 + wid * QBLK + r32) * LD + a.qcol + hi * 8;
#pragma unroll
  for (int d0 = 0; d0 < 8; ++d0) qr[d0] = *reinterpret_cast<const bf16x8*>(Qw + d0 * 16);
  const int sr = tid >> 4, sc = (tid & 15) * 8, vst0 = v_st(sr, sc), vst1 = v_st(32 + sr, sc);
  const int vb0 = (int)(uintptr_t)V_lds + v_rd_base(lane);
  const int qp = a.qpos0 + wid * QBLK + r32;
  const unsigned soff0 = (unsigned)(sr * LD + sc) * 2u, soff1 = soff0 + 32u * LD * 2u;
  struct { bf16x8 vs0, vs1, ks0, ks1; } sr_[2];
#define TROW(t) ((t) < a.n0 ? a.ctxrow0 + (t) * KVBLK : a.latrow0 + min(max(a.kstart + ((t) - a.n0) * KVBLK, 0), 4096 - KVBLK))
#define SLOAD(i, t) do { const char* tb_ = (const char*)a.qkv + (size_t)TROW(t) * (LD * 2); const char* tv_ = tb_ + a.vcol * 2; const char* tk_ = tb_ + a.kcol * 2; \
    sr_[i].vs0 = *reinterpret_cast<const bf16x8*>(tv_ + soff0); sr_[i].vs1 = *reinterpret_cast<const bf16x8*>(tv_ + soff1); \
    sr_[i].ks0 = *reinterpret_cast<const bf16x8*>(tk_ + soff0); sr_[i].ks1 = *reinterpret_cast<const bf16x8*>(tk_ + soff1); } while (0)
#define SWRITE(b, i) do { *(bf16x8*)((char*)V_lds + (b) * SHM_V + vst0) = sr_[i].vs0;          \
    *(bf16x8*)((char*)V_lds + (b) * SHM_V + vst1) = sr_[i].vs1; int kc = sc * 2;               \
    *(bf16x8*)((char*)K_lds + (b) * SHM_K + KSWZ(sr, kc)) = sr_[i].ks0;                       \
    *(bf16x8*)((char*)K_lds + (b) * SHM_K + KSWZ(32 + sr, kc)) = sr_[i].ks1; } while (0)
#define SWAIT() asm volatile("s_waitcnt vmcnt(4)" ::: "memory")
#define RESC(al) do { if (__any((al) < 1.f)) { if (hi == 0) al_l[r32] = (al); asm volatile("s_waitcnt lgkmcnt(0)" ::: "memory"); \
    _Pragma("unroll") for (int d = 0; d < 4; ++d) _Pragma("unroll") for (int r = 0; r < 16; ++r) o[d][r] *= al_l[crow(r, hi)]; } } while (0)
#define WMASK(P0, P1, t) do { if (WINDOW) { if ((t) >= a.n0) wmask(P0, P1, a.kstart + ((t) - a.n0) * KVBLK, qp, hi); } } while (0)
  f32x16 pA0, pA1, pB0, pB1; float mnA, mnB, alA, alB; bf16x8 pa0, pa1, pa2, pa3; const int NT = a.n0 + a.n1;
  constexpr int SE = 0, SO = 1;
  SLOAD(SE, 0); asm volatile("s_waitcnt vmcnt(0)" ::: "memory"); SWRITE(0, SE); __syncthreads();
  qkt(pA0, pA1, K_lds, qr, r32, hi); WMASK(pA0, pA1, 0); partialSM(pA0, pA1, m_reg, mnA, alA);
  SLOAD(SO, 1); if (2 < NT) SLOAD(SE, 2);
  SWAIT(); SWRITE(1, SO); __syncthreads();
  for (int j = 1; j + 1 < NT; j += 2) {
    SBAR(); qkt(pB0, pB1, (bf16*)((char*)K_lds + SHM_K), qr, r32, hi);
    finishSM(pA0, pA1, alA, l_reg, pa0, pa1, pa2, pa3); SBAR();
    SLOAD(SO, j + 2); SBAR();
    pv_d0(o, vb0, pa0, pa1, pa2, pa3); WMASK(pB0, pB1, j); partialSM(pB0, pB1, m_reg, mnB, alB);
    __syncthreads(); SWAIT(); SWRITE(0, SE);
    RESC(alB); __syncthreads();
    SBAR(); qkt(pA0, pA1, K_lds, qr, r32, hi);
    finishSM(pB0, pB1, alB, l_reg, pa0, pa1, pa2, pa3); SBAR();
    if (j + 3 < NT) SLOAD(SE, j + 3); SBAR();
    pv_d0(o, vb0 + (int)SHM_V, pa0, pa1, pa2, pa3); WMASK(pA0, pA1, j + 1); partialSM(pA0, pA1, m_reg, mnA, alA);
    __syncthreads(); SWAIT(); SWRITE(1, SO);
    RESC(alA); __syncthreads();
  }
  SBAR(); qkt(pB0, pB1, (bf16*)((char*)K_lds + SHM_K), qr, r32, hi);
  finishSM(pA0, pA1, alA, l_reg, pa0, pa1, pa2, pa3); SBAR();
  pv_d0(o, vb0, pa0, pa1, pa2, pa3); WMASK(pB0, pB1, NT - 1); partialSM(pB0, pB1, m_reg, mnB, alB);
  __syncthreads(); RESC(alB);
  finishSM(pB0, pB1, alB, l_reg, pa0, pa1, pa2, pa3); SBAR();
  pv_d0(o, vb0 + (int)SHM_V, pa0, pa1, pa2, pa3);
  if (hi == 0) li_l[r32] = l_reg; asm volatile("s_waitcnt lgkmcnt(0)" ::: "memory");
  float rli[16];
#pragma unroll
  for (int r = 0; r < 16; ++r) rli[r] = __builtin_amdgcn_rcpf(li_l[crow(r, hi)]);
  if (OUT_BF16) {
    bf16* Ow = (bf16*)a.out + (long)(a.qrow0 + wid * QBLK) * a.ldo + a.ocol;
#pragma unroll
    for (int r = 0; r < 16; ++r) { const int orow = crow(r, hi);
#pragma unroll
      for (int d0 = 0; d0 < 4; ++d0) Ow[(long)orow * a.ldo + d0 * 32 + r32] = (bf16)(cvtpk(o[d0][r] * rli[r], 0.f) & 0xffffu); }
  } else {
    float* Ow = (float*)a.out + (long)(a.qrow0 + wid * QBLK) * a.ldo + a.ocol;
#pragma unroll
    for (int r = 0; r < 16; ++r) { const int orow = crow(r, hi);
#pragma unroll
      for (int d0 = 0; d0 < 4; ++d0) Ow[(long)orow * a.ldo + d0 * 32 + r32] = o[d0][r] * rli[r]; }
  }
  __syncthreads();
#undef TROW
#undef SLOAD
#undef SWRITE
#undef SWAIT
#undef RESC
#undef WMASK
}

template <int LD>
__device__ __forceinline__ void dattn_unit(const bf16* qkv, int qrow0, int h, int ctxrow0, int latrow0, int n0, int n1, float lam, float gscale, const float* subg, bf16* AO,
                                           __attribute__((address_space(3))) unsigned char* L, char* lds) {
  typedef __attribute__((address_space(3))) unsigned char lds_b;
  const int tid = pg8::opaque_tid(), wid = __builtin_amdgcn_readfirstlane(tid >> 6), lane = tid & 63, r32 = lane & 31, hi = lane >> 5, g = wid & 3, c = wid >> 2;
  float* wsc = (float*)(lds + 132096 + wid * 256); float* li_l = wsc; float* al_l = wsc + 32;
  float m_reg = -1e30f, l_reg = 0.f; f32x16 o[8] = {}; bf16x8 qr[8];
  { const bf16* Qw = qkv + (long)(qrow0 + g * 32 + r32) * LD + (2 * h + c) * 128 + hi * 8;
#pragma unroll
    for (int d0 = 0; d0 < 8; ++d0) qr[d0] = *reinterpret_cast<const bf16x8*>(Qw + d0 * 16); }
  unsigned voK[2][2], voV[4];
#pragma unroll
  for (int cc = 0; cc < 2; ++cc)
#pragma unroll
    for (int i = 0; i < 2; ++i) { const int gi = i * 512 + tid, row = gi >> 4, cb = ((gi & 15) << 4) ^ ((row & 7) << 4); voK[cc][i] = (unsigned)((row * LD + 2048 + (2 * h + cc) * 128) * 2 + cb); }
#pragma unroll
  for (int i = 0; i < 4; ++i) { const int gi = i * 512 + tid, img = gi >> 10, o2 = (gi & 1023) << 4, st = o2 >> 9, e = (o2 & 511) >> 1, kk = (st >> 2) * 8 + (e >> 5);
    const int k = (kk & ~0xC) | ((kk & 4) << 1) | ((kk & 8) >> 1), col = (st & 3) * 32 + (e & 31); voV[i] = (unsigned)((k * LD + 4096 + h * 256 + img * 128 + col) * 2); }
  const int NT = n0 + n1;
#define DT_ROW(t) ((t) < n0 ? ctxrow0 + (t) * KVBLK : latrow0 + ((t) - n0) * KVBLK)
#define DT_DMA(t, b) do { const char* tb_ = (const char*)qkv + (size_t)DT_ROW(t) * (LD * 2); \
    _Pragma("unroll") for (int cc = 0; cc < 2; ++cc) _Pragma("unroll") for (int i = 0; i < 2; ++i) \
      __builtin_amdgcn_global_load_lds((const unsigned*)(tb_ + voK[cc][i]), (__attribute__((address_space(3))) unsigned*)(L + (b) * 32768 + cc * 16384 + i * 8192 + wid * 1024), 16, 0, 0); \
    _Pragma("unroll") for (int i = 0; i < 4; ++i) \
      __builtin_amdgcn_global_load_lds((const unsigned*)(tb_ + voV[i]), (__attribute__((address_space(3))) unsigned*)(L + 65536 + (b) * 32768 + i * 8192 + wid * 1024), 16, 0, 0); } while (0)
  DT_DMA(0, 0);
  if (1 < NT) DT_DMA(1, 1);
  if (1 < NT) asm volatile("s_waitcnt vmcnt(8)" ::: "memory"); else asm volatile("s_waitcnt vmcnt(0)" ::: "memory");
  __builtin_amdgcn_s_barrier(); asm volatile("" ::: "memory");
  for (int t = 0; t < NT; ++t) {
    const int b = t & 1;
    const bf16* Kt = (const bf16*)(lds + b * 32768 + c * 16384);
    const int vb = (int)(uintptr_t)(lds + 65536 + b * 32768) + v_rd_base(lane);
    f32x16 p0, p1; float mn, alpha; bf16x8 pa0, pa1, pa2, pa3;
    qkt(p0, p1, Kt, qr, r32, hi);
    partialSM(p0, p1, m_reg, mn, alpha);
    if (__any(alpha < 1.f)) { if (hi == 0) al_l[r32] = alpha; asm volatile("s_waitcnt lgkmcnt(0)" ::: "memory");
#pragma unroll
      for (int d = 0; d < 8; ++d)
#pragma unroll
        for (int r = 0; r < 16; ++r) o[d][r] *= al_l[crow(r, hi)]; }
    finishSM(p0, p1, alpha, l_reg, pa0, pa1, pa2, pa3);
    pv_one<0>(o[0], vb, pa0, pa1, pa2, pa3); pv_one<1>(o[1], vb, pa0, pa1, pa2, pa3); pv_one<2>(o[2], vb, pa0, pa1, pa2, pa3); pv_one<3>(o[3], vb, pa0, pa1, pa2, pa3);
    pv_one<0>(o[4], vb + 16384, pa0, pa1, pa2, pa3); pv_one<1>(o[5], vb + 16384, pa0, pa1, pa2, pa3); pv_one<2>(o[6], vb + 16384, pa0, pa1, pa2, pa3); pv_one<3>(o[7], vb + 16384, pa0, pa1, pa2, pa3);
    asm volatile("s_waitcnt lgkmcnt(0)" ::: "memory"); __builtin_amdgcn_s_barrier(); asm volatile("" ::: "memory");
    if (t + 2 < NT) { DT_DMA(t + 2, b); asm volatile("s_waitcnt vmcnt(8)" ::: "memory"); } else asm volatile("s_waitcnt vmcnt(0)" ::: "memory");
    __builtin_amdgcn_s_barrier(); asm volatile("" ::: "memory");
  }
#undef DT_ROW
#undef DT_DMA
  if (hi == 0) li_l[r32] = l_reg; asm volatile("s_waitcnt lgkmcnt(0)" ::: "memory");
#pragma unroll
  for (int r = 0; r < 16; ++r) { const float rl = __builtin_amdgcn_rcpf(li_l[crow(r, hi)]);
#pragma unroll
    for (int d = 0; d < 8; ++d) o[d][r] *= rl; }
  float* xch = (float*)(lds + g * 32768);
  if (c == 1) {
#pragma unroll
    for (int d = 0; d < 8; ++d)
#pragma unroll
      for (int r = 0; r < 16; ++r) xch[(d * 16 + r) * 64 + lane] = o[d][r]; }
  asm volatile("s_waitcnt lgkmcnt(0)" ::: "memory"); __builtin_amdgcn_s_barrier(); asm volatile("" ::: "memory");
  if (c == 0) {
    float gv[8];
#pragma unroll
    for (int d = 0; d < 8; ++d) gv[d] = subg[d * 32 + r32] * gscale;
#pragma unroll
    for (int r = 0; r < 16; ++r) { float s = 0.f;
#pragma unroll
      for (int d = 0; d < 8; ++d) { o[d][r] -= lam * xch[(d * 16 + r) * 64 + lane]; s += o[d][r] * o[d][r]; }
      for (int m_ = 1; m_ < 32; m_ <<= 1) s += __builtin_bit_cast(float, __builtin_amdgcn_ds_bpermute((lane ^ m_) << 2, __builtin_bit_cast(int, s)));
      const float rs = 1.0f / sqrtf(s * (1.0f / 256.0f) + 1e-6f);
      bf16* orow = AO + (long)(qrow0 + g * 32 + crow(r, hi)) * 2048 + h * 256 + r32;
#pragma unroll
      for (int d = 0; d < 8; ++d) orow[d * 32] = (bf16)(cvtpk(o[d][r] * rs * gv[d], 0.f) & 0xffffu); }
  }
  asm volatile("s_waitcnt vmcnt(0) lgkmcnt(0)" ::: "memory"); __builtin_amdgcn_s_barrier(); asm volatile("" ::: "memory");
}
#undef KSWZ
#undef SBAR
}

constexpr int NWAVES = 8;
constexpr int DM = 2048, NBATCH = 2, SEQ = 4096, MLAT = NBATCH * SEQ, CTXL = 256, MCTX = NBATCH * CTXL, MALL = MLAT + MCTX;
constexpr int DFF = 5504, NFC1 = 2 * DFF, NLAYER = 4, NMODC = 9 * DM;
constexpr int A_N = 3072, B_N = 12288, B_W = 6144, C_N = 6144;
constexpr float EPS = 1e-6f;
constexpr size_t MiB = 1u << 20;
constexpr size_t WS_CTL = 0, CTL_BYTES = 2 * MiB;
constexpr size_t WS_MODT = 2 * MiB;
constexpr size_t WS_ROPE = 3 * MiB;
constexpr size_t WS_XC = 5 * MiB;
constexpr size_t WS_STATS = 9 * MiB;
constexpr size_t WS_BSW = 10 * MiB;
constexpr size_t WS_SMALL = 10 * MiB + 512 * 1024;
constexpr int SM_SINK = 0, SM_VNG = 64, SM_VNB = SM_VNG + 6144, SM_BS = SM_VNB + 6144, SM_LQ1 = SM_BS + 1024, SM_LK1 = SM_LQ1 + 128, SM_LQ2 = SM_LK1 + 128, SM_LK2 = SM_LQ2 + 128, SM_SUBG = SM_LK2 + 128, SM_END = SM_SUBG + 256;
constexpr size_t WS_WFC1 = 11 * MiB;
constexpr size_t WS_WFC2 = WS_WFC1 + 344 * MiB;
constexpr size_t WS_WAIN = WS_WFC2 + 172 * MiB;
constexpr size_t WS_WAOUT = WS_WAIN + 24 * MiB;
constexpr size_t WS_WBIN = WS_WAOUT + 16 * MiB;
constexpr size_t WS_WBOUT = WS_WBIN + 48 * MiB;
constexpr size_t WS_WCIN = WS_WBOUT + 24 * MiB;
constexpr size_t WS_WCOUT = WS_WCIN + 24 * MiB;
constexpr size_t WS_H = WS_WCOUT + 8 * MiB;
constexpr size_t WS_HID = WS_H + 34 * MiB;
constexpr size_t WS_Y = WS_HID + 92 * MiB;
constexpr size_t WS_QKV = WS_Y + 68 * MiB;
constexpr size_t WS_AO = WS_QKV + 204 * MiB;
constexpr size_t WS_OC = WS_AO + 34 * MiB;
constexpr size_t WS_END = WS_OC + 136 * MiB;
static_assert((size_t)8 * NFC1 * DM * 2 <= 344 * MiB && (size_t)8 * DM * DFF * 2 <= 172 * MiB && (size_t)MALL * DFF * 2 <= 92 * MiB && (size_t)MALL * B_N * 2 <= 204 * MiB, "ws map");
constexpr int CW_PQ = 1024;
constexpr int CW_BAR = 4096;
constexpr int RING_BYTES = 131072, MISC_OFF = RING_BYTES + 320, LDS_BYTES = 147456;

#define GAS __attribute__((address_space(1)))
#define LAS __attribute__((address_space(3)))
typedef unsigned short bf16;
typedef unsigned v4u __attribute__((ext_vector_type(4)));
typedef unsigned v2u __attribute__((ext_vector_type(2)));
typedef float f32x4 __attribute__((ext_vector_type(4)));
typedef short bf16x8 __attribute__((ext_vector_type(8)));
typedef float f32x16 __attribute__((ext_vector_type(16)));
#define LDS_WAIT() asm volatile("s_waitcnt lgkmcnt(0)" ::: "memory")
#define VM_WAIT() asm volatile("s_waitcnt vmcnt(0)" ::: "memory")
__device__ __forceinline__ unsigned f2bf(float f) { unsigned u = __builtin_bit_cast(unsigned, f); return (u + 0x7fffu + ((u >> 16) & 1u)) >> 16; }
__device__ __forceinline__ unsigned pk2(float lo, float hi) { return f2bf(lo) | (f2bf(hi) << 16); }
__device__ __forceinline__ float bf2f(unsigned short b) { return __builtin_bit_cast(float, ((unsigned)b) << 16); }
__device__ __forceinline__ float lane_xor(float v, int lane, int mask) { return __builtin_bit_cast(float, __builtin_amdgcn_ds_bpermute((lane ^ mask) << 2, __builtin_bit_cast(int, v))); }
__device__ __forceinline__ float wave_sum(float v, int lane) {
#pragma unroll
    for (int o = 1; o < 64; o <<= 1) v += lane_xor(v, lane, o);
    return v;
}

#define XB_TMO      128
#define XB_XCNT(j)  (256  + 64 * (j))
#define XB_XSUB(j)  (1280 + 64 * (j))
#define XB_XGEN(j)  (2304 + 64 * (j))
#define XB_TOP      3328
#define XB_TOPGEN   3392
#define XCD_BAR_WORDS 3456
#define XB_SPIN_CAP (1u << 18)

__device__ __forceinline__ unsigned xb_ld(unsigned* p)              { return __hip_atomic_load(p, __ATOMIC_RELAXED, __HIP_MEMORY_SCOPE_AGENT); }
__device__ __forceinline__ unsigned xb_add(unsigned* p, unsigned v) { return __hip_atomic_fetch_add(p, v, __ATOMIC_RELAXED, __HIP_MEMORY_SCOPE_AGENT); }
__device__ __forceinline__ unsigned xb_xcc_id() { return (unsigned)__builtin_amdgcn_s_getreg((3 << 11) | 20) & 0xFu; }
#define XB_SPIN(cond, bar) do { unsigned _sp = 0; while (cond) { __builtin_amdgcn_s_sleep(1); \
    if ((++_sp & 255u) == 0u) { if (xb_ld(&(bar)[XB_TMO])) break; if (_sp > XB_SPIN_CAP) { atomicAdd(&(bar)[XB_TMO], 1u); break; } } } } while (0)

struct XcdBarrier {
    unsigned* bar; unsigned x;
    volatile LAS unsigned* st;
};

__device__ __forceinline__ XcdBarrier xcd_barrier_post(unsigned* bar, volatile LAS unsigned* st) {
    XcdBarrier b; b.bar = bar; b.x = xb_xcc_id(); b.st = st;
    if (threadIdx.x == 0) (void)xb_add(&bar[XB_XCNT(b.x)], 1u);
    return b;
}
__device__ __forceinline__ void xcd_barrier_complete(unsigned* bar, unsigned x, unsigned& nloc, unsigned& nx) {
    const unsigned G = gridDim.x * gridDim.y * gridDim.z;
    unsigned sum, cnt, mine, sp = 0u;
    for (;;) {
        sum = 0u; cnt = 0u; mine = 0u;
#pragma unroll
        for (unsigned j = 0; j < 16; ++j) { const unsigned c = xb_ld(&bar[XB_XCNT(j)]); sum += c; cnt += (c > 0u) ? 1u : 0u; mine = (j == x) ? c : mine; }
        if (sum == G) break;
        __builtin_amdgcn_s_sleep(1);
        if ((++sp & 255u) == 0u) { if (xb_ld(&bar[XB_TMO])) break; if (sp > XB_SPIN_CAP) { atomicAdd(&bar[XB_TMO], 1u); break; } }
    }
    nloc = mine > 0u ? mine : 1u; nx = cnt > 0u ? cnt : 1u;
}

__device__ __forceinline__ void xcd_barrier(const XcdBarrier& b) {
    asm volatile("s_waitcnt vmcnt(0)" ::: "memory");
    __syncthreads();
    if (threadIdx.x == 0) {
        unsigned* bar = b.bar;
        __builtin_amdgcn_s_waitcnt(0);
        unsigned nloc = b.st[0], nx = b.st[1];
        if (nloc == 0u) { xcd_barrier_complete(bar, b.x, nloc, nx); b.st[0] = nloc; b.st[1] = nx; }
        const unsigned old = xb_add(&bar[XB_XSUB(b.x)], 1u);
        const unsigned gen = old / nloc;
        if (old + 1u == (gen + 1u) * nloc) {
            __builtin_amdgcn_fence(__ATOMIC_RELEASE, "agent");
            asm volatile("s_waitcnt vmcnt(0)" ::: "memory");
            const unsigned og = xb_add(&bar[XB_TOP], 1u);
            const unsigned tg = og / nx;
            if (og + 1u == (tg + 1u) * nx) xb_add(&bar[XB_TOPGEN], 1u);
            else XB_SPIN(xb_ld(&bar[XB_TOPGEN]) == tg, bar);
            __builtin_amdgcn_fence(__ATOMIC_ACQUIRE, "agent");
            xb_add(&bar[XB_XGEN(b.x)], 1u);
            asm volatile("s_waitcnt vmcnt(0)" ::: "memory");
        } else {
            XB_SPIN(xb_ld(&bar[XB_XGEN(b.x)]) == gen, bar);
            __builtin_amdgcn_fence(__ATOMIC_ACQUIRE, "agent");
            asm volatile("s_waitcnt vmcnt(0)" ::: "memory");
        }
    }
    __syncthreads();
}

__device__ __forceinline__ void transpose_item(const float* W, int K, int N, bf16* WT, int fc1map, LAS float* scr, int item, int lane) {
    const int nblk = N / 32, kb = item / nblk, nb = item % nblk, k0 = 64 * kb, n0 = 32 * nb;
    int rowbase = n0;
    if (fc1map) { rowbase = (n0 < DFF) ? 256 * (n0 / 128) + (n0 % 128) : 256 * ((n0 - DFF) / 128) + 128 + ((n0 - DFF) % 128); }
    float tv[32];
#pragma unroll
    for (int i = 0; i < 32; ++i) tv[i] = W[(size_t)(k0 + 2 * i + (lane >> 5)) * N + n0 + (lane & 31)];
#pragma unroll
    for (int i = 0; i < 32; ++i) scr[(2 * i + (lane >> 5)) * 33 + (lane & 31)] = tv[i];
    LDS_WAIT(); asm volatile("" ::: "memory");
    const int c = lane & 7;
#pragma unroll
    for (int j = 0; j < 4; ++j) { const int n = (lane >> 3) + 8 * j; const LAS float* s = scr + (8 * c) * 33 + n;
        v4u o; o.x = pk2(s[0 * 33], s[1 * 33]); o.y = pk2(s[2 * 33], s[3 * 33]); o.z = pk2(s[4 * 33], s[5 * 33]); o.w = pk2(s[6 * 33], s[7 * 33]);
        *(GAS v4u*)(WT + (size_t)(rowbase + n) * K + k0 + 8 * c) = o; }
    LDS_WAIT(); asm volatile("" ::: "memory");
}

struct KArgs { const float* in[25]; float* out; unsigned char* ws; int ph_lo, ph_hi, li; float lam_init; float gscale; int pad0, pad1, pad2; };

__device__ __forceinline__ float* modt(unsigned char* ws, int layer, int slot, int modrow, int which) { return (float*)(ws + WS_MODT) + ((size_t)(((layer * 3 + slot) * 3 + modrow) * 3 + which)) * DM; }

__device__ __forceinline__ void prologue_phase(const KArgs& args, LAS unsigned char* L, int bx, int G) {
    const int tid = pg8::opaque_tid(), lane = tid & 63, wave = __builtin_amdgcn_readfirstlane(tid >> 6);
    unsigned char* ws = args.ws;
    LAS float* sl = (LAS float*)L;
    for (int i = tid; i < 3 * DM; i += NWAVES * 64) { const int r = i / DM, k = i % DM; const float v = (r < 2) ? args.in[1][r * DM + k] : args.in[3][k]; sl[i] = v / (1.0f + expf(-v)); }
    __syncthreads();
    LAS float* part = (LAS float*)(L + 24576);
    for (int rep_ = 0; rep_ < (PROBE_ID == 11 ? 2 : 1); ++rep_)
    for (int item = bx; item < NLAYER * 72; item += G) {
        const int layer = item / 72, n0 = (item % 72) * 256;
        const float* W = args.in[4] + ((size_t)layer * DM + wave * 256) * NMODC + n0 + lane * 4;
        const LAS float* s0 = sl + wave * 256;
        f32x4 a0 = {0.f, 0.f, 0.f, 0.f}, a1 = a0, a2 = a0;
#pragma unroll 8
        for (int kk = 0; kk < 256; ++kk) { const f32x4 w = *(const f32x4*)(W + (size_t)kk * NMODC); a0 += w * s0[kk]; a1 += w * s0[DM + kk]; a2 += w * s0[2 * DM + kk]; }
        *(LAS f32x4*)(part + (wave * 3 + 0) * 256 + lane * 4) = a0; *(LAS f32x4*)(part + (wave * 3 + 1) * 256 + lane * 4) = a1; *(LAS f32x4*)(part + (wave * 3 + 2) * 256 + lane * 4) = a2;
        __syncthreads();
        for (int idx = tid; idx < 768; idx += NWAVES * 64) { const int r = idx >> 8, cc = idx & 255, n = n0 + cc; float m = args.in[5][layer * NMODC + n];
#pragma unroll
            for (int w = 0; w < 8; ++w) m += part[(w * 3 + r) * 256 + cc];
            const int k9 = n / DM, c = n % DM, s = k9 / 3, which = k9 % 3; const float* g = args.in[6] + (size_t)layer * 6 * DM;
            if (which == 0) modt(ws, layer, s, r, 2)[c] = m;
            else if (which == 1) modt(ws, layer, s, r, 1)[c] = g[(2 * s) * DM + c] * (1.0f + m);
            else modt(ws, layer, s, r, 0)[c] = (s == 1 ? 1.0f : 0.5f) * m * g[(2 * s + 1) * DM + c]; }
        __syncthreads();
    }
    {
        LAS float* scr = (LAS float*)(L + 49152 + wave * 8448);
        const int gw = bx * NWAVES + wave, NGW = G * NWAVES;
        constexpr int I_FC1 = (DM / 64) * (NFC1 / 32), I_FC2 = (DFF / 64) * (DM / 32), I_AIN = (DM / 64) * (A_N / 32), I_SQ = (DM / 64) * (DM / 32), I_BIN = (DM / 64) * (B_N / 32), I_BOUT = (B_W / 64) * (DM / 32), I_CIN = (DM / 64) * (C_N / 32);
        constexpr int NITEMS = 8 * I_FC1 + 8 * I_FC2 + 2 * I_AIN + 2 * I_SQ + I_BIN + I_BOUT + I_CIN + I_SQ;
        for (int rep_ = 0; rep_ < (PROBE_ID == 12 ? 2 : 1); ++rep_)
        for (int it = gw; it < NITEMS; it += NGW) {
            int r = it;
            if (r < 8 * I_FC1) { const int mat = r / I_FC1; transpose_item(args.in[7] + (size_t)mat * DM * NFC1, DM, NFC1, (bf16*)(ws + WS_WFC1) + (size_t)mat * NFC1 * DM, 1, scr, r % I_FC1, lane); continue; } r -= 8 * I_FC1;
            if (r < 8 * I_FC2) { const int mat = r / I_FC2; transpose_item(args.in[8] + (size_t)mat * DFF * DM, DFF, DM, (bf16*)(ws + WS_WFC2) + (size_t)mat * DM * DFF, 0, scr, r % I_FC2, lane); continue; } r -= 8 * I_FC2;
            if (r < 2 * I_AIN) { const int mat = r / I_AIN; transpose_item(args.in[9] + (size_t)mat * DM * A_N, DM, A_N, (bf16*)(ws + WS_WAIN) + (size_t)mat * A_N * DM, 0, scr, r % I_AIN, lane); continue; } r -= 2 * I_AIN;
            if (r < 2 * I_SQ) { const int mat = r / I_SQ; transpose_item(args.in[10] + (size_t)mat * DM * DM, DM, DM, (bf16*)(ws + WS_WAOUT) + (size_t)mat * DM * DM, 0, scr, r % I_SQ, lane); continue; } r -= 2 * I_SQ;
            if (r < I_BIN) { transpose_item(args.in[12], DM, B_N, (bf16*)(ws + WS_WBIN), 0, scr, r, lane); continue; } r -= I_BIN;
            if (r < I_BOUT) { transpose_item(args.in[17], B_W, DM, (bf16*)(ws + WS_WBOUT), 0, scr, r, lane); continue; } r -= I_BOUT;
            if (r < I_CIN) { transpose_item(args.in[18], DM, C_N, (bf16*)(ws + WS_WCIN), 0, scr, r, lane); continue; } r -= I_CIN;
            transpose_item(args.in[19], DM, DM, (bf16*)(ws + WS_WCOUT), 0, scr, r, lane);
        }
    }
    for (int rep_ = 0; rep_ < (PROBE_ID == 13 ? 2 : 1); ++rep_)
    for (int e = bx * NWAVES * 64 + tid; e < SEQ * 64; e += G * NWAVES * 64) { const int t = e >> 6, p = e & 63, pi = p & 31;
        const float inv = (float)pow(10000.0, -(double)pi / 32.0); const float ang = (float)((p < 32) ? (t >> 6) : (t & 63)) * inv;
        float* o = (float*)(ws + WS_ROPE) + (size_t)e * 2; o[0] = (float)cos((double)ang); o[1] = (float)sin((double)ang); }
    for (int e = bx * NWAVES * 64 + tid; e < 8 * 128 * 128; e += G * NWAVES * 64) ((bf16*)(ws + WS_BSW))[e] = (bf16)f2bf(args.in[15][e]);
    if (bx == 0) { float* sm = (float*)(ws + WS_SMALL);
        for (int e = tid; e < SM_END; e += NWAVES * 64) { float v = 0.f;
            if (e < SM_VNG) { if (e < 32) v = args.in[11][e]; }
            else if (e < SM_VNB) v = args.in[13][e - SM_VNG];
            else if (e < SM_BS) v = args.in[14][e - SM_VNB];
            else if (e < SM_LQ1) v = args.in[16][e - SM_BS];
            else if (e < SM_LK1) v = args.in[20][e - SM_LQ1];
            else if (e < SM_LQ2) v = args.in[21][e - SM_LK1];
            else if (e < SM_LK2) v = args.in[22][e - SM_LQ2];
            else if (e < SM_SUBG) v = args.in[23][e - SM_LK2];
            else v = args.in[24][e - SM_SUBG];
            sm[e] = v; } }
}

__device__ __forceinline__ void norm_phase(const float* xs_lat, const float* xs_ctx, float* xd_lat, float* xd_ctx, const bf16* Y, const float* postT, const float* preT, bf16* H, int nrows, float oscale = 1.0f) {
    const int tid = pg8::opaque_tid(), lane = tid & 63, gw = blockIdx.x * NWAVES + __builtin_amdgcn_readfirstlane(tid >> 6), NGW = gridDim.x * NWAVES;
    for (int row = gw; row < nrows; row += NGW) {
        const int modrow = row < SEQ ? 0 : (row < MLAT ? 1 : 2);
        const float* xs = (row < MLAT) ? xs_lat + (size_t)row * DM : xs_ctx + (size_t)(row - MLAT) * DM;
        float* xd = (row < MLAT) ? xd_lat + (size_t)row * DM : xd_ctx + (size_t)(row - MLAT) * DM;
        f32x4 xv[8];
#pragma unroll
        for (int j = 0; j < 8; ++j) xv[j] = *(const f32x4*)(xs + 256 * j + 4 * lane);
        if (Y) {
            const bf16* yr = Y + (size_t)row * DM; const float* At = postT + (size_t)modrow * 3 * DM;
            f32x4 yv[8]; float ss = 0.f;
#pragma unroll
            for (int j = 0; j < 8; ++j) { const v2u raw = *(const v2u*)(yr + 256 * j + 4 * lane);
                yv[j].x = __builtin_bit_cast(float, raw.x << 16); yv[j].y = __builtin_bit_cast(float, raw.x & 0xffff0000u); yv[j].z = __builtin_bit_cast(float, raw.y << 16); yv[j].w = __builtin_bit_cast(float, raw.y & 0xffff0000u);
                ss += (yv[j].x * yv[j].x + yv[j].y * yv[j].y) + (yv[j].z * yv[j].z + yv[j].w * yv[j].w); }
            const float ry = 1.0f / sqrtf(wave_sum(ss, lane) * (1.0f / DM) + EPS);
#pragma unroll
            for (int j = 0; j < 8; ++j) { const f32x4 a = *(const f32x4*)(At + 256 * j + 4 * lane); xv[j] += yv[j] * ry * a; }
        }
#pragma unroll
        for (int j = 0; j < 8; ++j) *(f32x4*)(xd + 256 * j + 4 * lane) = (PROBE_ID >= 20) ? xv[j] * oscale : xv[j];
        if (H) {
            const float* Bt = preT + (size_t)(modrow * 3 + 1) * DM; const float* Ct = preT + (size_t)(modrow * 3 + 2) * DM;
            float ss = 0.f;
#pragma unroll
            for (int j = 0; j < 8; ++j) ss += (xv[j].x * xv[j].x + xv[j].y * xv[j].y) + (xv[j].z * xv[j].z + xv[j].w * xv[j].w);
            const float rx = 1.0f / sqrtf(wave_sum(ss, lane) * (1.0f / DM) + EPS);
            bf16* hr = H + (size_t)row * DM;
#pragma unroll
            for (int j = 0; j < 8; ++j) { const f32x4 b = *(const f32x4*)(Bt + 256 * j + 4 * lane), c = *(const f32x4*)(Ct + 256 * j + 4 * lane); const f32x4 h = xv[j] * rx * b + c;
                v2u o; o.x = pk2(h.x, h.y); o.y = pk2(h.z, h.w); *(v2u*)(hr + 256 * j + 4 * lane) = o; }
        }
    }
}
__device__ __forceinline__ void vstats_phase(const bf16* QKV, float* stats, int nrows) {
    const int tid = pg8::opaque_tid(), lane = tid & 63, gw = blockIdx.x * NWAVES + __builtin_amdgcn_readfirstlane(tid >> 6), NGW = gridDim.x * NWAVES;
    for (int row = gw; row < nrows; row += NGW) {
        const bf16* vr = QKV + (size_t)row * B_N + B_W + lane * 8; bf16x8 raw[12]; float s = 0.f;
#pragma unroll
        for (int i = 0; i < 12; ++i) { raw[i] = *(const bf16x8*)(vr + i * 512);
#pragma unroll
            for (int e = 0; e < 8; ++e) s += bf2f((unsigned short)raw[i][e]); }
        const float mean = wave_sum(s, lane) * (1.0f / B_W); float q = 0.f;
#pragma unroll
        for (int i = 0; i < 12; ++i)
#pragma unroll
            for (int e = 0; e < 8; ++e) { const float d = bf2f((unsigned short)raw[i][e]) - mean; q += d * d; }
        const float rstd = 1.0f / sqrtf(wave_sum(q, lane) * (1.0f / B_W) + EPS);
        if (lane == 0) { stats[2 * row] = mean; stats[2 * row + 1] = rstd; }
    }
}
__device__ __forceinline__ void spatial_phase(const bf16* QKV, bf16* Gout, const bf16* BSW, const float* stats, const float* vg, const float* vb, const float* bs, char* lds, int nchunks, int bx, int G) {
    const int tid = pg8::opaque_tid(), lane = tid & 63, wave = __builtin_amdgcn_readfirstlane(tid >> 6), r32 = lane & 31, hi = lane >> 5;
    constexpr int OP = 132;
    float* Ob = (float*)(lds + 32768);
    const int sr = tid >> 4, sc = (tid & 15) * 8, pb = wave & 3, dh = wave >> 2;
    for (int u = bx; u < nchunks * 48; u += G) {
        const int cb = u % 6, g = (u / 6) & 7, ch = u / 48, row0 = ch * 128, c0 = g * 768 + cb * 128;
        bf16x8 ureg[4];
#pragma unroll
        for (int i = 0; i < 4; ++i) ureg[i] = *(const bf16x8*)(QKV + (size_t)(row0 + sr + 32 * i) * B_N + c0 + sc);
        { const f32x4 g0 = *(const f32x4*)(vg + c0 + sc), g1 = *(const f32x4*)(vg + c0 + sc + 4), b0 = *(const f32x4*)(vb + c0 + sc), b1 = *(const f32x4*)(vb + c0 + sc + 4);
#pragma unroll
          for (int i = 0; i < 4; ++i) { const int q = sr + 32 * i; const bf16x8 raw = *(const bf16x8*)(QKV + (size_t)(row0 + q) * B_N + B_W + c0 + sc);
              const float mu = stats[2 * (row0 + q)], rs = stats[2 * (row0 + q) + 1]; float t[8];
#pragma unroll
              for (int e = 0; e < 8; ++e) t[e] = (bf2f((unsigned short)raw[e]) - mu) * rs * (e < 4 ? g0[e & 3] : g1[e & 3]) + (e < 4 ? b0[e & 3] : b1[e & 3]);
              v4u w; w.x = pk2(t[0], t[1]); w.y = pk2(t[2], t[3]); w.z = pk2(t[4], t[5]); w.w = pk2(t[6], t[7]);
              *(v4u*)(lds + (i >> 1) * 16384 + att::v_st(sr + 32 * (i & 1), sc)) = w; } }
        __syncthreads();
        bf16x8 pa[2][4];
        { const bf16* Wg = BSW + (size_t)g * 16384 + (size_t)(pb * 32 + r32) * 128 + hi * 8;
#pragma unroll
          for (int kt = 0; kt < 2; ++kt)
#pragma unroll
              for (int kk = 0; kk < 4; ++kk) pa[kt][kk] = *(const bf16x8*)(Wg + kt * 64 + kk * 16); }
        f32x16 o0 = {}, o1 = {};
#pragma unroll
        for (int kt = 0; kt < 2; ++kt) { const int vbase = (int)(uintptr_t)(lds + kt * 16384) + att::v_rd_base(lane);
            if (dh == 0) { att::pv_one<0>(o0, vbase, pa[kt][0], pa[kt][1], pa[kt][2], pa[kt][3]); att::pv_one<1>(o1, vbase, pa[kt][0], pa[kt][1], pa[kt][2], pa[kt][3]); }
            else { att::pv_one<2>(o0, vbase, pa[kt][0], pa[kt][1], pa[kt][2], pa[kt][3]); att::pv_one<3>(o1, vbase, pa[kt][0], pa[kt][1], pa[kt][2], pa[kt][3]); } }
#pragma unroll
        for (int r = 0; r < 16; ++r) { const int p = pb * 32 + (r & 3) + 8 * (r >> 2) + 4 * hi; Ob[p * OP + dh * 64 + r32] = o0[r]; Ob[p * OP + dh * 64 + 32 + r32] = o1[r]; }
        __syncthreads();
#pragma unroll
        for (int i = 0; i < 4; ++i) { const int p = sr + 32 * i; const float bias = bs[g * 128 + p];
            const f32x4 x0 = *(const f32x4*)(Ob + p * OP + sc), x1 = *(const f32x4*)(Ob + p * OP + sc + 4); float t[8];
#pragma unroll
            for (int e = 0; e < 8; ++e) t[e] = bf2f((unsigned short)ureg[i][e]) * ((e < 4 ? x0[e & 3] : x1[e & 3]) + bias);
            v4u w; w.x = pk2(t[0], t[1]); w.y = pk2(t[2], t[3]); w.z = pk2(t[4], t[5]); w.w = pk2(t[6], t[7]);
            *(v4u*)(Gout + (size_t)(row0 + p) * B_W + c0 + sc) = w; }
        __syncthreads();
    }
}
__device__ __forceinline__ void combine_phase(const float* OC, bf16* AO, const float* lq1, const float* lk1, const float* lq2, const float* lk2, const float* sg, float lam_init, int nrows) {
    const int tid = pg8::opaque_tid(), lane = tid & 63, gw = blockIdx.x * NWAVES + __builtin_amdgcn_readfirstlane(tid >> 6), NGW = gridDim.x * NWAVES;
    const float d1 = wave_sum(lq1[lane] * lk1[lane] + lq1[lane + 64] * lk1[lane + 64], lane), d2 = wave_sum(lq2[lane] * lk2[lane] + lq2[lane + 64] * lk2[lane + 64], lane);
    const float lam = expf(d1) - expf(d2) + lam_init;
    const f32x4 gv = *(const f32x4*)(sg + 4 * lane) * (1.0f - lam_init);
    for (int row = gw; row < nrows; row += NGW) {
        const float* orow = OC + (size_t)row * 4096; bf16* ar = AO + (size_t)row * DM;
#pragma unroll
        for (int h = 0; h < 8; ++h) { const f32x4 a = *(const f32x4*)(orow + (2 * h) * 256 + 4 * lane), b = *(const f32x4*)(orow + (2 * h + 1) * 256 + 4 * lane); const f32x4 o = a - lam * b;
            const float rs = 1.0f / sqrtf(wave_sum((o.x * o.x + o.y * o.y) + (o.z * o.z + o.w * o.w), lane) * (1.0f / 256.0f) + EPS); const f32x4 v = o * rs * gv;
            v2u w; w.x = pk2(v.x, v.y); w.y = pk2(v.z, v.w); *(v2u*)(ar + h * 256 + 4 * lane) = w; }
    }
}

template <int K, int LDA, int EPI>
__device__ __forceinline__ void ctx_tile(const bf16* A, const bf16* Bt, bf16* out, int ldc, int ntn, int tile, LAS unsigned char* L) {
    const int tid = pg8::opaque_tid(), lane = tid & 63, wave = __builtin_amdgcn_readfirstlane(tid >> 6), r32 = lane & 31, hi = lane >> 5;
    const int tm = tile / ntn, row0 = tm * 64, col0 = (tile - tm * ntn) * 64;
    constexpr int NB = K / 64;
    static_assert(K % 64 == 0, "K must be a multiple of 64");
    LAS unsigned char* W = L + wave * 16384;
    const int lr = lane >> 3, lc = lane & 7;
    const bf16* ag = A + (size_t)(row0 + lr) * LDA + lc * 8;
    const bf16* bg = Bt + (size_t)(col0 + lr) * K + lc * 8;
    const int wofs = lr * 128 + ((lc ^ (lr & 7)) << 4);
    const int rofs = r32 * 128;
    f32x16 acc00 = {}, acc01 = {}, acc10 = {}, acc11 = {};
    bf16x8 ga0[8], gb0[8], ga1[8], gb1[8];
#define CT_LOAD(GA, GB, kb_) do { _Pragma("unroll") for (int i = 0; i < 8; ++i) { GA[i] = *(const bf16x8*)(ag + (size_t)(8 * i) * LDA + (kb_) * 64); GB[i] = *(const bf16x8*)(bg + (size_t)(8 * i) * K + (kb_) * 64); } } while (0)
#define CT_STORE(GA, GB) do { _Pragma("unroll") for (int i = 0; i < 8; ++i) { *(LAS bf16x8*)(W + i * 1024 + wofs) = GA[i]; *(LAS bf16x8*)(W + 8192 + i * 1024 + wofs) = GB[i]; } } while (0)
#define CT_MMA() do { _Pragma("unroll") for (int s = 0; s < 4; ++s) { const int ch = (((2 * s + hi) ^ (r32 & 7)) << 4); \
        const bf16x8 a0 = *(const LAS bf16x8*)(W + rofs + ch), a1 = *(const LAS bf16x8*)(W + 4096 + rofs + ch), b0 = *(const LAS bf16x8*)(W + 8192 + rofs + ch), b1 = *(const LAS bf16x8*)(W + 12288 + rofs + ch); \
        acc00 = __builtin_amdgcn_mfma_f32_32x32x16_bf16(a0, b0, acc00, 0, 0, 0); acc01 = __builtin_amdgcn_mfma_f32_32x32x16_bf16(a0, b1, acc01, 0, 0, 0); \
        acc10 = __builtin_amdgcn_mfma_f32_32x32x16_bf16(a1, b0, acc10, 0, 0, 0); acc11 = __builtin_amdgcn_mfma_f32_32x32x16_bf16(a1, b1, acc11, 0, 0, 0); } } while (0)
    int kb = wave;
    if (kb < NB) CT_LOAD(ga0, gb0, kb);
    if (kb + 8 < NB) CT_LOAD(ga1, gb1, kb + 8);
    for (; kb < NB; kb += 16) {
        CT_STORE(ga0, gb0);
        if (kb + 16 < NB) CT_LOAD(ga0, gb0, kb + 16);
        CT_MMA();
        if (kb + 8 < NB) {
            CT_STORE(ga1, gb1);
            if (kb + 24 < NB) CT_LOAD(ga1, gb1, kb + 24);
            CT_MMA();
        }
    }
#undef CT_LOAD
#undef CT_STORE
#undef CT_MMA
    LDS_WAIT(); asm volatile("" ::: "memory");
    LAS float* red = (LAS float*)L + wave * 4096;
#pragma unroll
    for (int r = 0; r < 16; ++r) { const int m = (r & 3) + 8 * (r >> 2) + 4 * hi;
        red[m * 64 + r32] = acc00[r]; red[m * 64 + 32 + r32] = acc01[r]; red[(32 + m) * 64 + r32] = acc10[r]; red[(32 + m) * 64 + 32 + r32] = acc11[r]; }
    __syncthreads();
    { const int o = tid * 8, m = o >> 6, n = o & 63; f32x4 s0 = {0.f, 0.f, 0.f, 0.f}, s1 = s0;
#pragma unroll
      for (int w = 0; w < 8; ++w) { s0 += *(const LAS f32x4*)((LAS float*)L + w * 4096 + o); s1 += *(const LAS f32x4*)((LAS float*)L + w * 4096 + o + 4); }
      if (EPI == 1) {
#pragma unroll
          for (int j = 0; j < 4; ++j) { s0[j] = pg8::gelu_tanh(s0[j]); s1[j] = pg8::gelu_tanh(s1[j]); } }
      v4u w4; w4.x = pk2(s0.x, s0.y); w4.y = pk2(s0.z, s0.w); w4.z = pk2(s1.x, s1.y); w4.w = pk2(s1.z, s1.w);
      *(v4u*)(out + (size_t)(row0 + m) * ldc + col0 + n) = w4; }
    __syncthreads();
}

__global__ void __launch_bounds__(NWAVES * 64, 2) fwd(KArgs args) {
    extern __shared__ __attribute__((aligned(16))) unsigned char lds[];
    LAS unsigned char* L = (LAS unsigned char*)lds;
    const int tid = threadIdx.x, G = gridDim.x, bx = blockIdx.x;
    unsigned char* ws0 = args.ws;
    for (int u = tid; u < (LDS_BYTES - RING_BYTES) / 4; u += NWAVES * 64) ((LAS unsigned*)(L + RING_BYTES))[u] = 0u;
    __syncthreads();
    const int lo = args.ph_lo, hi = args.ph_hi;
    XcdBarrier bar; bar.bar = (unsigned*)(ws0 + WS_CTL) + CW_BAR + args.li * XCD_BAR_WORDS; bar.x = 0; bar.st = (volatile LAS unsigned*)(L + MISC_OFF + 32);
    if (hi - lo > 1) bar = xcd_barrier_post((unsigned*)(ws0 + WS_CTL) + CW_BAR + args.li * XCD_BAR_WORDS, (volatile LAS unsigned*)(L + MISC_OFF + 32));
    int ph = 0; unsigned long long bacc_ = 0; (void)bacc_;
#define PHASE_BEGIN if (ph >= lo && ph < hi) {
#define PHASE_END   if (ph + 1 < hi) { unsigned long long br0_ = 0; if (PROBE_ID == 21) br0_ = wall_clock64(); xcd_barrier(bar); if (PROBE_ID == 21) bacc_ += wall_clock64() - br0_; } } ++ph;
#define SETUP_PTRS() GAS unsigned char* wsg_ = (GAS unsigned char*)args.ws; asm volatile("" : "+s"(wsg_)); unsigned char* ws = (unsigned char*)wsg_; \
    GAS float* xlg_ = (GAS float*)args.out; asm volatile("" : "+s"(xlg_)); float* XL = (float*)xlg_; float* XC = (float*)(ws + WS_XC); \
    bf16* H = (bf16*)(ws + WS_H); bf16* HID = (bf16*)(ws + WS_HID); bf16* Y = (bf16*)(ws + WS_Y); bf16* QKV = (bf16*)(ws + WS_QKV); bf16* AO = (bf16*)(ws + WS_AO); float* OC = (float*)(ws + WS_OC); \
    const float* ROPE = (const float*)(ws + WS_ROPE); const float* SM = (const float*)(ws + WS_SMALL); (void)XC; (void)HID; (void)Y; (void)QKV; (void)AO; (void)OC; (void)ROPE; (void)SM; (void)H

    { SETUP_PTRS();
    PHASE_BEGIN
#ifndef OFF_PRO
    prologue_phase(args, L, bx, G);
#endif
    PHASE_END
    PHASE_BEGIN norm_phase(args.in[0], args.in[2], XL, XC, nullptr, nullptr, modt(ws, 0, 0, 0, 0), H, MALL); PHASE_END }

    for (int sl = 0; sl < 3 * NLAYER; ++sl) {
        SETUP_PTRS();
        const int layer = sl / 3, typ = sl % 3, kind = layer % 3, jm = layer / 3; const bool lastl = (layer == NLAYER - 1);
        const int Mrows = (lastl && typ >= 1) ? MLAT : MALL;
        pg8::Gemm gy;
        if (typ != 1) {
            const int f = (typ == 0) ? 0 : 1;
            PHASE_BEGIN
                pg8::Gemm g{H, (const bf16*)(ws + WS_WFC1) + (size_t)(layer * 2 + f) * NFC1 * DM, Mrows, NFC1, DM, DM}; pg8::StaticOrder S; S.init(Mrows, NFC1, G, bx);
                pg8::EpiSwiglu E{HID, DFF};
                #ifndef OFF_FC1
                unsigned long long pt0_ = 0, pr0_ = 0; if (PROBE_ID == 20 && sl == 3 && bx == 0) { pt0_ = clock64(); pr0_ = wall_clock64(); }
                for (int rep_ = 0; rep_ < (PROBE_ID == 2 ? 2 : 1); ++rep_) { pg8::gemm_phase<pg8::EpiSwiglu, pg8::StaticOrder, true, true, DM, DM>(L, g, S, E); }
                if (PROBE_ID == 20 && sl == 3 && bx == 0 && threadIdx.x == 0) { const unsigned long long t1_ = clock64(), r1_ = wall_clock64();
                    __hip_atomic_store((float*)(ws + WS_SMALL) + SM_END, floorf((float)(t1_ - pt0_) / ((float)(r1_ - pr0_) * 10.0f) * 4.0f + 0.5f) * 0.02f, __ATOMIC_RELAXED, __HIP_MEMORY_SCOPE_AGENT); }
#endif
            PHASE_END
            gy = pg8::Gemm{HID, (const bf16*)(ws + WS_WFC2) + (size_t)(layer * 2 + f) * DM * DFF, Mrows, DM, DFF, DFF};
        } else {
            if (kind != 1) {
                PHASE_BEGIN
                    const int N = (kind == 0) ? A_N : C_N, Min = (kind == 0) ? MALL : MLAT;
                    pg8::Gemm g{H, (kind == 0) ? (const bf16*)(ws + WS_WAIN) + (size_t)jm * A_N * DM : (const bf16*)(ws + WS_WCIN), Min, N, DM, DM}; pg8::StaticOrder S; S.init(Min, N, G, bx);
                    pg8::EpiBf16X<0> E{QKV, N, ROPE, (kind == 0) ? 2560 : 4096};
                    #ifndef OFF_ROPE
                    for (int rep_ = 0; rep_ < (PROBE_ID == 8 ? 2 : 1); ++rep_) { pg8::gemm_phase<pg8::EpiBf16X<0>, pg8::StaticOrder, true, true, DM, DM>(L, g, S, E); }
                    if (kind == 2) for (int t = bx; t < 8 * (C_N / 64); t += G) ctx_tile<DM, DM, 0>(H + (size_t)MLAT * DM, g.Bt, QKV + (size_t)MLAT * C_N, C_N, C_N / 64, t, L);
#endif
                PHASE_END
            } else {
                PHASE_BEGIN
                    pg8::Gemm g{H, (const bf16*)(ws + WS_WBIN), MLAT, B_N, DM, DM}; pg8::StaticOrder S; S.init(MLAT, B_N, G, bx);
                    pg8::EpiBf16X<1> E{QKV, B_N, nullptr, 0};
                    #ifndef OFF_GELU
                    for (int rep_ = 0; rep_ < (PROBE_ID == 9 ? 2 : 1); ++rep_) { pg8::gemm_phase<pg8::EpiBf16X<1>, pg8::StaticOrder, true, true, DM, DM>(L, g, S, E); }
                    for (int t = bx; t < 8 * (B_N / 64); t += G) ctx_tile<DM, DM, 1>(H + (size_t)MLAT * DM, g.Bt, QKV + (size_t)MLAT * B_N, B_N, B_N / 64, t, L);
#endif
                PHASE_END
            }
            if (kind == 0) {
                PHASE_BEGIN
                    const int nlat = NBATCH * 16 * 16, nall = nlat + (lastl ? 0 : NBATCH * 16);
                    for (int u = bx; u < nall; u += G) {
                        att::Args a; a.qkv = QKV; a.ld = A_N; a.n0 = 4; a.has_sink = 1; a.out = AO; a.ldo = DM;
                        if (u < nlat) { const int qb = u & 15, h = (u >> 4) & 15, b = u >> 8;
                            a.qrow0 = b * SEQ + qb * 256; a.qcol = h * 128; a.kcol = 2048 + (h >> 2) * 128; a.vcol = 2560 + (h >> 2) * 128; a.ctxrow0 = MLAT + b * CTXL; a.latrow0 = b * SEQ;
                            a.kstart = qb * 256 - 128; a.n1 = 8; a.qpos0 = qb * 256; a.sink = SM[SM_SINK + jm * 16 + h]; a.ocol = h * 128; }
                        else { const int cu = u - nlat, h = cu & 15, b = cu >> 4;
                            a.qrow0 = MLAT + b * CTXL; a.qcol = h * 128; a.kcol = 2048 + (h >> 2) * 128; a.vcol = 2560 + (h >> 2) * 128; a.ctxrow0 = MLAT + b * CTXL; a.latrow0 = b * SEQ;
                            a.kstart = 0; a.n1 = 0; a.qpos0 = 0; a.sink = SM[SM_SINK + jm * 16 + h]; a.ocol = h * 128; }
                        #ifndef OFF_ATTA
                        for (int rep_ = 0; rep_ < (PROBE_ID == 7 ? 2 : 1); ++rep_) { att::attn_unit<true, true, A_N>(a, (char*)lds); }
#endif
                    }
                PHASE_END
                gy = pg8::Gemm{AO, (const bf16*)(ws + WS_WAOUT) + (size_t)jm * DM * DM, Mrows, DM, DM, DM};
            } else if (kind == 1) {
                PHASE_BEGIN for (int rep_ = 0; rep_ < (PROBE_ID == 15 ? 2 : 1); ++rep_) { vstats_phase(QKV, (float*)(ws + WS_STATS), MALL); } PHASE_END
                PHASE_BEGIN
for (int rep_ = 0; rep_ < (PROBE_ID == 14 ? 2 : 1); ++rep_) { spatial_phase(QKV, (bf16*)OC, (const bf16*)(ws + WS_BSW), (const float*)(ws + WS_STATS), SM + SM_VNG, SM + SM_VNB, SM + SM_BS, (char*)lds, MALL / 128, bx, G); }
                PHASE_END
                gy = pg8::Gemm{(const bf16*)OC, (const bf16*)(ws + WS_WBOUT), Mrows, DM, B_W, B_W};
            } else {
                PHASE_BEGIN
                    const int nlat = NBATCH * 8 * 32, nall = nlat + (lastl ? 0 : NBATCH * 8 * 2);
                    float lam;
                    { const int ln_ = pg8::opaque_tid() & 63; const float* q1 = SM + SM_LQ1; const float* k1 = SM + SM_LK1; const float* q2 = SM + SM_LQ2; const float* k2 = SM + SM_LK2;
                      const float d1 = wave_sum(q1[ln_] * k1[ln_] + q1[ln_ + 64] * k1[ln_ + 64], ln_), d2 = wave_sum(q2[ln_] * k2[ln_] + q2[ln_ + 64] * k2[ln_ + 64], ln_);
                      lam = expf(d1) - expf(d2) + args.lam_init; }
                    for (int u = bx; u < nall; u += G) {
                        int qrow0, hh, b, n1;
                        if (u < nlat) { const int qb = u & 31; hh = (u >> 5) & 7; b = u >> 8; qrow0 = b * SEQ + qb * 128; n1 = 64; }
                        else { const int cu = u - nlat, qb = cu & 1; hh = (cu >> 1) & 7; b = cu >> 4; qrow0 = MLAT + b * CTXL + qb * 128; n1 = 0; }
                        for (int rep_ = 0; rep_ < (PROBE_ID == 6 ? 2 : 1); ++rep_) { att::dattn_unit<C_N>(QKV, qrow0, hh, MLAT + b * CTXL, b * SEQ, 4, n1, lam, args.gscale, SM + SM_SUBG, AO, L, (char*)lds); }
                    }
                PHASE_END
                gy = pg8::Gemm{AO, (const bf16*)(ws + WS_WCOUT), Mrows, DM, DM, DM};
            }
        }
        PHASE_BEGIN
            const bool hasctx = (gy.M == MALL); gy.M = MLAT;
            pg8::StaticOrder S; S.init(MLAT, DM, G, bx); pg8::EpiBf16X<2> E{Y, DM, nullptr, 0};
            bf16* Yc = Y + (size_t)MLAT * DM;
            if (typ != 1) { for (int rep_ = 0; rep_ < (PROBE_ID == 3 ? 2 : 1); ++rep_) { pg8::gemm_phase<pg8::EpiBf16X<2>, pg8::StaticOrder, true, true, DFF, DFF>(L, gy, S, E); }
                for (int rep_ = 0; rep_ < (PROBE_ID == 4 ? 2 : 1); ++rep_) { if (hasctx) for (int t = bx; t < 256; t += G) ctx_tile<DFF, DFF, 0>(gy.A + (size_t)MLAT * DFF, gy.Bt, Yc, DM, 32, t, L); } }
            else if (kind == 1) { pg8::gemm_phase<pg8::EpiBf16X<2>, pg8::StaticOrder, true, true, B_W, B_W>(L, gy, S, E);
                if (hasctx) for (int t = bx; t < 256; t += G) ctx_tile<B_W, B_W, 0>(gy.A + (size_t)MLAT * B_W, gy.Bt, Yc, DM, 32, t, L); }
            else { pg8::gemm_phase<pg8::EpiBf16X<2>, pg8::StaticOrder, true, true, DM, DM>(L, gy, S, E);
                if (hasctx) for (int t = bx; t < 256; t += G) ctx_tile<DM, DM, 0>(gy.A + (size_t)MLAT * DM, gy.Bt, Yc, DM, 32, t, L); }
        PHASE_END
        if (PROBE_ID == 21 && sl == 3 * NLAYER - 2 && bx == PROBE_BLK && threadIdx.x == 0) __hip_atomic_store((float*)(ws + WS_SMALL) + SM_END, floorf((float)bacc_ * 0.01f / 500.0f + 0.5f) * 0.02f, __ATOMIC_RELAXED, __HIP_MEMORY_SCOPE_AGENT);
        PHASE_BEGIN
            const bool fin = (sl == 3 * NLAYER - 1);
            const int nl = (typ == 2) ? layer + 1 : layer, ns = (typ == 2) ? 0 : typ + 1;
            if (PROBE_ID == 5) norm_phase(XL, XC, (float*)(ws + WS_END), (float*)(ws + WS_END + 64 * MiB), Y, modt(ws, layer, typ, 0, 0), fin ? nullptr : modt(ws, nl, ns, 0, 0), fin ? nullptr : (bf16*)(ws + WS_END + 72 * MiB), Mrows);
            norm_phase(XL, XC, XL, XC, Y, modt(ws, layer, typ, 0, 0), fin ? nullptr : modt(ws, nl, ns, 0, 0), fin ? nullptr : H, Mrows, (PROBE_ID >= 20 && fin) ? 1.0f + __hip_atomic_load((float*)(ws + WS_SMALL) + SM_END, __ATOMIC_RELAXED, __HIP_MEMORY_SCOPE_AGENT) : 1.0f);
        PHASE_END
    }
#undef PHASE_BEGIN
#undef PHASE_END
}

static int count_phases() { int n = 2; for (int sl = 0; sl < 3 * NLAYER; ++sl) { const int layer = sl / 3, typ = sl % 3, kind = layer % 3; n += (typ != 1) ? 3 : (kind == 1 ? 5 : 4); } return n; }
extern "C" void kernel_launch(void* const* d_in, const int* in_sizes, int n_in, void* d_out, int out_size, void* d_ws, size_t ws_size, hipStream_t stream) {
    static int grid = 0;
    if (grid == 0) {
        if (n_in != 25 || in_sizes[0] != MLAT * DM || out_size != MLAT * DM || ws_size < WS_END) { fprintf(stderr, "kernel_launch: unexpected shapes (n_in %d, in0 %d, out %d, ws %zu < %zu)\n", n_in, n_in > 0 ? in_sizes[0] : -1, out_size, ws_size, (size_t)WS_END); grid = -1; return; }
        int dev = 0, cus = 0, per_cu = 0;
        if (hipGetDevice(&dev) != hipSuccess || hipDeviceGetAttribute(&cus, hipDeviceAttributeMultiprocessorCount, dev) != hipSuccess) { grid = -1; return; }
        if (hipFuncSetAttribute((const void*)fwd, hipFuncAttributeMaxDynamicSharedMemorySize, LDS_BYTES) != hipSuccess) { fprintf(stderr, "kernel_launch: hipFuncSetAttribute failed\n"); grid = -1; return; }
        if (hipOccupancyMaxActiveBlocksPerMultiprocessor(&per_cu, (const void*)fwd, NWAVES * 64, LDS_BYTES) != hipSuccess || per_cu < 1) fprintf(stderr, "kernel_launch: occupancy query reports %d\n", per_cu);
        (void)hipGetLastError();
        grid = cus;
    }
    if (grid < 0) return;
    if (hipMemsetAsync((char*)d_ws + WS_CTL, 0, CTL_BYTES, stream) != hipSuccess) return;
    KArgs a{};
    for (int i = 0; i < 25; ++i) a.in[i] = (const float*)d_in[i];
    a.out = (float*)d_out; a.ws = (unsigned char*)d_ws; a.lam_init = (float)(0.8 - 0.6 * exp(-0.3 * 2.0)); a.gscale = 1.0f - a.lam_init;
    const int nph = count_phases();
#if MK_PER_PHASE
    for (int p = 0; p < nph; ++p) { a.ph_lo = p; a.ph_hi = p + 1; a.li = 0; hipLaunchKernelGGL(fwd, dim3(grid), dim3(NWAVES * 64), LDS_BYTES, stream, a); }
#else
    a.ph_lo = 0; a.ph_hi = nph; a.li = 0; hipLaunchKernelGGL(fwd, dim3(grid), dim3(NWAVES * 64), LDS_BYTES, stream, a);
#endif
    const hipError_t le = hipPeekAtLastError();
    if (le != hipSuccess) fprintf(stderr, "kernel_launch: launch failed: %s\n", hipGetErrorName(le));
}
```

```cpp
#include <hip/hip_runtime.h>
#include <cstdio>
#include <cstdint>
#include <cmath>

#ifndef PROBE_ID
#define PROBE_ID 0
#endif
#ifndef PROBE_Q
#define PROBE_Q 300.0f
#endif
#ifndef PROBE_BLK
#define PROBE_BLK 0
#endif
#ifndef MK_PER_PHASE
#define MK_PER_PHASE 0
#endif

namespace pg8 {
#define PG8_LAS __attribute__((address_space(3)))
typedef unsigned short bf16_t;
typedef short bf16x8 __attribute__((ext_vector_type(8)));
typedef float f32x4 __attribute__((ext_vector_type(4)));
typedef unsigned u32x4 __attribute__((ext_vector_type(4)));
__device__ __forceinline__ int opaque_tid() { int t = threadIdx.x; asm volatile("" : "+v"(t)); return t; }
#ifndef WT_STORES
#define WT_STORES 0
#endif
__device__ __forceinline__ void st16(void* p, u32x4 v) {
#if WT_STORES
    asm volatile("global_store_dwordx4 %0, %1, off sc1\n\ts_nop 1" :: "v"(p), "v"(v) : "memory");
#else
    *(u32x4*)p = v;
#endif
}
typedef unsigned u32x2_t __attribute__((ext_vector_type(2)));
__device__ __forceinline__ void st8(void* p, u32x2_t v) {
#if WT_STORES
    asm volatile("global_store_dwordx2 %0, %1, off sc1\n\ts_nop 1" :: "v"(p), "v"(v) : "memory");
#else
    *(u32x2_t*)p = v;
#endif
}
constexpr int BM = 256, BK = 64, HALF = 128, HTB = HALF * BK * 2  , STAGE_BYTES = 8 * HTB, NXCD = 8, WGM = 8;

__host__ __device__ __forceinline__ int lds_byte(int r, int c) { const int st = (r >> 4) * 2 + (c >> 5), rr = r & 15, cc = c & 31, ob = rr * 64 + cc * 2; return st * 1024 + (ob ^ (((ob >> 9) & 1) << 5)); }
__host__ __device__ __forceinline__ void stage_rc(int b, int& R, int& C) { const int st = b / 1024, sb = b % 1024, swz = sb ^ (((sb >> 9) & 1) << 5); R = (st >> 1) * 16 + swz / 64; C = (st & 1) * 32 + (swz % 64) / 2; }
__host__ __device__ __forceinline__ int perm32(int rho) { const int n = rho >> 4, i = rho & 15; return 8 * (i >> 2) + 4 * n + (i & 3); }

struct Unit { int pm, pn; };
struct Gemm { const bf16_t* A; const bf16_t* Bt; int M, N, K, lda; };

struct StaticOrder {
    int nM, nN, nwg, G, c;
    __host__ __device__ void init(int M, int N, int G_, int c_) { nM = M / BM; nN = N / BM; nwg = nM * nN; G = G_; c = c_; }
    __host__ __device__ bool next(int i, Unit& u) const {
        const long L = (long)i * G + c; if (L >= nwg) return false;
        int wgid = (int)L; { const int q = nwg / NXCD, r = nwg % NXCD, xcd = wgid % NXCD, off = wgid / NXCD; wgid = (xcd < r ? xcd * (q + 1) : r * (q + 1) + (xcd - r) * q) + off; }
        const int nig = WGM * nN, gid = wgid / nig, fm = gid * WGM, gsz = (nM - fm) < WGM ? (nM - fm) : WGM;
        u.pm = fm + ((wgid % nig) % gsz); u.pn = (wgid % nig) / gsz; return true;
    }
    __device__ __forceinline__ void a_ready(const Unit&) const {}
    __device__ __forceinline__ void done(const Unit&) const {}
};


__device__ __forceinline__ unsigned cvt_pk_bf16(float lo, float hi) { unsigned r; asm volatile("v_cvt_pk_bf16_f32 %0, %1, %2" : "=v"(r) : "v"(lo), "v"(hi)); return r; }
__device__ __forceinline__ float sigmoid_fast(float z) { return __builtin_amdgcn_rcpf(1.0f + __builtin_amdgcn_exp2f(-1.4426950408889634f * z)); }
__device__ __forceinline__ float gelu_tanh(float x) { const float z = 1.5957691216057308f * (x + 0.044715f * x * x * x); return x * sigmoid_fast(z); }

struct EpiSwiglu {
    static constexpr bool PERM = true, AFTER_DRAIN = false;
    bf16_t* O; int ldc;
    __device__ __forceinline__ void operator()(const f32x4 (&acc)[2][2][4][2], const Unit& u, int wr, int wc, int fr, int fq) const {
        const int row0 = u.pm * BM + wr * 64 + fr, col0 = u.pn * HALF + wc * 32 + 8 * fq;
#pragma unroll
        for (int ai = 0; ai < 2; ++ai)
#pragma unroll
            for (int m = 0; m < 4; ++m) { bf16_t* rowp = O + (size_t)(row0 + ai * HALF + m * 16) * ldc + col0;
                float v[8];
#pragma unroll
                for (int n = 0; n < 2; ++n)
#pragma unroll
                    for (int j = 0; j < 4; ++j) { const float g = acc[ai][0][m][n][j], uu = acc[ai][1][m][n][j]; v[n * 4 + j] = g * sigmoid_fast(g) * uu; }
                u32x4 w; w.x = cvt_pk_bf16(v[0], v[1]); w.y = cvt_pk_bf16(v[2], v[3]); w.z = cvt_pk_bf16(v[4], v[5]); w.w = cvt_pk_bf16(v[6], v[7]);
                st16(rowp, w); }
    }
};
struct EpiF32 {
    static constexpr bool PERM = true, AFTER_DRAIN = false;
    float* C; int ldc;
    __device__ __forceinline__ void operator()(const f32x4 (&acc)[2][2][4][2], const Unit& u, int wr, int wc, int fr, int fq) const {
        const int row0 = u.pm * BM + wr * 64 + fr, col0 = u.pn * BM + wc * 32 + 8 * fq;
#pragma unroll
        for (int ai = 0; ai < 2; ++ai)
#pragma unroll
            for (int m = 0; m < 4; ++m) { float* rowp = C + (size_t)(row0 + ai * HALF + m * 16) * ldc + col0;
#pragma unroll
                for (int bj = 0; bj < 2; ++bj) { *(f32x4*)(rowp + bj * HALF) = acc[ai][bj][m][0]; *(f32x4*)(rowp + bj * HALF + 4) = acc[ai][bj][m][1]; } }
    }
};
template <int MODE  > struct EpiBf16X {
    static constexpr bool PERM = true, AFTER_DRAIN = false;
    bf16_t* O; int ldc; const float* rope; int rope_cols;
    __device__ __forceinline__ void operator()(const f32x4 (&acc)[2][2][4][2], const Unit& u, int wr, int wc, int fr, int fq) const {
        const int row0 = u.pm * BM + wr * 64 + fr, col0 = u.pn * BM + wc * 32 + 8 * fq;
        const bool do_rope = (MODE == 0) && (u.pm < 32) && (u.pn * BM < rope_cols);
        const int p0 = 16 * wc + 4 * fq;
#pragma unroll
        for (int ai = 0; ai < 2; ++ai)
#pragma unroll
            for (int m = 0; m < 4; ++m) { const int row = row0 + ai * HALF + m * 16; bf16_t* rowp = O + (size_t)row * ldc + col0;
                f32x4 cs0 = (f32x4){1.f, 0.f, 1.f, 0.f}, cs1 = cs0;
                if (do_rope) { const float* rp = rope + ((size_t)(row & 4095) * 64 + p0) * 2; cs0 = *(const f32x4*)rp; cs1 = *(const f32x4*)(rp + 4); }
#pragma unroll
                for (int bj = 0; bj < 2; ++bj) { f32x4 v0 = acc[ai][bj][m][0], v1 = acc[ai][bj][m][1];
                    if (MODE == 1) {
#pragma unroll
                        for (int j = 0; j < 4; ++j) { v0[j] = gelu_tanh(v0[j]); v1[j] = gelu_tanh(v1[j]); } }
                    else if (do_rope) {
                        const f32x4 a = v0, b = v1;
                        v0[0] = a[0] * cs0[0] - a[1] * cs0[1]; v0[1] = a[0] * cs0[1] + a[1] * cs0[0]; v0[2] = a[2] * cs0[2] - a[3] * cs0[3]; v0[3] = a[2] * cs0[3] + a[3] * cs0[2];
                        v1[0] = b[0] * cs1[0] - b[1] * cs1[1]; v1[1] = b[0] * cs1[1] + b[1] * cs1[0]; v1[2] = b[2] * cs1[2] - b[3] * cs1[3]; v1[3] = b[2] * cs1[3] + b[3] * cs1[2]; }
                    u32x4 w; w.x = cvt_pk_bf16(v0[0], v0[1]); w.y = cvt_pk_bf16(v0[2], v0[3]); w.z = cvt_pk_bf16(v1[0], v1[1]); w.w = cvt_pk_bf16(v1[2], v1[3]);
                    st16(rowp + bj * HALF, w); } }
    }
};

template <class Epi, class Sched, bool ALIGN_EPI, bool SP2, int K, int LDA>
__device__ __forceinline__ void gemm_phase(PG8_LAS unsigned char* lds, const Gemm g, const Sched& S, const Epi& E) {
    const int tid = opaque_tid(), wid = __builtin_amdgcn_readfirstlane(tid >> 6), lane = tid & 63, wr = wid >> 2, wc = wid & 3, fr = lane & 15, fq = lane >> 4;
    constexpr int nt = K / BK;
    unsigned voffA[2], voffB[2];
#pragma unroll
    for (int i = 0; i < 2; ++i) { int R, C; stage_rc(tid * 16 + i * 8192, R, C); const int Rb = Epi::PERM ? ((R & ~31) + perm32(R & 31)) : R;
        voffA[i] = (unsigned)(R * LDA + C) * 2u; voffB[i] = (unsigned)(Rb * K + C) * 2u; }
    constexpr size_t kstep = (size_t)(BK * 2);
    constexpr size_t hstepA = (size_t)HALF * LDA * 2, hstepB = (size_t)HALF * K * 2;
    constexpr size_t tstepA = 2 * hstepA, tstepB = 2 * hstepB;
    const unsigned ldsw = (unsigned)wid * 1024u;
    const int aoff = lds_byte(wr * 64 + fr, fq * 8), boff = lds_byte(wc * 32 + fr, fq * 8);
#define PG8_SA(b, h) (((b) * 2 + (h)) * HTB)
#define PG8_SB(b, h) ((4 + (b) * 2 + (h)) * HTB)
#define PG8_STAGE(bufoff, gbase, voff) do { _Pragma("unroll") for (int _i = 0; _i < 2; ++_i) \
        __builtin_amdgcn_global_load_lds((const unsigned*)((const char*)(gbase) + (voff)[_i]), (PG8_LAS unsigned*)(lds + (bufoff) + ldsw + _i * 8192), 16, 0, 0); } while (0)
#define PG8_LDA(dst, b, h) do { _Pragma("unroll") for (int m = 0; m < 4; ++m) _Pragma("unroll") for (int k = 0; k < 2; ++k) dst[m][k] = *(const PG8_LAS bf16x8*)(lds + PG8_SA(b, h) + aoff + m * 2048 + k * 1024); } while (0)
#define PG8_LDB(dst, b, h) do { _Pragma("unroll") for (int n = 0; n < 2; ++n) _Pragma("unroll") for (int k = 0; k < 2; ++k) dst[n][k] = *(const PG8_LAS bf16x8*)(lds + PG8_SB(b, h) + boff + n * 2048 + k * 1024); } while (0)
#define PG8_MMA(ai, bj, At, Bt) do { __builtin_amdgcn_s_setprio(1); _Pragma("unroll") for (int m = 0; m < 4; ++m) _Pragma("unroll") for (int n = 0; n < 2; ++n) _Pragma("unroll") for (int k = 0; k < 2; ++k) \
        acc[ai][bj][m][n] = __builtin_amdgcn_mfma_f32_16x16x32_bf16(Bt[n][k], At[m][k], acc[ai][bj][m][n], 0, 0, 0); __builtin_amdgcn_s_setprio(0); } while (0)
#define PG8_WAIT_V(n) asm volatile("s_waitcnt vmcnt(" #n ")" ::: "memory")
#define PG8_WAIT_L(n) asm volatile("s_waitcnt lgkmcnt(" #n ")" ::: "memory")
#define PG8_BAR __builtin_amdgcn_s_barrier()
#define PG8_SCHED __builtin_amdgcn_sched_barrier(0)
    Unit cur, nxt; int ui = 0;
    if (!S.next(0, cur)) return;
    f32x4 acc[2][2][4][2];
#pragma unroll
    for (int a = 0; a < 2; ++a)
#pragma unroll
        for (int b = 0; b < 2; ++b)
#pragma unroll
            for (int m = 0; m < 4; ++m)
#pragma unroll
                for (int n = 0; n < 2; ++n) acc[a][b][m][n] = (f32x4){0.f, 0.f, 0.f, 0.f};
    bf16x8 At[4][2], B0[2][2], B1[2][2];
    const char* cA = (const char*)g.A + (size_t)cur.pm * tstepA; const char* cB = (const char*)g.Bt + (size_t)cur.pn * tstepB;
    S.a_ready(cur);
    if constexpr (SP2) {
        PG8_STAGE(PG8_SB(0, 0), cB, voffB); PG8_STAGE(PG8_SB(0, 1), cB + hstepB, voffB); PG8_STAGE(PG8_SA(0, 0), cA, voffA); PG8_STAGE(PG8_SA(0, 1), cA + hstepA, voffA);
        if (wr == 1) PG8_BAR;
        PG8_WAIT_V(2); PG8_BAR;
        PG8_STAGE(PG8_SB(1, 0), cB + kstep, voffB); PG8_STAGE(PG8_SA(1, 0), cA + kstep, voffA); PG8_STAGE(PG8_SB(1, 1), cB + hstepB + kstep, voffB);
        PG8_WAIT_V(6); PG8_BAR;
    } else {
        PG8_STAGE(PG8_SB(0, 0), cB, voffB); PG8_STAGE(PG8_SA(0, 0), cA, voffA); PG8_STAGE(PG8_SB(0, 1), cB + hstepB, voffB); PG8_STAGE(PG8_SA(0, 1), cA + hstepA, voffA);
        if (wr == 1) PG8_BAR;
        PG8_WAIT_V(4); PG8_BAR;
        PG8_STAGE(PG8_SB(1, 0), cB + kstep, voffB); PG8_STAGE(PG8_SA(1, 0), cA + kstep, voffA); PG8_STAGE(PG8_SB(1, 1), cB + hstepB + kstep, voffB);
        PG8_WAIT_V(6); PG8_BAR;
    }
    for (;;) {
        const bool has_next = S.next(ui + 1, nxt);
        const char* nA = has_next ? (const char*)g.A + (size_t)nxt.pm * tstepA : cA; const char* nB = has_next ? (const char*)g.Bt + (size_t)nxt.pn * tstepB : cB;
        for (int t = 0; t < nt; t += 2) {
            const bool last = (t == nt - 2);
            const char* a1 = cA + (size_t)(t + 1) * kstep;
            const char* a2 = last ? nA : cA + (size_t)(t + 2) * kstep; const char* b2 = last ? nB : cB + (size_t)(t + 2) * kstep;
            const char* a3 = a2 + kstep; const char* b3 = b2 + kstep;
            if (last && has_next) S.a_ready(nxt);
            if constexpr (SP2) {
            PG8_LDB(B0, 0, 0); PG8_LDB(B1, 0, 1); PG8_SCHED; PG8_LDA(At, 0, 0); PG8_STAGE(PG8_SA(1, 1), a1 + hstepA, voffA);
            PG8_WAIT_V(8); PG8_WAIT_L(0); PG8_BAR; PG8_MMA(0, 0, At, B0); PG8_MMA(0, 1, At, B1); PG8_BAR; PG8_SCHED;
            PG8_LDA(At, 0, 1); PG8_STAGE(PG8_SB(0, 0), b2, voffB); PG8_STAGE(PG8_SB(0, 1), b2 + hstepB, voffB); PG8_STAGE(PG8_SA(0, 0), a2, voffA);
            PG8_WAIT_V(8); PG8_WAIT_L(0); PG8_BAR; PG8_MMA(1, 0, At, B0); PG8_MMA(1, 1, At, B1); PG8_BAR; PG8_SCHED;
            PG8_LDB(B0, 1, 0); PG8_LDB(B1, 1, 1); PG8_SCHED; PG8_LDA(At, 1, 0); PG8_STAGE(PG8_SA(0, 1), a2 + hstepA, voffA);
            PG8_WAIT_V(8); PG8_WAIT_L(0); PG8_BAR; PG8_MMA(0, 0, At, B0); PG8_MMA(0, 1, At, B1); PG8_BAR; PG8_SCHED;
            PG8_LDA(At, 1, 1); PG8_STAGE(PG8_SB(1, 0), b3, voffB); PG8_STAGE(PG8_SB(1, 1), b3 + hstepB, voffB); PG8_STAGE(PG8_SA(1, 0), a3, voffA);
            PG8_WAIT_V(8); PG8_WAIT_L(0); PG8_BAR; PG8_MMA(1, 0, At, B0); PG8_MMA(1, 1, At, B1); PG8_BAR; PG8_SCHED;
            } else {
            PG8_LDB(B0, 0, 0); PG8_SCHED; PG8_LDA(At, 0, 0); PG8_STAGE(PG8_SA(1, 1), a1 + hstepA, voffA);
            PG8_WAIT_L(8); PG8_BAR; PG8_WAIT_L(0); PG8_MMA(0, 0, At, B0); PG8_BAR; PG8_SCHED;
            PG8_LDB(B1, 0, 1); PG8_STAGE(PG8_SB(0, 0), b2, voffB);
            PG8_BAR; PG8_WAIT_L(0); PG8_MMA(0, 1, At, B1); PG8_BAR;
            PG8_LDA(At, 0, 1); PG8_STAGE(PG8_SA(0, 0), a2, voffA);
            PG8_BAR; PG8_WAIT_L(0); PG8_MMA(1, 0, At, B0); PG8_BAR; PG8_SCHED;
            PG8_STAGE(PG8_SB(0, 1), b2 + hstepB, voffB);
            PG8_WAIT_V(6); PG8_BAR; PG8_MMA(1, 1, At, B1); PG8_BAR;
            PG8_LDB(B0, 1, 0); PG8_SCHED; PG8_LDA(At, 1, 0); PG8_STAGE(PG8_SA(0, 1), a2 + hstepA, voffA);
            PG8_WAIT_L(8); PG8_BAR; PG8_WAIT_L(0); PG8_MMA(0, 0, At, B0); PG8_BAR; PG8_SCHED;
            PG8_LDB(B1, 1, 1); PG8_STAGE(PG8_SB(1, 0), b3, voffB);
            PG8_BAR; PG8_WAIT_L(0); PG8_MMA(0, 1, At, B1); PG8_BAR;
            PG8_LDA(At, 1, 1); PG8_STAGE(PG8_SA(1, 0), a3, voffA);
            PG8_BAR; PG8_WAIT_L(0); PG8_MMA(1, 0, At, B0); PG8_BAR; PG8_SCHED;
            PG8_STAGE(PG8_SB(1, 1), b3 + hstepB, voffB);
            PG8_WAIT_V(6); PG8_BAR; PG8_MMA(1, 1, At, B1); PG8_BAR;
            }
        }
        if constexpr (ALIGN_EPI) { if (wr == 0) PG8_BAR; }
        if constexpr (!Epi::AFTER_DRAIN) { E(acc, cur, wr, wc, fr, fq); S.done(cur); }
        if (!has_next) break;
#pragma unroll
        for (int a = 0; a < 2; ++a)
#pragma unroll
            for (int b = 0; b < 2; ++b)
#pragma unroll
                for (int m = 0; m < 4; ++m)
#pragma unroll
                    for (int n = 0; n < 2; ++n) acc[a][b][m][n] = (f32x4){0.f, 0.f, 0.f, 0.f};
        cur = nxt; cA = nA; cB = nB; ++ui;
        if constexpr (ALIGN_EPI) { if (wr == 1) PG8_BAR; }
    }
    PG8_WAIT_V(0);
    if constexpr (!ALIGN_EPI) { if (wr == 0) PG8_BAR; }
    PG8_BAR;
    if constexpr (Epi::AFTER_DRAIN) { E.fused(acc, cur, wr, wc, fr, fq, lds, wid, lane); S.done(cur); }
#undef PG8_SA
#undef PG8_SB
#undef PG8_STAGE
#undef PG8_LDA
#undef PG8_LDB
#undef PG8_MMA
#undef PG8_WAIT_V
#undef PG8_WAIT_L
#undef PG8_BAR
#undef PG8_SCHED
}
}

namespace att {
typedef unsigned short bf16;
using bf16x8 = __attribute__((ext_vector_type(8))) short;
using s16x4  = __attribute__((ext_vector_type(4))) short;
using f32x16 = __attribute__((ext_vector_type(16))) float;
using u32x4  = __attribute__((ext_vector_type(4))) unsigned;
constexpr int   D = 128, NW = 8, QBLK = 32, KVBLK = 64;
constexpr float SCALE = 0.088388347648318440f;
constexpr float THR = 8.f;
constexpr int SHM_V = KVBLK * D * 2, SHM_K = KVBLK * D * 2, SHM_ATTN = 2 * SHM_V + 2 * SHM_K + NW * 64 * 4;
#define KSWZ(row, colB) ((row) * 256 + ((colB) ^ (((row) & 7) << 4)))
#define SBAR() __builtin_amdgcn_sched_barrier(0)
__device__ __forceinline__ int crow(int r, int hi) { return (r & 3) + 8 * (r >> 2) + 4 * hi; }
__device__ __forceinline__ unsigned cvtpk(float lo, float hi) { unsigned r; asm volatile("v_cvt_pk_bf16_f32 %0, %1, %2" : "=v"(r) : "v"(lo), "v"(hi)); return r; }

__device__ __forceinline__ void wmask(f32x16& p0, f32x16& p1, int kpos0, int qp, int hi) {
  const bool oob = (kpos0 < 0) || (kpos0 >= 4096);
  const int base = kpos0 - qp + 128;
#pragma unroll
  for (int r = 0; r < 16; ++r) { const int c = crow(r, hi);
    if (oob || (unsigned)(base + c) > 256u) p0[r] = -1e30f;
    if (oob || (unsigned)(base + 32 + c) > 256u) p1[r] = -1e30f; }
}
__device__ __forceinline__ void partialSM(f32x16& p0, f32x16& p1, float& m_reg, float& mn, float& alpha) {
  constexpr float C = SCALE * 1.4426950408889634f;
  float pmax = p0[0];
#pragma unroll
  for (int r = 1; r < 16; ++r) pmax = fmaxf(pmax, p0[r]);
#pragma unroll
  for (int r = 0; r < 16; ++r) pmax = fmaxf(pmax, p1[r]);
  { auto rr = __builtin_amdgcn_permlane32_swap(__float_as_uint(pmax), __float_as_uint(pmax), false, false);
    pmax = fmaxf(__uint_as_float(rr[0]), __uint_as_float(rr[1])); }
  if (__builtin_expect(__all(pmax - m_reg <= THR / SCALE), 1)) { mn = m_reg; alpha = 1.f; }
  else { mn = fmaxf(m_reg, pmax); alpha = __builtin_amdgcn_exp2f((m_reg - mn) * C); m_reg = mn; }
  float mnC = -mn * C;
#pragma unroll
  for (int r = 0; r < 16; ++r) p0[r] = fmaf(p0[r], C, mnC);
#pragma unroll
  for (int r = 0; r < 16; ++r) p1[r] = fmaf(p1[r], C, mnC);
#pragma unroll
  for (int r = 0; r < 16; ++r) p0[r] = __builtin_amdgcn_exp2f(p0[r]);
}
__device__ __forceinline__ void finishSM(f32x16& p0, f32x16& p1, float alpha, float& l_reg, bf16x8& pa0, bf16x8& pa1, bf16x8& pa2, bf16x8& pa3) {
#pragma unroll
  for (int r = 0; r < 16; ++r) p1[r] = __builtin_amdgcn_exp2f(p1[r]);
  float ps = 0;
#pragma unroll
  for (int r = 0; r < 16; ++r) ps += p0[r];
#pragma unroll
  for (int r = 0; r < 16; ++r) ps += p1[r];
  { auto rr = __builtin_amdgcn_permlane32_swap(__float_as_uint(ps), __float_as_uint(ps), false, false);
    ps = __uint_as_float(rr[0]) + __uint_as_float(rr[1]); }
  l_reg = l_reg * alpha + ps;
#define PK4(P, BASE, OUT) do { unsigned a0 = cvtpk(P[BASE + 0], P[BASE + 1]), a1 = cvtpk(P[BASE + 2], P[BASE + 3]);   \
    unsigned b0 = cvtpk(P[BASE + 4], P[BASE + 5]), b1 = cvtpk(P[BASE + 6], P[BASE + 7]);                              \
    auto r0 = __builtin_amdgcn_permlane32_swap(a0, b0, false, false); auto r1 = __builtin_amdgcn_permlane32_swap(a1, b1, false, false); \
    u32x4 w = {r0[0], r1[0], r0[1], r1[1]}; OUT = *reinterpret_cast<bf16x8*>(&w); } while (0)
  PK4(p0, 0, pa0); PK4(p0, 8, pa1); PK4(p1, 0, pa2); PK4(p1, 8, pa3);
#undef PK4
}
__device__ __forceinline__ void qkt(f32x16& p0, f32x16& p1, const bf16* Ks, const bf16x8* qr, int r32, int hi) {
  p0 = f32x16{}; p1 = f32x16{};
#pragma unroll
  for (int d0 = 0; d0 < 8; ++d0) { int cb = (d0 * 16 + hi * 8) * 2;
    bf16x8 b0 = *reinterpret_cast<const bf16x8*>((const char*)Ks + KSWZ(r32, cb));
    bf16x8 b1 = *reinterpret_cast<const bf16x8*>((const char*)Ks + KSWZ(32 + r32, cb));
    p0 = __builtin_amdgcn_mfma_f32_32x32x16_bf16(b0, qr[d0], p0, 0, 0, 0);
    p1 = __builtin_amdgcn_mfma_f32_32x32x16_bf16(b1, qr[d0], p1, 0, 0, 0); }
}
__device__ __forceinline__ int v_st(int k, int c) { const int kk = (k & ~0xC) | ((k & 4) << 1) | ((k & 8) >> 1); return ((kk >> 3) * 4 + (c >> 5)) * 512 + ((kk & 7) * 32 + (c & 31)) * 2; }
__device__ __forceinline__ int v_rd_base(int lane) { return ((lane & 3) << 3) | (((lane >> 2) & 3) << 6) | (((lane >> 4) & 1) << 5) | (((lane >> 5) & 1) << 8); }
constexpr int v_rd_off(int d0, int ks, int half) { return d0 * 512 + ks * 4096 + half * 2048; }
template <int OFF> __device__ __forceinline__ s16x4 tr_read(int vb) {
  s16x4 r; asm volatile("ds_read_b64_tr_b16 %0, %1 offset:%2" : "=&v"(r) : "v"(vb), "i"(OFF) : "memory"); return r;
}
template <int D0> __device__ __forceinline__ void pv_one(f32x16& od, int vb, bf16x8 pa0, bf16x8 pa1, bf16x8 pa2, bf16x8 pa3) {
  const s16x4 l0 = tr_read<v_rd_off(D0, 0, 0)>(vb), h0 = tr_read<v_rd_off(D0, 0, 1)>(vb), l1 = tr_read<v_rd_off(D0, 1, 0)>(vb), h1 = tr_read<v_rd_off(D0, 1, 1)>(vb);
  const s16x4 l2 = tr_read<v_rd_off(D0, 2, 0)>(vb), h2 = tr_read<v_rd_off(D0, 2, 1)>(vb), l3 = tr_read<v_rd_off(D0, 3, 0)>(vb), h3 = tr_read<v_rd_off(D0, 3, 1)>(vb);
  asm volatile("s_waitcnt lgkmcnt(0)" ::: "memory"); SBAR();
#define PK(L, H) (bf16x8){L[0], L[1], L[2], L[3], H[0], H[1], H[2], H[3]}
  od = __builtin_amdgcn_mfma_f32_32x32x16_bf16(pa0, PK(l0, h0), od, 0, 0, 0);
  od = __builtin_amdgcn_mfma_f32_32x32x16_bf16(pa1, PK(l1, h1), od, 0, 0, 0);
  od = __builtin_amdgcn_mfma_f32_32x32x16_bf16(pa2, PK(l2, h2), od, 0, 0, 0);
  od = __builtin_amdgcn_mfma_f32_32x32x16_bf16(pa3, PK(l3, h3), od, 0, 0, 0);
#undef PK
}
__device__ __forceinline__ void pv_d0(f32x16* o, int vb, bf16x8 pa0, bf16x8 pa1, bf16x8 pa2, bf16x8 pa3) {
  pv_one<0>(o[0], vb, pa0, pa1, pa2, pa3); pv_one<1>(o[1], vb, pa0, pa1, pa2, pa3); pv_one<2>(o[2], vb, pa0, pa1, pa2, pa3); pv_one<3>(o[3], vb, pa0, pa1, pa2, pa3);
}

struct Args {
  const bf16* qkv; int ld;
  int qrow0, qcol, kcol, vcol;
  int ctxrow0, latrow0;
  int kstart, n0, n1;
  int qpos0;
  float sink; int has_sink;
  void* out; int ldo, ocol;
};

template <bool WINDOW, bool OUT_BF16, int LD>
__device__ __forceinline__ void attn_unit(const Args& a, char* lds) {
  const int tid = pg8::opaque_tid(), wid = tid >> 6, lane = tid & 63, r32 = lane & 31, hi = lane >> 5;
  bf16* V_lds = (bf16*)lds; bf16* K_lds = (bf16*)(lds + 2 * SHM_V);
  float* ws = (float*)(lds + 2 * SHM_V + 2 * SHM_K) + wid * 64; float* li_l = ws; float* al_l = ws + 32;
  float m_reg = a.has_sink ? a.sink * (1.0f / SCALE) : -1e30f, l_reg = a.has_sink ? 1.0f : 0.0f; f32x16 o[4] = {}; bf16x8 qr[8];
  const bf16* Qw = a.qkv + (long)(a.qrow0 + wid * QBLK + r32) * LD + a.qcol + hi * 8;
#pragma unroll
  for (int d0 = 0; d0 < 8; ++d0) qr[d0] = *reinterpret_cast<const bf16x8*>(Qw + d0 * 16);
  const int sr = tid >> 4, sc = (tid & 15) * 8, vst0 = v_st(sr, sc), vst1 = v_st(32 + sr, sc);
  const int vb0 = (int)(uintptr_t)V_lds + v_rd_base(lane);
  const int qp = a.qpos0 + wid * QBLK + r32;
  const unsigned soff0 = (unsigned)(sr * LD + sc) * 2u, soff1 = soff0 + 32u * LD * 2u;
  struct { bf16x8 vs0, vs1, ks0, ks1; } sr_[2];
#define TROW(t) ((t) < a.n0 ? a.ctxrow0 + (t) * KVBLK : a.latrow0 + min(max(a.kstart + ((t) - a.n0) * KVBLK, 0), 4096 - KVBLK))
#define SLOAD(i, t) do { const char* tb_ = (const char*)a.qkv + (size_t)TROW(t) * (LD * 2); const char* tv_ = tb_ + a.vcol * 2; const char* tk_ = tb_ + a.kcol * 2; \
    sr_[i].vs0 = *reinterpret_cast<const bf16x8*>(tv_ + soff0); sr_[i].vs1 = *reinterpret_cast<const bf16x8*>(tv_ + soff1); \
    sr_[i].ks0 = *reinterpret_cast<const bf16x8*>(tk_ + soff0); sr_[i].ks1 = *reinterpret_cast<const bf16x8*>(tk_ + soff1); } while (0)
#define SWRITE(b, i) do { *(bf16x8*)((char*)V_lds + (b) * SHM_V + vst0) = sr_[i].vs0;          \
    *(bf16x8*)((char*)V_lds + (b) * SHM_V + vst1) = sr_[i].vs1; int kc = sc * 2;               \
    *(bf16x8*)((char*)K_lds + (b) * SHM_K + KSWZ(sr, kc)) = sr_[i].ks0;                       \
    *(bf16x8*)((char*)K_lds + (b) * SHM_K + KSWZ(32 + sr, kc)) = sr_[i].ks1; } while (0)
#define SWAIT() asm volatile("s_waitcnt vmcnt(4)" ::: "memory")
#define RESC(al) do { if (__any((al) < 1.f)) { if (hi == 0) al_l[r32] = (al); asm volatile("s_waitcnt lgkmcnt(0)" ::: "memory"); \
    _Pragma("unroll") for (int d = 0; d < 4; ++d) _Pragma("unroll") for (int r = 0; r < 16; ++r) o[d][r] *= al_l[crow(r, hi)]; } } while (0)
#define WMASK(P0, P1, t) do { if (WINDOW) { if ((t) >= a.n0) wmask(P0, P1, a.kstart + ((t) - a.n0) * KVBLK, qp, hi); } } while (0)
  f32x16 pA0, pA1, pB0, pB1; float mnA, mnB, alA, alB; bf16x8 pa0, pa1, pa2, pa3; const int NT = a.n0 + a.n1;
  constexpr int SE = 0, SO = 1;
  SLOAD(SE, 0); asm volatile("s_waitcnt vmcnt(0)" ::: "memory"); SWRITE(0, SE); __syncthreads();
  qkt(pA0, pA1, K_lds, qr, r32, hi); WMASK(pA0, pA1, 0); partialSM(pA0, pA1, m_reg, mnA, alA);
  SLOAD(SO, 1); if (2 < NT) SLOAD(SE, 2);
  SWAIT(); SWRITE(1, SO); __syncthreads();
  for (int j = 1; j + 1 < NT; j += 2) {
    SBAR(); qkt(pB0, pB1, (bf16*)((char*)K_lds + SHM_K), qr, r32, hi);
    finishSM(pA0, pA1, alA, l_reg, pa0, pa1, pa2, pa3); SBAR();
    SLOAD(SO, j + 2); SBAR();
    pv_d0(o, vb0, pa0, pa1, pa2, pa3); WMASK(pB0, pB1, j); partialSM(pB0, pB1, m_reg, mnB, alB);
    __syncthreads(); SWAIT(); SWRITE(0, SE);
    RESC(alB); __syncthreads();
    SBAR(); qkt(pA0, pA1, K_lds, qr, r32, hi);
    finishSM(pB0, pB1, alB, l_reg, pa0, pa1, pa2, pa3); SBAR();
    if (j + 3 < NT) SLOAD(SE, j + 3); SBAR();
    pv_d0(o, vb0 + (int)SHM_V, pa0, pa1, pa2, pa3); WMASK(pA0, pA1, j + 1); partialSM(pA0, pA1, m_reg, mnA, alA);
    __syncthreads(); SWAIT(); SWRITE(1, SO);
    RESC(alA); __syncthreads();
  }
  SBAR(); qkt(pB0, pB1, (bf16*)((char*)K_lds + SHM_K), qr, r32, hi);
  finishSM(pA0, pA1, alA, l_reg, pa0, pa1, pa2, pa3); SBAR();
  pv_d0(o, vb0, pa0, pa1, pa2, pa3); WMASK(pB0, pB1, NT - 1); partialSM(pB0, pB1, m_reg, mnB, alB);
  __syncthreads(); RESC(alB);
  finishSM(pB0, pB1, alB, l_reg, pa0, pa1, pa2, pa3); SBAR();
  pv_d0(o, vb0 + (int)SHM_V, pa0, pa1, pa2, pa3);
  if (hi == 0) li_l[r32] = l_reg; asm volatile("s_waitcnt lgkmcnt(0)" ::: "memory");
  float rli[16];
#pragma unroll
  for (int r = 0; r < 16; ++r) rli[r] = __builtin_amdgcn_rcpf(li_l[crow(r, hi)]);
  if (OUT_BF16) {
    bf16* Ow = (bf16*)a.out + (long)(a.qrow0 + wid * QBLK) * a.ldo + a.ocol;
#pragma unroll
    for (int r = 0; r < 16; ++r) { const int orow = crow(r, hi);
#pragma unroll
      for (int d0 = 0; d0 < 4; ++d0) Ow[(long)orow * a.ldo + d0 * 32 + r32] = (bf16)(cvtpk(o[d0][r] * rli[r], 0.f) & 0xffffu); }
  } else {
    float* Ow = (float*)a.out + (long)(a.qrow0 + wid * QBLK) * a.ldo + a.ocol;
#pragma unroll
    for (int r = 0; r < 16; ++r) { const int orow = crow(r, hi);
#pragma unroll
      for (int d0 = 0; d0 < 4; ++d0) Ow[(long)orow * a.ldo + d0 * 32 + r32] = o[d0][r] * rli[r]; }
  }
  __syncthreads();
#undef TROW
#undef SLOAD
#undef SWRITE
#undef SWAIT
#undef RESC
#undef WMASK
}

template <int LD>
__device__ __forceinline__ void dattn_unit(const bf16* qkv, int qrow0, int h, int ctxrow0, int latrow0, int n0, int n1, float lam, float gscale, const float* subg, bf16* AO,
                                           __attribute__((address_space(3))) unsigned char* L, char* lds) {
  typedef __attribute__((address_space(3))) unsigned char lds_b;
  const int tid = pg8::opaque_tid(), wid = __builtin_amdgcn_readfirstlane(tid >> 6), lane = tid & 63, r32 = lane & 31, hi = lane >> 5, g = wid & 3, c = wid >> 2;
  float* wsc = (float*)(lds + 132096 + wid * 256); float* li_l = wsc; float* al_l = wsc + 32;
  float m_reg = -1e30f, l_reg = 0.f; f32x16 o[8] = {}; bf16x8 qr[8];
  { const bf16* Qw = qkv + (long)(qrow0 + g * 32 + r32) * LD + (2 * h + c) * 128 + hi * 8;
#pragma unroll
    for (int d0 = 0; d0 < 8; ++d0) qr[d0] = *reinterpret_cast<const bf16x8*>(Qw + d0 * 16); }
  unsigned voK[2][2], voV[4];
#pragma unroll
  for (int cc = 0; cc < 2; ++cc)
#pragma unroll
    for (int i = 0; i < 2; ++i) { const int gi = i * 512 + tid, row = gi >> 4, cb = ((gi & 15) << 4) ^ ((row & 7) << 4); voK[cc][i] = (unsigned)((row * LD + 2048 + (2 * h + cc) * 128) * 2 + cb); }
#pragma unroll
  for (int i = 0; i < 4; ++i) { const int gi = i * 512 + tid, img = gi >> 10, o2 = (gi & 1023) << 4, st = o2 >> 9, e = (o2 & 511) >> 1, kk = (st >> 2) * 8 + (e >> 5);
    const int k = (kk & ~0xC) | ((kk & 4) << 1) | ((kk & 8) >> 1), col = (st & 3) * 32 + (e & 31); voV[i] = (unsigned)((k * LD + 4096 + h * 256 + img * 128 + col) * 2); }
  const int NT = n0 + n1;
#define DT_ROW(t) ((t) < n0 ? ctxrow0 + (t) * KVBLK : latrow0 + ((t) - n0) * KVBLK)
#define DT_DMA(t, b) do { const char* tb_ = (const char*)qkv + (size_t)DT_ROW(t) * (LD * 2); \
    _Pragma("unroll") for (int cc = 0; cc < 2; ++cc) _Pragma("unroll") for (int i = 0; i < 2; ++i) \
      __builtin_amdgcn_global_load_lds((const unsigned*)(tb_ + voK[cc][i]), (__attribute__((address_space(3))) unsigned*)(L + (b) * 32768 + cc * 16384 + i * 8192 + wid * 1024), 16, 0, 0); \
    _Pragma("unroll") for (int i = 0; i < 4; ++i) \
      __builtin_amdgcn_global_load_lds((const unsigned*)(tb_ + voV[i]), (__attribute__((address_space(3))) unsigned*)(L + 65536 + (b) * 32768 + i * 8192 + wid * 1024), 16, 0, 0); } while (0)
  DT_DMA(0, 0);
  if (1 < NT) DT_DMA(1, 1);
  if (1 < NT) asm volatile("s_waitcnt vmcnt(8)" ::: "memory"); else asm volatile("s_waitcnt vmcnt(0)" ::: "memory");
  __builtin_amdgcn_s_barrier(); asm volatile("" ::: "memory");
  for (int t = 0; t < NT; ++t) {
    const int b = t & 1;
    const bf16* Kt = (const bf16*)(lds + b * 32768 + c * 16384);
    const int vb = (int)(uintptr_t)(lds + 65536 + b * 32768) + v_rd_base(lane);
    f32x16 p0, p1; float mn, alpha; bf16x8 pa0, pa1, pa2, pa3;
    qkt(p0, p1, Kt, qr, r32, hi);
    partialSM(p0, p1, m_reg, mn, alpha);
    if (__any(alpha < 1.f)) { if (hi == 0) al_l[r32] = alpha; asm volatile("s_waitcnt lgkmcnt(0)" ::: "memory");
#pragma unroll
      for (int d = 0; d < 8; ++d)
#pragma unroll
        for (int r = 0; r < 16; ++r) o[d][r] *= al_l[crow(r, hi)]; }
    finishSM(p0, p1, alpha, l_reg, pa0, pa1, pa2, pa3);
    pv_one<0>(o[0], vb, pa0, pa1, pa2, pa3); pv_one<1>(o[1], vb, pa0, pa1, pa2, pa3); pv_one<2>(o[2], vb, pa0, pa1, pa2, pa3); pv_one<3>(o[3], vb, pa0, pa1, pa2, pa3);
    pv_one<0>(o[4], vb + 16384, pa0, pa1, pa2, pa3); pv_one<1>(o[5], vb + 16384, pa0, pa1, pa2, pa3); pv_one<2>(o[6], vb + 16384, pa0, pa1, pa2, pa3); pv_one<3>(o[7], vb + 16384, pa0, pa1, pa2, pa3);
    asm volatile("s_waitcnt lgkmcnt(0)" ::: "memory"); __builtin_amdgcn_s_barrier(); asm volatile("" ::: "memory");
    if (t + 2 < NT) { DT_DMA(t + 2, b); asm volatile("s_waitcnt vmcnt(8)" ::: "memory"); } else asm volatile("s_waitcnt vmcnt(0)" ::: "memory");
    __builtin_amdgcn_s_barrier(); asm volatile("" ::: "memory");
  }
#undef DT_ROW
#undef DT_DMA
  if (hi == 0) li_l[r32] = l_reg; asm volatile("s_waitcnt lgkmcnt(0)" ::: "memory");
#pragma unroll
  for (int r = 0; r < 16; ++r) { const float rl = __builtin_amdgcn_rcpf(li_l[crow(r, hi)]);
#pragma unroll
    for (int d = 0; d < 8; ++d) o[d][r] *= rl; }
  float* xch = (float*)(lds + g * 32768);
  if (c == 1) {
#pragma unroll
    for (int d = 0; d < 8; ++d)
#pragma unroll
      for (int r = 0; r < 16; ++r) xch[(d * 16 + r) * 64 + lane] = o[d][r]; }
  asm volatile("s_waitcnt lgkmcnt(0)" ::: "memory"); __builtin_amdgcn_s_barrier(); asm volatile("" ::: "memory");
  if (c == 0) {
    float gv[8];
#pragma unroll
    for (int d = 0; d < 8; ++d) gv[d] = subg[d * 32 + r32] * gscale;
#pragma unroll
    for (int r = 0; r < 16; ++r) { float s = 0.f;
#pragma unroll
      for (int d = 0; d < 8; ++d) { o[d][r] -= lam * xch[(d * 16 + r) * 64 + lane]; s += o[d][r] * o[d][r]; }
      for (int m_ = 1; m_ < 32; m_ <<= 1) s += __builtin_bit_cast(float, __builtin_amdgcn_ds_bpermute((lane ^ m_) << 2, __builtin_bit_cast(int, s)));
      const float rs = 1.0f / sqrtf(s * (1.0f / 256.0f) + 1e-6f);
      bf16* orow = AO + (long)(qrow0 + g * 32 + crow(r, hi)) * 2048 + h * 256 + r32;
#pragma unroll
      for (int d = 0; d < 8; ++d) orow[d * 32] = (bf16)(cvtpk(o[d][r] * rs * gv[d], 0.f) & 0xffffu); }
  }
  asm volatile("s_waitcnt vmcnt(0) lgkmcnt(0)" ::: "memory"); __builtin_amdgcn_s_barrier(); asm volatile("" ::: "memory");
}
#undef KSWZ
#undef SBAR
}

constexpr int NWAVES = 8;
constexpr int DM = 2048, NBATCH = 2, SEQ = 4096, MLAT = NBATCH * SEQ, CTXL = 256, MCTX = NBATCH * CTXL, MALL = MLAT + MCTX;
constexpr int DFF = 5504, NFC1 = 2 * DFF, NLAYER = 4, NMODC = 9 * DM;
constexpr int A_N = 3072, B_N = 12288, B_W = 6144, C_N = 6144;
constexpr float EPS = 1e-6f;
constexpr size_t MiB = 1u << 20;
constexpr size_t WS_CTL = 0, CTL_BYTES = 2 * MiB;
constexpr size_t WS_MODT = 2 * MiB;
constexpr size_t WS_ROPE = 3 * MiB;
constexpr size_t WS_XC = 5 * MiB;
constexpr size_t WS_STATS = 9 * MiB;
constexpr size_t WS_BSW = 10 * MiB;
constexpr size_t WS_SMALL = 10 * MiB + 512 * 1024;
constexpr int SM_SINK = 0, SM_VNG = 64, SM_VNB = SM_VNG + 6144, SM_BS = SM_VNB + 6144, SM_LQ1 = SM_BS + 1024, SM_LK1 = SM_LQ1 + 128, SM_LQ2 = SM_LK1 + 128, SM_LK2 = SM_LQ2 + 128, SM_SUBG = SM_LK2 + 128, SM_END = SM_SUBG + 256;
constexpr size_t WS_WFC1 = 11 * MiB;
constexpr size_t WS_WFC2 = WS_WFC1 + 344 * MiB;
constexpr size_t WS_WAIN = WS_WFC2 + 172 * MiB;
constexpr size_t WS_WAOUT = WS_WAIN + 24 * MiB;
constexpr size_t WS_WBIN = WS_WAOUT + 16 * MiB;
constexpr size_t WS_WBOUT = WS_WBIN + 48 * MiB;
constexpr size_t WS_WCIN = WS_WBOUT + 24 * MiB;
constexpr size_t WS_WCOUT = WS_WCIN + 24 * MiB;
constexpr size_t WS_H = WS_WCOUT + 8 * MiB;
constexpr size_t WS_HID = WS_H + 34 * MiB;
constexpr size_t WS_Y = WS_HID + 92 * MiB;
constexpr size_t WS_QKV = WS_Y + 68 * MiB;
constexpr size_t WS_AO = WS_QKV + 204 * MiB;
constexpr size_t WS_OC = WS_AO + 34 * MiB;
constexpr size_t WS_END = WS_OC + 136 * MiB;
static_assert((size_t)8 * NFC1 * DM * 2 <= 344 * MiB && (size_t)8 * DM * DFF * 2 <= 172 * MiB && (size_t)MALL * DFF * 2 <= 92 * MiB && (size_t)MALL * B_N * 2 <= 204 * MiB, "ws map");
constexpr int CW_PQ = 1024;
constexpr int CW_BAR = 4096;
constexpr int RING_BYTES = 131072, MISC_OFF = RING_BYTES + 320, LDS_BYTES = 147456;

#define GAS __attribute__((address_space(1)))
#define LAS __attribute__((address_space(3)))
typedef unsigned short bf16;
typedef unsigned v4u __attribute__((ext_vector_type(4)));
typedef unsigned v2u __attribute__((ext_vector_type(2)));
typedef float f32x4 __attribute__((ext_vector_type(4)));
typedef short bf16x8 __attribute__((ext_vector_type(8)));
typedef float f32x16 __attribute__((ext_vector_type(16)));
#define LDS_WAIT() asm volatile("s_waitcnt lgkmcnt(0)" ::: "memory")
#define VM_WAIT() asm volatile("s_waitcnt vmcnt(0)" ::: "memory")
__device__ __forceinline__ unsigned f2bf(float f) { unsigned u = __builtin_bit_cast(unsigned, f); return (u + 0x7fffu + ((u >> 16) & 1u)) >> 16; }
__device__ __forceinline__ unsigned pk2(float lo, float hi) { return f2bf(lo) | (f2bf(hi) << 16); }
__device__ __forceinline__ float bf2f(unsigned short b) { return __builtin_bit_cast(float, ((unsigned)b) << 16); }
__device__ __forceinline__ float lane_xor(float v, int lane, int mask) { return __builtin_bit_cast(float, __builtin_amdgcn_ds_bpermute((lane ^ mask) << 2, __builtin_bit_cast(int, v))); }
__device__ __forceinline__ float wave_sum(float v, int lane) {
#pragma unroll
    for (int o = 1; o < 64; o <<= 1) v += lane_xor(v, lane, o);
    return v;
}

#define XB_TMO      128
#define XB_XCNT(j)  (256  + 64 * (j))
#define XB_XSUB(j)  (1280 + 64 * (j))
#define XB_XGEN(j)  (2304 + 64 * (j))
#define XB_TOP      3328
#define XB_TOPGEN   3392
#define XCD_BAR_WORDS 3456
#define XB_SPIN_CAP (1u << 18)

__device__ __forceinline__ unsigned xb_ld(unsigned* p)              { return __hip_atomic_load(p, __ATOMIC_RELAXED, __HIP_MEMORY_SCOPE_AGENT); }
__device__ __forceinline__ unsigned xb_add(unsigned* p, unsigned v) { return __hip_atomic_fetch_add(p, v, __ATOMIC_RELAXED, __HIP_MEMORY_SCOPE_AGENT); }
__device__ __forceinline__ unsigned xb_xcc_id() { return (unsigned)__builtin_amdgcn_s_getreg((3 << 11) | 20) & 0xFu; }
#define XB_SPIN(cond, bar) do { unsigned _sp = 0; while (cond) { __builtin_amdgcn_s_sleep(1); \
    if ((++_sp & 255u) == 0u) { if (xb_ld(&(bar)[XB_TMO])) break; if (_sp > XB_SPIN_CAP) { atomicAdd(&(bar)[XB_TMO], 1u); break; } } } } while (0)

struct XcdBarrier {
    unsigned* bar; unsigned x;
    volatile LAS unsigned* st;
};

__device__ __forceinline__ XcdBarrier xcd_barrier_post(unsigned* bar, volatile LAS unsigned* st) {
    XcdBarrier b; b.bar = bar; b.x = xb_xcc_id(); b.st = st;
    if (threadIdx.x == 0) (void)xb_add(&bar[XB_XCNT(b.x)], 1u);
    return b;
}
__device__ __forceinline__ void xcd_barrier_complete(unsigned* bar, unsigned x, unsigned& nloc, unsigned& nx) {
    const unsigned G = gridDim.x * gridDim.y * gridDim.z;
    unsigned sum, cnt, mine, sp = 0u;
    for (;;) {
        sum = 0u; cnt = 0u; mine = 0u;
#pragma unroll
        for (unsigned j = 0; j < 16; ++j) { const unsigned c = xb_ld(&bar[XB_XCNT(j)]); sum += c; cnt += (c > 0u) ? 1u : 0u; mine = (j == x) ? c : mine; }
        if (sum == G) break;
        __builtin_amdgcn_s_sleep(1);
        if ((++sp & 255u) == 0u) { if (xb_ld(&bar[XB_TMO])) break; if (sp > XB_SPIN_CAP) { atomicAdd(&bar[XB_TMO], 1u); break; } }
    }
    nloc = mine > 0u ? mine : 1u; nx = cnt > 0u ? cnt : 1u;
}

__device__ __forceinline__ void xcd_barrier(const XcdBarrier& b) {
    asm volatile("s_waitcnt vmcnt(0)" ::: "memory");
    __syncthreads();
    if (threadIdx.x == 0) {
        unsigned* bar = b.bar;
        __builtin_amdgcn_s_waitcnt(0);
        unsigned nloc = b.st[0], nx = b.st[1];
        if (nloc == 0u) { xcd_barrier_complete(bar, b.x, nloc, nx); b.st[0] = nloc; b.st[1] = nx; }
        const unsigned old = xb_add(&bar[XB_XSUB(b.x)], 1u);
        const unsigned gen = old / nloc;
        if (old + 1u == (gen + 1u) * nloc) {
            __builtin_amdgcn_fence(__ATOMIC_RELEASE, "agent");
            asm volatile("s_waitcnt vmcnt(0)" ::: "memory");
            const unsigned og = xb_add(&bar[XB_TOP], 1u);
            const unsigned tg = og / nx;
            if (og + 1u == (tg + 1u) * nx) xb_add(&bar[XB_TOPGEN], 1u);
            else XB_SPIN(xb_ld(&bar[XB_TOPGEN]) == tg, bar);
            __builtin_amdgcn_fence(__ATOMIC_ACQUIRE, "agent");
            xb_add(&bar[XB_XGEN(b.x)], 1u);
            asm volatile("s_waitcnt vmcnt(0)" ::: "memory");
        } else {
            XB_SPIN(xb_ld(&bar[XB_XGEN(b.x)]) == gen, bar);
            __builtin_amdgcn_fence(__ATOMIC_ACQUIRE, "agent");
            asm volatile("s_waitcnt vmcnt(0)" ::: "memory");
        }
    }
    __syncthreads();
}

__device__ __forceinline__ void transpose_item(const float* W, int K, int N, bf16* WT, int fc1map, LAS float* scr, int item, int lane) {
    const int nblk = N / 32, kb = item / nblk, nb = item % nblk, k0 = 64 * kb, n0 = 32 * nb;
    int rowbase = n0;
    if (fc1map) { rowbase = (n0 < DFF) ? 256 * (n0 / 128) + (n0 % 128) : 256 * ((n0 - DFF) / 128) + 128 + ((n0 - DFF) % 128); }
    float tv[32];
#pragma unroll
    for (int i = 0; i < 32; ++i) tv[i] = W[(size_t)(k0 + 2 * i + (lane >> 5)) * N + n0 + (lane & 31)];
#pragma unroll
    for (int i = 0; i < 32; ++i) scr[(2 * i + (lane >> 5)) * 33 + (lane & 31)] = tv[i];
    LDS_WAIT(); asm volatile("" ::: "memory");
    const int c = lane & 7;
#pragma unroll
    for (int j = 0; j < 4; ++j) { const int n = (lane >> 3) + 8 * j; const LAS float* s = scr + (8 * c) * 33 + n;
        v4u o; o.x = pk2(s[0 * 33], s[1 * 33]); o.y = pk2(s[2 * 33], s[3 * 33]); o.z = pk2(s[4 * 33], s[5 * 33]); o.w = pk2(s[6 * 33], s[7 * 33]);
        *(GAS v4u*)(WT + (size_t)(rowbase + n) * K + k0 + 8 * c) = o; }
    LDS_WAIT(); asm volatile("" ::: "memory");
}

struct KArgs { const float* in[25]; float* out; unsigned char* ws; int ph_lo, ph_hi, li; float lam_init; float gscale; int pad0, pad1, pad2; };

__device__ __forceinline__ float* modt(unsigned char* ws, int layer, int slot, int modrow, int which) { return (float*)(ws + WS_MODT) + ((size_t)(((layer * 3 + slot) * 3 + modrow) * 3 + which)) * DM; }

__device__ __forceinline__ void prologue_phase(const KArgs& args, LAS unsigned char* L, int bx, int G) {
    const int tid = pg8::opaque_tid(), lane = tid & 63, wave = __builtin_amdgcn_readfirstlane(tid >> 6);
    unsigned char* ws = args.ws;
    LAS float* sl = (LAS float*)L;
    for (int i = tid; i < 3 * DM; i += NWAVES * 64) { const int r = i / DM, k = i % DM; const float v = (r < 2) ? args.in[1][r * DM + k] : args.in[3][k]; sl[i] = v / (1.0f + expf(-v)); }
    __syncthreads();
    LAS float* part = (LAS float*)(L + 24576);
    for (int rep_ = 0; rep_ < (PROBE_ID == 11 ? 2 : 1); ++rep_)
    for (int item = bx; item < NLAYER * 72; item += G) {
        const int layer = item / 72, n0 = (item % 72) * 256;
        const float* W = args.in[4] + ((size_t)layer * DM + wave * 256) * NMODC + n0 + lane * 4;
        const LAS float* s0 = sl + wave * 256;
        f32x4 a0 = {0.f, 0.f, 0.f, 0.f}, a1 = a0, a2 = a0;
#pragma unroll 8
        for (int kk = 0; kk < 256; ++kk) { const f32x4 w = *(const f32x4*)(W + (size_t)kk * NMODC); a0 += w * s0[kk]; a1 += w * s0[DM + kk]; a2 += w * s0[2 * DM + kk]; }
        *(LAS f32x4*)(part + (wave * 3 + 0) * 256 + lane * 4) = a0; *(LAS f32x4*)(part + (wave * 3 + 1) * 256 + lane * 4) = a1; *(LAS f32x4*)(part + (wave * 3 + 2) * 256 + lane * 4) = a2;
        __syncthreads();
        for (int idx = tid; idx < 768; idx += NWAVES * 64) { const int r = idx >> 8, cc = idx & 255, n = n0 + cc; float m = args.in[5][layer * NMODC + n];
#pragma unroll
            for (int w = 0; w < 8; ++w) m += part[(w * 3 + r) * 256 + cc];
            const int k9 = n / DM, c = n % DM, s = k9 / 3, which = k9 % 3; const float* g = args.in[6] + (size_t)layer * 6 * DM;
            if (which == 0) modt(ws, layer, s, r, 2)[c] = m;
            else if (which == 1) modt(ws, layer, s, r, 1)[c] = g[(2 * s) * DM + c] * (1.0f + m);
            else modt(ws, layer, s, r, 0)[c] = (s == 1 ? 1.0f : 0.5f) * m * g[(2 * s + 1) * DM + c]; }
        __syncthreads();
    }
    {
        LAS float* scr = (LAS float*)(L + 49152 + wave * 8448);
        const int gw = bx * NWAVES + wave, NGW = G * NWAVES;
        constexpr int I_FC1 = (DM / 64) * (NFC1 / 32), I_FC2 = (DFF / 64) * (DM / 32), I_AIN = (DM / 64) * (A_N / 32), I_SQ = (DM / 64) * (DM / 32), I_BIN = (DM / 64) * (B_N / 32), I_BOUT = (B_W / 64) * (DM / 32), I_CIN = (DM / 64) * (C_N / 32);
        constexpr int NITEMS = 8 * I_FC1 + 8 * I_FC2 + 2 * I_AIN + 2 * I_SQ + I_BIN + I_BOUT + I_CIN + I_SQ;
        const int nheavy = (NLAYER * 72 > G) ? (NLAYER * 72 - G) : 0, SKIP_R = 24, nlightw = (G - nheavy) * NWAVES;
        const bool heavy = bx < nheavy;
        for (int rep_ = 0; rep_ < (PROBE_ID == 12 ? 2 : 1); ++rep_)
        for (int rnd = heavy ? SKIP_R : 0;; ++rnd) {
            const int it = (rnd < SKIP_R) ? rnd * nlightw + (gw - nheavy * NWAVES) : SKIP_R * nlightw + (rnd - SKIP_R) * NGW + gw;
            if (it >= NITEMS) break;
            int r = it;
            if (r < 8 * I_FC1) { const int mat = r / I_FC1; transpose_item(args.in[7] + (size_t)mat * DM * NFC1, DM, NFC1, (bf16*)(ws + WS_WFC1) + (size_t)mat * NFC1 * DM, 1, scr, r % I_FC1, lane); continue; } r -= 8 * I_FC1;
            if (r < 8 * I_FC2) { const int mat = r / I_FC2; transpose_item(args.in[8] + (size_t)mat * DFF * DM, DFF, DM, (bf16*)(ws + WS_WFC2) + (size_t)mat * DM * DFF, 0, scr, r % I_FC2, lane); continue; } r -= 8 * I_FC2;
            if (r < 2 * I_AIN) { const int mat = r / I_AIN; transpose_item(args.in[9] + (size_t)mat * DM * A_N, DM, A_N, (bf16*)(ws + WS_WAIN) + (size_t)mat * A_N * DM, 0, scr, r % I_AIN, lane); continue; } r -= 2 * I_AIN;
            if (r < 2 * I_SQ) { const int mat = r / I_SQ; transpose_item(args.in[10] + (size_t)mat * DM * DM, DM, DM, (bf16*)(ws + WS_WAOUT) + (size_t)mat * DM * DM, 0, scr, r % I_SQ, lane); continue; } r -= 2 * I_SQ;
            if (r < I_BIN) { transpose_item(args.in[12], DM, B_N, (bf16*)(ws + WS_WBIN), 0, scr, r, lane); continue; } r -= I_BIN;
            if (r < I_BOUT) { transpose_item(args.in[17], B_W, DM, (bf16*)(ws + WS_WBOUT), 0, scr, r, lane); continue; } r -= I_BOUT;
            if (r < I_CIN) { transpose_item(args.in[18], DM, C_N, (bf16*)(ws + WS_WCIN), 0, scr, r, lane); continue; } r -= I_CIN;
            transpose_item(args.in[19], DM, DM, (bf16*)(ws + WS_WCOUT), 0, scr, r, lane);
        }
    }
    for (int rep_ = 0; rep_ < (PROBE_ID == 13 ? 2 : 1); ++rep_)
    for (int e = bx * NWAVES * 64 + tid; e < SEQ * 64; e += G * NWAVES * 64) { const int t = e >> 6, p = e & 63, pi = p & 31;
        const float inv = (float)pow(10000.0, -(double)pi / 32.0); const float ang = (float)((p < 32) ? (t >> 6) : (t & 63)) * inv;
        float* o = (float*)(ws + WS_ROPE) + (size_t)e * 2; o[0] = (float)cos((double)ang); o[1] = (float)sin((double)ang); }
    for (int e = bx * NWAVES * 64 + tid; e < 8 * 128 * 128; e += G * NWAVES * 64) ((bf16*)(ws + WS_BSW))[e] = (bf16)f2bf(args.in[15][e]);
    if (bx == 0) { float* sm = (float*)(ws + WS_SMALL);
        for (int e = tid; e < SM_END; e += NWAVES * 64) { float v = 0.f;
            if (e < SM_VNG) { if (e < 32) v = args.in[11][e]; }
            else if (e < SM_VNB) v = args.in[13][e - SM_VNG];
            else if (e < SM_BS) v = args.in[14][e - SM_VNB];
            else if (e < SM_LQ1) v = args.in[16][e - SM_BS];
            else if (e < SM_LK1) v = args.in[20][e - SM_LQ1];
            else if (e < SM_LQ2) v = args.in[21][e - SM_LK1];
            else if (e < SM_LK2) v = args.in[22][e - SM_LQ2];
            else if (e < SM_SUBG) v = args.in[23][e - SM_LK2];
            else v = args.in[24][e - SM_SUBG];
            sm[e] = v; } }
}

__device__ __forceinline__ void norm_phase(const float* xs_lat, const float* xs_ctx, float* xd_lat, float* xd_ctx, const bf16* Y, const float* postT, const float* preT, bf16* H, int nrows, LAS unsigned char* L, float oscale = 1.0f) {
    const int tid = pg8::opaque_tid(), lane = tid & 63, wave = __builtin_amdgcn_readfirstlane(tid >> 6), gw = blockIdx.x * NWAVES + wave, NGW = gridDim.x * NWAVES;
    const int nlat = nrows < MLAT ? nrows : MLAT;
    for (int row = gw; row < nlat; row += NGW) {
        const int modrow = row < SEQ ? 0 : 1;
        const float* xs = xs_lat + (size_t)row * DM; float* xd = xd_lat + (size_t)row * DM;
        f32x4 xv[8];
#pragma unroll
        for (int j = 0; j < 8; ++j) xv[j] = *(const f32x4*)(xs + 256 * j + 4 * lane);
        if (Y) {
            const bf16* yr = Y + (size_t)row * DM; const float* At = postT + (size_t)modrow * 3 * DM;
            f32x4 yv[8]; float ss = 0.f;
#pragma unroll
            for (int j = 0; j < 8; ++j) { const v2u raw = *(const v2u*)(yr + 256 * j + 4 * lane);
                yv[j].x = __builtin_bit_cast(float, raw.x << 16); yv[j].y = __builtin_bit_cast(float, raw.x & 0xffff0000u); yv[j].z = __builtin_bit_cast(float, raw.y << 16); yv[j].w = __builtin_bit_cast(float, raw.y & 0xffff0000u);
                ss += (yv[j].x * yv[j].x + yv[j].y * yv[j].y) + (yv[j].z * yv[j].z + yv[j].w * yv[j].w); }
            const float ry = 1.0f / sqrtf(wave_sum(ss, lane) * (1.0f / DM) + EPS);
#pragma unroll
            for (int j = 0; j < 8; ++j) { const f32x4 a = *(const f32x4*)(At + 256 * j + 4 * lane); xv[j] += yv[j] * ry * a; }
        }
#pragma unroll
        for (int j = 0; j < 8; ++j) *(f32x4*)(xd + 256 * j + 4 * lane) = (PROBE_ID >= 20) ? xv[j] * oscale : xv[j];
        if (H) {
            const float* Bt = preT + (size_t)(modrow * 3 + 1) * DM; const float* Ct = preT + (size_t)(modrow * 3 + 2) * DM;
            float ss = 0.f;
#pragma unroll
            for (int j = 0; j < 8; ++j) ss += (xv[j].x * xv[j].x + xv[j].y * xv[j].y) + (xv[j].z * xv[j].z + xv[j].w * xv[j].w);
            const float rx = 1.0f / sqrtf(wave_sum(ss, lane) * (1.0f / DM) + EPS);
            bf16* hr = H + (size_t)row * DM;
#pragma unroll
            for (int j = 0; j < 8; ++j) { const f32x4 b = *(const f32x4*)(Bt + 256 * j + 4 * lane), c = *(const f32x4*)(Ct + 256 * j + 4 * lane); const f32x4 h = xv[j] * rx * b + c;
                v2u o; o.x = pk2(h.x, h.y); o.y = pk2(h.z, h.w); *(v2u*)(hr + 256 * j + 4 * lane) = o; }
        }
    }
    if (nrows > MLAT) {
        LAS float* red = (LAS float*)L;
        const int rsel = wave >> 2, qtr = wave & 3;
        for (int base = 2 * (int)blockIdx.x; base < MCTX; base += 2 * (int)gridDim.x) {
            const int cr = base + rsel; const float* xs = xs_ctx + (size_t)cr * DM + 512 * qtr; float* xd = xd_ctx + (size_t)cr * DM + 512 * qtr;
            f32x4 xv[2];
#pragma unroll
            for (int j = 0; j < 2; ++j) xv[j] = *(const f32x4*)(xs + 256 * j + 4 * lane);
            if (Y) {
                const bf16* yr = Y + (size_t)(MLAT + cr) * DM + 512 * qtr; const float* At = postT + (size_t)2 * 3 * DM + 512 * qtr;
                f32x4 yv[2]; float ss = 0.f;
#pragma unroll
                for (int j = 0; j < 2; ++j) { const v2u raw = *(const v2u*)(yr + 256 * j + 4 * lane);
                    yv[j].x = __builtin_bit_cast(float, raw.x << 16); yv[j].y = __builtin_bit_cast(float, raw.x & 0xffff0000u); yv[j].z = __builtin_bit_cast(float, raw.y << 16); yv[j].w = __builtin_bit_cast(float, raw.y & 0xffff0000u);
                    ss += (yv[j].x * yv[j].x + yv[j].y * yv[j].y) + (yv[j].z * yv[j].z + yv[j].w * yv[j].w); }
                ss = wave_sum(ss, lane); if (lane == 0) red[wave] = ss;
                __syncthreads();
                const float ry = 1.0f / sqrtf(((red[rsel * 4] + red[rsel * 4 + 1]) + (red[rsel * 4 + 2] + red[rsel * 4 + 3])) * (1.0f / DM) + EPS);
#pragma unroll
                for (int j = 0; j < 2; ++j) { const f32x4 a = *(const f32x4*)(At + 256 * j + 4 * lane); xv[j] += yv[j] * ry * a; }
            }
#pragma unroll
            for (int j = 0; j < 2; ++j) *(f32x4*)(xd + 256 * j + 4 * lane) = xv[j];
            if (H) {
                const float* Bt = preT + (size_t)(2 * 3 + 1) * DM + 512 * qtr; const float* Ct = preT + (size_t)(2 * 3 + 2) * DM + 512 * qtr;
                float ss = 0.f;
#pragma unroll
                for (int j = 0; j < 2; ++j) ss += (xv[j].x * xv[j].x + xv[j].y * xv[j].y) + (xv[j].z * xv[j].z + xv[j].w * xv[j].w);
                ss = wave_sum(ss, lane); if (lane == 0) red[8 + wave] = ss;
                __syncthreads();
                const float rx = 1.0f / sqrtf(((red[8 + rsel * 4] + red[8 + rsel * 4 + 1]) + (red[8 + rsel * 4 + 2] + red[8 + rsel * 4 + 3])) * (1.0f / DM) + EPS);
                bf16* hr = H + (size_t)(MLAT + cr) * DM + 512 * qtr;
#pragma unroll
                for (int j = 0; j < 2; ++j) { const f32x4 b = *(const f32x4*)(Bt + 256 * j + 4 * lane), c = *(const f32x4*)(Ct + 256 * j + 4 * lane); const f32x4 h = xv[j] * rx * b + c;
                    v2u o; o.x = pk2(h.x, h.y); o.y = pk2(h.z, h.w); *(v2u*)(hr + 256 * j + 4 * lane) = o; }
            }
            __syncthreads();
        }
    }
}
__device__ __forceinline__ void vstats_phase(const bf16* QKV, float* stats, int nrows) {
    const int tid = pg8::opaque_tid(), lane = tid & 63, gw = blockIdx.x * NWAVES + __builtin_amdgcn_readfirstlane(tid >> 6), NGW = gridDim.x * NWAVES;
    for (int row = gw; row < nrows; row += NGW) {
        const bf16* vr = QKV + (size_t)row * B_N + B_W + lane * 8; bf16x8 raw[12]; float s = 0.f;
#pragma unroll
        for (int i = 0; i < 12; ++i) { raw[i] = *(const bf16x8*)(vr + i * 512);
#pragma unroll
            for (int e = 0; e < 8; ++e) s += bf2f((unsigned short)raw[i][e]); }
        const float mean = wave_sum(s, lane) * (1.0f / B_W); float q = 0.f;
#pragma unroll
        for (int i = 0; i < 12; ++i)
#pragma unroll
            for (int e = 0; e < 8; ++e) { const float d = bf2f((unsigned short)raw[i][e]) - mean; q += d * d; }
        const float rstd = 1.0f / sqrtf(wave_sum(q, lane) * (1.0f / B_W) + EPS);
        if (lane == 0) { stats[2 * row] = mean; stats[2 * row + 1] = rstd; }
    }
}
__device__ __forceinline__ void spatial_phase(const bf16* QKV, bf16* Gout, const bf16* BSW, const float* stats, const float* vg, const float* vb, const float* bs, char* lds, int nchunks, int bx, int G) {
    const int tid = pg8::opaque_tid(), lane = tid & 63, wave = __builtin_amdgcn_readfirstlane(tid >> 6), r32 = lane & 31, hi = lane >> 5;
    constexpr int OP = 132;
    float* Ob = (float*)(lds + 32768);
    const int sr = tid >> 4, sc = (tid & 15) * 8, pb = wave & 3, dh = wave >> 2;
    for (int u = bx; u < nchunks * 48; u += G) {
        const int cb = u % 6, g = (u / 6) & 7, ch = u / 48, row0 = ch * 128, c0 = g * 768 + cb * 128;
        bf16x8 ureg[4];
#pragma unroll
        for (int i = 0; i < 4; ++i) ureg[i] = *(const bf16x8*)(QKV + (size_t)(row0 + sr + 32 * i) * B_N + c0 + sc);
        { const f32x4 g0 = *(const f32x4*)(vg + c0 + sc), g1 = *(const f32x4*)(vg + c0 + sc + 4), b0 = *(const f32x4*)(vb + c0 + sc), b1 = *(const f32x4*)(vb + c0 + sc + 4);
#pragma unroll
          for (int i = 0; i < 4; ++i) { const int q = sr + 32 * i; const bf16x8 raw = *(const bf16x8*)(QKV + (size_t)(row0 + q) * B_N + B_W + c0 + sc);
              const float mu = stats[2 * (row0 + q)], rs = stats[2 * (row0 + q) + 1]; float t[8];
#pragma unroll
              for (int e = 0; e < 8; ++e) t[e] = (bf2f((unsigned short)raw[e]) - mu) * rs * (e < 4 ? g0[e & 3] : g1[e & 3]) + (e < 4 ? b0[e & 3] : b1[e & 3]);
              v4u w; w.x = pk2(t[0], t[1]); w.y = pk2(t[2], t[3]); w.z = pk2(t[4], t[5]); w.w = pk2(t[6], t[7]);
              *(v4u*)(lds + (i >> 1) * 16384 + att::v_st(sr + 32 * (i & 1), sc)) = w; } }
        __syncthreads();
        bf16x8 pa[2][4];
        { const bf16* Wg = BSW + (size_t)g * 16384 + (size_t)(pb * 32 + r32) * 128 + hi * 8;
#pragma unroll
          for (int kt = 0; kt < 2; ++kt)
#pragma unroll
              for (int kk = 0; kk < 4; ++kk) pa[kt][kk] = *(const bf16x8*)(Wg + kt * 64 + kk * 16); }
        f32x16 o0 = {}, o1 = {};
#pragma unroll
        for (int kt = 0; kt < 2; ++kt) { const int vbase = (int)(uintptr_t)(lds + kt * 16384) + att::v_rd_base(lane);
            if (dh == 0) { att::pv_one<0>(o0, vbase, pa[kt][0], pa[kt][1], pa[kt][2], pa[kt][3]); att::pv_one<1>(o1, vbase, pa[kt][0], pa[kt][1], pa[kt][2], pa[kt][3]); }
            else { att::pv_one<2>(o0, vbase, pa[kt][0], pa[kt][1], pa[kt][2], pa[kt][3]); att::pv_one<3>(o1, vbase, pa[kt][0], pa[kt][1], pa[kt][2], pa[kt][3]); } }
#pragma unroll
        for (int r = 0; r < 16; ++r) { const int p = pb * 32 + (r & 3) + 8 * (r >> 2) + 4 * hi; Ob[p * OP + dh * 64 + r32] = o0[r]; Ob[p * OP + dh * 64 + 32 + r32] = o1[r]; }
        __syncthreads();
#pragma unroll
        for (int i = 0; i < 4; ++i) { const int p = sr + 32 * i; const float bias = bs[g * 128 + p];
            const f32x4 x0 = *(const f32x4*)(Ob + p * OP + sc), x1 = *(const f32x4*)(Ob + p * OP + sc + 4); float t[8];
#pragma unroll
            for (int e = 0; e < 8; ++e) t[e] = bf2f((unsigned short)ureg[i][e]) * ((e < 4 ? x0[e & 3] : x1[e & 3]) + bias);
            v4u w; w.x = pk2(t[0], t[1]); w.y = pk2(t[2], t[3]); w.z = pk2(t[4], t[5]); w.w = pk2(t[6], t[7]);
            pg8::st16(Gout + (size_t)(row0 + p) * B_W + c0 + sc, w); }
        __syncthreads();
    }
}
__device__ __forceinline__ void combine_phase(const float* OC, bf16* AO, const float* lq1, const float* lk1, const float* lq2, const float* lk2, const float* sg, float lam_init, int nrows) {
    const int tid = pg8::opaque_tid(), lane = tid & 63, gw = blockIdx.x * NWAVES + __builtin_amdgcn_readfirstlane(tid >> 6), NGW = gridDim.x * NWAVES;
    const float d1 = wave_sum(lq1[lane] * lk1[lane] + lq1[lane + 64] * lk1[lane + 64], lane), d2 = wave_sum(lq2[lane] * lk2[lane] + lq2[lane + 64] * lk2[lane + 64], lane);
    const float lam = expf(d1) - expf(d2) + lam_init;
    const f32x4 gv = *(const f32x4*)(sg + 4 * lane) * (1.0f - lam_init);
    for (int row = gw; row < nrows; row += NGW) {
        const float* orow = OC + (size_t)row * 4096; bf16* ar = AO + (size_t)row * DM;
#pragma unroll
        for (int h = 0; h < 8; ++h) { const f32x4 a = *(const f32x4*)(orow + (2 * h) * 256 + 4 * lane), b = *(const f32x4*)(orow + (2 * h + 1) * 256 + 4 * lane); const f32x4 o = a - lam * b;
            const float rs = 1.0f / sqrtf(wave_sum((o.x * o.x + o.y * o.y) + (o.z * o.z + o.w * o.w), lane) * (1.0f / 256.0f) + EPS); const f32x4 v = o * rs * gv;
            v2u w; w.x = pk2(v.x, v.y); w.y = pk2(v.z, v.w); *(v2u*)(ar + h * 256 + 4 * lane) = w; }
    }
}

template <int K, int LDA, int EPI>
__device__ __forceinline__ void ctx_tile(const bf16* A, const bf16* Bt, bf16* out, int ldc, int ntn, int tile, LAS unsigned char* L) {
    const int tid = pg8::opaque_tid(), lane = tid & 63, wave = __builtin_amdgcn_readfirstlane(tid >> 6), r32 = lane & 31, hi = lane >> 5;
    const int tm = tile / ntn, row0 = tm * 64, col0 = (tile - tm * ntn) * 64;
    constexpr int NB = K / 64;
    static_assert(K % 64 == 0, "K must be a multiple of 64");
    LAS unsigned char* W = L + wave * 16384;
    const int lr = lane >> 3, lc = lane & 7;
    const bf16* ag = A + (size_t)(row0 + lr) * LDA + lc * 8;
    const bf16* bg = Bt + (size_t)(col0 + lr) * K + lc * 8;
    const int wofs = lr * 128 + ((lc ^ (lr & 7)) << 4);
    const int rofs = r32 * 128;
    f32x16 acc00 = {}, acc01 = {}, acc10 = {}, acc11 = {};
    bf16x8 ga0[8], gb0[8], ga1[8], gb1[8];
#define CT_LOAD(GA, GB, kb_) do { _Pragma("unroll") for (int i = 0; i < 8; ++i) { GA[i] = *(const bf16x8*)(ag + (size_t)(8 * i) * LDA + (kb_) * 64); GB[i] = *(const bf16x8*)(bg + (size_t)(8 * i) * K + (kb_) * 64); } } while (0)
#define CT_STORE(GA, GB) do { _Pragma("unroll") for (int i = 0; i < 8; ++i) { *(LAS bf16x8*)(W + i * 1024 + wofs) = GA[i]; *(LAS bf16x8*)(W + 8192 + i * 1024 + wofs) = GB[i]; } } while (0)
#define CT_MMA() do { _Pragma("unroll") for (int s = 0; s < 4; ++s) { const int ch = (((2 * s + hi) ^ (r32 & 7)) << 4); \
        const bf16x8 a0 = *(const LAS bf16x8*)(W + rofs + ch), a1 = *(const LAS bf16x8*)(W + 4096 + rofs + ch), b0 = *(const LAS bf16x8*)(W + 8192 + rofs + ch), b1 = *(const LAS bf16x8*)(W + 12288 + rofs + ch); \
        acc00 = __builtin_amdgcn_mfma_f32_32x32x16_bf16(a0, b0, acc00, 0, 0, 0); acc01 = __builtin_amdgcn_mfma_f32_32x32x16_bf16(a0, b1, acc01, 0, 0, 0); \
        acc10 = __builtin_amdgcn_mfma_f32_32x32x16_bf16(a1, b0, acc10, 0, 0, 0); acc11 = __builtin_amdgcn_mfma_f32_32x32x16_bf16(a1, b1, acc11, 0, 0, 0); } } while (0)
    int kb = wave;
    if (kb < NB) CT_LOAD(ga0, gb0, kb);
    if (kb + 8 < NB) CT_LOAD(ga1, gb1, kb + 8);
    for (; kb < NB; kb += 16) {
        CT_STORE(ga0, gb0);
        if (kb + 16 < NB) CT_LOAD(ga0, gb0, kb + 16);
        CT_MMA();
        if (kb + 8 < NB) {
            CT_STORE(ga1, gb1);
            if (kb + 24 < NB) CT_LOAD(ga1, gb1, kb + 24);
            CT_MMA();
        }
    }
#undef CT_LOAD
#undef CT_STORE
#undef CT_MMA
    LDS_WAIT(); asm volatile("" ::: "memory");
    LAS float* red = (LAS float*)L + wave * 4096;
#pragma unroll
    for (int r = 0; r < 16; ++r) { const int m = (r & 3) + 8 * (r >> 2) + 4 * hi;
        red[m * 64 + r32] = acc00[r]; red[m * 64 + 32 + r32] = acc01[r]; red[(32 + m) * 64 + r32] = acc10[r]; red[(32 + m) * 64 + 32 + r32] = acc11[r]; }
    __syncthreads();
    { const int o = tid * 8, m = o >> 6, n = o & 63; f32x4 s0 = {0.f, 0.f, 0.f, 0.f}, s1 = s0;
#pragma unroll
      for (int w = 0; w < 8; ++w) { s0 += *(const LAS f32x4*)((LAS float*)L + w * 4096 + o); s1 += *(const LAS f32x4*)((LAS float*)L + w * 4096 + o + 4); }
      if (EPI == 1) {
#pragma unroll
          for (int j = 0; j < 4; ++j) { s0[j] = pg8::gelu_tanh(s0[j]); s1[j] = pg8::gelu_tanh(s1[j]); } }
      v4u w4; w4.x = pk2(s0.x, s0.y); w4.y = pk2(s0.z, s0.w); w4.z = pk2(s1.x, s1.y); w4.w = pk2(s1.z, s1.w);
      pg8::st16(out + (size_t)(row0 + m) * ldc + col0 + n, w4); }
    __syncthreads();
}

__global__ void __launch_bounds__(NWAVES * 64, 2) fwd(KArgs args) {
    extern __shared__ __attribute__((aligned(16))) unsigned char lds[];
    LAS unsigned char* L = (LAS unsigned char*)lds;
    const int tid = threadIdx.x, G = gridDim.x, bx = blockIdx.x;
    unsigned char* ws0 = args.ws;
    for (int u = tid; u < (LDS_BYTES - RING_BYTES) / 4; u += NWAVES * 64) ((LAS unsigned*)(L + RING_BYTES))[u] = 0u;
    __syncthreads();
    const int lo = args.ph_lo, hi = args.ph_hi;
    XcdBarrier bar; bar.bar = (unsigned*)(ws0 + WS_CTL) + CW_BAR + args.li * XCD_BAR_WORDS; bar.x = 0; bar.st = (volatile LAS unsigned*)(L + MISC_OFF + 32);
    if (hi - lo > 1) bar = xcd_barrier_post((unsigned*)(ws0 + WS_CTL) + CW_BAR + args.li * XCD_BAR_WORDS, (volatile LAS unsigned*)(L + MISC_OFF + 32));
    int ph = 0; unsigned long long bacc_ = 0; (void)bacc_;
#define PHASE_BEGIN if (ph >= lo && ph < hi) {
#define PHASE_END   if (ph + 1 < hi) { unsigned long long br0_ = 0; if (PROBE_ID == 21 || PROBE_ID == 22) br0_ = wall_clock64(); xcd_barrier(bar); \
        if ((PROBE_ID == 21 || PROBE_ID == 22) && threadIdx.x == 0) { const unsigned dt_ = (unsigned)(wall_clock64() - br0_); \
            if (PROBE_ID == 21) atomicAdd((unsigned*)(args.ws + WS_CTL) + 2048, dt_); else atomicMin((unsigned*)(args.ws + WS_CTL) + 2304 + ph, dt_); } } } ++ph;
#define SETUP_PTRS() GAS unsigned char* wsg_ = (GAS unsigned char*)args.ws; asm volatile("" : "+s"(wsg_)); unsigned char* ws = (unsigned char*)wsg_; \
    GAS float* xlg_ = (GAS float*)args.out; asm volatile("" : "+s"(xlg_)); float* XL = (float*)xlg_; float* XC = (float*)(ws + WS_XC); \
    bf16* H = (bf16*)(ws + WS_H); bf16* HID = (bf16*)(ws + WS_HID); bf16* Y = (bf16*)(ws + WS_Y); bf16* QKV = (bf16*)(ws + WS_QKV); bf16* AO = (bf16*)(ws + WS_AO); float* OC = (float*)(ws + WS_OC); \
    const float* ROPE = (const float*)(ws + WS_ROPE); const float* SM = (const float*)(ws + WS_SMALL); (void)XC; (void)HID; (void)Y; (void)QKV; (void)AO; (void)OC; (void)ROPE; (void)SM; (void)H

    if (PROBE_ID == 22 && bx == 0 && threadIdx.x < 64) ((unsigned*)(args.ws + WS_CTL) + 2304)[threadIdx.x] = 0xffffffffu;
    { SETUP_PTRS();
    PHASE_BEGIN
#ifndef OFF_PRO
    prologue_phase(args, L, bx, G);
#endif
    PHASE_END
    PHASE_BEGIN norm_phase(args.in[0], args.in[2], XL, XC, nullptr, nullptr, modt(ws, 0, 0, 0, 0), H, MALL, L); PHASE_END }

    for (int sl = 0; sl < 3 * NLAYER; ++sl) {
        SETUP_PTRS();
        const int layer = sl / 3, typ = sl % 3, kind = layer % 3, jm = layer / 3; const bool lastl = (layer == NLAYER - 1);
        const int Mrows = (lastl && typ >= 1) ? MLAT : MALL;
        pg8::Gemm gy;
        if (typ != 1) {
            const int f = (typ == 0) ? 0 : 1;
            PHASE_BEGIN
                pg8::Gemm g{H, (const bf16*)(ws + WS_WFC1) + (size_t)(layer * 2 + f) * NFC1 * DM, Mrows, NFC1, DM, DM}; pg8::StaticOrder S; S.init(Mrows, NFC1, G, bx);
                pg8::EpiSwiglu E{HID, DFF};
                #ifndef OFF_FC1
                unsigned long long pt0_ = 0, pr0_ = 0; if (PROBE_ID == 20 && sl == 3 && bx == 0) { pt0_ = clock64(); pr0_ = wall_clock64(); }
                for (int rep_ = 0; rep_ < (PROBE_ID == 2 ? 2 : 1); ++rep_) { pg8::gemm_phase<pg8::EpiSwiglu, pg8::StaticOrder, true, true, DM, DM>(L, g, S, E); }
                if (PROBE_ID == 20 && sl == 3 && bx == 0 && threadIdx.x == 0) { const unsigned long long t1_ = clock64(), r1_ = wall_clock64();
                    __hip_atomic_store((float*)(ws + WS_SMALL) + SM_END, floorf((float)(t1_ - pt0_) / ((float)(r1_ - pr0_) * 10.0f) * 4.0f + 0.5f) * 0.02f, __ATOMIC_RELAXED, __HIP_MEMORY_SCOPE_AGENT); }
#endif
            PHASE_END
            gy = pg8::Gemm{HID, (const bf16*)(ws + WS_WFC2) + (size_t)(layer * 2 + f) * DM * DFF, Mrows, DM, DFF, DFF};
        } else {
            if (kind != 1) {
                PHASE_BEGIN
                    const int N = (kind == 0) ? A_N : C_N, Min = (kind == 0) ? MALL : MLAT;
                    pg8::Gemm g{H, (kind == 0) ? (const bf16*)(ws + WS_WAIN) + (size_t)jm * A_N * DM : (const bf16*)(ws + WS_WCIN), Min, N, DM, DM}; pg8::StaticOrder S; S.init(Min, N, G, bx);
                    pg8::EpiBf16X<0> E{QKV, N, ROPE, (kind == 0) ? 2560 : 4096};
                    #ifndef OFF_ROPE
                    for (int rep_ = 0; rep_ < (PROBE_ID == 8 ? 2 : 1); ++rep_) { pg8::gemm_phase<pg8::EpiBf16X<0>, pg8::StaticOrder, true, true, DM, DM>(L, g, S, E); }
                    if (kind == 2) for (int t = bx; t < 8 * (C_N / 64); t += G) ctx_tile<DM, DM, 0>(H + (size_t)MLAT * DM, g.Bt, QKV + (size_t)MLAT * C_N, C_N, C_N / 64, t, L);
#endif
                PHASE_END
            } else {
                PHASE_BEGIN
                    pg8::Gemm g{H, (const bf16*)(ws + WS_WBIN), MLAT, B_N, DM, DM}; pg8::StaticOrder S; S.init(MLAT, B_N, G, bx);
                    pg8::EpiBf16X<1> E{QKV, B_N, nullptr, 0};
                    #ifndef OFF_GELU
                    for (int rep_ = 0; rep_ < (PROBE_ID == 9 ? 2 : 1); ++rep_) { pg8::gemm_phase<pg8::EpiBf16X<1>, pg8::StaticOrder, true, true, DM, DM>(L, g, S, E); }
                    for (int t = bx; t < 8 * (B_N / 64); t += G) ctx_tile<DM, DM, 1>(H + (size_t)MLAT * DM, g.Bt, QKV + (size_t)MLAT * B_N, B_N, B_N / 64, t, L);
#endif
                PHASE_END
            }
            if (kind == 0) {
                PHASE_BEGIN
                    const int nlat = NBATCH * 16 * 16, nall = nlat + (lastl ? 0 : NBATCH * 16);
                    for (int u = bx; u < nall; u += G) {
                        att::Args a; a.qkv = QKV; a.ld = A_N; a.n0 = 4; a.has_sink = 1; a.out = AO; a.ldo = DM;
                        if (u < nlat) { const int qb = u & 15, h = (u >> 4) & 15, b = u >> 8;
                            a.qrow0 = b * SEQ + qb * 256; a.qcol = h * 128; a.kcol = 2048 + (h >> 2) * 128; a.vcol = 2560 + (h >> 2) * 128; a.ctxrow0 = MLAT + b * CTXL; a.latrow0 = b * SEQ;
                            a.kstart = qb * 256 - 128; a.n1 = 8; a.qpos0 = qb * 256; a.sink = SM[SM_SINK + jm * 16 + h]; a.ocol = h * 128; }
                        else { const int cu = u - nlat, h = cu & 15, b = cu >> 4;
                            a.qrow0 = MLAT + b * CTXL; a.qcol = h * 128; a.kcol = 2048 + (h >> 2) * 128; a.vcol = 2560 + (h >> 2) * 128; a.ctxrow0 = MLAT + b * CTXL; a.latrow0 = b * SEQ;
                            a.kstart = 0; a.n1 = 0; a.qpos0 = 0; a.sink = SM[SM_SINK + jm * 16 + h]; a.ocol = h * 128; }
                        #ifndef OFF_ATTA
                        for (int rep_ = 0; rep_ < (PROBE_ID == 7 ? 2 : 1); ++rep_) { att::attn_unit<true, true, A_N>(a, (char*)lds); }
#endif
                    }
                PHASE_END
                gy = pg8::Gemm{AO, (const bf16*)(ws + WS_WAOUT) + (size_t)jm * DM * DM, Mrows, DM, DM, DM};
            } else if (kind == 1) {
                PHASE_BEGIN for (int rep_ = 0; rep_ < (PROBE_ID == 15 ? 2 : 1); ++rep_) { vstats_phase(QKV, (float*)(ws + WS_STATS), MALL); } PHASE_END
                PHASE_BEGIN
for (int rep_ = 0; rep_ < (PROBE_ID == 14 ? 2 : 1); ++rep_) { spatial_phase(QKV, (bf16*)OC, (const bf16*)(ws + WS_BSW), (const float*)(ws + WS_STATS), SM + SM_VNG, SM + SM_VNB, SM + SM_BS, (char*)lds, MALL / 128, bx, G); }
                PHASE_END
                gy = pg8::Gemm{(const bf16*)OC, (const bf16*)(ws + WS_WBOUT), Mrows, DM, B_W, B_W};
            } else {
                PHASE_BEGIN
                    const int nlat = NBATCH * 8 * 32, nall = nlat + (lastl ? 0 : NBATCH * 8 * 2);
                    float lam;
                    { const int ln_ = pg8::opaque_tid() & 63; const float* q1 = SM + SM_LQ1; const float* k1 = SM + SM_LK1; const float* q2 = SM + SM_LQ2; const float* k2 = SM + SM_LK2;
                      const float d1 = wave_sum(q1[ln_] * k1[ln_] + q1[ln_ + 64] * k1[ln_ + 64], ln_), d2 = wave_sum(q2[ln_] * k2[ln_] + q2[ln_ + 64] * k2[ln_ + 64], ln_);
                      lam = expf(d1) - expf(d2) + args.lam_init; }
                    for (int u = bx; u < nall; u += G) {
                        int qrow0, hh, b, n1;
                        if (u < nlat) { const int qb = u & 31; hh = (u >> 5) & 7; b = u >> 8; qrow0 = b * SEQ + qb * 128; n1 = 64; }
                        else { const int cu = u - nlat, qb = cu & 1; hh = (cu >> 1) & 7; b = cu >> 4; qrow0 = MLAT + b * CTXL + qb * 128; n1 = 0; }
                        for (int rep_ = 0; rep_ < (PROBE_ID == 6 ? 2 : 1); ++rep_) { att::dattn_unit<C_N>(QKV, qrow0, hh, MLAT + b * CTXL, b * SEQ, 4, n1, lam, args.gscale, SM + SM_SUBG, AO, L, (char*)lds); }
                    }
                PHASE_END
                gy = pg8::Gemm{AO, (const bf16*)(ws + WS_WCOUT), Mrows, DM, DM, DM};
            }
        }
        PHASE_BEGIN
            const bool hasctx = (gy.M == MALL); gy.M = MLAT;
            pg8::StaticOrder S; S.init(MLAT, DM, G, bx); pg8::EpiBf16X<2> E{Y, DM, nullptr, 0};
            bf16* Yc = Y + (size_t)MLAT * DM;
            if (typ != 1) { for (int rep_ = 0; rep_ < (PROBE_ID == 3 ? 2 : 1); ++rep_) { pg8::gemm_phase<pg8::EpiBf16X<2>, pg8::StaticOrder, true, true, DFF, DFF>(L, gy, S, E); }
                for (int rep_ = 0; rep_ < (PROBE_ID == 4 ? 2 : 1); ++rep_) { if (hasctx) for (int t = bx; t < 256; t += G) ctx_tile<DFF, DFF, 0>(gy.A + (size_t)MLAT * DFF, gy.Bt, Yc, DM, 32, t, L); } }
            else if (kind == 1) { pg8::gemm_phase<pg8::EpiBf16X<2>, pg8::StaticOrder, true, true, B_W, B_W>(L, gy, S, E);
                if (hasctx) for (int t = bx; t < 256; t += G) ctx_tile<B_W, B_W, 0>(gy.A + (size_t)MLAT * B_W, gy.Bt, Yc, DM, 32, t, L); }
            else { pg8::gemm_phase<pg8::EpiBf16X<2>, pg8::StaticOrder, true, true, DM, DM>(L, gy, S, E);
                if (hasctx) for (int t = bx; t < 256; t += G) ctx_tile<DM, DM, 0>(gy.A + (size_t)MLAT * DM, gy.Bt, Yc, DM, 32, t, L); }
        PHASE_END
        if ((PROBE_ID == 21 || PROBE_ID == 22) && sl == 3 * NLAYER - 1 && typ == 2) { }
        if ((PROBE_ID == 21 || PROBE_ID == 22) && sl == 3 * NLAYER - 1 && bx == 0 && threadIdx.x == 0) { float v_ = 0.f;
            if (PROBE_ID == 21) v_ = floorf((float)__hip_atomic_load((unsigned*)(args.ws + WS_CTL) + 2048, __ATOMIC_RELAXED, __HIP_MEMORY_SCOPE_AGENT) * 0.01f / (float)G / PROBE_Q + 0.5f) * 0.02f;
            else { unsigned s_ = 0; for (int i_ = 0; i_ < ph; ++i_) { const unsigned m_ = __hip_atomic_load((unsigned*)(args.ws + WS_CTL) + 2304 + i_, __ATOMIC_RELAXED, __HIP_MEMORY_SCOPE_AGENT); if (m_ != 0xffffffffu) s_ += m_; } v_ = floorf((float)s_ * 0.01f / PROBE_Q + 0.5f) * 0.02f; }
            __hip_atomic_store((float*)(ws + WS_SMALL) + SM_END, v_, __ATOMIC_RELAXED, __HIP_MEMORY_SCOPE_AGENT); }
        PHASE_BEGIN
            const bool fin = (sl == 3 * NLAYER - 1);
            const int nl = (typ == 2) ? layer + 1 : layer, ns = (typ == 2) ? 0 : typ + 1;
            if (PROBE_ID == 5) norm_phase(XL, XC, (float*)(ws + WS_END), (float*)(ws + WS_END + 64 * MiB), Y, modt(ws, layer, typ, 0, 0), fin ? nullptr : modt(ws, nl, ns, 0, 0), fin ? nullptr : (bf16*)(ws + WS_END + 72 * MiB), Mrows, L);
            norm_phase(XL, XC, XL, XC, Y, modt(ws, layer, typ, 0, 0), fin ? nullptr : modt(ws, nl, ns, 0, 0), fin ? nullptr : H, Mrows, L, (PROBE_ID >= 20 && fin) ? 1.0f + __hip_atomic_load((float*)(ws + WS_SMALL) + SM_END, __ATOMIC_RELAXED, __HIP_MEMORY_SCOPE_AGENT) : 1.0f);
        PHASE_END
    }
#undef PHASE_BEGIN
#undef PHASE_END
}

static int count_phases() { int n = 2; for (int sl = 0; sl < 3 * NLAYER; ++sl) { const int layer = sl / 3, typ = sl % 3, kind = layer % 3; n += (typ != 1) ? 3 : (kind == 1 ? 5 : 4); } return n; }
extern "C" void kernel_launch(void* const* d_in, const int* in_sizes, int n_in, void* d_out, int out_size, void* d_ws, size_t ws_size, hipStream_t stream) {
    static int grid = 0;
    if (grid == 0) {
        if (n_in != 25 || in_sizes[0] != MLAT * DM || out_size != MLAT * DM || ws_size < WS_END) { fprintf(stderr, "kernel_launch: unexpected shapes (n_in %d, in0 %d, out %d, ws %zu < %zu)\n", n_in, n_in > 0 ? in_sizes[0] : -1, out_size, ws_size, (size_t)WS_END); grid = -1; return; }
        int dev = 0, cus = 0, per_cu = 0;
        if (hipGetDevice(&dev) != hipSuccess || hipDeviceGetAttribute(&cus, hipDeviceAttributeMultiprocessorCount, dev) != hipSuccess) { grid = -1; return; }
        if (hipFuncSetAttribute((const void*)fwd, hipFuncAttributeMaxDynamicSharedMemorySize, LDS_BYTES) != hipSuccess) { fprintf(stderr, "kernel_launch: hipFuncSetAttribute failed\n"); grid = -1; return; }
        if (hipOccupancyMaxActiveBlocksPerMultiprocessor(&per_cu, (const void*)fwd, NWAVES * 64, LDS_BYTES) != hipSuccess || per_cu < 1) fprintf(stderr, "kernel_launch: occupancy query reports %d\n", per_cu);
        (void)hipGetLastError();
        grid = cus;
    }
    if (grid < 0) return;
    if (hipMemsetAsync((char*)d_ws + WS_CTL, 0, CTL_BYTES, stream) != hipSuccess) return;
    KArgs a{};
    for (int i = 0; i < 25; ++i) a.in[i] = (const float*)d_in[i];
    a.out = (float*)d_out; a.ws = (unsigned char*)d_ws; a.lam_init = (float)(0.8 - 0.6 * exp(-0.3 * 2.0)); a.gscale = 1.0f - a.lam_init;
    const int nph = count_phases();
#if MK_PER_PHASE
    for (int p = 0; p < nph; ++p) { a.ph_lo = p; a.ph_hi = p + 1; a.li = 0; hipLaunchKernelGGL(fwd, dim3(grid), dim3(NWAVES * 64), LDS_BYTES, stream, a); }
#else
    a.ph_lo = 0; a.ph_hi = nph; a.li = 0; hipLaunchKernelGGL(fwd, dim3(grid), dim3(NWAVES * 64), LDS_BYTES, stream, a);
#endif
    const hipError_t le = hipPeekAtLastError();
    if (le != hipSuccess) fprintf(stderr, "kernel_launch: launch failed: %s\n", hipGetErrorName(le));
}
```

```cpp
#include <hip/hip_runtime.h>
#include <cstdio>
#include <cstdint>
#include <cmath>

#ifndef PROBE_ID
#define PROBE_ID 0
#endif
#ifndef PROBE_Q
#define PROBE_Q 300.0f
#endif
#ifndef PROBE_BLK
#define PROBE_BLK 0
#endif
#ifndef MK_PER_PHASE
#define MK_PER_PHASE 0
#endif

namespace pg8 {
#define PG8_LAS __attribute__((address_space(3)))
typedef unsigned short bf16_t;
typedef short bf16x8 __attribute__((ext_vector_type(8)));
typedef float f32x4 __attribute__((ext_vector_type(4)));
typedef unsigned u32x4 __attribute__((ext_vector_type(4)));
__device__ __forceinline__ int opaque_tid() { int t = threadIdx.x; asm volatile("" : "+v"(t)); return t; }
#ifndef WT_STORES
#define WT_STORES 0
#endif
__device__ __forceinline__ void st16(void* p, u32x4 v) {
#if WT_STORES
    asm volatile("global_store_dwordx4 %0, %1, off sc1\n\ts_nop 1" :: "v"(p), "v"(v) : "memory");
#else
    *(u32x4*)p = v;
#endif
}
typedef unsigned u32x2_t __attribute__((ext_vector_type(2)));
__device__ __forceinline__ void st8(void* p, u32x2_t v) {
#if WT_STORES
    asm volatile("global_store_dwordx2 %0, %1, off sc1\n\ts_nop 1" :: "v"(p), "v"(v) : "memory");
#else
    *(u32x2_t*)p = v;
#endif
}
constexpr int BM = 256, BK = 64, HALF = 128, HTB = HALF * BK * 2  , STAGE_BYTES = 8 * HTB, NXCD = 8, WGM = 8;

__host__ __device__ __forceinline__ int lds_byte(int r, int c) { const int st = (r >> 4) * 2 + (c >> 5), rr = r & 15, cc = c & 31, ob = rr * 64 + cc * 2; return st * 1024 + (ob ^ (((ob >> 9) & 1) << 5)); }
__host__ __device__ __forceinline__ void stage_rc(int b, int& R, int& C) { const int st = b / 1024, sb = b % 1024, swz = sb ^ (((sb >> 9) & 1) << 5); R = (st >> 1) * 16 + swz / 64; C = (st & 1) * 32 + (swz % 64) / 2; }
__host__ __device__ __forceinline__ int perm32(int rho) { const int n = rho >> 4, i = rho & 15; return 8 * (i >> 2) + 4 * n + (i & 3); }

struct Unit { int pm, pn; };
struct Gemm { const bf16_t* A; const bf16_t* Bt; int M, N, K, lda; };

struct StaticOrder {
    int nM, nN, nwg, G, c;
    __host__ __device__ void init(int M, int N, int G_, int c_) { nM = M / BM; nN = N / BM; nwg = nM * nN; G = G_; c = c_; }
    __host__ __device__ bool next(int i, Unit& u) const {
        const long L = (long)i * G + c; if (L >= nwg) return false;
        int wgid = (int)L; { const int q = nwg / NXCD, r = nwg % NXCD, xcd = wgid % NXCD, off = wgid / NXCD; wgid = (xcd < r ? xcd * (q + 1) : r * (q + 1) + (xcd - r) * q) + off; }
        const int nig = WGM * nN, gid = wgid / nig, fm = gid * WGM, gsz = (nM - fm) < WGM ? (nM - fm) : WGM;
        u.pm = fm + ((wgid % nig) % gsz); u.pn = (wgid % nig) / gsz; return true;
    }
    __device__ __forceinline__ void a_ready(const Unit&) const {}
    __device__ __forceinline__ void done(const Unit&) const {}
};


__device__ __forceinline__ unsigned cvt_pk_bf16(float lo, float hi) { unsigned r; asm volatile("v_cvt_pk_bf16_f32 %0, %1, %2" : "=v"(r) : "v"(lo), "v"(hi)); return r; }
__device__ __forceinline__ float sigmoid_fast(float z) { return __builtin_amdgcn_rcpf(1.0f + __builtin_amdgcn_exp2f(-1.4426950408889634f * z)); }
__device__ __forceinline__ float gelu_tanh(float x) { const float z = 1.5957691216057308f * (x + 0.044715f * x * x * x); return x * sigmoid_fast(z); }

struct EpiSwiglu {
    static constexpr bool PERM = true, AFTER_DRAIN = false;
    bf16_t* O; int ldc;
    __device__ __forceinline__ void operator()(const f32x4 (&acc)[2][2][4][2], const Unit& u, int wr, int wc, int fr, int fq) const {
        const int row0 = u.pm * BM + wr * 64 + fr, col0 = u.pn * HALF + wc * 32 + 8 * fq;
#pragma unroll
        for (int ai = 0; ai < 2; ++ai)
#pragma unroll
            for (int m = 0; m < 4; ++m) { bf16_t* rowp = O + (size_t)(row0 + ai * HALF + m * 16) * ldc + col0;
                float v[8];
#pragma unroll
                for (int n = 0; n < 2; ++n)
#pragma unroll
                    for (int j = 0; j < 4; ++j) { const float g = acc[ai][0][m][n][j], uu = acc[ai][1][m][n][j]; v[n * 4 + j] = g * sigmoid_fast(g) * uu; }
                u32x4 w; w.x = cvt_pk_bf16(v[0], v[1]); w.y = cvt_pk_bf16(v[2], v[3]); w.z = cvt_pk_bf16(v[4], v[5]); w.w = cvt_pk_bf16(v[6], v[7]);
                st16(rowp, w); }
    }
};
struct EpiF32 {
    static constexpr bool PERM = true, AFTER_DRAIN = false;
    float* C; int ldc;
    __device__ __forceinline__ void operator()(const f32x4 (&acc)[2][2][4][2], const Unit& u, int wr, int wc, int fr, int fq) const {
        const int row0 = u.pm * BM + wr * 64 + fr, col0 = u.pn * BM + wc * 32 + 8 * fq;
#pragma unroll
        for (int ai = 0; ai < 2; ++ai)
#pragma unroll
            for (int m = 0; m < 4; ++m) { float* rowp = C + (size_t)(row0 + ai * HALF + m * 16) * ldc + col0;
#pragma unroll
                for (int bj = 0; bj < 2; ++bj) { *(f32x4*)(rowp + bj * HALF) = acc[ai][bj][m][0]; *(f32x4*)(rowp + bj * HALF + 4) = acc[ai][bj][m][1]; } }
    }
};
template <int MODE  > struct EpiBf16X {
    static constexpr bool PERM = true, AFTER_DRAIN = false;
    bf16_t* O; int ldc; const float* rope; int rope_cols;
    __device__ __forceinline__ void operator()(const f32x4 (&acc)[2][2][4][2], const Unit& u, int wr, int wc, int fr, int fq) const {
        const int row0 = u.pm * BM + wr * 64 + fr, col0 = u.pn * BM + wc * 32 + 8 * fq;
        const bool do_rope = (MODE == 0) && (u.pm < 32) && (u.pn * BM < rope_cols);
        const int p0 = 16 * wc + 4 * fq;
#pragma unroll
        for (int ai = 0; ai < 2; ++ai)
#pragma unroll
            for (int m = 0; m < 4; ++m) { const int row = row0 + ai * HALF + m * 16; bf16_t* rowp = O + (size_t)row * ldc + col0;
                f32x4 cs0 = (f32x4){1.f, 0.f, 1.f, 0.f}, cs1 = cs0;
                if (do_rope) { const float* rp = rope + ((size_t)(row & 4095) * 64 + p0) * 2; cs0 = *(const f32x4*)rp; cs1 = *(const f32x4*)(rp + 4); }
#pragma unroll
                for (int bj = 0; bj < 2; ++bj) { f32x4 v0 = acc[ai][bj][m][0], v1 = acc[ai][bj][m][1];
                    if (MODE == 1) {
#pragma unroll
                        for (int j = 0; j < 4; ++j) { v0[j] = gelu_tanh(v0[j]); v1[j] = gelu_tanh(v1[j]); } }
                    else if (do_rope) {
                        const f32x4 a = v0, b = v1;
                        v0[0] = a[0] * cs0[0] - a[1] * cs0[1]; v0[1] = a[0] * cs0[1] + a[1] * cs0[0]; v0[2] = a[2] * cs0[2] - a[3] * cs0[3]; v0[3] = a[2] * cs0[3] + a[3] * cs0[2];
                        v1[0] = b[0] * cs1[0] - b[1] * cs1[1]; v1[1] = b[0] * cs1[1] + b[1] * cs1[0]; v1[2] = b[2] * cs1[2] - b[3] * cs1[3]; v1[3] = b[2] * cs1[3] + b[3] * cs1[2]; }
                    u32x4 w; w.x = cvt_pk_bf16(v0[0], v0[1]); w.y = cvt_pk_bf16(v0[2], v0[3]); w.z = cvt_pk_bf16(v1[0], v1[1]); w.w = cvt_pk_bf16(v1[2], v1[3]);
                    st16(rowp + bj * HALF, w); } }
    }
};

template <class Epi, class Sched, bool ALIGN_EPI, bool SP2, int K, int LDA>
__device__ __forceinline__ void gemm_phase(PG8_LAS unsigned char* lds, const Gemm g, const Sched& S, const Epi& E) {
    const int tid = opaque_tid(), wid = __builtin_amdgcn_readfirstlane(tid >> 6), lane = tid & 63, wr = wid >> 2, wc = wid & 3, fr = lane & 15, fq = lane >> 4;
    constexpr int nt = K / BK;
    unsigned voffA[2], voffB[2];
#pragma unroll
    for (int i = 0; i < 2; ++i) { int R, C; stage_rc(tid * 16 + i * 8192, R, C); const int Rb = Epi::PERM ? ((R & ~31) + perm32(R & 31)) : R;
        voffA[i] = (unsigned)(R * LDA + C) * 2u; voffB[i] = (unsigned)(Rb * K + C) * 2u; }
    constexpr size_t kstep = (size_t)(BK * 2);
    constexpr size_t hstepA = (size_t)HALF * LDA * 2, hstepB = (size_t)HALF * K * 2;
    constexpr size_t tstepA = 2 * hstepA, tstepB = 2 * hstepB;
    const unsigned ldsw = (unsigned)wid * 1024u;
    const int aoff = lds_byte(wr * 64 + fr, fq * 8), boff = lds_byte(wc * 32 + fr, fq * 8);
#define PG8_SA(b, h) (((b) * 2 + (h)) * HTB)
#define PG8_SB(b, h) ((4 + (b) * 2 + (h)) * HTB)
#define PG8_STAGE(bufoff, gbase, voff) do { _Pragma("unroll") for (int _i = 0; _i < 2; ++_i) \
        __builtin_amdgcn_global_load_lds((const unsigned*)((const char*)(gbase) + (voff)[_i]), (PG8_LAS unsigned*)(lds + (bufoff) + ldsw + _i * 8192), 16, 0, 0); } while (0)
#define PG8_LDA(dst, b, h) do { _Pragma("unroll") for (int m = 0; m < 4; ++m) _Pragma("unroll") for (int k = 0; k < 2; ++k) dst[m][k] = *(const PG8_LAS bf16x8*)(lds + PG8_SA(b, h) + aoff + m * 2048 + k * 1024); } while (0)
#define PG8_LDB(dst, b, h) do { _Pragma("unroll") for (int n = 0; n < 2; ++n) _Pragma("unroll") for (int k = 0; k < 2; ++k) dst[n][k] = *(const PG8_LAS bf16x8*)(lds + PG8_SB(b, h) + boff + n * 2048 + k * 1024); } while (0)
#define PG8_MMA(ai, bj, At, Bt) do { __builtin_amdgcn_s_setprio(1); _Pragma("unroll") for (int m = 0; m < 4; ++m) _Pragma("unroll") for (int n = 0; n < 2; ++n) _Pragma("unroll") for (int k = 0; k < 2; ++k) \
        acc[ai][bj][m][n] = __builtin_amdgcn_mfma_f32_16x16x32_bf16(Bt[n][k], At[m][k], acc[ai][bj][m][n], 0, 0, 0); __builtin_amdgcn_s_setprio(0); } while (0)
#define PG8_WAIT_V(n) asm volatile("s_waitcnt vmcnt(" #n ")" ::: "memory")
#define PG8_WAIT_L(n) asm volatile("s_waitcnt lgkmcnt(" #n ")" ::: "memory")
#define PG8_BAR __builtin_amdgcn_s_barrier()
#define PG8_SCHED __builtin_amdgcn_sched_barrier(0)
    Unit cur, nxt; int ui = 0;
    if (!S.next(0, cur)) return;
    f32x4 acc[2][2][4][2];
#pragma unroll
    for (int a = 0; a < 2; ++a)
#pragma unroll
        for (int b = 0; b < 2; ++b)
#pragma unroll
            for (int m = 0; m < 4; ++m)
#pragma unroll
                for (int n = 0; n < 2; ++n) acc[a][b][m][n] = (f32x4){0.f, 0.f, 0.f, 0.f};
    bf16x8 At[4][2], B0[2][2], B1[2][2];
    const char* cA = (const char*)g.A + (size_t)cur.pm * tstepA; const char* cB = (const char*)g.Bt + (size_t)cur.pn * tstepB;
    S.a_ready(cur);
    if constexpr (SP2) {
        PG8_STAGE(PG8_SB(0, 0), cB, voffB); PG8_STAGE(PG8_SB(0, 1), cB + hstepB, voffB); PG8_STAGE(PG8_SA(0, 0), cA, voffA); PG8_STAGE(PG8_SA(0, 1), cA + hstepA, voffA);
        if (wr == 1) PG8_BAR;
        PG8_WAIT_V(2); PG8_BAR;
        PG8_STAGE(PG8_SB(1, 0), cB + kstep, voffB); PG8_STAGE(PG8_SA(1, 0), cA + kstep, voffA); PG8_STAGE(PG8_SB(1, 1), cB + hstepB + kstep, voffB);
        PG8_WAIT_V(6); PG8_BAR;
    } else {
        PG8_STAGE(PG8_SB(0, 0), cB, voffB); PG8_STAGE(PG8_SA(0, 0), cA, voffA); PG8_STAGE(PG8_SB(0, 1), cB + hstepB, voffB); PG8_STAGE(PG8_SA(0, 1), cA + hstepA, voffA);
        if (wr == 1) PG8_BAR;
        PG8_WAIT_V(4); PG8_BAR;
        PG8_STAGE(PG8_SB(1, 0), cB + kstep, voffB); PG8_STAGE(PG8_SA(1, 0), cA + kstep, voffA); PG8_STAGE(PG8_SB(1, 1), cB + hstepB + kstep, voffB);
        PG8_WAIT_V(6); PG8_BAR;
    }
    for (;;) {
        const bool has_next = S.next(ui + 1, nxt);
        const char* nA = has_next ? (const char*)g.A + (size_t)nxt.pm * tstepA : cA; const char* nB = has_next ? (const char*)g.Bt + (size_t)nxt.pn * tstepB : cB;
        for (int t = 0; t < nt; t += 2) {
            const bool last = (t == nt - 2);
            const char* a1 = cA + (size_t)(t + 1) * kstep;
            const char* a2 = last ? nA : cA + (size_t)(t + 2) * kstep; const char* b2 = last ? nB : cB + (size_t)(t + 2) * kstep;
            const char* a3 = a2 + kstep; const char* b3 = b2 + kstep;
            if (last && has_next) S.a_ready(nxt);
            if constexpr (SP2) {
            PG8_LDB(B0, 0, 0); PG8_LDB(B1, 0, 1); PG8_SCHED; PG8_LDA(At, 0, 0); PG8_STAGE(PG8_SA(1, 1), a1 + hstepA, voffA);
            PG8_WAIT_V(8); PG8_WAIT_L(0); PG8_BAR; PG8_MMA(0, 0, At, B0); PG8_MMA(0, 1, At, B1); PG8_BAR; PG8_SCHED;
            PG8_LDA(At, 0, 1); PG8_STAGE(PG8_SB(0, 0), b2, voffB); PG8_STAGE(PG8_SB(0, 1), b2 + hstepB, voffB); PG8_STAGE(PG8_SA(0, 0), a2, voffA);
            PG8_WAIT_V(8); PG8_WAIT_L(0); PG8_BAR; PG8_MMA(1, 0, At, B0); PG8_MMA(1, 1, At, B1); PG8_BAR; PG8_SCHED;
            PG8_LDB(B0, 1, 0); PG8_LDB(B1, 1, 1); PG8_SCHED; PG8_LDA(At, 1, 0); PG8_STAGE(PG8_SA(0, 1), a2 + hstepA, voffA);
            PG8_WAIT_V(8); PG8_WAIT_L(0); PG8_BAR; PG8_MMA(0, 0, At, B0); PG8_MMA(0, 1, At, B1); PG8_BAR; PG8_SCHED;
            PG8_LDA(At, 1, 1); PG8_STAGE(PG8_SB(1, 0), b3, voffB); PG8_STAGE(PG8_SB(1, 1), b3 + hstepB, voffB); PG8_STAGE(PG8_SA(1, 0), a3, voffA);
            PG8_WAIT_V(8); PG8_WAIT_L(0); PG8_BAR; PG8_MMA(1, 0, At, B0); PG8_MMA(1, 1, At, B1); PG8_BAR; PG8_SCHED;
            } else {
            PG8_LDB(B0, 0, 0); PG8_SCHED; PG8_LDA(At, 0, 0); PG8_STAGE(PG8_SA(1, 1), a1 + hstepA, voffA);
            PG8_WAIT_L(8); PG8_BAR; PG8_WAIT_L(0); PG8_MMA(0, 0, At, B0); PG8_BAR; PG8_SCHED;
            PG8_LDB(B1, 0, 1); PG8_STAGE(PG8_SB(0, 0), b2, voffB);
            PG8_BAR; PG8_WAIT_L(0); PG8_MMA(0, 1, At, B1); PG8_BAR;
            PG8_LDA(At, 0, 1); PG8_STAGE(PG8_SA(0, 0), a2, voffA);
            PG8_BAR; PG8_WAIT_L(0); PG8_MMA(1, 0, At, B0); PG8_BAR; PG8_SCHED;
            PG8_STAGE(PG8_SB(0, 1), b2 + hstepB, voffB);
            PG8_WAIT_V(6); PG8_BAR; PG8_MMA(1, 1, At, B1); PG8_BAR;
            PG8_LDB(B0, 1, 0); PG8_SCHED; PG8_LDA(At, 1, 0); PG8_STAGE(PG8_SA(0, 1), a2 + hstepA, voffA);
            PG8_WAIT_L(8); PG8_BAR; PG8_WAIT_L(0); PG8_MMA(0, 0, At, B0); PG8_BAR; PG8_SCHED;
            PG8_LDB(B1, 1, 1); PG8_STAGE(PG8_SB(1, 0), b3, voffB);
            PG8_BAR; PG8_WAIT_L(0); PG8_MMA(0, 1, At, B1); PG8_BAR;
            PG8_LDA(At, 1, 1); PG8_STAGE(PG8_SA(1, 0), a3, voffA);
            PG8_BAR; PG8_WAIT_L(0); PG8_MMA(1, 0, At, B0); PG8_BAR; PG8_SCHED;
            PG8_STAGE(PG8_SB(1, 1), b3 + hstepB, voffB);
            PG8_WAIT_V(6); PG8_BAR; PG8_MMA(1, 1, At, B1); PG8_BAR;
            }
        }
        if constexpr (ALIGN_EPI) { if (wr == 0) PG8_BAR; }
        if constexpr (!Epi::AFTER_DRAIN) { E(acc, cur, wr, wc, fr, fq); S.done(cur); }
        if (!has_next) break;
#pragma unroll
        for (int a = 0; a < 2; ++a)
#pragma unroll
            for (int b = 0; b < 2; ++b)
#pragma unroll
                for (int m = 0; m < 4; ++m)
#pragma unroll
                    for (int n = 0; n < 2; ++n) acc[a][b][m][n] = (f32x4){0.f, 0.f, 0.f, 0.f};
        cur = nxt; cA = nA; cB = nB; ++ui;
        if constexpr (ALIGN_EPI) { if (wr == 1) PG8_BAR; }
    }
    PG8_WAIT_V(0);
    if constexpr (!ALIGN_EPI) { if (wr == 0) PG8_BAR; }
    PG8_BAR;
    if constexpr (Epi::AFTER_DRAIN) { E.fused(acc, cur, wr, wc, fr, fq, lds, wid, lane); S.done(cur); }
#undef PG8_SA
#undef PG8_SB
#undef PG8_STAGE
#undef PG8_LDA
#undef PG8_LDB
#undef PG8_MMA
#undef PG8_WAIT_V
#undef PG8_WAIT_L
#undef PG8_BAR
#undef PG8_SCHED
}
}

namespace att {
typedef unsigned short bf16;
using bf16x8 = __attribute__((ext_vector_type(8))) short;
using s16x4  = __attribute__((ext_vector_type(4))) short;
using f32x16 = __attribute__((ext_vector_type(16))) float;
using u32x4  = __attribute__((ext_vector_type(4))) unsigned;
constexpr int   D = 128, NW = 8, QBLK = 32, KVBLK = 64;
constexpr float SCALE = 0.088388347648318440f;
constexpr float THR = 8.f;
constexpr int SHM_V = KVBLK * D * 2, SHM_K = KVBLK * D * 2, SHM_ATTN = 2 * SHM_V + 2 * SHM_K + NW * 64 * 4;
#define KSWZ(row, colB) ((row) * 256 + ((colB) ^ (((row) & 7) << 4)))
#define SBAR() __builtin_amdgcn_sched_barrier(0)
__device__ __forceinline__ int crow(int r, int hi) { return (r & 3) + 8 * (r >> 2) + 4 * hi; }
__device__ __forceinline__ unsigned cvtpk(float lo, float hi) { unsigned r; asm volatile("v_cvt_pk_bf16_f32 %0, %1, %2" : "=v"(r) : "v"(lo), "v"(hi)); return r; }

__device__ __forceinline__ void wmask(f32x16& p0, f32x16& p1, int kpos0, int qp, int hi) {
  const bool oob = (kpos0 < 0) || (kpos0 >= 4096);
  const int base = kpos0 - qp + 128;
#pragma unroll
  for (int r = 0; r < 16; ++r) { const int c = crow(r, hi);
    if (oob || (unsigned)(base + c) > 256u) p0[r] = -1e30f;
    if (oob || (unsigned)(base + 32 + c) > 256u) p1[r] = -1e30f; }
}
__device__ __forceinline__ void partialSM(f32x16& p0, f32x16& p1, float& m_reg, float& mn, float& alpha) {
  constexpr float C = SCALE * 1.4426950408889634f;
  float pmax = p0[0];
#pragma unroll
  for (int r = 1; r < 16; ++r) pmax = fmaxf(pmax, p0[r]);
#pragma unroll
  for (int r = 0; r < 16; ++r) pmax = fmaxf(pmax, p1[r]);
  { auto rr = __builtin_amdgcn_permlane32_swap(__float_as_uint(pmax), __float_as_uint(pmax), false, false);
    pmax = fmaxf(__uint_as_float(rr[0]), __uint_as_float(rr[1])); }
  if (__builtin_expect(__all(pmax - m_reg <= THR / SCALE), 1)) { mn = m_reg; alpha = 1.f; }
  else { mn = fmaxf(m_reg, pmax); alpha = __builtin_amdgcn_exp2f((m_reg - mn) * C); m_reg = mn; }
  float mnC = -mn * C;
#pragma unroll
  for (int r = 0; r < 16; ++r) p0[r] = fmaf(p0[r], C, mnC);
#pragma unroll
  for (int r = 0; r < 16; ++r) p1[r] = fmaf(p1[r], C, mnC);
#pragma unroll
  for (int r = 0; r < 16; ++r) p0[r] = __builtin_amdgcn_exp2f(p0[r]);
}
__device__ __forceinline__ void finishSM(f32x16& p0, f32x16& p1, float alpha, float& l_reg, bf16x8& pa0, bf16x8& pa1, bf16x8& pa2, bf16x8& pa3) {
#pragma unroll
  for (int r = 0; r < 16; ++r) p1[r] = __builtin_amdgcn_exp2f(p1[r]);
  float ps = 0;
#pragma unroll
  for (int r = 0; r < 16; ++r) ps += p0[r];
#pragma unroll
  for (int r = 0; r < 16; ++r) ps += p1[r];
  { auto rr = __builtin_amdgcn_permlane32_swap(__float_as_uint(ps), __float_as_uint(ps), false, false);
    ps = __uint_as_float(rr[0]) + __uint_as_float(rr[1]); }
  l_reg = l_reg * alpha + ps;
#define PK4(P, BASE, OUT) do { unsigned a0 = cvtpk(P[BASE + 0], P[BASE + 1]), a1 = cvtpk(P[BASE + 2], P[BASE + 3]);   \
    unsigned b0 = cvtpk(P[BASE + 4], P[BASE + 5]), b1 = cvtpk(P[BASE + 6], P[BASE + 7]);                              \
    auto r0 = __builtin_amdgcn_permlane32_swap(a0, b0, false, false); auto r1 = __builtin_amdgcn_permlane32_swap(a1, b1, false, false); \
    u32x4 w = {r0[0], r1[0], r0[1], r1[1]}; OUT = *reinterpret_cast<bf16x8*>(&w); } while (0)
  PK4(p0, 0, pa0); PK4(p0, 8, pa1); PK4(p1, 0, pa2); PK4(p1, 8, pa3);
#undef PK4
}
__device__ __forceinline__ void qkt(f32x16& p0, f32x16& p1, const bf16* Ks, const bf16x8* qr, int r32, int hi) {
  p0 = f32x16{}; p1 = f32x16{};
#pragma unroll
  for (int d0 = 0; d0 < 8; ++d0) { int cb = (d0 * 16 + hi * 8) * 2;
    bf16x8 b0 = *reinterpret_cast<const bf16x8*>((const char*)Ks + KSWZ(r32, cb));
    bf16x8 b1 = *reinterpret_cast<const bf16x8*>((const char*)Ks + KSWZ(32 + r32, cb));
    p0 = __builtin_amdgcn_mfma_f32_32x32x16_bf16(b0, qr[d0], p0, 0, 0, 0);
    p1 = __builtin_amdgcn_mfma_f32_32x32x16_bf16(b1, qr[d0], p1, 0, 0, 0); }
}
__device__ __forceinline__ int v_st(int k, int c) { const int kk = (k & ~0xC) | ((k & 4) << 1) | ((k & 8) >> 1); return ((kk >> 3) * 4 + (c >> 5)) * 512 + ((kk & 7) * 32 + (c & 31)) * 2; }
__device__ __forceinline__ int v_rd_base(int lane) { return ((lane & 3) << 3) | (((lane >> 2) & 3) << 6) | (((lane >> 4) & 1) << 5) | (((lane >> 5) & 1) << 8); }
constexpr int v_rd_off(int d0, int ks, int half) { return d0 * 512 + ks * 4096 + half * 2048; }
template <int OFF> __device__ __forceinline__ s16x4 tr_read(int vb) {
  s16x4 r; asm volatile("ds_read_b64_tr_b16 %0, %1 offset:%2" : "=&v"(r) : "v"(vb), "i"(OFF) : "memory"); return r;
}
template <int D0> __device__ __forceinline__ void pv_one(f32x16& od, int vb, bf16x8 pa0, bf16x8 pa1, bf16x8 pa2, bf16x8 pa3) {
  const s16x4 l0 = tr_read<v_rd_off(D0, 0, 0)>(vb), h0 = tr_read<v_rd_off(D0, 0, 1)>(vb), l1 = tr_read<v_rd_off(D0, 1, 0)>(vb), h1 = tr_read<v_rd_off(D0, 1, 1)>(vb);
  const s16x4 l2 = tr_read<v_rd_off(D0, 2, 0)>(vb), h2 = tr_read<v_rd_off(D0, 2, 1)>(vb), l3 = tr_read<v_rd_off(D0, 3, 0)>(vb), h3 = tr_read<v_rd_off(D0, 3, 1)>(vb);
  asm volatile("s_waitcnt lgkmcnt(0)" ::: "memory"); SBAR();
#define PK(L, H) (bf16x8){L[0], L[1], L[2], L[3], H[0], H[1], H[2], H[3]}
  od = __builtin_amdgcn_mfma_f32_32x32x16_bf16(pa0, PK(l0, h0), od, 0, 0, 0);
  od = __builtin_amdgcn_mfma_f32_32x32x16_bf16(pa1, PK(l1, h1), od, 0, 0, 0);
  od = __builtin_amdgcn_mfma_f32_32x32x16_bf16(pa2, PK(l2, h2), od, 0, 0, 0);
  od = __builtin_amdgcn_mfma_f32_32x32x16_bf16(pa3, PK(l3, h3), od, 0, 0, 0);
#undef PK
}
__device__ __forceinline__ void pv_d0(f32x16* o, int vb, bf16x8 pa0, bf16x8 pa1, bf16x8 pa2, bf16x8 pa3) {
  pv_one<0>(o[0], vb, pa0, pa1, pa2, pa3); pv_one<1>(o[1], vb, pa0, pa1, pa2, pa3); pv_one<2>(o[2], vb, pa0, pa1, pa2, pa3); pv_one<3>(o[3], vb, pa0, pa1, pa2, pa3);
}

struct Args {
  const bf16* qkv; int ld;
  int qrow0, qcol, kcol, vcol;
  int ctxrow0, latrow0;
  int kstart, n0, n1;
  int qpos0;
  float sink; int has_sink;
  void* out; int ldo, ocol;
};

template <bool WINDOW, bool OUT_BF16, int LD>
__device__ __forceinline__ void attn_unit(const Args& a, char* lds) {
  const int tid = pg8::opaque_tid(), wid = tid >> 6, lane = tid & 63, r32 = lane & 31, hi = lane >> 5;
  bf16* V_lds = (bf16*)lds; bf16* K_lds = (bf16*)(lds + 2 * SHM_V);
  float* ws = (float*)(lds + 2 * SHM_V + 2 * SHM_K) + wid * 64; float* li_l = ws; float* al_l = ws + 32;
  float m_reg = a.has_sink ? a.sink * (1.0f / SCALE) : -1e30f, l_reg = a.has_sink ? 1.0f : 0.0f; f32x16 o[4] = {}; bf16x8 qr[8];
  const bf16* Qw = a.qkv + (long)(a.qrow0 + wid * QBLK + r32) * LD + a.qcol + hi * 8;
#pragma unroll
  for (int d0 = 0; d0 < 8; ++d0) qr[d0] = *reinterpret_cast<const bf16x8*>(Qw + d0 * 16);
  const int sr = tid >> 4, sc = (tid & 15) * 8, vst0 = v_st(sr, sc), vst1 = v_st(32 + sr, sc);
  const int vb0 = (int)(uintptr_t)V_lds + v_rd_base(lane);
  const int qp = a.qpos0 + wid * QBLK + r32;
  const unsigned soff0 = (unsigned)(sr * LD + sc) * 2u, soff1 = soff0 + 32u * LD * 2u;
  struct { bf16x8 vs0, vs1, ks0, ks1; } sr_[2];
#define TROW(t) ((t) < a.n0 ? a.ctxrow0 + (t) * KVBLK : a.latrow0 + min(max(a.kstart + ((t) - a.n0) * KVBLK, 0), 4096 - KVBLK))
#define SLOAD(i, t) do { const char* tb_ = (const char*)a.qkv + (size_t)TROW(t) * (LD * 2); const char* tv_ = tb_ + a.vcol * 2; const char* tk_ = tb_ + a.kcol * 2; \
    sr_[i].vs0 = *reinterpret_cast<const bf16x8*>(tv_ + soff0); sr_[i].vs1 = *reinterpret_cast<const bf16x8*>(tv_ + soff1); \
    sr_[i].ks0 = *reinterpret_cast<const bf16x8*>(tk_ + soff0); sr_[i].ks1 = *reinterpret_cast<const bf16x8*>(tk_ + soff1); } while (0)
#define SWRITE(b, i) do { *(bf16x8*)((char*)V_lds + (b) * SHM_V + vst0) = sr_[i].vs0;          \
    *(bf16x8*)((char*)V_lds + (b) * SHM_V + vst1) = sr_[i].vs1; int kc = sc * 2;               \
    *(bf16x8*)((char*)K_lds + (b) * SHM_K + KSWZ(sr, kc)) = sr_[i].ks0;                       \
    *(bf16x8*)((char*)K_lds + (b) * SHM_K + KSWZ(32 + sr, kc)) = sr_[i].ks1; } while (0)
#define SWAIT() asm volatile("s_waitcnt vmcnt(4)" ::: "memory")
#define RESC(al) do { if (__any((al) < 1.f)) { if (hi == 0) al_l[r32] = (al); asm volatile("s_waitcnt lgkmcnt(0)" ::: "memory"); \
    _Pragma("unroll") for (int d = 0; d < 4; ++d) _Pragma("unroll") for (int r = 0; r < 16; ++r) o[d][r] *= al_l[crow(r, hi)]; } } while (0)
#define WMASK(P0, P1, t) do { if (WINDOW) { if ((t) >= a.n0) wmask(P0, P1, a.kstart + ((t) - a.n0) * KVBLK, qp, hi); } } while (0)
  f32x16 pA0, pA1, pB0, pB1; float mnA, mnB, alA, alB; bf16x8 pa0, pa1, pa2, pa3; const int NT = a.n0 + a.n1;
  constexpr int SE = 0, SO = 1;
  SLOAD(SE, 0); asm volatile("s_waitcnt vmcnt(0)" ::: "memory"); SWRITE(0, SE); __syncthreads();
  qkt(pA0, pA1, K_lds, qr, r32, hi); WMASK(pA0, pA1, 0); partialSM(pA0, pA1, m_reg, mnA, alA);
  SLOAD(SO, 1); if (2 < NT) SLOAD(SE, 2);
  SWAIT(); SWRITE(1, SO); __syncthreads();
  for (int j = 1; j + 1 < NT; j += 2) {
    SBAR(); qkt(pB0, pB1, (bf16*)((char*)K_lds + SHM_K), qr, r32, hi);
    finishSM(pA0, pA1, alA, l_reg, pa0, pa1, pa2, pa3); SBAR();
    SLOAD(SO, j + 2); SBAR();
    pv_d0(o, vb0, pa0, pa1, pa2, pa3); WMASK(pB0, pB1, j); partialSM(pB0, pB1, m_reg, mnB, alB);
    __syncthreads(); SWAIT(); SWRITE(0, SE);
    RESC(alB); __syncthreads();
    SBAR(); qkt(pA0, pA1, K_lds, qr, r32, hi);
    finishSM(pB0, pB1, alB, l_reg, pa0, pa1, pa2, pa3); SBAR();
    if (j + 3 < NT) SLOAD(SE, j + 3); SBAR();
    pv_d0(o, vb0 + (int)SHM_V, pa0, pa1, pa2, pa3); WMASK(pA0, pA1, j + 1); partialSM(pA0, pA1, m_reg, mnA, alA);
    __syncthreads(); SWAIT(); SWRITE(1, SO);
    RESC(alA); __syncthreads();
  }
  SBAR(); qkt(pB0, pB1, (bf16*)((char*)K_lds + SHM_K), qr, r32, hi);
  finishSM(pA0, pA1, alA, l_reg, pa0, pa1, pa2, pa3); SBAR();
  pv_d0(o, vb0, pa0, pa1, pa2, pa3); WMASK(pB0, pB1, NT - 1); partialSM(pB0, pB1, m_reg, mnB, alB);
  __syncthreads(); RESC(alB);
  finishSM(pB0, pB1, alB, l_reg, pa0, pa1, pa2, pa3); SBAR();
  pv_d0(o, vb0 + (int)SHM_V, pa0, pa1, pa2, pa3);
  if (hi == 0) li_l[r32] = l_reg; asm volatile("s_waitcnt lgkmcnt(0)" ::: "memory");
  float rli[16];
#pragma unroll
  for (int r = 0; r < 16; ++r) rli[r] = __builtin_amdgcn_rcpf(li_l[crow(r, hi)]);
  if (OUT_BF16) {
    bf16* Ow = (bf16*)a.out + (long)(a.qrow0 + wid * QBLK) * a.ldo + a.ocol;
#pragma unroll
    for (int r = 0; r < 16; ++r) { const int orow = crow(r, hi);
#pragma unroll
      for (int d0 = 0; d0 < 4; ++d0) Ow[(long)orow * a.ldo + d0 * 32 + r32] = (bf16)(cvtpk(o[d0][r] * rli[r], 0.f) & 0xffffu); }
  } else {
    float* Ow = (float*)a.out + (long)(a.qrow0 + wid * QBLK) * a.ldo + a.ocol;
#pragma unroll
    for (int r = 0; r < 16; ++r) { const int orow = crow(r, hi);
#pragma unroll
      for (int d0 = 0; d0 < 4; ++d0) Ow[(long)orow * a.ldo + d0 * 32 + r32] = o[d0][r] * rli[r]; }
  }
  __syncthreads();
#undef TROW
#undef SLOAD
#undef SWRITE
#undef SWAIT
#undef RESC
#undef WMASK
}

template <int LD>
__device__ __forceinline__ void dattn_unit(const bf16* qkv, int qrow0, int h, int ctxrow0, int latrow0, int n0, int n1, float lam, float gscale, const float* subg, bf16* AO,
                                           __attribute__((address_space(3))) unsigned char* L, char* lds) {
  typedef __attribute__((address_space(3))) unsigned char lds_b;
  const int tid = pg8::opaque_tid(), wid = __builtin_amdgcn_readfirstlane(tid >> 6), lane = tid & 63, r32 = lane & 31, hi = lane >> 5, g = wid & 3, c = wid >> 2;
  float* wsc = (float*)(lds + 132096 + wid * 256); float* li_l = wsc; float* al_l = wsc + 32;
  float m_reg = -1e30f, l_reg = 0.f; f32x16 o[8] = {}; bf16x8 qr[8];
  { const bf16* Qw = qkv + (long)(qrow0 + g * 32 + r32) * LD + (2 * h + c) * 128 + hi * 8;
#pragma unroll
    for (int d0 = 0; d0 < 8; ++d0) qr[d0] = *reinterpret_cast<const bf16x8*>(Qw + d0 * 16); }
  unsigned voK[2][2], voV[4];
#pragma unroll
  for (int cc = 0; cc < 2; ++cc)
#pragma unroll
    for (int i = 0; i < 2; ++i) { const int gi = i * 512 + tid, row = gi >> 4, cb = ((gi & 15) << 4) ^ ((row & 7) << 4); voK[cc][i] = (unsigned)((row * LD + 2048 + (2 * h + cc) * 128) * 2 + cb); }
#pragma unroll
  for (int i = 0; i < 4; ++i) { const int gi = i * 512 + tid, img = gi >> 10, o2 = (gi & 1023) << 4, st = o2 >> 9, e = (o2 & 511) >> 1, kk = (st >> 2) * 8 + (e >> 5);
    const int k = (kk & ~0xC) | ((kk & 4) << 1) | ((kk & 8) >> 1), col = (st & 3) * 32 + (e & 31); voV[i] = (unsigned)((k * LD + 4096 + h * 256 + img * 128 + col) * 2); }
  const int NT = n0 + n1;
#define DT_ROW(t) ((t) < n0 ? ctxrow0 + (t) * KVBLK : latrow0 + ((t) - n0) * KVBLK)
#define DT_DMA(t, b) do { const char* tb_ = (const char*)qkv + (size_t)DT_ROW(t) * (LD * 2); \
    _Pragma("unroll") for (int cc = 0; cc < 2; ++cc) _Pragma("unroll") for (int i = 0; i < 2; ++i) \
      __builtin_amdgcn_global_load_lds((const unsigned*)(tb_ + voK[cc][i]), (__attribute__((address_space(3))) unsigned*)(L + (b) * 32768 + cc * 16384 + i * 8192 + wid * 1024), 16, 0, 0); \
    _Pragma("unroll") for (int i = 0; i < 4; ++i) \
      __builtin_amdgcn_global_load_lds((const unsigned*)(tb_ + voV[i]), (__attribute__((address_space(3))) unsigned*)(L + 65536 + (b) * 32768 + i * 8192 + wid * 1024), 16, 0, 0); } while (0)
  DT_DMA(0, 0);
  if (1 < NT) DT_DMA(1, 1);
  if (1 < NT) asm volatile("s_waitcnt vmcnt(8)" ::: "memory"); else asm volatile("s_waitcnt vmcnt(0)" ::: "memory");
  __builtin_amdgcn_s_barrier(); asm volatile("" ::: "memory");
  for (int t = 0; t < NT; ++t) {
    const int b = t & 1;
    const bf16* Kt = (const bf16*)(lds + b * 32768 + c * 16384);
    const int vb = (int)(uintptr_t)(lds + 65536 + b * 32768) + v_rd_base(lane);
    f32x16 p0, p1; float mn, alpha; bf16x8 pa0, pa1, pa2, pa3;
    qkt(p0, p1, Kt, qr, r32, hi);
    partialSM(p0, p1, m_reg, mn, alpha);
    if (__any(alpha < 1.f)) { if (hi == 0) al_l[r32] = alpha; asm volatile("s_waitcnt lgkmcnt(0)" ::: "memory");
#pragma unroll
      for (int d = 0; d < 8; ++d)
#pragma unroll
        for (int r = 0; r < 16; ++r) o[d][r] *= al_l[crow(r, hi)]; }
    finishSM(p0, p1, alpha, l_reg, pa0, pa1, pa2, pa3);
    pv_one<0>(o[0], vb, pa0, pa1, pa2, pa3); pv_one<1>(o[1], vb, pa0, pa1, pa2, pa3); pv_one<2>(o[2], vb, pa0, pa1, pa2, pa3); pv_one<3>(o[3], vb, pa0, pa1, pa2, pa3);
    pv_one<0>(o[4], vb + 16384, pa0, pa1, pa2, pa3); pv_one<1>(o[5], vb + 16384, pa0, pa1, pa2, pa3); pv_one<2>(o[6], vb + 16384, pa0, pa1, pa2, pa3); pv_one<3>(o[7], vb + 16384, pa0, pa1, pa2, pa3);
    asm volatile("s_waitcnt lgkmcnt(0)" ::: "memory"); __builtin_amdgcn_s_barrier(); asm volatile("" ::: "memory");
    if (t + 2 < NT) { DT_DMA(t + 2, b); asm volatile("s_waitcnt vmcnt(8)" ::: "memory"); } else asm volatile("s_waitcnt vmcnt(0)" ::: "memory");
    __builtin_amdgcn_s_barrier(); asm volatile("" ::: "memory");
  }
#undef DT_ROW
#undef DT_DMA
  if (hi == 0) li_l[r32] = l_reg; asm volatile("s_waitcnt lgkmcnt(0)" ::: "memory");
#pragma unroll
  for (int r = 0; r < 16; ++r) { const float rl = __builtin_amdgcn_rcpf(li_l[crow(r, hi)]);
#pragma unroll
    for (int d = 0; d < 8; ++d) o[d][r] *= rl; }
  float* xch = (float*)(lds + g * 32768);
  if (c == 1) {
#pragma unroll
    for (int d = 0; d < 8; ++d)
#pragma unroll
      for (int r = 0; r < 16; ++r) xch[(d * 16 + r) * 64 + lane] = o[d][r]; }
  asm volatile("s_waitcnt lgkmcnt(0)" ::: "memory"); __builtin_amdgcn_s_barrier(); asm volatile("" ::: "memory");
  if (c == 0) {
    float gv[8];
#pragma unroll
    for (int d = 0; d < 8; ++d) gv[d] = subg[d * 32 + r32] * gscale;
#pragma unroll
    for (int r = 0; r < 16; ++r) { float s = 0.f;
#pragma unroll
      for (int d = 0; d < 8; ++d) { o[d][r] -= lam * xch[(d * 16 + r) * 64 + lane]; s += o[d][r] * o[d][r]; }
      for (int m_ = 1; m_ < 32; m_ <<= 1) s += __builtin_bit_cast(float, __builtin_amdgcn_ds_bpermute((lane ^ m_) << 2, __builtin_bit_cast(int, s)));
      const float rs = 1.0f / sqrtf(s * (1.0f / 256.0f) + 1e-6f);
      bf16* orow = AO + (long)(qrow0 + g * 32 + crow(r, hi)) * 2048 + h * 256 + r32;
#pragma unroll
      for (int d = 0; d < 8; ++d) orow[d * 32] = (bf16)(cvtpk(o[d][r] * rs * gv[d], 0.f) & 0xffffu); }
  }
  asm volatile("s_waitcnt vmcnt(0) lgkmcnt(0)" ::: "memory"); __builtin_amdgcn_s_barrier(); asm volatile("" ::: "memory");
}
#undef KSWZ
#undef SBAR
}

constexpr int NWAVES = 8;
constexpr int DM = 2048, NBATCH = 2, SEQ = 4096, MLAT = NBATCH * SEQ, CTXL = 256, MCTX = NBATCH * CTXL, MALL = MLAT + MCTX;
constexpr int DFF = 5504, NFC1 = 2 * DFF, NLAYER = 4, NMODC = 9 * DM;
constexpr int A_N = 3072, B_N = 12288, B_W = 6144, C_N = 6144;
constexpr float EPS = 1e-6f;
constexpr size_t MiB = 1u << 20;
constexpr size_t WS_CTL = 0, CTL_BYTES = 2 * MiB;
constexpr size_t WS_MODT = 2 * MiB;
constexpr size_t WS_ROPE = 3 * MiB;
constexpr size_t WS_XC = 5 * MiB;
constexpr size_t WS_STATS = 9 * MiB;
constexpr size_t WS_BSW = 10 * MiB;
constexpr size_t WS_SMALL = 10 * MiB + 512 * 1024;
constexpr int SM_SINK = 0, SM_VNG = 64, SM_VNB = SM_VNG + 6144, SM_BS = SM_VNB + 6144, SM_LQ1 = SM_BS + 1024, SM_LK1 = SM_LQ1 + 128, SM_LQ2 = SM_LK1 + 128, SM_LK2 = SM_LQ2 + 128, SM_SUBG = SM_LK2 + 128, SM_END = SM_SUBG + 256;
constexpr size_t WS_WFC1 = 11 * MiB;
constexpr size_t WS_WFC2 = WS_WFC1 + 344 * MiB;
constexpr size_t WS_WAIN = WS_WFC2 + 172 * MiB;
constexpr size_t WS_WAOUT = WS_WAIN + 24 * MiB;
constexpr size_t WS_WBIN = WS_WAOUT + 16 * MiB;
constexpr size_t WS_WBOUT = WS_WBIN + 48 * MiB;
constexpr size_t WS_WCIN = WS_WBOUT + 24 * MiB;
constexpr size_t WS_WCOUT = WS_WCIN + 24 * MiB;
constexpr size_t WS_H = WS_WCOUT + 8 * MiB;
constexpr size_t WS_HID = WS_H + 34 * MiB;
constexpr size_t WS_Y = WS_HID + 92 * MiB;
constexpr size_t WS_QKV = WS_Y + 68 * MiB;
constexpr size_t WS_AO = WS_QKV + 204 * MiB;
constexpr size_t WS_OC = WS_AO + 34 * MiB;
constexpr size_t WS_XB = WS_OC + 136 * MiB;
constexpr size_t WS_END = WS_XB + 34 * MiB;
static_assert((size_t)8 * NFC1 * DM * 2 <= 344 * MiB && (size_t)8 * DM * DFF * 2 <= 172 * MiB && (size_t)MALL * DFF * 2 <= 92 * MiB && (size_t)MALL * B_N * 2 <= 204 * MiB, "ws map");
constexpr int CW_PQ = 1024;
constexpr int CW_BAR = 4096;
constexpr int RING_BYTES = 131072, MISC_OFF = RING_BYTES + 320, LDS_BYTES = 147456;

#define GAS __attribute__((address_space(1)))
#define LAS __attribute__((address_space(3)))
typedef unsigned short bf16;
typedef unsigned v4u __attribute__((ext_vector_type(4)));
typedef unsigned v2u __attribute__((ext_vector_type(2)));
typedef float f32x4 __attribute__((ext_vector_type(4)));
typedef short bf16x8 __attribute__((ext_vector_type(8)));
typedef float f32x16 __attribute__((ext_vector_type(16)));
#define LDS_WAIT() asm volatile("s_waitcnt lgkmcnt(0)" ::: "memory")
#define VM_WAIT() asm volatile("s_waitcnt vmcnt(0)" ::: "memory")
__device__ __forceinline__ unsigned f2bf(float f) { unsigned u = __builtin_bit_cast(unsigned, f); return (u + 0x7fffu + ((u >> 16) & 1u)) >> 16; }
__device__ __forceinline__ unsigned pk2(float lo, float hi) { return f2bf(lo) | (f2bf(hi) << 16); }
__device__ __forceinline__ float bf2f(unsigned short b) { return __builtin_bit_cast(float, ((unsigned)b) << 16); }
__device__ __forceinline__ float lane_xor(float v, int lane, int mask) { return __builtin_bit_cast(float, __builtin_amdgcn_ds_bpermute((lane ^ mask) << 2, __builtin_bit_cast(int, v))); }
__device__ __forceinline__ float wave_sum(float v, int lane) {
#pragma unroll
    for (int o = 1; o < 64; o <<= 1) v += lane_xor(v, lane, o);
    return v;
}

#define XB_TMO      128
#define XB_XCNT(j)  (256  + 64 * (j))
#define XB_XSUB(j)  (1280 + 64 * (j))
#define XB_XGEN(j)  (2304 + 64 * (j))
#define XB_TOP      3328
#define XB_TOPGEN   3392
#define XCD_BAR_WORDS 3456
#define XB_SPIN_CAP (1u << 18)

__device__ __forceinline__ unsigned xb_ld(unsigned* p)              { return __hip_atomic_load(p, __ATOMIC_RELAXED, __HIP_MEMORY_SCOPE_AGENT); }
__device__ __forceinline__ unsigned xb_add(unsigned* p, unsigned v) { return __hip_atomic_fetch_add(p, v, __ATOMIC_RELAXED, __HIP_MEMORY_SCOPE_AGENT); }
__device__ __forceinline__ unsigned xb_xcc_id() { return (unsigned)__builtin_amdgcn_s_getreg((3 << 11) | 20) & 0xFu; }
#define XB_SPIN(cond, bar) do { unsigned _sp = 0; while (cond) { __builtin_amdgcn_s_sleep(1); \
    if ((++_sp & 255u) == 0u) { if (xb_ld(&(bar)[XB_TMO])) break; if (_sp > XB_SPIN_CAP) { atomicAdd(&(bar)[XB_TMO], 1u); break; } } } } while (0)

struct XcdBarrier {
    unsigned* bar; unsigned x;
    volatile LAS unsigned* st;
};

__device__ __forceinline__ XcdBarrier xcd_barrier_post(unsigned* bar, volatile LAS unsigned* st) {
    XcdBarrier b; b.bar = bar; b.x = xb_xcc_id(); b.st = st;
    if (threadIdx.x == 0) (void)xb_add(&bar[XB_XCNT(b.x)], 1u);
    return b;
}
__device__ __forceinline__ void xcd_barrier_complete(unsigned* bar, unsigned x, unsigned& nloc, unsigned& nx) {
    const unsigned G = gridDim.x * gridDim.y * gridDim.z;
    unsigned sum, cnt, mine, sp = 0u;
    for (;;) {
        sum = 0u; cnt = 0u; mine = 0u;
#pragma unroll
        for (unsigned j = 0; j < 16; ++j) { const unsigned c = xb_ld(&bar[XB_XCNT(j)]); sum += c; cnt += (c > 0u) ? 1u : 0u; mine = (j == x) ? c : mine; }
        if (sum == G) break;
        __builtin_amdgcn_s_sleep(1);
        if ((++sp & 255u) == 0u) { if (xb_ld(&bar[XB_TMO])) break; if (sp > XB_SPIN_CAP) { atomicAdd(&bar[XB_TMO], 1u); break; } }
    }
    nloc = mine > 0u ? mine : 1u; nx = cnt > 0u ? cnt : 1u;
}

__device__ __forceinline__ void xcd_barrier(const XcdBarrier& b) {
    asm volatile("s_waitcnt vmcnt(0)" ::: "memory");
    __syncthreads();
    if (threadIdx.x == 0) {
        unsigned* bar = b.bar;
        __builtin_amdgcn_s_waitcnt(0);
        unsigned nloc = b.st[0], nx = b.st[1];
        if (nloc == 0u) { xcd_barrier_complete(bar, b.x, nloc, nx); b.st[0] = nloc; b.st[1] = nx; }
        const unsigned old = xb_add(&bar[XB_XSUB(b.x)], 1u);
        const unsigned gen = old / nloc;
        if (old + 1u == (gen + 1u) * nloc) {
            __builtin_amdgcn_fence(__ATOMIC_RELEASE, "agent");
            asm volatile("s_waitcnt vmcnt(0)" ::: "memory");
            const unsigned og = xb_add(&bar[XB_TOP], 1u);
            const unsigned tg = og / nx;
            if (og + 1u == (tg + 1u) * nx) xb_add(&bar[XB_TOPGEN], 1u);
            else XB_SPIN(xb_ld(&bar[XB_TOPGEN]) == tg, bar);
            __builtin_amdgcn_fence(__ATOMIC_ACQUIRE, "agent");
            xb_add(&bar[XB_XGEN(b.x)], 1u);
            asm volatile("s_waitcnt vmcnt(0)" ::: "memory");
        } else {
            XB_SPIN(xb_ld(&bar[XB_XGEN(b.x)]) == gen, bar);
            __builtin_amdgcn_fence(__ATOMIC_ACQUIRE, "agent");
            asm volatile("s_waitcnt vmcnt(0)" ::: "memory");
        }
    }
    __syncthreads();
}

__device__ __forceinline__ void transpose_item(const float* W, int K, int N, bf16* WT, int fc1map, LAS float* scr, int item, int lane) {
    const int nblk = N / 32, kb = item / nblk, nb = item % nblk, k0 = 64 * kb, n0 = 32 * nb;
    int rowbase = n0;
    if (fc1map) { rowbase = (n0 < DFF) ? 256 * (n0 / 128) + (n0 % 128) : 256 * ((n0 - DFF) / 128) + 128 + ((n0 - DFF) % 128); }
    float tv[32];
#pragma unroll
    for (int i = 0; i < 32; ++i) tv[i] = W[(size_t)(k0 + 2 * i + (lane >> 5)) * N + n0 + (lane & 31)];
#pragma unroll
    for (int i = 0; i < 32; ++i) scr[(2 * i + (lane >> 5)) * 33 + (lane & 31)] = tv[i];
    LDS_WAIT(); asm volatile("" ::: "memory");
    const int c = lane & 7;
#pragma unroll
    for (int j = 0; j < 4; ++j) { const int n = (lane >> 3) + 8 * j; const LAS float* s = scr + (8 * c) * 33 + n;
        v4u o; o.x = pk2(s[0 * 33], s[1 * 33]); o.y = pk2(s[2 * 33], s[3 * 33]); o.z = pk2(s[4 * 33], s[5 * 33]); o.w = pk2(s[6 * 33], s[7 * 33]);
        *(GAS v4u*)(WT + (size_t)(rowbase + n) * K + k0 + 8 * c) = o; }
    LDS_WAIT(); asm volatile("" ::: "memory");
}

struct KArgs { const float* in[25]; float* out; unsigned char* ws; int ph_lo, ph_hi, li; float lam_init; float gscale; int pad0, pad1, pad2; };

__device__ __forceinline__ float* modt(unsigned char* ws, int layer, int slot, int modrow, int which) { return (float*)(ws + WS_MODT) + ((size_t)(((layer * 3 + slot) * 3 + modrow) * 3 + which)) * DM; }

__device__ __forceinline__ void prologue_phase(const KArgs& args, LAS unsigned char* L, int bx, int G) {
    const int tid = pg8::opaque_tid(), lane = tid & 63, wave = __builtin_amdgcn_readfirstlane(tid >> 6);
    unsigned char* ws = args.ws;
    LAS float* sl = (LAS float*)L;
    for (int i = tid; i < 3 * DM; i += NWAVES * 64) { const int r = i / DM, k = i % DM; const float v = (r < 2) ? args.in[1][r * DM + k] : args.in[3][k]; sl[i] = v / (1.0f + expf(-v)); }
    __syncthreads();
    LAS float* part = (LAS float*)(L + 24576);
    for (int rep_ = 0; rep_ < (PROBE_ID == 11 ? 2 : 1); ++rep_)
    for (int item = bx; item < NLAYER * 72; item += G) {
        const int layer = item / 72, n0 = (item % 72) * 256;
        const float* W = args.in[4] + ((size_t)layer * DM + wave * 256) * NMODC + n0 + lane * 4;
        const LAS float* s0 = sl + wave * 256;
        f32x4 a0 = {0.f, 0.f, 0.f, 0.f}, a1 = a0, a2 = a0;
#pragma unroll 8
        for (int kk = 0; kk < 256; ++kk) { const f32x4 w = *(const f32x4*)(W + (size_t)kk * NMODC); a0 += w * s0[kk]; a1 += w * s0[DM + kk]; a2 += w * s0[2 * DM + kk]; }
        *(LAS f32x4*)(part + (wave * 3 + 0) * 256 + lane * 4) = a0; *(LAS f32x4*)(part + (wave * 3 + 1) * 256 + lane * 4) = a1; *(LAS f32x4*)(part + (wave * 3 + 2) * 256 + lane * 4) = a2;
        __syncthreads();
        for (int idx = tid; idx < 768; idx += NWAVES * 64) { const int r = idx >> 8, cc = idx & 255, n = n0 + cc; float m = args.in[5][layer * NMODC + n];
#pragma unroll
            for (int w = 0; w < 8; ++w) m += part[(w * 3 + r) * 256 + cc];
            const int k9 = n / DM, c = n % DM, s = k9 / 3, which = k9 % 3; const float* g = args.in[6] + (size_t)layer * 6 * DM;
            if (which == 0) modt(ws, layer, s, r, 2)[c] = m;
            else if (which == 1) modt(ws, layer, s, r, 1)[c] = g[(2 * s) * DM + c] * (1.0f + m);
            else modt(ws, layer, s, r, 0)[c] = (s == 1 ? 1.0f : 0.5f) * m * g[(2 * s + 1) * DM + c]; }
        __syncthreads();
    }
    {
        LAS float* scr = (LAS float*)(L + 49152 + wave * 8448);
        const int gw = bx * NWAVES + wave, NGW = G * NWAVES;
        constexpr int I_FC1 = (DM / 64) * (NFC1 / 32), I_FC2 = (DFF / 64) * (DM / 32), I_AIN = (DM / 64) * (A_N / 32), I_SQ = (DM / 64) * (DM / 32), I_BIN = (DM / 64) * (B_N / 32), I_BOUT = (B_W / 64) * (DM / 32), I_CIN = (DM / 64) * (C_N / 32);
        constexpr int NITEMS = 8 * I_FC1 + 8 * I_FC2 + 2 * I_AIN + 2 * I_SQ + I_BIN + I_BOUT + I_CIN + I_SQ;
        const int nheavy = (NLAYER * 72 > G) ? (NLAYER * 72 - G) : 0, SKIP_R = 24, nlightw = (G - nheavy) * NWAVES;
        const bool heavy = bx < nheavy;
        for (int rep_ = 0; rep_ < (PROBE_ID == 12 ? 2 : 1); ++rep_)
        for (int rnd = heavy ? SKIP_R : 0;; ++rnd) {
            const int it = (rnd < SKIP_R) ? rnd * nlightw + (gw - nheavy * NWAVES) : SKIP_R * nlightw + (rnd - SKIP_R) * NGW + gw;
            if (it >= NITEMS) break;
            int r = it;
            if (r < 8 * I_FC1) { const int mat = r / I_FC1; transpose_item(args.in[7] + (size_t)mat * DM * NFC1, DM, NFC1, (bf16*)(ws + WS_WFC1) + (size_t)mat * NFC1 * DM, 1, scr, r % I_FC1, lane); continue; } r -= 8 * I_FC1;
            if (r < 8 * I_FC2) { const int mat = r / I_FC2; transpose_item(args.in[8] + (size_t)mat * DFF * DM, DFF, DM, (bf16*)(ws + WS_WFC2) + (size_t)mat * DM * DFF, 0, scr, r % I_FC2, lane); continue; } r -= 8 * I_FC2;
            if (r < 2 * I_AIN) { const int mat = r / I_AIN; transpose_item(args.in[9] + (size_t)mat * DM * A_N, DM, A_N, (bf16*)(ws + WS_WAIN) + (size_t)mat * A_N * DM, 0, scr, r % I_AIN, lane); continue; } r -= 2 * I_AIN;
            if (r < 2 * I_SQ) { const int mat = r / I_SQ; transpose_item(args.in[10] + (size_t)mat * DM * DM, DM, DM, (bf16*)(ws + WS_WAOUT) + (size_t)mat * DM * DM, 0, scr, r % I_SQ, lane); continue; } r -= 2 * I_SQ;
            if (r < I_BIN) { transpose_item(args.in[12], DM, B_N, (bf16*)(ws + WS_WBIN), 0, scr, r, lane); continue; } r -= I_BIN;
            if (r < I_BOUT) { transpose_item(args.in[17], B_W, DM, (bf16*)(ws + WS_WBOUT), 0, scr, r, lane); continue; } r -= I_BOUT;
            if (r < I_CIN) { transpose_item(args.in[18], DM, C_N, (bf16*)(ws + WS_WCIN), 0, scr, r, lane); continue; } r -= I_CIN;
            transpose_item(args.in[19], DM, DM, (bf16*)(ws + WS_WCOUT), 0, scr, r, lane);
        }
    }
    for (int rep_ = 0; rep_ < (PROBE_ID == 13 ? 2 : 1); ++rep_)
    for (int e = bx * NWAVES * 64 + tid; e < SEQ * 64; e += G * NWAVES * 64) { const int t = e >> 6, p = e & 63, pi = p & 31;
        const float inv = (float)pow(10000.0, -(double)pi / 32.0); const float ang = (float)((p < 32) ? (t >> 6) : (t & 63)) * inv;
        float* o = (float*)(ws + WS_ROPE) + (size_t)e * 2; o[0] = (float)cos((double)ang); o[1] = (float)sin((double)ang); }
    for (int e = bx * NWAVES * 64 + tid; e < 8 * 128 * 128; e += G * NWAVES * 64) ((bf16*)(ws + WS_BSW))[e] = (bf16)f2bf(args.in[15][e]);
    if (bx == 0) { float* sm = (float*)(ws + WS_SMALL);
        for (int e = tid; e < SM_END; e += NWAVES * 64) { float v = 0.f;
            if (e < SM_VNG) { if (e < 32) v = args.in[11][e]; }
            else if (e < SM_VNB) v = args.in[13][e - SM_VNG];
            else if (e < SM_BS) v = args.in[14][e - SM_VNB];
            else if (e < SM_LQ1) v = args.in[16][e - SM_BS];
            else if (e < SM_LK1) v = args.in[20][e - SM_LQ1];
            else if (e < SM_LQ2) v = args.in[21][e - SM_LK1];
            else if (e < SM_LK2) v = args.in[22][e - SM_LQ2];
            else if (e < SM_SUBG) v = args.in[23][e - SM_LK2];
            else v = args.in[24][e - SM_SUBG];
            sm[e] = v; } }
}

__device__ __forceinline__ f32x4 ld4_x(const void* p, bool f32src) {
    if (f32src) return *(const f32x4*)p;
    const v2u raw = *(const v2u*)p; f32x4 r; r.x = __builtin_bit_cast(float, raw.x << 16); r.y = __builtin_bit_cast(float, raw.x & 0xffff0000u); r.z = __builtin_bit_cast(float, raw.y << 16); r.w = __builtin_bit_cast(float, raw.y & 0xffff0000u); return r;
}
__device__ __forceinline__ void st4_x(void* p, f32x4 v, bool f32dst) { if (f32dst) *(f32x4*)p = v; else { v2u o; o.x = pk2(v.x, v.y); o.y = pk2(v.z, v.w); *(v2u*)p = o; } }
__device__ __forceinline__ void norm_phase(const void* xs_lat, const void* xs_ctx, bool f32src, void* xd_lat, void* xd_ctx, bool f32dst, const bf16* Y, const float* postT, const float* preT, bf16* H, int nrows, LAS unsigned char* L, float oscale = 1.0f) {
    const int tid = pg8::opaque_tid(), lane = tid & 63, wave = __builtin_amdgcn_readfirstlane(tid >> 6), gw = blockIdx.x * NWAVES + wave, NGW = gridDim.x * NWAVES;
    const int nlat = nrows < MLAT ? nrows : MLAT, ssz = f32src ? 4 : 2, dsz = f32dst ? 4 : 2;
    for (int row = gw; row < nlat; row += NGW) {
        const int modrow = row < SEQ ? 0 : 1;
        const char* xs = (const char*)xs_lat + (size_t)row * DM * ssz; char* xd = (char*)xd_lat + (size_t)row * DM * dsz;
        f32x4 xv[8];
#pragma unroll
        for (int j = 0; j < 8; ++j) xv[j] = ld4_x(xs + (256 * j + 4 * lane) * ssz, f32src);
        if (Y) {
            const bf16* yr = Y + (size_t)row * DM; const float* At = postT + (size_t)modrow * 3 * DM;
            f32x4 yv[8]; float ss = 0.f;
#pragma unroll
            for (int j = 0; j < 8; ++j) { yv[j] = ld4_x(yr + 256 * j + 4 * lane, false); ss += (yv[j].x * yv[j].x + yv[j].y * yv[j].y) + (yv[j].z * yv[j].z + yv[j].w * yv[j].w); }
            const float ry = 1.0f / sqrtf(wave_sum(ss, lane) * (1.0f / DM) + EPS);
#pragma unroll
            for (int j = 0; j < 8; ++j) { const f32x4 a = *(const f32x4*)(At + 256 * j + 4 * lane); xv[j] += yv[j] * ry * a; }
        }
#pragma unroll
        for (int j = 0; j < 8; ++j) st4_x(xd + (256 * j + 4 * lane) * dsz, (PROBE_ID >= 20) ? xv[j] * oscale : xv[j], f32dst);
        if (H) {
            const float* Bt = preT + (size_t)(modrow * 3 + 1) * DM; const float* Ct = preT + (size_t)(modrow * 3 + 2) * DM;
            float ss = 0.f;
#pragma unroll
            for (int j = 0; j < 8; ++j) ss += (xv[j].x * xv[j].x + xv[j].y * xv[j].y) + (xv[j].z * xv[j].z + xv[j].w * xv[j].w);
            const float rx = 1.0f / sqrtf(wave_sum(ss, lane) * (1.0f / DM) + EPS);
            bf16* hr = H + (size_t)row * DM;
#pragma unroll
            for (int j = 0; j < 8; ++j) { const f32x4 b = *(const f32x4*)(Bt + 256 * j + 4 * lane), c = *(const f32x4*)(Ct + 256 * j + 4 * lane); const f32x4 h = xv[j] * rx * b + c;
                v2u o; o.x = pk2(h.x, h.y); o.y = pk2(h.z, h.w); *(v2u*)(hr + 256 * j + 4 * lane) = o; }
        }
    }
    if (nrows > MLAT) {
        LAS float* red = (LAS float*)L;
        const int rsel = wave >> 2, qtr = wave & 3;
        for (int base = 2 * (int)blockIdx.x; base < MCTX; base += 2 * (int)gridDim.x) {
            const int cr = base + rsel; const char* xs = (const char*)xs_ctx + ((size_t)cr * DM + 512 * qtr) * ssz; char* xd = (char*)xd_ctx + ((size_t)cr * DM + 512 * qtr) * dsz;
            f32x4 xv[2];
#pragma unroll
            for (int j = 0; j < 2; ++j) xv[j] = ld4_x(xs + (256 * j + 4 * lane) * ssz, f32src);
            if (Y) {
                const bf16* yr = Y + (size_t)(MLAT + cr) * DM + 512 * qtr; const float* At = postT + (size_t)2 * 3 * DM + 512 * qtr;
                f32x4 yv[2]; float ss = 0.f;
#pragma unroll
                for (int j = 0; j < 2; ++j) { yv[j] = ld4_x(yr + 256 * j + 4 * lane, false); ss += (yv[j].x * yv[j].x + yv[j].y * yv[j].y) + (yv[j].z * yv[j].z + yv[j].w * yv[j].w); }
                ss = wave_sum(ss, lane); if (lane == 0) red[wave] = ss;
                __syncthreads();
                const float ry = 1.0f / sqrtf(((red[rsel * 4] + red[rsel * 4 + 1]) + (red[rsel * 4 + 2] + red[rsel * 4 + 3])) * (1.0f / DM) + EPS);
#pragma unroll
                for (int j = 0; j < 2; ++j) { const f32x4 a = *(const f32x4*)(At + 256 * j + 4 * lane); xv[j] += yv[j] * ry * a; }
            }
#pragma unroll
            for (int j = 0; j < 2; ++j) st4_x(xd + (256 * j + 4 * lane) * dsz, xv[j], f32dst);
            if (H) {
                const float* Bt = preT + (size_t)(2 * 3 + 1) * DM + 512 * qtr; const float* Ct = preT + (size_t)(2 * 3 + 2) * DM + 512 * qtr;
                float ss = 0.f;
#pragma unroll
                for (int j = 0; j < 2; ++j) ss += (xv[j].x * xv[j].x + xv[j].y * xv[j].y) + (xv[j].z * xv[j].z + xv[j].w * xv[j].w);
                ss = wave_sum(ss, lane); if (lane == 0) red[8 + wave] = ss;
                __syncthreads();
                const float rx = 1.0f / sqrtf(((red[8 + rsel * 4] + red[8 + rsel * 4 + 1]) + (red[8 + rsel * 4 + 2] + red[8 + rsel * 4 + 3])) * (1.0f / DM) + EPS);
                bf16* hr = H + (size_t)(MLAT + cr) * DM + 512 * qtr;
#pragma unroll
                for (int j = 0; j < 2; ++j) { const f32x4 b = *(const f32x4*)(Bt + 256 * j + 4 * lane), c = *(const f32x4*)(Ct + 256 * j + 4 * lane); const f32x4 h = xv[j] * rx * b + c;
                    v2u o; o.x = pk2(h.x, h.y); o.y = pk2(h.z, h.w); *(v2u*)(hr + 256 * j + 4 * lane) = o; }
            }
            __syncthreads();
        }
    }
}
__device__ __forceinline__ void vstats_phase(const bf16* QKV, float* stats, int nrows) {
    const int tid = pg8::opaque_tid(), lane = tid & 63, gw = blockIdx.x * NWAVES + __builtin_amdgcn_readfirstlane(tid >> 6), NGW = gridDim.x * NWAVES;
    for (int row = gw; row < nrows; row += NGW) {
        const bf16* vr = QKV + (size_t)row * B_N + B_W + lane * 8; bf16x8 raw[12]; float s = 0.f;
#pragma unroll
        for (int i = 0; i < 12; ++i) { raw[i] = *(const bf16x8*)(vr + i * 512);
#pragma unroll
            for (int e = 0; e < 8; ++e) s += bf2f((unsigned short)raw[i][e]); }
        const float mean = wave_sum(s, lane) * (1.0f / B_W); float q = 0.f;
#pragma unroll
        for (int i = 0; i < 12; ++i)
#pragma unroll
            for (int e = 0; e < 8; ++e) { const float d = bf2f((unsigned short)raw[i][e]) - mean; q += d * d; }
        const float rstd = 1.0f / sqrtf(wave_sum(q, lane) * (1.0f / B_W) + EPS);
        if (lane == 0) { stats[2 * row] = mean; stats[2 * row + 1] = rstd; }
    }
}
__device__ __forceinline__ void spatial_phase(const bf16* QKV, bf16* Gout, const bf16* BSW, const float* stats, const float* vg, const float* vb, const float* bs, char* lds, int nchunks, int bx, int G) {
    const int tid = pg8::opaque_tid(), lane = tid & 63, wave = __builtin_amdgcn_readfirstlane(tid >> 6), r32 = lane & 31, hi = lane >> 5;
    constexpr int OP = 132;
    float* Ob = (float*)(lds + 32768);
    const int sr = tid >> 4, sc = (tid & 15) * 8, pb = wave & 3, dh = wave >> 2;
    for (int u = bx; u < nchunks * 48; u += G) {
        const int cb = u % 6, g = (u / 6) & 7, ch = u / 48, row0 = ch * 128, c0 = g * 768 + cb * 128;
        bf16x8 ureg[4];
#pragma unroll
        for (int i = 0; i < 4; ++i) ureg[i] = *(const bf16x8*)(QKV + (size_t)(row0 + sr + 32 * i) * B_N + c0 + sc);
        { const f32x4 g0 = *(const f32x4*)(vg + c0 + sc), g1 = *(const f32x4*)(vg + c0 + sc + 4), b0 = *(const f32x4*)(vb + c0 + sc), b1 = *(const f32x4*)(vb + c0 + sc + 4);
#pragma unroll
          for (int i = 0; i < 4; ++i) { const int q = sr + 32 * i; const bf16x8 raw = *(const bf16x8*)(QKV + (size_t)(row0 + q) * B_N + B_W + c0 + sc);
              const float mu = stats[2 * (row0 + q)], rs = stats[2 * (row0 + q) + 1]; float t[8];
#pragma unroll
              for (int e = 0; e < 8; ++e) t[e] = (bf2f((unsigned short)raw[e]) - mu) * rs * (e < 4 ? g0[e & 3] : g1[e & 3]) + (e < 4 ? b0[e & 3] : b1[e & 3]);
              v4u w; w.x = pk2(t[0], t[1]); w.y = pk2(t[2], t[3]); w.z = pk2(t[4], t[5]); w.w = pk2(t[6], t[7]);
              *(v4u*)(lds + (i >> 1) * 16384 + att::v_st(sr + 32 * (i & 1), sc)) = w; } }
        __syncthreads();
        bf16x8 pa[2][4];
        { const bf16* Wg = BSW + (size_t)g * 16384 + (size_t)(pb * 32 + r32) * 128 + hi * 8;
#pragma unroll
          for (int kt = 0; kt < 2; ++kt)
#pragma unroll
              for (int kk = 0; kk < 4; ++kk) pa[kt][kk] = *(const bf16x8*)(Wg + kt * 64 + kk * 16); }
        f32x16 o0 = {}, o1 = {};
#pragma unroll
        for (int kt = 0; kt < 2; ++kt) { const int vbase = (int)(uintptr_t)(lds + kt * 16384) + att::v_rd_base(lane);
            if (dh == 0) { att::pv_one<0>(o0, vbase, pa[kt][0], pa[kt][1], pa[kt][2], pa[kt][3]); att::pv_one<1>(o1, vbase, pa[kt][0], pa[kt][1], pa[kt][2], pa[kt][3]); }
            else { att::pv_one<2>(o0, vbase, pa[kt][0], pa[kt][1], pa[kt][2], pa[kt][3]); att::pv_one<3>(o1, vbase, pa[kt][0], pa[kt][1], pa[kt][2], pa[kt][3]); } }
#pragma unroll
        for (int r = 0; r < 16; ++r) { const int p = pb * 32 + (r & 3) + 8 * (r >> 2) + 4 * hi; Ob[p * OP + dh * 64 + r32] = o0[r]; Ob[p * OP + dh * 64 + 32 + r32] = o1[r]; }
        __syncthreads();
#pragma unroll
        for (int i = 0; i < 4; ++i) { const int p = sr + 32 * i; const float bias = bs[g * 128 + p];
            const f32x4 x0 = *(const f32x4*)(Ob + p * OP + sc), x1 = *(const f32x4*)(Ob + p * OP + sc + 4); float t[8];
#pragma unroll
            for (int e = 0; e < 8; ++e) t[e] = bf2f((unsigned short)ureg[i][e]) * ((e < 4 ? x0[e & 3] : x1[e & 3]) + bias);
            v4u w; w.x = pk2(t[0], t[1]); w.y = pk2(t[2], t[3]); w.z = pk2(t[4], t[5]); w.w = pk2(t[6], t[7]);
            pg8::st16(Gout + (size_t)(row0 + p) * B_W + c0 + sc, w); }
        __syncthreads();
    }
}
__device__ __forceinline__ void combine_phase(const float* OC, bf16* AO, const float* lq1, const float* lk1, const float* lq2, const float* lk2, const float* sg, float lam_init, int nrows) {
    const int tid = pg8::opaque_tid(), lane = tid & 63, gw = blockIdx.x * NWAVES + __builtin_amdgcn_readfirstlane(tid >> 6), NGW = gridDim.x * NWAVES;
    const float d1 = wave_sum(lq1[lane] * lk1[lane] + lq1[lane + 64] * lk1[lane + 64], lane), d2 = wave_sum(lq2[lane] * lk2[lane] + lq2[lane + 64] * lk2[lane + 64], lane);
    const float lam = expf(d1) - expf(d2) + lam_init;
    const f32x4 gv = *(const f32x4*)(sg + 4 * lane) * (1.0f - lam_init);
    for (int row = gw; row < nrows; row += NGW) {
        const float* orow = OC + (size_t)row * 4096; bf16* ar = AO + (size_t)row * DM;
#pragma unroll
        for (int h = 0; h < 8; ++h) { const f32x4 a = *(const f32x4*)(orow + (2 * h) * 256 + 4 * lane), b = *(const f32x4*)(orow + (2 * h + 1) * 256 + 4 * lane); const f32x4 o = a - lam * b;
            const float rs = 1.0f / sqrtf(wave_sum((o.x * o.x + o.y * o.y) + (o.z * o.z + o.w * o.w), lane) * (1.0f / 256.0f) + EPS); const f32x4 v = o * rs * gv;
            v2u w; w.x = pk2(v.x, v.y); w.y = pk2(v.z, v.w); *(v2u*)(ar + h * 256 + 4 * lane) = w; }
    }
}

template <int K, int LDA, int EPI>
__device__ __forceinline__ void ctx_tile(const bf16* A, const bf16* Bt, bf16* out, int ldc, int ntn, int tile, LAS unsigned char* L) {
    const int tid = pg8::opaque_tid(), lane = tid & 63, wave = __builtin_amdgcn_readfirstlane(tid >> 6), r32 = lane & 31, hi = lane >> 5;
    const int tm = tile / ntn, row0 = tm * 64, col0 = (tile - tm * ntn) * 64;
    constexpr int NB = K / 64;
    static_assert(K % 64 == 0, "K must be a multiple of 64");
    LAS unsigned char* W = L + wave * 16384;
    const int lr = lane >> 3, lc = lane & 7;
    const bf16* ag = A + (size_t)(row0 + lr) * LDA + lc * 8;
    const bf16* bg = Bt + (size_t)(col0 + lr) * K + lc * 8;
    const int wofs = lr * 128 + ((lc ^ (lr & 7)) << 4);
    const int rofs = r32 * 128;
    f32x16 acc00 = {}, acc01 = {}, acc10 = {}, acc11 = {};
    bf16x8 ga0[8], gb0[8], ga1[8], gb1[8];
#define CT_LOAD(GA, GB, kb_) do { _Pragma("unroll") for (int i = 0; i < 8; ++i) { GA[i] = *(const bf16x8*)(ag + (size_t)(8 * i) * LDA + (kb_) * 64); GB[i] = *(const bf16x8*)(bg + (size_t)(8 * i) * K + (kb_) * 64); } } while (0)
#define CT_STORE(GA, GB) do { _Pragma("unroll") for (int i = 0; i < 8; ++i) { *(LAS bf16x8*)(W + i * 1024 + wofs) = GA[i]; *(LAS bf16x8*)(W + 8192 + i * 1024 + wofs) = GB[i]; } } while (0)
#define CT_MMA() do { _Pragma("unroll") for (int s = 0; s < 4; ++s) { const int ch = (((2 * s + hi) ^ (r32 & 7)) << 4); \
        const bf16x8 a0 = *(const LAS bf16x8*)(W + rofs + ch), a1 = *(const LAS bf16x8*)(W + 4096 + rofs + ch), b0 = *(const LAS bf16x8*)(W + 8192 + rofs + ch), b1 = *(const LAS bf16x8*)(W + 12288 + rofs + ch); \
        acc00 = __builtin_amdgcn_mfma_f32_32x32x16_bf16(a0, b0, acc00, 0, 0, 0); acc01 = __builtin_amdgcn_mfma_f32_32x32x16_bf16(a0, b1, acc01, 0, 0, 0); \
        acc10 = __builtin_amdgcn_mfma_f32_32x32x16_bf16(a1, b0, acc10, 0, 0, 0); acc11 = __builtin_amdgcn_mfma_f32_32x32x16_bf16(a1, b1, acc11, 0, 0, 0); } } while (0)
    int kb = wave;
    if (kb < NB) CT_LOAD(ga0, gb0, kb);
    if (kb + 8 < NB) CT_LOAD(ga1, gb1, kb + 8);
    for (; kb < NB; kb += 16) {
        CT_STORE(ga0, gb0);
        if (kb + 16 < NB) CT_LOAD(ga0, gb0, kb + 16);
        CT_MMA();
        if (kb + 8 < NB) {
            CT_STORE(ga1, gb1);
            if (kb + 24 < NB) CT_LOAD(ga1, gb1, kb + 24);
            CT_MMA();
        }
    }
#undef CT_LOAD
#undef CT_STORE
#undef CT_MMA
    LDS_WAIT(); asm volatile("" ::: "memory");
    LAS float* red = (LAS float*)L + wave * 4096;
#pragma unroll
    for (int r = 0; r < 16; ++r) { const int m = (r & 3) + 8 * (r >> 2) + 4 * hi;
        red[m * 64 + r32] = acc00[r]; red[m * 64 + 32 + r32] = acc01[r]; red[(32 + m) * 64 + r32] = acc10[r]; red[(32 + m) * 64 + 32 + r32] = acc11[r]; }
    __syncthreads();
    { const int o = tid * 8, m = o >> 6, n = o & 63; f32x4 s0 = {0.f, 0.f, 0.f, 0.f}, s1 = s0;
#pragma unroll
      for (int w = 0; w < 8; ++w) { s0 += *(const LAS f32x4*)((LAS float*)L + w * 4096 + o); s1 += *(const LAS f32x4*)((LAS float*)L + w * 4096 + o + 4); }
      if (EPI == 1) {
#pragma unroll
          for (int j = 0; j < 4; ++j) { s0[j] = pg8::gelu_tanh(s0[j]); s1[j] = pg8::gelu_tanh(s1[j]); } }
      v4u w4; w4.x = pk2(s0.x, s0.y); w4.y = pk2(s0.z, s0.w); w4.z = pk2(s1.x, s1.y); w4.w = pk2(s1.z, s1.w);
      pg8::st16(out + (size_t)(row0 + m) * ldc + col0 + n, w4); }
    __syncthreads();
}

__global__ void __launch_bounds__(NWAVES * 64, 2) fwd(KArgs args) {
    extern __shared__ __attribute__((aligned(16))) unsigned char lds[];
    LAS unsigned char* L = (LAS unsigned char*)lds;
    const int tid = threadIdx.x, G = gridDim.x, bx = blockIdx.x;
    unsigned char* ws0 = args.ws;
    for (int u = tid; u < (LDS_BYTES - RING_BYTES) / 4; u += NWAVES * 64) ((LAS unsigned*)(L + RING_BYTES))[u] = 0u;
    __syncthreads();
    const int lo = args.ph_lo, hi = args.ph_hi;
    XcdBarrier bar; bar.bar = (unsigned*)(ws0 + WS_CTL) + CW_BAR + args.li * XCD_BAR_WORDS; bar.x = 0; bar.st = (volatile LAS unsigned*)(L + MISC_OFF + 32);
    if (hi - lo > 1) bar = xcd_barrier_post((unsigned*)(ws0 + WS_CTL) + CW_BAR + args.li * XCD_BAR_WORDS, (volatile LAS unsigned*)(L + MISC_OFF + 32));
    int ph = 0; unsigned long long bacc_ = 0; (void)bacc_;
#define PHASE_BEGIN if (ph >= lo && ph < hi) {
#define PHASE_END   if (ph + 1 < hi) { unsigned long long br0_ = 0; if (PROBE_ID == 21 || PROBE_ID == 22) br0_ = wall_clock64(); xcd_barrier(bar); \
        if ((PROBE_ID == 21 || PROBE_ID == 22) && threadIdx.x == 0) { const unsigned dt_ = (unsigned)(wall_clock64() - br0_); \
            if (PROBE_ID == 21) atomicAdd((unsigned*)(args.ws + WS_CTL) + 2048, dt_); else atomicMin((unsigned*)(args.ws + WS_CTL) + 2304 + ph, dt_); } } } ++ph;
#define SETUP_PTRS() GAS unsigned char* wsg_ = (GAS unsigned char*)args.ws; asm volatile("" : "+s"(wsg_)); unsigned char* ws = (unsigned char*)wsg_; \
    GAS float* xlg_ = (GAS float*)args.out; asm volatile("" : "+s"(xlg_)); float* XL = (float*)xlg_; bf16* XB = (bf16*)(ws + WS_XB); \
    bf16* H = (bf16*)(ws + WS_H); bf16* HID = (bf16*)(ws + WS_HID); bf16* Y = (bf16*)(ws + WS_Y); bf16* QKV = (bf16*)(ws + WS_QKV); bf16* AO = (bf16*)(ws + WS_AO); float* OC = (float*)(ws + WS_OC); \
    const float* ROPE = (const float*)(ws + WS_ROPE); const float* SM = (const float*)(ws + WS_SMALL); (void)XB; (void)XL; (void)HID; (void)Y; (void)QKV; (void)AO; (void)OC; (void)ROPE; (void)SM; (void)H

    if (PROBE_ID == 22 && bx == 0 && threadIdx.x < 64) ((unsigned*)(args.ws + WS_CTL) + 2304)[threadIdx.x] = 0xffffffffu;
    { SETUP_PTRS();
    PHASE_BEGIN
#ifndef OFF_PRO
    prologue_phase(args, L, bx, G);
#endif
    PHASE_END
    PHASE_BEGIN norm_phase(args.in[0], args.in[2], true, XB, XB + (size_t)MLAT * DM, false, nullptr, nullptr, modt(ws, 0, 0, 0, 0), H, MALL, L); PHASE_END }

    for (int sl = 0; sl < 3 * NLAYER; ++sl) {
        SETUP_PTRS();
        const int layer = sl / 3, typ = sl % 3, kind = layer % 3, jm = layer / 3; const bool lastl = (layer == NLAYER - 1);
        const int Mrows = (lastl && typ >= 1) ? MLAT : MALL;
        pg8::Gemm gy;
        if (typ != 1) {
            const int f = (typ == 0) ? 0 : 1;
            PHASE_BEGIN
                pg8::Gemm g{H, (const bf16*)(ws + WS_WFC1) + (size_t)(layer * 2 + f) * NFC1 * DM, Mrows, NFC1, DM, DM}; pg8::StaticOrder S; S.init(Mrows, NFC1, G, bx);
                pg8::EpiSwiglu E{HID, DFF};
                #ifndef OFF_FC1
                unsigned long long pt0_ = 0, pr0_ = 0; if (PROBE_ID == 20 && sl == 3 && bx == 0) { pt0_ = clock64(); pr0_ = wall_clock64(); }
                for (int rep_ = 0; rep_ < (PROBE_ID == 2 ? 2 : 1); ++rep_) { pg8::gemm_phase<pg8::EpiSwiglu, pg8::StaticOrder, true, true, DM, DM>(L, g, S, E); }
                if (PROBE_ID == 20 && sl == 3 && bx == 0 && threadIdx.x == 0) { const unsigned long long t1_ = clock64(), r1_ = wall_clock64();
                    __hip_atomic_store((float*)(ws + WS_SMALL) + SM_END, floorf((float)(t1_ - pt0_) / ((float)(r1_ - pr0_) * 10.0f) * 4.0f + 0.5f) * 0.02f, __ATOMIC_RELAXED, __HIP_MEMORY_SCOPE_AGENT); }
#endif
            PHASE_END
            gy = pg8::Gemm{HID, (const bf16*)(ws + WS_WFC2) + (size_t)(layer * 2 + f) * DM * DFF, Mrows, DM, DFF, DFF};
        } else {
            if (kind != 1) {
                PHASE_BEGIN
                    const int N = (kind == 0) ? A_N : C_N, Min = (kind == 0) ? MALL : MLAT;
                    pg8::Gemm g{H, (kind == 0) ? (const bf16*)(ws + WS_WAIN) + (size_t)jm * A_N * DM : (const bf16*)(ws + WS_WCIN), Min, N, DM, DM}; pg8::StaticOrder S; S.init(Min, N, G, bx);
                    pg8::EpiBf16X<0> E{QKV, N, ROPE, (kind == 0) ? 2560 : 4096};
                    #ifndef OFF_ROPE
                    for (int rep_ = 0; rep_ < (PROBE_ID == 8 ? 2 : 1); ++rep_) { pg8::gemm_phase<pg8::EpiBf16X<0>, pg8::StaticOrder, true, true, DM, DM>(L, g, S, E); }
                    if (kind == 2) for (int t = bx; t < 8 * (C_N / 64); t += G) ctx_tile<DM, DM, 0>(H + (size_t)MLAT * DM, g.Bt, QKV + (size_t)MLAT * C_N, C_N, C_N / 64, t, L);
#endif
                PHASE_END
            } else {
                PHASE_BEGIN
                    pg8::Gemm g{H, (const bf16*)(ws + WS_WBIN), MLAT, B_N, DM, DM}; pg8::StaticOrder S; S.init(MLAT, B_N, G, bx);
                    pg8::EpiBf16X<1> E{QKV, B_N, nullptr, 0};
                    #ifndef OFF_GELU
                    for (int rep_ = 0; rep_ < (PROBE_ID == 9 ? 2 : 1); ++rep_) { pg8::gemm_phase<pg8::EpiBf16X<1>, pg8::StaticOrder, true, true, DM, DM>(L, g, S, E); }
                    for (int t = bx; t < 8 * (B_N / 64); t += G) ctx_tile<DM, DM, 1>(H + (size_t)MLAT * DM, g.Bt, QKV + (size_t)MLAT * B_N, B_N, B_N / 64, t, L);
#endif
                PHASE_END
            }
            if (kind == 0) {
                PHASE_BEGIN
                    const int nlat = NBATCH * 16 * 16, nall = nlat + (lastl ? 0 : NBATCH * 16);
                    for (int u = bx; u < nall; u += G) {
                        att::Args a; a.qkv = QKV; a.ld = A_N; a.n0 = 4; a.has_sink = 1; a.out = AO; a.ldo = DM;
                        if (u < nlat) { const int qb = u & 15, h = (u >> 4) & 15, b = u >> 8;
                            a.qrow0 = b * SEQ + qb * 256; a.qcol = h * 128; a.kcol = 2048 + (h >> 2) * 128; a.vcol = 2560 + (h >> 2) * 128; a.ctxrow0 = MLAT + b * CTXL; a.latrow0 = b * SEQ;
                            a.kstart = qb * 256 - 128; a.n1 = 8; a.qpos0 = qb * 256; a.sink = SM[SM_SINK + jm * 16 + h]; a.ocol = h * 128; }
                        else { const int cu = u - nlat, h = cu & 15, b = cu >> 4;
                            a.qrow0 = MLAT + b * CTXL; a.qcol = h * 128; a.kcol = 2048 + (h >> 2) * 128; a.vcol = 2560 + (h >> 2) * 128; a.ctxrow0 = MLAT + b * CTXL; a.latrow0 = b * SEQ;
                            a.kstart = 0; a.n1 = 0; a.qpos0 = 0; a.sink = SM[SM_SINK + jm * 16 + h]; a.ocol = h * 128; }
                        #ifndef OFF_ATTA
                        for (int rep_ = 0; rep_ < (PROBE_ID == 7 ? 2 : 1); ++rep_) { att::attn_unit<true, true, A_N>(a, (char*)lds); }
#endif
                    }
                PHASE_END
                gy = pg8::Gemm{AO, (const bf16*)(ws + WS_WAOUT) + (size_t)jm * DM * DM, Mrows, DM, DM, DM};
            } else if (kind == 1) {
                PHASE_BEGIN for (int rep_ = 0; rep_ < (PROBE_ID == 15 ? 2 : 1); ++rep_) { vstats_phase(QKV, (float*)(ws + WS_STATS), MALL); } PHASE_END
                PHASE_BEGIN
for (int rep_ = 0; rep_ < (PROBE_ID == 14 ? 2 : 1); ++rep_) { spatial_phase(QKV, (bf16*)OC, (const bf16*)(ws + WS_BSW), (const float*)(ws + WS_STATS), SM + SM_VNG, SM + SM_VNB, SM + SM_BS, (char*)lds, MALL / 128, bx, G); }
                PHASE_END
                gy = pg8::Gemm{(const bf16*)OC, (const bf16*)(ws + WS_WBOUT), Mrows, DM, B_W, B_W};
            } else {
                PHASE_BEGIN
                    const int nlat = NBATCH * 8 * 32, nall = nlat + (lastl ? 0 : NBATCH * 8 * 2);
                    float lam;
                    { const int ln_ = pg8::opaque_tid() & 63; const float* q1 = SM + SM_LQ1; const float* k1 = SM + SM_LK1; const float* q2 = SM + SM_LQ2; const float* k2 = SM + SM_LK2;
                      const float d1 = wave_sum(q1[ln_] * k1[ln_] + q1[ln_ + 64] * k1[ln_ + 64], ln_), d2 = wave_sum(q2[ln_] * k2[ln_] + q2[ln_ + 64] * k2[ln_ + 64], ln_);
                      lam = expf(d1) - expf(d2) + args.lam_init; }
                    for (int u = bx; u < nall; u += G) {
                        int qrow0, hh, b, n1;
                        if (u < nlat) { const int qb = u & 31; hh = (u >> 5) & 7; b = u >> 8; qrow0 = b * SEQ + qb * 128; n1 = 64; }
                        else { const int cu = u - nlat, qb = cu & 1; hh = (cu >> 1) & 7; b = cu >> 4; qrow0 = MLAT + b * CTXL + qb * 128; n1 = 0; }
                        for (int rep_ = 0; rep_ < (PROBE_ID == 6 ? 2 : 1); ++rep_) { att::dattn_unit<C_N>(QKV, qrow0, hh, MLAT + b * CTXL, b * SEQ, 4, n1, lam, args.gscale, SM + SM_SUBG, AO, L, (char*)lds); }
                    }
                PHASE_END
                gy = pg8::Gemm{AO, (const bf16*)(ws + WS_WCOUT), Mrows, DM, DM, DM};
            }
        }
        PHASE_BEGIN
            const bool hasctx = (gy.M == MALL); gy.M = MLAT;
            pg8::StaticOrder S; S.init(MLAT, DM, G, bx); pg8::EpiBf16X<2> E{Y, DM, nullptr, 0};
            bf16* Yc = Y + (size_t)MLAT * DM;
            if (typ != 1) { for (int rep_ = 0; rep_ < (PROBE_ID == 3 ? 2 : 1); ++rep_) { pg8::gemm_phase<pg8::EpiBf16X<2>, pg8::StaticOrder, true, true, DFF, DFF>(L, gy, S, E); }
                for (int rep_ = 0; rep_ < (PROBE_ID == 4 ? 2 : 1); ++rep_) { if (hasctx) for (int t = bx; t < 256; t += G) ctx_tile<DFF, DFF, 0>(gy.A + (size_t)MLAT * DFF, gy.Bt, Yc, DM, 32, t, L); } }
            else if (kind == 1) { pg8::gemm_phase<pg8::EpiBf16X<2>, pg8::StaticOrder, true, true, B_W, B_W>(L, gy, S, E);
                if (hasctx) for (int t = bx; t < 256; t += G) ctx_tile<B_W, B_W, 0>(gy.A + (size_t)MLAT * B_W, gy.Bt, Yc, DM, 32, t, L); }
            else { pg8::gemm_phase<pg8::EpiBf16X<2>, pg8::StaticOrder, true, true, DM, DM>(L, gy, S, E);
                if (hasctx) for (int t = bx; t < 256; t += G) ctx_tile<DM, DM, 0>(gy.A + (size_t)MLAT * DM, gy.Bt, Yc, DM, 32, t, L); }
        PHASE_END
        if ((PROBE_ID == 21 || PROBE_ID == 22) && sl == 3 * NLAYER - 1 && typ == 2) { }
        if ((PROBE_ID == 21 || PROBE_ID == 22) && sl == 3 * NLAYER - 1 && bx == 0 && threadIdx.x == 0) { float v_ = 0.f;
            if (PROBE_ID == 21) v_ = floorf((float)__hip_atomic_load((unsigned*)(args.ws + WS_CTL) + 2048, __ATOMIC_RELAXED, __HIP_MEMORY_SCOPE_AGENT) * 0.01f / (float)G / PROBE_Q + 0.5f) * 0.02f;
            else { unsigned s_ = 0; for (int i_ = 0; i_ < ph; ++i_) { const unsigned m_ = __hip_atomic_load((unsigned*)(args.ws + WS_CTL) + 2304 + i_, __ATOMIC_RELAXED, __HIP_MEMORY_SCOPE_AGENT); if (m_ != 0xffffffffu) s_ += m_; } v_ = floorf((float)s_ * 0.01f / PROBE_Q + 0.5f) * 0.02f; }
            __hip_atomic_store((float*)(ws + WS_SMALL) + SM_END, v_, __ATOMIC_RELAXED, __HIP_MEMORY_SCOPE_AGENT); }
        PHASE_BEGIN
            const bool fin = (sl == 3 * NLAYER - 1);
            const int nl = (typ == 2) ? layer + 1 : layer, ns = (typ == 2) ? 0 : typ + 1;
            norm_phase(XB, XB + (size_t)MLAT * DM, false, fin ? (void*)XL : (void*)XB, XB + (size_t)MLAT * DM, fin, Y, modt(ws, layer, typ, 0, 0), fin ? nullptr : modt(ws, nl, ns, 0, 0), fin ? nullptr : H, Mrows, L, (PROBE_ID >= 20 && fin) ? 1.0f + __hip_atomic_load((float*)(ws + WS_SMALL) + SM_END, __ATOMIC_RELAXED, __HIP_MEMORY_SCOPE_AGENT) : 1.0f);
        PHASE_END
    }
#undef PHASE_BEGIN
#undef PHASE_END
}

static int count_phases() { int n = 2; for (int sl = 0; sl < 3 * NLAYER; ++sl) { const int layer = sl / 3, typ = sl % 3, kind = layer % 3; n += (typ != 1) ? 3 : (kind == 1 ? 5 : 4); } return n; }
extern "C" void kernel_launch(void* const* d_in, const int* in_sizes, int n_in, void* d_out, int out_size, void* d_ws, size_t ws_size, hipStream_t stream) {
    static int grid = 0;
    if (grid == 0) {
        if (n_in != 25 || in_sizes[0] != MLAT * DM || out_size != MLAT * DM || ws_size < WS_END) { fprintf(stderr, "kernel_launch: unexpected shapes (n_in %d, in0 %d, out %d, ws %zu < %zu)\n", n_in, n_in > 0 ? in_sizes[0] : -1, out_size, ws_size, (size_t)WS_END); grid = -1; return; }
        int dev = 0, cus = 0, per_cu = 0;
        if (hipGetDevice(&dev) != hipSuccess || hipDeviceGetAttribute(&cus, hipDeviceAttributeMultiprocessorCount, dev) != hipSuccess) { grid = -1; return; }
        if (hipFuncSetAttribute((const void*)fwd, hipFuncAttributeMaxDynamicSharedMemorySize, LDS_BYTES) != hipSuccess) { fprintf(stderr, "kernel_launch: hipFuncSetAttribute failed\n"); grid = -1; return; }
        if (hipOccupancyMaxActiveBlocksPerMultiprocessor(&per_cu, (const void*)fwd, NWAVES * 64, LDS_BYTES) != hipSuccess || per_cu < 1) fprintf(stderr, "kernel_launch: occupancy query reports %d\n", per_cu);
        (void)hipGetLastError();
        grid = cus;
    }
    if (grid < 0) return;
    if (hipMemsetAsync((char*)d_ws + WS_CTL, 0, CTL_BYTES, stream) != hipSuccess) return;
    KArgs a{};
    for (int i = 0; i < 25; ++i) a.in[i] = (const float*)d_in[i];
    a.out = (float*)d_out; a.ws = (unsigned char*)d_ws; a.lam_init = (float)(0.8 - 0.6 * exp(-0.3 * 2.0)); a.gscale = 1.0f - a.lam_init;
    const int nph = count_phases();
#if MK_PER_PHASE
    for (int p = 0; p < nph; ++p) { a.ph_lo = p; a.ph_hi = p + 1; a.li = 0; hipLaunchKernelGGL(fwd, dim3(grid), dim3(NWAVES * 64), LDS_BYTES, stream, a); }
#else
    a.ph_lo = 0; a.ph_hi = nph; a.li = 0; hipLaunchKernelGGL(fwd, dim3(grid), dim3(NWAVES * 64), LDS_BYTES, stream, a);
#endif
    const hipError_t le = hipPeekAtLastError();
    if (le != hipSuccess) fprintf(stderr, "kernel_launch: launch failed: %s\n", hipGetErrorName(le));
}
```

```cpp
#include <hip/hip_runtime.h>
#include <cstdio>
#include <cstdint>
#include <cmath>

#ifndef PROBE_ID
#define PROBE_ID 0
#endif
#ifndef PROBE_Q
#define PROBE_Q 300.0f
#endif
#ifndef PROBE_BLK
#define PROBE_BLK 0
#endif
#ifndef MK_PER_PHASE
#define MK_PER_PHASE 0
#endif

namespace pg8 {
#define PG8_LAS __attribute__((address_space(3)))
typedef unsigned short bf16_t;
typedef short bf16x8 __attribute__((ext_vector_type(8)));
typedef float f32x4 __attribute__((ext_vector_type(4)));
typedef unsigned u32x4 __attribute__((ext_vector_type(4)));
__device__ __forceinline__ int opaque_tid() { int t = threadIdx.x; asm volatile("" : "+v"(t)); return t; }
#ifndef WT_STORES
#define WT_STORES 0
#endif
__device__ __forceinline__ void st16(void* p, u32x4 v) {
#if WT_STORES
    asm volatile("global_store_dwordx4 %0, %1, off sc1\n\ts_nop 1" :: "v"(p), "v"(v) : "memory");
#else
    *(u32x4*)p = v;
#endif
}
typedef unsigned u32x2_t __attribute__((ext_vector_type(2)));
__device__ __forceinline__ void st8(void* p, u32x2_t v) {
#if WT_STORES
    asm volatile("global_store_dwordx2 %0, %1, off sc1\n\ts_nop 1" :: "v"(p), "v"(v) : "memory");
#else
    *(u32x2_t*)p = v;
#endif
}
constexpr int BM = 256, BK = 64, HALF = 128, HTB = HALF * BK * 2  , STAGE_BYTES = 8 * HTB, NXCD = 8, WGM = 8;

__host__ __device__ __forceinline__ int lds_byte(int r, int c) { const int st = (r >> 4) * 2 + (c >> 5), rr = r & 15, cc = c & 31, ob = rr * 64 + cc * 2; return st * 1024 + (ob ^ (((ob >> 9) & 1) << 5)); }
__host__ __device__ __forceinline__ void stage_rc(int b, int& R, int& C) { const int st = b / 1024, sb = b % 1024, swz = sb ^ (((sb >> 9) & 1) << 5); R = (st >> 1) * 16 + swz / 64; C = (st & 1) * 32 + (swz % 64) / 2; }
__host__ __device__ __forceinline__ int perm32(int rho) { const int n = rho >> 4, i = rho & 15; return 8 * (i >> 2) + 4 * n + (i & 3); }

struct Unit { int pm, pn; };
struct Gemm { const bf16_t* A; const bf16_t* Bt; int M, N, K, lda; };

struct StaticOrder {
    int nM, nN, nwg, G, c;
    __host__ __device__ void init(int M, int N, int G_, int c_) { nM = M / BM; nN = N / BM; nwg = nM * nN; G = G_; c = c_; }
    __host__ __device__ bool next(int i, Unit& u) const {
        const long L = (long)i * G + c; if (L >= nwg) return false;
        int wgid = (int)L; { const int q = nwg / NXCD, r = nwg % NXCD, xcd = wgid % NXCD, off = wgid / NXCD; wgid = (xcd < r ? xcd * (q + 1) : r * (q + 1) + (xcd - r) * q) + off; }
        const int nig = WGM * nN, gid = wgid / nig, fm = gid * WGM, gsz = (nM - fm) < WGM ? (nM - fm) : WGM;
        u.pm = fm + ((wgid % nig) % gsz); u.pn = (wgid % nig) / gsz; return true;
    }
    __device__ __forceinline__ void a_ready(const Unit&) const {}
    __device__ __forceinline__ void done(const Unit&) const {}
};


__device__ __forceinline__ unsigned cvt_pk_bf16(float lo, float hi) { unsigned r; asm volatile("v_cvt_pk_bf16_f32 %0, %1, %2" : "=v"(r) : "v"(lo), "v"(hi)); return r; }
__device__ __forceinline__ float sigmoid_fast(float z) { return __builtin_amdgcn_rcpf(1.0f + __builtin_amdgcn_exp2f(-1.4426950408889634f * z)); }
__device__ __forceinline__ float gelu_tanh(float x) { const float z = 1.5957691216057308f * (x + 0.044715f * x * x * x); return x * sigmoid_fast(z); }

struct EpiSwiglu {
    static constexpr bool PERM = true, AFTER_DRAIN = false;
    bf16_t* O; int ldc;
    __device__ __forceinline__ void operator()(const f32x4 (&acc)[2][2][4][2], const Unit& u, int wr, int wc, int fr, int fq) const {
        const int row0 = u.pm * BM + wr * 64 + fr, col0 = u.pn * HALF + wc * 32 + 8 * fq;
#pragma unroll
        for (int ai = 0; ai < 2; ++ai)
#pragma unroll
            for (int m = 0; m < 4; ++m) { bf16_t* rowp = O + (size_t)(row0 + ai * HALF + m * 16) * ldc + col0;
                float v[8];
#pragma unroll
                for (int n = 0; n < 2; ++n)
#pragma unroll
                    for (int j = 0; j < 4; ++j) { const float g = acc[ai][0][m][n][j], uu = acc[ai][1][m][n][j]; v[n * 4 + j] = g * sigmoid_fast(g) * uu; }
                u32x4 w; w.x = cvt_pk_bf16(v[0], v[1]); w.y = cvt_pk_bf16(v[2], v[3]); w.z = cvt_pk_bf16(v[4], v[5]); w.w = cvt_pk_bf16(v[6], v[7]);
                st16(rowp, w); }
    }
};
struct EpiF32 {
    static constexpr bool PERM = true, AFTER_DRAIN = false;
    float* C; int ldc;
    __device__ __forceinline__ void operator()(const f32x4 (&acc)[2][2][4][2], const Unit& u, int wr, int wc, int fr, int fq) const {
        const int row0 = u.pm * BM + wr * 64 + fr, col0 = u.pn * BM + wc * 32 + 8 * fq;
#pragma unroll
        for (int ai = 0; ai < 2; ++ai)
#pragma unroll
            for (int m = 0; m < 4; ++m) { float* rowp = C + (size_t)(row0 + ai * HALF + m * 16) * ldc + col0;
#pragma unroll
                for (int bj = 0; bj < 2; ++bj) { *(f32x4*)(rowp + bj * HALF) = acc[ai][bj][m][0]; *(f32x4*)(rowp + bj * HALF + 4) = acc[ai][bj][m][1]; } }
    }
};
template <int MODE  > struct EpiBf16X {
    static constexpr bool PERM = true, AFTER_DRAIN = false;
    bf16_t* O; int ldc; const float* rope; int rope_cols;
    __device__ __forceinline__ void operator()(const f32x4 (&acc)[2][2][4][2], const Unit& u, int wr, int wc, int fr, int fq) const {
        const int row0 = u.pm * BM + wr * 64 + fr, col0 = u.pn * BM + wc * 32 + 8 * fq;
        const bool do_rope = (MODE == 0) && (u.pm < 32) && (u.pn * BM < rope_cols);
        const int p0 = 16 * wc + 4 * fq;
#pragma unroll
        for (int ai = 0; ai < 2; ++ai)
#pragma unroll
            for (int m = 0; m < 4; ++m) { const int row = row0 + ai * HALF + m * 16; bf16_t* rowp = O + (size_t)row * ldc + col0;
                f32x4 cs0 = (f32x4){1.f, 0.f, 1.f, 0.f}, cs1 = cs0;
                if (do_rope) { const float* rp = rope + ((size_t)(row & 4095) * 64 + p0) * 2; cs0 = *(const f32x4*)rp; cs1 = *(const f32x4*)(rp + 4); }
#pragma unroll
                for (int bj = 0; bj < 2; ++bj) { f32x4 v0 = acc[ai][bj][m][0], v1 = acc[ai][bj][m][1];
                    if (MODE == 1) {
#pragma unroll
                        for (int j = 0; j < 4; ++j) { v0[j] = gelu_tanh(v0[j]); v1[j] = gelu_tanh(v1[j]); } }
                    else if (do_rope) {
                        const f32x4 a = v0, b = v1;
                        v0[0] = a[0] * cs0[0] - a[1] * cs0[1]; v0[1] = a[0] * cs0[1] + a[1] * cs0[0]; v0[2] = a[2] * cs0[2] - a[3] * cs0[3]; v0[3] = a[2] * cs0[3] + a[3] * cs0[2];
                        v1[0] = b[0] * cs1[0] - b[1] * cs1[1]; v1[1] = b[0] * cs1[1] + b[1] * cs1[0]; v1[2] = b[2] * cs1[2] - b[3] * cs1[3]; v1[3] = b[2] * cs1[3] + b[3] * cs1[2]; }
                    u32x4 w; w.x = cvt_pk_bf16(v0[0], v0[1]); w.y = cvt_pk_bf16(v0[2], v0[3]); w.z = cvt_pk_bf16(v1[0], v1[1]); w.w = cvt_pk_bf16(v1[2], v1[3]);
                    st16(rowp + bj * HALF, w); } }
    }
};

template <class Epi, class Sched, bool ALIGN_EPI, bool SP2, int K, int LDA>
__device__ __forceinline__ void gemm_phase(PG8_LAS unsigned char* lds, const Gemm g, const Sched& S, const Epi& E) {
    const int tid = opaque_tid(), wid = __builtin_amdgcn_readfirstlane(tid >> 6), lane = tid & 63, wr = wid >> 2, wc = wid & 3, fr = lane & 15, fq = lane >> 4;
    constexpr int nt = K / BK;
    unsigned voffA[2], voffB[2];
#pragma unroll
    for (int i = 0; i < 2; ++i) { int R, C; stage_rc(tid * 16 + i * 8192, R, C); const int Rb = Epi::PERM ? ((R & ~31) + perm32(R & 31)) : R;
        voffA[i] = (unsigned)(R * LDA + C) * 2u; voffB[i] = (unsigned)(Rb * K + C) * 2u; }
    constexpr size_t kstep = (size_t)(BK * 2);
    constexpr size_t hstepA = (size_t)HALF * LDA * 2, hstepB = (size_t)HALF * K * 2;
    constexpr size_t tstepA = 2 * hstepA, tstepB = 2 * hstepB;
    const unsigned ldsw = (unsigned)wid * 1024u;
    const int aoff = lds_byte(wr * 64 + fr, fq * 8), boff = lds_byte(wc * 32 + fr, fq * 8);
#define PG8_SA(b, h) (((b) * 2 + (h)) * HTB)
#define PG8_SB(b, h) ((4 + (b) * 2 + (h)) * HTB)
#define PG8_STAGE(bufoff, gbase, voff) do { _Pragma("unroll") for (int _i = 0; _i < 2; ++_i) \
        __builtin_amdgcn_global_load_lds((const unsigned*)((const char*)(gbase) + (voff)[_i]), (PG8_LAS unsigned*)(lds + (bufoff) + ldsw + _i * 8192), 16, 0, 0); } while (0)
#define PG8_LDA(dst, b, h) do { _Pragma("unroll") for (int m = 0; m < 4; ++m) _Pragma("unroll") for (int k = 0; k < 2; ++k) dst[m][k] = *(const PG8_LAS bf16x8*)(lds + PG8_SA(b, h) + aoff + m * 2048 + k * 1024); } while (0)
#define PG8_LDB(dst, b, h) do { _Pragma("unroll") for (int n = 0; n < 2; ++n) _Pragma("unroll") for (int k = 0; k < 2; ++k) dst[n][k] = *(const PG8_LAS bf16x8*)(lds + PG8_SB(b, h) + boff + n * 2048 + k * 1024); } while (0)
#define PG8_MMA(ai, bj, At, Bt) do { __builtin_amdgcn_s_setprio(1); _Pragma("unroll") for (int m = 0; m < 4; ++m) _Pragma("unroll") for (int n = 0; n < 2; ++n) _Pragma("unroll") for (int k = 0; k < 2; ++k) \
        acc[ai][bj][m][n] = __builtin_amdgcn_mfma_f32_16x16x32_bf16(Bt[n][k], At[m][k], acc[ai][bj][m][n], 0, 0, 0); __builtin_amdgcn_s_setprio(0); } while (0)
#define PG8_WAIT_V(n) asm volatile("s_waitcnt vmcnt(" #n ")" ::: "memory")
#define PG8_WAIT_L(n) asm volatile("s_waitcnt lgkmcnt(" #n ")" ::: "memory")
#define PG8_BAR __builtin_amdgcn_s_barrier()
#define PG8_SCHED __builtin_amdgcn_sched_barrier(0)
    Unit cur, nxt; int ui = 0;
    if (!S.next(0, cur)) return;
    f32x4 acc[2][2][4][2];
#pragma unroll
    for (int a = 0; a < 2; ++a)
#pragma unroll
        for (int b = 0; b < 2; ++b)
#pragma unroll
            for (int m = 0; m < 4; ++m)
#pragma unroll
                for (int n = 0; n < 2; ++n) acc[a][b][m][n] = (f32x4){0.f, 0.f, 0.f, 0.f};
    bf16x8 At[4][2], B0[2][2], B1[2][2];
    const char* cA = (const char*)g.A + (size_t)cur.pm * tstepA; const char* cB = (const char*)g.Bt + (size_t)cur.pn * tstepB;
    S.a_ready(cur);
    if constexpr (SP2) {
        PG8_STAGE(PG8_SB(0, 0), cB, voffB); PG8_STAGE(PG8_SB(0, 1), cB + hstepB, voffB); PG8_STAGE(PG8_SA(0, 0), cA, voffA); PG8_STAGE(PG8_SA(0, 1), cA + hstepA, voffA);
        if (wr == 1) PG8_BAR;
        PG8_WAIT_V(2); PG8_BAR;
        PG8_STAGE(PG8_SB(1, 0), cB + kstep, voffB); PG8_STAGE(PG8_SA(1, 0), cA + kstep, voffA); PG8_STAGE(PG8_SB(1, 1), cB + hstepB + kstep, voffB);
        PG8_WAIT_V(6); PG8_BAR;
    } else {
        PG8_STAGE(PG8_SB(0, 0), cB, voffB); PG8_STAGE(PG8_SA(0, 0), cA, voffA); PG8_STAGE(PG8_SB(0, 1), cB + hstepB, voffB); PG8_STAGE(PG8_SA(0, 1), cA + hstepA, voffA);
        if (wr == 1) PG8_BAR;
        PG8_WAIT_V(4); PG8_BAR;
        PG8_STAGE(PG8_SB(1, 0), cB + kstep, voffB); PG8_STAGE(PG8_SA(1, 0), cA + kstep, voffA); PG8_STAGE(PG8_SB(1, 1), cB + hstepB + kstep, voffB);
        PG8_WAIT_V(6); PG8_BAR;
    }
    for (;;) {
        const bool has_next = S.next(ui + 1, nxt);
        const char* nA = has_next ? (const char*)g.A + (size_t)nxt.pm * tstepA : cA; const char* nB = has_next ? (const char*)g.Bt + (size_t)nxt.pn * tstepB : cB;
        for (int t = 0; t < nt; t += 2) {
            const bool last = (t == nt - 2);
            const char* a1 = cA + (size_t)(t + 1) * kstep;
            const char* a2 = last ? nA : cA + (size_t)(t + 2) * kstep; const char* b2 = last ? nB : cB + (size_t)(t + 2) * kstep;
            const char* a3 = a2 + kstep; const char* b3 = b2 + kstep;
            if (last && has_next) S.a_ready(nxt);
            if constexpr (SP2) {
            PG8_LDB(B0, 0, 0); PG8_LDB(B1, 0, 1); PG8_SCHED; PG8_LDA(At, 0, 0); PG8_STAGE(PG8_SA(1, 1), a1 + hstepA, voffA);
            PG8_WAIT_V(8); PG8_WAIT_L(0); PG8_BAR; PG8_MMA(0, 0, At, B0); PG8_MMA(0, 1, At, B1); PG8_BAR; PG8_SCHED;
            PG8_LDA(At, 0, 1); PG8_STAGE(PG8_SB(0, 0), b2, voffB); PG8_STAGE(PG8_SB(0, 1), b2 + hstepB, voffB); PG8_STAGE(PG8_SA(0, 0), a2, voffA);
            PG8_WAIT_V(8); PG8_WAIT_L(0); PG8_BAR; PG8_MMA(1, 0, At, B0); PG8_MMA(1, 1, At, B1); PG8_BAR; PG8_SCHED;
            PG8_LDB(B0, 1, 0); PG8_LDB(B1, 1, 1); PG8_SCHED; PG8_LDA(At, 1, 0); PG8_STAGE(PG8_SA(0, 1), a2 + hstepA, voffA);
            PG8_WAIT_V(8); PG8_WAIT_L(0); PG8_BAR; PG8_MMA(0, 0, At, B0); PG8_MMA(0, 1, At, B1); PG8_BAR; PG8_SCHED;
            PG8_LDA(At, 1, 1); PG8_STAGE(PG8_SB(1, 0), b3, voffB); PG8_STAGE(PG8_SB(1, 1), b3 + hstepB, voffB); PG8_STAGE(PG8_SA(1, 0), a3, voffA);
            PG8_WAIT_V(8); PG8_WAIT_L(0); PG8_BAR; PG8_MMA(1, 0, At, B0); PG8_MMA(1, 1, At, B1); PG8_BAR; PG8_SCHED;
            } else {
            PG8_LDB(B0, 0, 0); PG8_SCHED; PG8_LDA(At, 0, 0); PG8_STAGE(PG8_SA(1, 1), a1 + hstepA, voffA);
            PG8_WAIT_L(8); PG8_BAR; PG8_WAIT_L(0); PG8_MMA(0, 0, At, B0); PG8_BAR; PG8_SCHED;
            PG8_LDB(B1, 0, 1); PG8_STAGE(PG8_SB(0, 0), b2, voffB);
            PG8_BAR; PG8_WAIT_L(0); PG8_MMA(0, 1, At, B1); PG8_BAR;
            PG8_LDA(At, 0, 1); PG8_STAGE(PG8_SA(0, 0), a2, voffA);
            PG8_BAR; PG8_WAIT_L(0); PG8_MMA(1, 0, At, B0); PG8_BAR; PG8_SCHED;
            PG8_STAGE(PG8_SB(0, 1), b2 + hstepB, voffB);
            PG8_WAIT_V(6); PG8_BAR; PG8_MMA(1, 1, At, B1); PG8_BAR;
            PG8_LDB(B0, 1, 0); PG8_SCHED; PG8_LDA(At, 1, 0); PG8_STAGE(PG8_SA(0, 1), a2 + hstepA, voffA);
            PG8_WAIT_L(8); PG8_BAR; PG8_WAIT_L(0); PG8_MMA(0, 0, At, B0); PG8_BAR; PG8_SCHED;
            PG8_LDB(B1, 1, 1); PG8_STAGE(PG8_SB(1, 0), b3, voffB);
            PG8_BAR; PG8_WAIT_L(0); PG8_MMA(0, 1, At, B1); PG8_BAR;
            PG8_LDA(At, 1, 1); PG8_STAGE(PG8_SA(1, 0), a3, voffA);
            PG8_BAR; PG8_WAIT_L(0); PG8_MMA(1, 0, At, B0); PG8_BAR; PG8_SCHED;
            PG8_STAGE(PG8_SB(1, 1), b3 + hstepB, voffB);
            PG8_WAIT_V(6); PG8_BAR; PG8_MMA(1, 1, At, B1); PG8_BAR;
            }
        }
        if constexpr (ALIGN_EPI) { if (wr == 0) PG8_BAR; }
        if constexpr (!Epi::AFTER_DRAIN) { E(acc, cur, wr, wc, fr, fq); S.done(cur); }
        if (!has_next) break;
#pragma unroll
        for (int a = 0; a < 2; ++a)
#pragma unroll
            for (int b = 0; b < 2; ++b)
#pragma unroll
                for (int m = 0; m < 4; ++m)
#pragma unroll
                    for (int n = 0; n < 2; ++n) acc[a][b][m][n] = (f32x4){0.f, 0.f, 0.f, 0.f};
        cur = nxt; cA = nA; cB = nB; ++ui;
        if constexpr (ALIGN_EPI) { if (wr == 1) PG8_BAR; }
    }
    PG8_WAIT_V(0);
    if constexpr (!ALIGN_EPI) { if (wr == 0) PG8_BAR; }
    PG8_BAR;
    if constexpr (Epi::AFTER_DRAIN) { E.fused(acc, cur, wr, wc, fr, fq, lds, wid, lane); S.done(cur); }
#undef PG8_SA
#undef PG8_SB
#undef PG8_STAGE
#undef PG8_LDA
#undef PG8_LDB
#undef PG8_MMA
#undef PG8_WAIT_V
#undef PG8_WAIT_L
#undef PG8_BAR
#undef PG8_SCHED
}
}

namespace att {
typedef unsigned short bf16;
using bf16x8 = __attribute__((ext_vector_type(8))) short;
using s16x4  = __attribute__((ext_vector_type(4))) short;
using f32x16 = __attribute__((ext_vector_type(16))) float;
using u32x4  = __attribute__((ext_vector_type(4))) unsigned;
constexpr int   D = 128, NW = 8, QBLK = 32, KVBLK = 64;
constexpr float SCALE = 0.088388347648318440f;
constexpr float THR = 8.f;
constexpr int SHM_V = KVBLK * D * 2, SHM_K = KVBLK * D * 2, SHM_ATTN = 2 * SHM_V + 2 * SHM_K + NW * 64 * 4;
#define KSWZ(row, colB) ((row) * 256 + ((colB) ^ (((row) & 7) << 4)))
#define SBAR() __builtin_amdgcn_sched_barrier(0)
__device__ __forceinline__ int crow(int r, int hi) { return (r & 3) + 8 * (r >> 2) + 4 * hi; }
__device__ __forceinline__ unsigned cvtpk(float lo, float hi) { unsigned r; asm volatile("v_cvt_pk_bf16_f32 %0, %1, %2" : "=v"(r) : "v"(lo), "v"(hi)); return r; }

__device__ __forceinline__ void wmask(f32x16& p0, f32x16& p1, int kpos0, int qp, int hi) {
  const bool oob = (kpos0 < 0) || (kpos0 >= 4096);
  const int base = kpos0 - qp + 128;
#pragma unroll
  for (int r = 0; r < 16; ++r) { const int c = crow(r, hi);
    if (oob || (unsigned)(base + c) > 256u) p0[r] = -1e30f;
    if (oob || (unsigned)(base + 32 + c) > 256u) p1[r] = -1e30f; }
}
__device__ __forceinline__ void partialSM(f32x16& p0, f32x16& p1, float& m_reg, float& mn, float& alpha) {
  constexpr float C = SCALE * 1.4426950408889634f;
  float pmax = p0[0];
#pragma unroll
  for (int r = 1; r < 16; ++r) pmax = fmaxf(pmax, p0[r]);
#pragma unroll
  for (int r = 0; r < 16; ++r) pmax = fmaxf(pmax, p1[r]);
  { auto rr = __builtin_amdgcn_permlane32_swap(__float_as_uint(pmax), __float_as_uint(pmax), false, false);
    pmax = fmaxf(__uint_as_float(rr[0]), __uint_as_float(rr[1])); }
  if (__builtin_expect(__all(pmax - m_reg <= THR / SCALE), 1)) { mn = m_reg; alpha = 1.f; }
  else { mn = fmaxf(m_reg, pmax); alpha = __builtin_amdgcn_exp2f((m_reg - mn) * C); m_reg = mn; }
  float mnC = -mn * C;
#pragma unroll
  for (int r = 0; r < 16; ++r) p0[r] = fmaf(p0[r], C, mnC);
#pragma unroll
  for (int r = 0; r < 16; ++r) p1[r] = fmaf(p1[r], C, mnC);
#pragma unroll
  for (int r = 0; r < 16; ++r) p0[r] = __builtin_amdgcn_exp2f(p0[r]);
}
__device__ __forceinline__ void finishSM(f32x16& p0, f32x16& p1, float alpha, float& l_reg, bf16x8& pa0, bf16x8& pa1, bf16x8& pa2, bf16x8& pa3) {
#pragma unroll
  for (int r = 0; r < 16; ++r) p1[r] = __builtin_amdgcn_exp2f(p1[r]);
  float ps = 0;
#pragma unroll
  for (int r = 0; r < 16; ++r) ps += p0[r];
#pragma unroll
  for (int r = 0; r < 16; ++r) ps += p1[r];
  { auto rr = __builtin_amdgcn_permlane32_swap(__float_as_uint(ps), __float_as_uint(ps), false, false);
    ps = __uint_as_float(rr[0]) + __uint_as_float(rr[1]); }
  l_reg = l_reg * alpha + ps;
#define PK4(P, BASE, OUT) do { unsigned a0 = cvtpk(P[BASE + 0], P[BASE + 1]), a1 = cvtpk(P[BASE + 2], P[BASE + 3]);   \
    unsigned b0 = cvtpk(P[BASE + 4], P[BASE + 5]), b1 = cvtpk(P[BASE + 6], P[BASE + 7]);                              \
    auto r0 = __builtin_amdgcn_permlane32_swap(a0, b0, false, false); auto r1 = __builtin_amdgcn_permlane32_swap(a1, b1, false, false); \
    u32x4 w = {r0[0], r1[0], r0[1], r1[1]}; OUT = *reinterpret_cast<bf16x8*>(&w); } while (0)
  PK4(p0, 0, pa0); PK4(p0, 8, pa1); PK4(p1, 0, pa2); PK4(p1, 8, pa3);
#undef PK4
}
__device__ __forceinline__ void qkt(f32x16& p0, f32x16& p1, const bf16* Ks, const bf16x8* qr, int r32, int hi) {
  p0 = f32x16{}; p1 = f32x16{};
#pragma unroll
  for (int d0 = 0; d0 < 8; ++d0) { int cb = (d0 * 16 + hi * 8) * 2;
    bf16x8 b0 = *reinterpret_cast<const bf16x8*>((const char*)Ks + KSWZ(r32, cb));
    bf16x8 b1 = *reinterpret_cast<const bf16x8*>((const char*)Ks + KSWZ(32 + r32, cb));
    p0 = __builtin_amdgcn_mfma_f32_32x32x16_bf16(b0, qr[d0], p0, 0, 0, 0);
    p1 = __builtin_amdgcn_mfma_f32_32x32x16_bf16(b1, qr[d0], p1, 0, 0, 0); }
}
__device__ __forceinline__ int v_st(int k, int c) { const int kk = (k & ~0xC) | ((k & 4) << 1) | ((k & 8) >> 1); return ((kk >> 3) * 4 + (c >> 5)) * 512 + ((kk & 7) * 32 + (c & 31)) * 2; }
__device__ __forceinline__ int v_rd_base(int lane) { return ((lane & 3) << 3) | (((lane >> 2) & 3) << 6) | (((lane >> 4) & 1) << 5) | (((lane >> 5) & 1) << 8); }
constexpr int v_rd_off(int d0, int ks, int half) { return d0 * 512 + ks * 4096 + half * 2048; }
template <int OFF> __device__ __forceinline__ s16x4 tr_read(int vb) {
  s16x4 r; asm volatile("ds_read_b64_tr_b16 %0, %1 offset:%2" : "=&v"(r) : "v"(vb), "i"(OFF) : "memory"); return r;
}
template <int D0> __device__ __forceinline__ void pv_one(f32x16& od, int vb, bf16x8 pa0, bf16x8 pa1, bf16x8 pa2, bf16x8 pa3) {
  const s16x4 l0 = tr_read<v_rd_off(D0, 0, 0)>(vb), h0 = tr_read<v_rd_off(D0, 0, 1)>(vb), l1 = tr_read<v_rd_off(D0, 1, 0)>(vb), h1 = tr_read<v_rd_off(D0, 1, 1)>(vb);
  const s16x4 l2 = tr_read<v_rd_off(D0, 2, 0)>(vb), h2 = tr_read<v_rd_off(D0, 2, 1)>(vb), l3 = tr_read<v_rd_off(D0, 3, 0)>(vb), h3 = tr_read<v_rd_off(D0, 3, 1)>(vb);
  asm volatile("s_waitcnt lgkmcnt(0)" ::: "memory"); SBAR();
#define PK(L, H) (bf16x8){L[0], L[1], L[2], L[3], H[0], H[1], H[2], H[3]}
  od = __builtin_amdgcn_mfma_f32_32x32x16_bf16(pa0, PK(l0, h0), od, 0, 0, 0);
  od = __builtin_amdgcn_mfma_f32_32x32x16_bf16(pa1, PK(l1, h1), od, 0, 0, 0);
  od = __builtin_amdgcn_mfma_f32_32x32x16_bf16(pa2, PK(l2, h2), od, 0, 0, 0);
  od = __builtin_amdgcn_mfma_f32_32x32x16_bf16(pa3, PK(l3, h3), od, 0, 0, 0);
#undef PK
}
__device__ __forceinline__ void pv_d0(f32x16* o, int vb, bf16x8 pa0, bf16x8 pa1, bf16x8 pa2, bf16x8 pa3) {
  pv_one<0>(o[0], vb, pa0, pa1, pa2, pa3); pv_one<1>(o[1], vb, pa0, pa1, pa2, pa3); pv_one<2>(o[2], vb, pa0, pa1, pa2, pa3); pv_one<3>(o[3], vb, pa0, pa1, pa2, pa3);
}

struct Args {
  const bf16* qkv; int ld;
  int qrow0, qcol, kcol, vcol;
  int ctxrow0, latrow0;
  int kstart, n0, n1;
  int qpos0;
  const float* sinkp;
  void* out; int ldo, ocol;
};

template <bool WINDOW, bool OUT_BF16, int LD, bool PAIR>
__device__ __forceinline__ void attn_unit(const Args& a, char* lds) {
  const int tid = pg8::opaque_tid(), wid = tid >> 6, lane = tid & 63, r32 = lane & 31, hi = lane >> 5;
  bf16* V_lds = (bf16*)lds; bf16* K_lds = (bf16*)(lds + 2 * SHM_V);
  float* ws = (float*)(lds + 2 * SHM_V + 2 * SHM_K) + wid * 64; float* li_l = ws; float* al_l = ws + 32;
  const bool hs = a.sinkp != nullptr; const float sk = hs ? a.sinkp[PAIR ? (wid >> 2) : 0] : 0.f;
  float m_reg = hs ? sk * (1.0f / SCALE) : -1e30f, l_reg = hs ? 1.0f : 0.0f; f32x16 o[4] = {}; bf16x8 qr[8];
  const int wrow = PAIR ? (wid & 3) * QBLK : wid * QBLK, whd = PAIR ? (wid >> 2) * D : 0;
  const bf16* Qw = a.qkv + (long)(a.qrow0 + wrow + r32) * LD + a.qcol + whd + hi * 8;
#pragma unroll
  for (int d0 = 0; d0 < 8; ++d0) qr[d0] = *reinterpret_cast<const bf16x8*>(Qw + d0 * 16);
  const int sr = tid >> 4, sc = (tid & 15) * 8, vst0 = v_st(sr, sc), vst1 = v_st(32 + sr, sc);
  const int vb0 = (int)(uintptr_t)V_lds + v_rd_base(lane);
  const int qp = a.qpos0 + wrow + r32;
  const unsigned soff0 = (unsigned)(sr * LD + sc) * 2u, soff1 = soff0 + 32u * LD * 2u;
  struct { bf16x8 vs0, vs1, ks0, ks1; } sr_[2];
#define TROW(t) ((t) < a.n0 ? a.ctxrow0 + (t) * KVBLK : a.latrow0 + min(max(a.kstart + ((t) - a.n0) * KVBLK, 0), 4096 - KVBLK))
#define SLOAD(i, t) do { const char* tb_ = (const char*)a.qkv + (size_t)TROW(t) * (LD * 2); const char* tv_ = tb_ + a.vcol * 2; const char* tk_ = tb_ + a.kcol * 2; \
    sr_[i].vs0 = *reinterpret_cast<const bf16x8*>(tv_ + soff0); sr_[i].vs1 = *reinterpret_cast<const bf16x8*>(tv_ + soff1); \
    sr_[i].ks0 = *reinterpret_cast<const bf16x8*>(tk_ + soff0); sr_[i].ks1 = *reinterpret_cast<const bf16x8*>(tk_ + soff1); } while (0)
#define SWRITE(b, i) do { *(bf16x8*)((char*)V_lds + (b) * SHM_V + vst0) = sr_[i].vs0;          \
    *(bf16x8*)((char*)V_lds + (b) * SHM_V + vst1) = sr_[i].vs1; int kc = sc * 2;               \
    *(bf16x8*)((char*)K_lds + (b) * SHM_K + KSWZ(sr, kc)) = sr_[i].ks0;                       \
    *(bf16x8*)((char*)K_lds + (b) * SHM_K + KSWZ(32 + sr, kc)) = sr_[i].ks1; } while (0)
#define SWAIT() asm volatile("s_waitcnt vmcnt(4)" ::: "memory")
#define RESC(al) do { if (__any((al) < 1.f)) { if (hi == 0) al_l[r32] = (al); asm volatile("s_waitcnt lgkmcnt(0)" ::: "memory"); \
    _Pragma("unroll") for (int d = 0; d < 4; ++d) _Pragma("unroll") for (int r = 0; r < 16; ++r) o[d][r] *= al_l[crow(r, hi)]; } } while (0)
#define WMASK(P0, P1, t) do { if (WINDOW) { if ((t) >= a.n0) wmask(P0, P1, a.kstart + ((t) - a.n0) * KVBLK, qp, hi); } } while (0)
  f32x16 pA0, pA1, pB0, pB1; float mnA, mnB, alA, alB; bf16x8 pa0, pa1, pa2, pa3; const int NT = a.n0 + a.n1;
  constexpr int SE = 0, SO = 1;
  SLOAD(SE, 0); asm volatile("s_waitcnt vmcnt(0)" ::: "memory"); SWRITE(0, SE); __syncthreads();
  qkt(pA0, pA1, K_lds, qr, r32, hi); WMASK(pA0, pA1, 0); partialSM(pA0, pA1, m_reg, mnA, alA);
  SLOAD(SO, 1); if (2 < NT) SLOAD(SE, 2);
  SWAIT(); SWRITE(1, SO); __syncthreads();
  for (int j = 1; j + 1 < NT; j += 2) {
    SBAR(); qkt(pB0, pB1, (bf16*)((char*)K_lds + SHM_K), qr, r32, hi);
    finishSM(pA0, pA1, alA, l_reg, pa0, pa1, pa2, pa3); SBAR();
    SLOAD(SO, j + 2); SBAR();
    pv_d0(o, vb0, pa0, pa1, pa2, pa3); WMASK(pB0, pB1, j); partialSM(pB0, pB1, m_reg, mnB, alB);
    __syncthreads(); SWAIT(); SWRITE(0, SE);
    RESC(alB); __syncthreads();
    SBAR(); qkt(pA0, pA1, K_lds, qr, r32, hi);
    finishSM(pB0, pB1, alB, l_reg, pa0, pa1, pa2, pa3); SBAR();
    if (j + 3 < NT) SLOAD(SE, j + 3); SBAR();
    pv_d0(o, vb0 + (int)SHM_V, pa0, pa1, pa2, pa3); WMASK(pA0, pA1, j + 1); partialSM(pA0, pA1, m_reg, mnA, alA);
    __syncthreads(); SWAIT(); SWRITE(1, SO);
    RESC(alA); __syncthreads();
  }
  SBAR(); qkt(pB0, pB1, (bf16*)((char*)K_lds + SHM_K), qr, r32, hi);
  finishSM(pA0, pA1, alA, l_reg, pa0, pa1, pa2, pa3); SBAR();
  pv_d0(o, vb0, pa0, pa1, pa2, pa3); WMASK(pB0, pB1, NT - 1); partialSM(pB0, pB1, m_reg, mnB, alB);
  __syncthreads(); RESC(alB);
  finishSM(pB0, pB1, alB, l_reg, pa0, pa1, pa2, pa3); SBAR();
  pv_d0(o, vb0 + (int)SHM_V, pa0, pa1, pa2, pa3);
  if (hi == 0) li_l[r32] = l_reg; asm volatile("s_waitcnt lgkmcnt(0)" ::: "memory");
  float rli[16];
#pragma unroll
  for (int r = 0; r < 16; ++r) rli[r] = __builtin_amdgcn_rcpf(li_l[crow(r, hi)]);
  if (OUT_BF16) {
    bf16* Ow = (bf16*)a.out + (long)(a.qrow0 + wrow) * a.ldo + a.ocol + whd;
#pragma unroll
    for (int r = 0; r < 16; ++r) { const int orow = crow(r, hi);
#pragma unroll
      for (int d0 = 0; d0 < 4; ++d0) Ow[(long)orow * a.ldo + d0 * 32 + r32] = (bf16)(cvtpk(o[d0][r] * rli[r], 0.f) & 0xffffu); }
  } else {
    float* Ow = (float*)a.out + (long)(a.qrow0 + wrow) * a.ldo + a.ocol + whd;
#pragma unroll
    for (int r = 0; r < 16; ++r) { const int orow = crow(r, hi);
#pragma unroll
      for (int d0 = 0; d0 < 4; ++d0) Ow[(long)orow * a.ldo + d0 * 32 + r32] = o[d0][r] * rli[r]; }
  }
  __syncthreads();
#undef TROW
#undef SLOAD
#undef SWRITE
#undef SWAIT
#undef RESC
#undef WMASK
}

template <int LD>
__device__ __forceinline__ void dattn_unit(const bf16* qkv, int qrow0, int h, int ctxrow0, int latrow0, int n0, int n1, float lam, float gscale, const float* subg, bf16* AO,
                                           __attribute__((address_space(3))) unsigned char* L, char* lds) {
  typedef __attribute__((address_space(3))) unsigned char lds_b;
  const int tid = pg8::opaque_tid(), wid = __builtin_amdgcn_readfirstlane(tid >> 6), lane = tid & 63, r32 = lane & 31, hi = lane >> 5, g = wid & 3, c = wid >> 2;
  float* wsc = (float*)(lds + 132096 + wid * 256); float* li_l = wsc; float* al_l = wsc + 32;
  float m_reg = -1e30f, l_reg = 0.f; f32x16 o[8] = {}; bf16x8 qr[8];
  { const bf16* Qw = qkv + (long)(qrow0 + g * 32 + r32) * LD + (2 * h + c) * 128 + hi * 8;
#pragma unroll
    for (int d0 = 0; d0 < 8; ++d0) qr[d0] = *reinterpret_cast<const bf16x8*>(Qw + d0 * 16); }
  unsigned voK[2][2], voV[4];
#pragma unroll
  for (int cc = 0; cc < 2; ++cc)
#pragma unroll
    for (int i = 0; i < 2; ++i) { const int gi = i * 512 + tid, row = gi >> 4, cb = ((gi & 15) << 4) ^ ((row & 7) << 4); voK[cc][i] = (unsigned)((row * LD + 2048 + (2 * h + cc) * 128) * 2 + cb); }
#pragma unroll
  for (int i = 0; i < 4; ++i) { const int gi = i * 512 + tid, img = gi >> 10, o2 = (gi & 1023) << 4, st = o2 >> 9, e = (o2 & 511) >> 1, kk = (st >> 2) * 8 + (e >> 5);
    const int k = (kk & ~0xC) | ((kk & 4) << 1) | ((kk & 8) >> 1), col = (st & 3) * 32 + (e & 31); voV[i] = (unsigned)((k * LD + 4096 + h * 256 + img * 128 + col) * 2); }
  const int NT = n0 + n1;
#define DT_ROW(t) ((t) < n0 ? ctxrow0 + (t) * KVBLK : latrow0 + ((t) - n0) * KVBLK)
#define DT_DMA(t, b) do { const char* tb_ = (const char*)qkv + (size_t)DT_ROW(t) * (LD * 2); \
    _Pragma("unroll") for (int cc = 0; cc < 2; ++cc) _Pragma("unroll") for (int i = 0; i < 2; ++i) \
      __builtin_amdgcn_global_load_lds((const unsigned*)(tb_ + voK[cc][i]), (__attribute__((address_space(3))) unsigned*)(L + (b) * 32768 + cc * 16384 + i * 8192 + wid * 1024), 16, 0, 0); \
    _Pragma("unroll") for (int i = 0; i < 4; ++i) \
      __builtin_amdgcn_global_load_lds((const unsigned*)(tb_ + voV[i]), (__attribute__((address_space(3))) unsigned*)(L + 65536 + (b) * 32768 + i * 8192 + wid * 1024), 16, 0, 0); } while (0)
  DT_DMA(0, 0);
  if (1 < NT) DT_DMA(1, 1);
  if (1 < NT) asm volatile("s_waitcnt vmcnt(8)" ::: "memory"); else asm volatile("s_waitcnt vmcnt(0)" ::: "memory");
  __builtin_amdgcn_s_barrier(); asm volatile("" ::: "memory");
  for (int t = 0; t < NT; ++t) {
    const int b = t & 1;
    const bf16* Kt = (const bf16*)(lds + b * 32768 + c * 16384);
    const int vb = (int)(uintptr_t)(lds + 65536 + b * 32768) + v_rd_base(lane);
    f32x16 p0, p1; float mn, alpha; bf16x8 pa0, pa1, pa2, pa3;
    qkt(p0, p1, Kt, qr, r32, hi);
    partialSM(p0, p1, m_reg, mn, alpha);
    if (__any(alpha < 1.f)) { if (hi == 0) al_l[r32] = alpha; asm volatile("s_waitcnt lgkmcnt(0)" ::: "memory");
#pragma unroll
      for (int d = 0; d < 8; ++d)
#pragma unroll
        for (int r = 0; r < 16; ++r) o[d][r] *= al_l[crow(r, hi)]; }
    finishSM(p0, p1, alpha, l_reg, pa0, pa1, pa2, pa3);
    pv_one<0>(o[0], vb, pa0, pa1, pa2, pa3); pv_one<1>(o[1], vb, pa0, pa1, pa2, pa3); pv_one<2>(o[2], vb, pa0, pa1, pa2, pa3); pv_one<3>(o[3], vb, pa0, pa1, pa2, pa3);
    pv_one<0>(o[4], vb + 16384, pa0, pa1, pa2, pa3); pv_one<1>(o[5], vb + 16384, pa0, pa1, pa2, pa3); pv_one<2>(o[6], vb + 16384, pa0, pa1, pa2, pa3); pv_one<3>(o[7], vb + 16384, pa0, pa1, pa2, pa3);
    asm volatile("s_waitcnt lgkmcnt(0)" ::: "memory"); __builtin_amdgcn_s_barrier(); asm volatile("" ::: "memory");
    if (t + 2 < NT) { DT_DMA(t + 2, b); asm volatile("s_waitcnt vmcnt(8)" ::: "memory"); } else asm volatile("s_waitcnt vmcnt(0)" ::: "memory");
    __builtin_amdgcn_s_barrier(); asm volatile("" ::: "memory");
  }
#undef DT_ROW
#undef DT_DMA
  if (hi == 0) li_l[r32] = l_reg; asm volatile("s_waitcnt lgkmcnt(0)" ::: "memory");
#pragma unroll
  for (int r = 0; r < 16; ++r) { const float rl = __builtin_amdgcn_rcpf(li_l[crow(r, hi)]);
#pragma unroll
    for (int d = 0; d < 8; ++d) o[d][r] *= rl; }
  float* xch = (float*)(lds + g * 32768);
  if (c == 1) {
#pragma unroll
    for (int d = 0; d < 8; ++d)
#pragma unroll
      for (int r = 0; r < 16; ++r) xch[(d * 16 + r) * 64 + lane] = o[d][r]; }
  asm volatile("s_waitcnt lgkmcnt(0)" ::: "memory"); __builtin_amdgcn_s_barrier(); asm volatile("" ::: "memory");
  if (c == 0) {
    float gv[8];
#pragma unroll
    for (int d = 0; d < 8; ++d) gv[d] = subg[d * 32 + r32] * gscale;
#pragma unroll
    for (int r = 0; r < 16; ++r) { float s = 0.f;
#pragma unroll
      for (int d = 0; d < 8; ++d) { o[d][r] -= lam * xch[(d * 16 + r) * 64 + lane]; s += o[d][r] * o[d][r]; }
      for (int m_ = 1; m_ < 32; m_ <<= 1) s += __builtin_bit_cast(float, __builtin_amdgcn_ds_bpermute((lane ^ m_) << 2, __builtin_bit_cast(int, s)));
      const float rs = 1.0f / sqrtf(s * (1.0f / 256.0f) + 1e-6f);
      bf16* orow = AO + (long)(qrow0 + g * 32 + crow(r, hi)) * 2048 + h * 256 + r32;
#pragma unroll
      for (int d = 0; d < 8; ++d) orow[d * 32] = (bf16)(cvtpk(o[d][r] * rs * gv[d], 0.f) & 0xffffu); }
  }
  asm volatile("s_waitcnt vmcnt(0) lgkmcnt(0)" ::: "memory"); __builtin_amdgcn_s_barrier(); asm volatile("" ::: "memory");
}
#undef KSWZ
#undef SBAR
}

constexpr int NWAVES = 8;
constexpr int DM = 2048, NBATCH = 2, SEQ = 4096, MLAT = NBATCH * SEQ, CTXL = 256, MCTX = NBATCH * CTXL, MALL = MLAT + MCTX;
constexpr int DFF = 5504, NFC1 = 2 * DFF, NLAYER = 4, NMODC = 9 * DM;
constexpr int A_N = 3072, B_N = 12288, B_W = 6144, C_N = 6144;
constexpr float EPS = 1e-6f;
constexpr size_t MiB = 1u << 20;
constexpr size_t WS_CTL = 0, CTL_BYTES = 2 * MiB;
constexpr size_t WS_MODT = 2 * MiB;
constexpr size_t WS_ROPE = 3 * MiB;
constexpr size_t WS_XC = 5 * MiB;
constexpr size_t WS_STATS = 9 * MiB;
constexpr size_t WS_BSW = 10 * MiB;
constexpr size_t WS_SMALL = 10 * MiB + 512 * 1024;
constexpr int SM_SINK = 0, SM_VNG = 64, SM_VNB = SM_VNG + 6144, SM_BS = SM_VNB + 6144, SM_LQ1 = SM_BS + 1024, SM_LK1 = SM_LQ1 + 128, SM_LQ2 = SM_LK1 + 128, SM_LK2 = SM_LQ2 + 128, SM_SUBG = SM_LK2 + 128, SM_END = SM_SUBG + 256;
constexpr size_t WS_WFC1 = 11 * MiB;
constexpr size_t WS_WFC2 = WS_WFC1 + 344 * MiB;
constexpr size_t WS_WAIN = WS_WFC2 + 172 * MiB;
constexpr size_t WS_WAOUT = WS_WAIN + 24 * MiB;
constexpr size_t WS_WBIN = WS_WAOUT + 16 * MiB;
constexpr size_t WS_WBOUT = WS_WBIN + 48 * MiB;
constexpr size_t WS_WCIN = WS_WBOUT + 24 * MiB;
constexpr size_t WS_WCOUT = WS_WCIN + 24 * MiB;
constexpr size_t WS_H = WS_WCOUT + 8 * MiB;
constexpr size_t WS_HID = WS_H + 34 * MiB;
constexpr size_t WS_Y = WS_HID + 92 * MiB;
constexpr size_t WS_QKV = WS_Y + 68 * MiB;
constexpr size_t WS_AO = WS_QKV + 204 * MiB;
constexpr size_t WS_OC = WS_AO + 34 * MiB;
constexpr size_t WS_XB = WS_OC + 136 * MiB;
constexpr size_t WS_END = WS_XB + 34 * MiB;
static_assert((size_t)8 * NFC1 * DM * 2 <= 344 * MiB && (size_t)8 * DM * DFF * 2 <= 172 * MiB && (size_t)MALL * DFF * 2 <= 92 * MiB && (size_t)MALL * B_N * 2 <= 204 * MiB, "ws map");
constexpr int CW_PQ = 1024;
constexpr int CW_BAR = 4096;
constexpr int RING_BYTES = 131072, MISC_OFF = RING_BYTES + 320, LDS_BYTES = 147456;

#define GAS __attribute__((address_space(1)))
#define LAS __attribute__((address_space(3)))
typedef unsigned short bf16;
typedef unsigned v4u __attribute__((ext_vector_type(4)));
typedef unsigned v2u __attribute__((ext_vector_type(2)));
typedef float f32x4 __attribute__((ext_vector_type(4)));
typedef short bf16x8 __attribute__((ext_vector_type(8)));
typedef float f32x16 __attribute__((ext_vector_type(16)));
#define LDS_WAIT() asm volatile("s_waitcnt lgkmcnt(0)" ::: "memory")
#define VM_WAIT() asm volatile("s_waitcnt vmcnt(0)" ::: "memory")
__device__ __forceinline__ unsigned f2bf(float f) { unsigned u = __builtin_bit_cast(unsigned, f); return (u + 0x7fffu + ((u >> 16) & 1u)) >> 16; }
__device__ __forceinline__ unsigned pk2(float lo, float hi) { return f2bf(lo) | (f2bf(hi) << 16); }
__device__ __forceinline__ float bf2f(unsigned short b) { return __builtin_bit_cast(float, ((unsigned)b) << 16); }
__device__ __forceinline__ float lane_xor(float v, int lane, int mask) { return __builtin_bit_cast(float, __builtin_amdgcn_ds_bpermute((lane ^ mask) << 2, __builtin_bit_cast(int, v))); }
__device__ __forceinline__ float wave_sum(float v, int lane) {
#pragma unroll
    for (int o = 1; o < 64; o <<= 1) v += lane_xor(v, lane, o);
    return v;
}

#define XB_TMO      128
#define XB_XCNT(j)  (256  + 64 * (j))
#define XB_XSUB(j)  (1280 + 64 * (j))
#define XB_XGEN(j)  (2304 + 64 * (j))
#define XB_TOP      3328
#define XB_TOPGEN   3392
#define XCD_BAR_WORDS 3456
#define XB_SPIN_CAP (1u << 18)

__device__ __forceinline__ unsigned xb_ld(unsigned* p)              { return __hip_atomic_load(p, __ATOMIC_RELAXED, __HIP_MEMORY_SCOPE_AGENT); }
__device__ __forceinline__ unsigned xb_add(unsigned* p, unsigned v) { return __hip_atomic_fetch_add(p, v, __ATOMIC_RELAXED, __HIP_MEMORY_SCOPE_AGENT); }
__device__ __forceinline__ unsigned xb_xcc_id() { return (unsigned)__builtin_amdgcn_s_getreg((3 << 11) | 20) & 0xFu; }
#define XB_SPIN(cond, bar) do { unsigned _sp = 0; while (cond) { __builtin_amdgcn_s_sleep(1); \
    if ((++_sp & 255u) == 0u) { if (xb_ld(&(bar)[XB_TMO])) break; if (_sp > XB_SPIN_CAP) { atomicAdd(&(bar)[XB_TMO], 1u); break; } } } } while (0)

struct XcdBarrier {
    unsigned* bar; unsigned x;
    volatile LAS unsigned* st;
};

__device__ __forceinline__ XcdBarrier xcd_barrier_post(unsigned* bar, volatile LAS unsigned* st) {
    XcdBarrier b; b.bar = bar; b.x = xb_xcc_id(); b.st = st;
    if (threadIdx.x == 0) (void)xb_add(&bar[XB_XCNT(b.x)], 1u);
    return b;
}
__device__ __forceinline__ void xcd_barrier_complete(unsigned* bar, unsigned x, unsigned& nloc, unsigned& nx) {
    const unsigned G = gridDim.x * gridDim.y * gridDim.z;
    unsigned sum, cnt, mine, sp = 0u;
    for (;;) {
        sum = 0u; cnt = 0u; mine = 0u;
#pragma unroll
        for (unsigned j = 0; j < 16; ++j) { const unsigned c = xb_ld(&bar[XB_XCNT(j)]); sum += c; cnt += (c > 0u) ? 1u : 0u; mine = (j == x) ? c : mine; }
        if (sum == G) break;
        __builtin_amdgcn_s_sleep(1);
        if ((++sp & 255u) == 0u) { if (xb_ld(&bar[XB_TMO])) break; if (sp > XB_SPIN_CAP) { atomicAdd(&bar[XB_TMO], 1u); break; } }
    }
    nloc = mine > 0u ? mine : 1u; nx = cnt > 0u ? cnt : 1u;
}

__device__ __forceinline__ void xcd_barrier(const XcdBarrier& b) {
    asm volatile("s_waitcnt vmcnt(0)" ::: "memory");
    __syncthreads();
    if (threadIdx.x == 0) {
        unsigned* bar = b.bar;
        __builtin_amdgcn_s_waitcnt(0);
        unsigned nloc = b.st[0], nx = b.st[1];
        if (nloc == 0u) { xcd_barrier_complete(bar, b.x, nloc, nx); b.st[0] = nloc; b.st[1] = nx; }
        const unsigned old = xb_add(&bar[XB_XSUB(b.x)], 1u);
        const unsigned gen = old / nloc;
        if (old + 1u == (gen + 1u) * nloc) {
            __builtin_amdgcn_fence(__ATOMIC_RELEASE, "agent");
            asm volatile("s_waitcnt vmcnt(0)" ::: "memory");
            const unsigned og = xb_add(&bar[XB_TOP], 1u);
            const unsigned tg = og / nx;
            if (og + 1u == (tg + 1u) * nx) xb_add(&bar[XB_TOPGEN], 1u);
            else XB_SPIN(xb_ld(&bar[XB_TOPGEN]) == tg, bar);
            __builtin_amdgcn_fence(__ATOMIC_ACQUIRE, "agent");
            xb_add(&bar[XB_XGEN(b.x)], 1u);
            asm volatile("s_waitcnt vmcnt(0)" ::: "memory");
        } else {
            XB_SPIN(xb_ld(&bar[XB_XGEN(b.x)]) == gen, bar);
            __builtin_amdgcn_fence(__ATOMIC_ACQUIRE, "agent");
            asm volatile("s_waitcnt vmcnt(0)" ::: "memory");
        }
    }
    __syncthreads();
}

__device__ __forceinline__ void transpose_item(const float* W, int K, int N, bf16* WT, int fc1map, LAS float* scr, int item, int lane) {
    const int nblk = N / 32, kb = item / nblk, nb = item % nblk, k0 = 64 * kb, n0 = 32 * nb;
    int rowbase = n0;
    if (fc1map) { rowbase = (n0 < DFF) ? 256 * (n0 / 128) + (n0 % 128) : 256 * ((n0 - DFF) / 128) + 128 + ((n0 - DFF) % 128); }
    float tv[32];
#pragma unroll
    for (int i = 0; i < 32; ++i) tv[i] = W[(size_t)(k0 + 2 * i + (lane >> 5)) * N + n0 + (lane & 31)];
#pragma unroll
    for (int i = 0; i < 32; ++i) scr[(2 * i + (lane >> 5)) * 33 + (lane & 31)] = tv[i];
    LDS_WAIT(); asm volatile("" ::: "memory");
    const int c = lane & 7;
#pragma unroll
    for (int j = 0; j < 4; ++j) { const int n = (lane >> 3) + 8 * j; const LAS float* s = scr + (8 * c) * 33 + n;
        v4u o; o.x = pk2(s[0 * 33], s[1 * 33]); o.y = pk2(s[2 * 33], s[3 * 33]); o.z = pk2(s[4 * 33], s[5 * 33]); o.w = pk2(s[6 * 33], s[7 * 33]);
        *(GAS v4u*)(WT + (size_t)(rowbase + n) * K + k0 + 8 * c) = o; }
    LDS_WAIT(); asm volatile("" ::: "memory");
}

struct KArgs { const float* in[25]; float* out; unsigned char* ws; int ph_lo, ph_hi, li; float lam_init; float gscale; int pad0, pad1, pad2; };

__device__ __forceinline__ float* modt(unsigned char* ws, int layer, int slot, int modrow, int which) { return (float*)(ws + WS_MODT) + ((size_t)(((layer * 3 + slot) * 3 + modrow) * 3 + which)) * DM; }

__device__ __forceinline__ void prologue_phase(const KArgs& args, LAS unsigned char* L, int bx, int G) {
    const int tid = pg8::opaque_tid(), lane = tid & 63, wave = __builtin_amdgcn_readfirstlane(tid >> 6);
    unsigned char* ws = args.ws;
    LAS float* sl = (LAS float*)L;
    for (int i = tid; i < 3 * DM; i += NWAVES * 64) { const int r = i / DM, k = i % DM; const float v = (r < 2) ? args.in[1][r * DM + k] : args.in[3][k]; sl[i] = v / (1.0f + expf(-v)); }
    __syncthreads();
    LAS float* part = (LAS float*)(L + 24576);
    for (int rep_ = 0; rep_ < (PROBE_ID == 11 ? 2 : 1); ++rep_)
    for (int item = bx; item < NLAYER * 72; item += G) {
        const int layer = item / 72, n0 = (item % 72) * 256;
        const float* W = args.in[4] + ((size_t)layer * DM + wave * 256) * NMODC + n0 + lane * 4;
        const LAS float* s0 = sl + wave * 256;
        f32x4 a0 = {0.f, 0.f, 0.f, 0.f}, a1 = a0, a2 = a0;
#pragma unroll 8
        for (int kk = 0; kk < 256; ++kk) { const f32x4 w = *(const f32x4*)(W + (size_t)kk * NMODC); a0 += w * s0[kk]; a1 += w * s0[DM + kk]; a2 += w * s0[2 * DM + kk]; }
        *(LAS f32x4*)(part + (wave * 3 + 0) * 256 + lane * 4) = a0; *(LAS f32x4*)(part + (wave * 3 + 1) * 256 + lane * 4) = a1; *(LAS f32x4*)(part + (wave * 3 + 2) * 256 + lane * 4) = a2;
        __syncthreads();
        for (int idx = tid; idx < 768; idx += NWAVES * 64) { const int r = idx >> 8, cc = idx & 255, n = n0 + cc; float m = args.in[5][layer * NMODC + n];
#pragma unroll
            for (int w = 0; w < 8; ++w) m += part[(w * 3 + r) * 256 + cc];
            const int k9 = n / DM, c = n % DM, s = k9 / 3, which = k9 % 3; const float* g = args.in[6] + (size_t)layer * 6 * DM;
            if (which == 0) modt(ws, layer, s, r, 2)[c] = m;
            else if (which == 1) modt(ws, layer, s, r, 1)[c] = g[(2 * s) * DM + c] * (1.0f + m);
            else modt(ws, layer, s, r, 0)[c] = (s == 1 ? 1.0f : 0.5f) * m * g[(2 * s + 1) * DM + c]; }
        __syncthreads();
    }
    {
        LAS float* scr = (LAS float*)(L + 49152 + wave * 8448);
        const int gw = bx * NWAVES + wave, NGW = G * NWAVES;
        constexpr int I_FC1 = (DM / 64) * (NFC1 / 32), I_FC2 = (DFF / 64) * (DM / 32), I_AIN = (DM / 64) * (A_N / 32), I_SQ = (DM / 64) * (DM / 32), I_BIN = (DM / 64) * (B_N / 32), I_BOUT = (B_W / 64) * (DM / 32), I_CIN = (DM / 64) * (C_N / 32);
        constexpr int NITEMS = 8 * I_FC1 + 8 * I_FC2 + 2 * I_AIN + 2 * I_SQ + I_BIN + I_BOUT + I_CIN + I_SQ;
        const int nheavy = (NLAYER * 72 > G) ? (NLAYER * 72 - G) : 0, SKIP_R = 24, nlightw = (G - nheavy) * NWAVES;
        const bool heavy = bx < nheavy;
        for (int rep_ = 0; rep_ < (PROBE_ID == 12 ? 2 : 1); ++rep_)
        for (int rnd = heavy ? SKIP_R : 0;; ++rnd) {
            const int it = (rnd < SKIP_R) ? rnd * nlightw + (gw - nheavy * NWAVES) : SKIP_R * nlightw + (rnd - SKIP_R) * NGW + gw;
            if (it >= NITEMS) break;
            int r = it;
            if (r < 8 * I_FC1) { const int mat = r / I_FC1; transpose_item(args.in[7] + (size_t)mat * DM * NFC1, DM, NFC1, (bf16*)(ws + WS_WFC1) + (size_t)mat * NFC1 * DM, 1, scr, r % I_FC1, lane); continue; } r -= 8 * I_FC1;
            if (r < 8 * I_FC2) { const int mat = r / I_FC2; transpose_item(args.in[8] + (size_t)mat * DFF * DM, DFF, DM, (bf16*)(ws + WS_WFC2) + (size_t)mat * DM * DFF, 0, scr, r % I_FC2, lane); continue; } r -= 8 * I_FC2;
            if (r < 2 * I_AIN) { const int mat = r / I_AIN; transpose_item(args.in[9] + (size_t)mat * DM * A_N, DM, A_N, (bf16*)(ws + WS_WAIN) + (size_t)mat * A_N * DM, 0, scr, r % I_AIN, lane); continue; } r -= 2 * I_AIN;
            if (r < 2 * I_SQ) { const int mat = r / I_SQ; transpose_item(args.in[10] + (size_t)mat * DM * DM, DM, DM, (bf16*)(ws + WS_WAOUT) + (size_t)mat * DM * DM, 0, scr, r % I_SQ, lane); continue; } r -= 2 * I_SQ;
            if (r < I_BIN) { transpose_item(args.in[12], DM, B_N, (bf16*)(ws + WS_WBIN), 0, scr, r, lane); continue; } r -= I_BIN;
            if (r < I_BOUT) { transpose_item(args.in[17], B_W, DM, (bf16*)(ws + WS_WBOUT), 0, scr, r, lane); continue; } r -= I_BOUT;
            if (r < I_CIN) { transpose_item(args.in[18], DM, C_N, (bf16*)(ws + WS_WCIN), 0, scr, r, lane); continue; } r -= I_CIN;
            transpose_item(args.in[19], DM, DM, (bf16*)(ws + WS_WCOUT), 0, scr, r, lane);
        }
    }
    for (int rep_ = 0; rep_ < (PROBE_ID == 13 ? 2 : 1); ++rep_)
    for (int e = bx * NWAVES * 64 + tid; e < SEQ * 64; e += G * NWAVES * 64) { const int t = e >> 6, p = e & 63, pi = p & 31;
        const float inv = (float)pow(10000.0, -(double)pi / 32.0); const float ang = (float)((p < 32) ? (t >> 6) : (t & 63)) * inv;
        float* o = (float*)(ws + WS_ROPE) + (size_t)e * 2; o[0] = (float)cos((double)ang); o[1] = (float)sin((double)ang); }
    for (int e = bx * NWAVES * 64 + tid; e < 8 * 128 * 128; e += G * NWAVES * 64) ((bf16*)(ws + WS_BSW))[e] = (bf16)f2bf(args.in[15][e]);
    if (bx == 0) { float* sm = (float*)(ws + WS_SMALL);
        for (int e = tid; e < SM_END; e += NWAVES * 64) { float v = 0.f;
            if (e < SM_VNG) { if (e < 32) v = args.in[11][e]; }
            else if (e < SM_VNB) v = args.in[13][e - SM_VNG];
            else if (e < SM_BS) v = args.in[14][e - SM_VNB];
            else if (e < SM_LQ1) v = args.in[16][e - SM_BS];
            else if (e < SM_LK1) v = args.in[20][e - SM_LQ1];
            else if (e < SM_LQ2) v = args.in[21][e - SM_LK1];
            else if (e < SM_LK2) v = args.in[22][e - SM_LQ2];
            else if (e < SM_SUBG) v = args.in[23][e - SM_LK2];
            else v = args.in[24][e - SM_SUBG];
            sm[e] = v; } }
}

__device__ __forceinline__ f32x4 ld4_x(const void* p, bool f32src) {
    if (f32src) return *(const f32x4*)p;
    const v2u raw = *(const v2u*)p; f32x4 r; r.x = __builtin_bit_cast(float, raw.x << 16); r.y = __builtin_bit_cast(float, raw.x & 0xffff0000u); r.z = __builtin_bit_cast(float, raw.y << 16); r.w = __builtin_bit_cast(float, raw.y & 0xffff0000u); return r;
}
__device__ __forceinline__ void st4_x(void* p, f32x4 v, bool f32dst) { if (f32dst) *(f32x4*)p = v; else { v2u o; o.x = pk2(v.x, v.y); o.y = pk2(v.z, v.w); *(v2u*)p = o; } }
__device__ __forceinline__ void norm_phase(const void* xs_lat, const void* xs_ctx, bool f32src, void* xd_lat, void* xd_ctx, bool f32dst, const bf16* Y, const float* postT, const float* preT, bf16* H, int nrows, LAS unsigned char* L, float oscale = 1.0f) {
    const int tid = pg8::opaque_tid(), lane = tid & 63, wave = __builtin_amdgcn_readfirstlane(tid >> 6), gw = blockIdx.x * NWAVES + wave, NGW = gridDim.x * NWAVES;
    const int nlat = nrows < MLAT ? nrows : MLAT, ssz = f32src ? 4 : 2, dsz = f32dst ? 4 : 2;
    for (int row = gw; row < nlat; row += NGW) {
        const int modrow = row < SEQ ? 0 : 1;
        const char* xs = (const char*)xs_lat + (size_t)row * DM * ssz; char* xd = (char*)xd_lat + (size_t)row * DM * dsz;
        f32x4 xv[8];
#pragma unroll
        for (int j = 0; j < 8; ++j) xv[j] = ld4_x(xs + (256 * j + 4 * lane) * ssz, f32src);
        if (Y) {
            const bf16* yr = Y + (size_t)row * DM; const float* At = postT + (size_t)modrow * 3 * DM;
            f32x4 yv[8]; float ss = 0.f;
#pragma unroll
            for (int j = 0; j < 8; ++j) { yv[j] = ld4_x(yr + 256 * j + 4 * lane, false); ss += (yv[j].x * yv[j].x + yv[j].y * yv[j].y) + (yv[j].z * yv[j].z + yv[j].w * yv[j].w); }
            const float ry = 1.0f / sqrtf(wave_sum(ss, lane) * (1.0f / DM) + EPS);
#pragma unroll
            for (int j = 0; j < 8; ++j) { const f32x4 a = *(const f32x4*)(At + 256 * j + 4 * lane); xv[j] += yv[j] * ry * a; }
        }
#pragma unroll
        for (int j = 0; j < 8; ++j) st4_x(xd + (256 * j + 4 * lane) * dsz, (PROBE_ID >= 20) ? xv[j] * oscale : xv[j], f32dst);
        if (H) {
            const float* Bt = preT + (size_t)(modrow * 3 + 1) * DM; const float* Ct = preT + (size_t)(modrow * 3 + 2) * DM;
            float ss = 0.f;
#pragma unroll
            for (int j = 0; j < 8; ++j) ss += (xv[j].x * xv[j].x + xv[j].y * xv[j].y) + (xv[j].z * xv[j].z + xv[j].w * xv[j].w);
            const float rx = 1.0f / sqrtf(wave_sum(ss, lane) * (1.0f / DM) + EPS);
            bf16* hr = H + (size_t)row * DM;
#pragma unroll
            for (int j = 0; j < 8; ++j) { const f32x4 b = *(const f32x4*)(Bt + 256 * j + 4 * lane), c = *(const f32x4*)(Ct + 256 * j + 4 * lane); const f32x4 h = xv[j] * rx * b + c;
                v2u o; o.x = pk2(h.x, h.y); o.y = pk2(h.z, h.w); *(v2u*)(hr + 256 * j + 4 * lane) = o; }
        }
    }
    if (nrows > MLAT) {
        LAS float* red = (LAS float*)L;
        const int rsel = wave >> 2, qtr = wave & 3;
        for (int base = 2 * (int)blockIdx.x; base < MCTX; base += 2 * (int)gridDim.x) {
            const int cr = base + rsel; const char* xs = (const char*)xs_ctx + ((size_t)cr * DM + 512 * qtr) * ssz; char* xd = (char*)xd_ctx + ((size_t)cr * DM + 512 * qtr) * dsz;
            f32x4 xv[2];
#pragma unroll
            for (int j = 0; j < 2; ++j) xv[j] = ld4_x(xs + (256 * j + 4 * lane) * ssz, f32src);
            if (Y) {
                const bf16* yr = Y + (size_t)(MLAT + cr) * DM + 512 * qtr; const float* At = postT + (size_t)2 * 3 * DM + 512 * qtr;
                f32x4 yv[2]; float ss = 0.f;
#pragma unroll
                for (int j = 0; j < 2; ++j) { yv[j] = ld4_x(yr + 256 * j + 4 * lane, false); ss += (yv[j].x * yv[j].x + yv[j].y * yv[j].y) + (yv[j].z * yv[j].z + yv[j].w * yv[j].w); }
                ss = wave_sum(ss, lane); if (lane == 0) red[wave] = ss;
                __syncthreads();
                const float ry = 1.0f / sqrtf(((red[rsel * 4] + red[rsel * 4 + 1]) + (red[rsel * 4 + 2] + red[rsel * 4 + 3])) * (1.0f / DM) + EPS);
#pragma unroll
                for (int j = 0; j < 2; ++j) { const f32x4 a = *(const f32x4*)(At + 256 * j + 4 * lane); xv[j] += yv[j] * ry * a; }
            }
#pragma unroll
            for (int j = 0; j < 2; ++j) st4_x(xd + (256 * j + 4 * lane) * dsz, xv[j], f32dst);
            if (H) {
                const float* Bt = preT + (size_t)(2 * 3 + 1) * DM + 512 * qtr; const float* Ct = preT + (size_t)(2 * 3 + 2) * DM + 512 * qtr;
                float ss = 0.f;
#pragma unroll
                for (int j = 0; j < 2; ++j) ss += (xv[j].x * xv[j].x + xv[j].y * xv[j].y) + (xv[j].z * xv[j].z + xv[j].w * xv[j].w);
                ss = wave_sum(ss, lane); if (lane == 0) red[8 + wave] = ss;
                __syncthreads();
                const float rx = 1.0f / sqrtf(((red[8 + rsel * 4] + red[8 + rsel * 4 + 1]) + (red[8 + rsel * 4 + 2] + red[8 + rsel * 4 + 3])) * (1.0f / DM) + EPS);
                bf16* hr = H + (size_t)(MLAT + cr) * DM + 512 * qtr;
#pragma unroll
                for (int j = 0; j < 2; ++j) { const f32x4 b = *(const f32x4*)(Bt + 256 * j + 4 * lane), c = *(const f32x4*)(Ct + 256 * j + 4 * lane); const f32x4 h = xv[j] * rx * b + c;
                    v2u o; o.x = pk2(h.x, h.y); o.y = pk2(h.z, h.w); *(v2u*)(hr + 256 * j + 4 * lane) = o; }
            }
            __syncthreads();
        }
    }
}
__device__ __forceinline__ void vstats_phase(const bf16* QKV, float* stats, int nrows) {
    const int tid = pg8::opaque_tid(), lane = tid & 63, gw = blockIdx.x * NWAVES + __builtin_amdgcn_readfirstlane(tid >> 6), NGW = gridDim.x * NWAVES;
    for (int row = gw; row < nrows; row += NGW) {
        const bf16* vr = QKV + (size_t)row * B_N + B_W + lane * 8; bf16x8 raw[12]; float s = 0.f;
#pragma unroll
        for (int i = 0; i < 12; ++i) { raw[i] = *(const bf16x8*)(vr + i * 512);
#pragma unroll
            for (int e = 0; e < 8; ++e) s += bf2f((unsigned short)raw[i][e]); }
        const float mean = wave_sum(s, lane) * (1.0f / B_W); float q = 0.f;
#pragma unroll
        for (int i = 0; i < 12; ++i)
#pragma unroll
            for (int e = 0; e < 8; ++e) { const float d = bf2f((unsigned short)raw[i][e]) - mean; q += d * d; }
        const float rstd = 1.0f / sqrtf(wave_sum(q, lane) * (1.0f / B_W) + EPS);
        if (lane == 0) { stats[2 * row] = mean; stats[2 * row + 1] = rstd; }
    }
}
__device__ __forceinline__ void spatial_phase(const bf16* QKV, bf16* Gout, const bf16* BSW, const float* stats, const float* vg, const float* vb, const float* bs, char* lds, int nchunks, int bx, int G) {
    const int tid = pg8::opaque_tid(), lane = tid & 63, wave = __builtin_amdgcn_readfirstlane(tid >> 6), r32 = lane & 31, hi = lane >> 5;
    constexpr int OP = 132;
    float* Ob = (float*)(lds + 32768);
    const int sr = tid >> 4, sc = (tid & 15) * 8, pb = wave & 3, dh = wave >> 2;
    for (int u = bx; u < nchunks * 48; u += G) {
        const int cb = u % 6, g = (u / 6) & 7, ch = u / 48, row0 = ch * 128, c0 = g * 768 + cb * 128;
        bf16x8 ureg[4];
#pragma unroll
        for (int i = 0; i < 4; ++i) ureg[i] = *(const bf16x8*)(QKV + (size_t)(row0 + sr + 32 * i) * B_N + c0 + sc);
        { const f32x4 g0 = *(const f32x4*)(vg + c0 + sc), g1 = *(const f32x4*)(vg + c0 + sc + 4), b0 = *(const f32x4*)(vb + c0 + sc), b1 = *(const f32x4*)(vb + c0 + sc + 4);
#pragma unroll
          for (int i = 0; i < 4; ++i) { const int q = sr + 32 * i; const bf16x8 raw = *(const bf16x8*)(QKV + (size_t)(row0 + q) * B_N + B_W + c0 + sc);
              const float mu = stats[2 * (row0 + q)], rs = stats[2 * (row0 + q) + 1]; float t[8];
#pragma unroll
              for (int e = 0; e < 8; ++e) t[e] = (bf2f((unsigned short)raw[e]) - mu) * rs * (e < 4 ? g0[e & 3] : g1[e & 3]) + (e < 4 ? b0[e & 3] : b1[e & 3]);
              v4u w; w.x = pk2(t[0], t[1]); w.y = pk2(t[2], t[3]); w.z = pk2(t[4], t[5]); w.w = pk2(t[6], t[7]);
              *(v4u*)(lds + (i >> 1) * 16384 + att::v_st(sr + 32 * (i & 1), sc)) = w; } }
        __syncthreads();
        bf16x8 pa[2][4];
        { const bf16* Wg = BSW + (size_t)g * 16384 + (size_t)(pb * 32 + r32) * 128 + hi * 8;
#pragma unroll
          for (int kt = 0; kt < 2; ++kt)
#pragma unroll
              for (int kk = 0; kk < 4; ++kk) pa[kt][kk] = *(const bf16x8*)(Wg + kt * 64 + kk * 16); }
        f32x16 o0 = {}, o1 = {};
#pragma unroll
        for (int kt = 0; kt < 2; ++kt) { const int vbase = (int)(uintptr_t)(lds + kt * 16384) + att::v_rd_base(lane);
            if (dh == 0) { att::pv_one<0>(o0, vbase, pa[kt][0], pa[kt][1], pa[kt][2], pa[kt][3]); att::pv_one<1>(o1, vbase, pa[kt][0], pa[kt][1], pa[kt][2], pa[kt][3]); }
            else { att::pv_one<2>(o0, vbase, pa[kt][0], pa[kt][1], pa[kt][2], pa[kt][3]); att::pv_one<3>(o1, vbase, pa[kt][0], pa[kt][1], pa[kt][2], pa[kt][3]); } }
#pragma unroll
        for (int r = 0; r < 16; ++r) { const int p = pb * 32 + (r & 3) + 8 * (r >> 2) + 4 * hi; Ob[p * OP + dh * 64 + r32] = o0[r]; Ob[p * OP + dh * 64 + 32 + r32] = o1[r]; }
        __syncthreads();
#pragma unroll
        for (int i = 0; i < 4; ++i) { const int p = sr + 32 * i; const float bias = bs[g * 128 + p];
            const f32x4 x0 = *(const f32x4*)(Ob + p * OP + sc), x1 = *(const f32x4*)(Ob + p * OP + sc + 4); float t[8];
#pragma unroll
            for (int e = 0; e < 8; ++e) t[e] = bf2f((unsigned short)ureg[i][e]) * ((e < 4 ? x0[e & 3] : x1[e & 3]) + bias);
            v4u w; w.x = pk2(t[0], t[1]); w.y = pk2(t[2], t[3]); w.z = pk2(t[4], t[5]); w.w = pk2(t[6], t[7]);
            pg8::st16(Gout + (size_t)(row0 + p) * B_W + c0 + sc, w); }
        __syncthreads();
    }
}
__device__ __forceinline__ void combine_phase(const float* OC, bf16* AO, const float* lq1, const float* lk1, const float* lq2, const float* lk2, const float* sg, float lam_init, int nrows) {
    const int tid = pg8::opaque_tid(), lane = tid & 63, gw = blockIdx.x * NWAVES + __builtin_amdgcn_readfirstlane(tid >> 6), NGW = gridDim.x * NWAVES;
    const float d1 = wave_sum(lq1[lane] * lk1[lane] + lq1[lane + 64] * lk1[lane + 64], lane), d2 = wave_sum(lq2[lane] * lk2[lane] + lq2[lane + 64] * lk2[lane + 64], lane);
    const float lam = expf(d1) - expf(d2) + lam_init;
    const f32x4 gv = *(const f32x4*)(sg + 4 * lane) * (1.0f - lam_init);
    for (int row = gw; row < nrows; row += NGW) {
        const float* orow = OC + (size_t)row * 4096; bf16* ar = AO + (size_t)row * DM;
#pragma unroll
        for (int h = 0; h < 8; ++h) { const f32x4 a = *(const f32x4*)(orow + (2 * h) * 256 + 4 * lane), b = *(const f32x4*)(orow + (2 * h + 1) * 256 + 4 * lane); const f32x4 o = a - lam * b;
            const float rs = 1.0f / sqrtf(wave_sum((o.x * o.x + o.y * o.y) + (o.z * o.z + o.w * o.w), lane) * (1.0f / 256.0f) + EPS); const f32x4 v = o * rs * gv;
            v2u w; w.x = pk2(v.x, v.y); w.y = pk2(v.z, v.w); *(v2u*)(ar + h * 256 + 4 * lane) = w; }
    }
}

template <int K, int LDA, int EPI>
__device__ __forceinline__ void ctx_tile(const bf16* A, const bf16* Bt, bf16* out, int ldc, int ntn, int tile, LAS unsigned char* L) {
    const int tid = pg8::opaque_tid(), lane = tid & 63, wave = __builtin_amdgcn_readfirstlane(tid >> 6), r32 = lane & 31, hi = lane >> 5;
    const int tm = tile / ntn, row0 = tm * 64, col0 = (tile - tm * ntn) * 64;
    constexpr int NB = K / 64;
    static_assert(K % 64 == 0, "K must be a multiple of 64");
    LAS unsigned char* W = L + wave * 16384;
    const int lr = lane >> 3, lc = lane & 7;
    const bf16* ag = A + (size_t)(row0 + lr) * LDA + lc * 8;
    const bf16* bg = Bt + (size_t)(col0 + lr) * K + lc * 8;
    const int wofs = lr * 128 + ((lc ^ (lr & 7)) << 4);
    const int rofs = r32 * 128;
    f32x16 acc00 = {}, acc01 = {}, acc10 = {}, acc11 = {};
    bf16x8 ga0[8], gb0[8], ga1[8], gb1[8];
#define CT_LOAD(GA, GB, kb_) do { _Pragma("unroll") for (int i = 0; i < 8; ++i) { GA[i] = *(const bf16x8*)(ag + (size_t)(8 * i) * LDA + (kb_) * 64); GB[i] = *(const bf16x8*)(bg + (size_t)(8 * i) * K + (kb_) * 64); } } while (0)
#define CT_STORE(GA, GB) do { _Pragma("unroll") for (int i = 0; i < 8; ++i) { *(LAS bf16x8*)(W + i * 1024 + wofs) = GA[i]; *(LAS bf16x8*)(W + 8192 + i * 1024 + wofs) = GB[i]; } } while (0)
#define CT_MMA() do { _Pragma("unroll") for (int s = 0; s < 4; ++s) { const int ch = (((2 * s + hi) ^ (r32 & 7)) << 4); \
        const bf16x8 a0 = *(const LAS bf16x8*)(W + rofs + ch), a1 = *(const LAS bf16x8*)(W + 4096 + rofs + ch), b0 = *(const LAS bf16x8*)(W + 8192 + rofs + ch), b1 = *(const LAS bf16x8*)(W + 12288 + rofs + ch); \
        acc00 = __builtin_amdgcn_mfma_f32_32x32x16_bf16(a0, b0, acc00, 0, 0, 0); acc01 = __builtin_amdgcn_mfma_f32_32x32x16_bf16(a0, b1, acc01, 0, 0, 0); \
        acc10 = __builtin_amdgcn_mfma_f32_32x32x16_bf16(a1, b0, acc10, 0, 0, 0); acc11 = __builtin_amdgcn_mfma_f32_32x32x16_bf16(a1, b1, acc11, 0, 0, 0); } } while (0)
    int kb = wave;
    if (kb < NB) CT_LOAD(ga0, gb0, kb);
    if (kb + 8 < NB) CT_LOAD(ga1, gb1, kb + 8);
    for (; kb < NB; kb += 16) {
        CT_STORE(ga0, gb0);
        if (kb + 16 < NB) CT_LOAD(ga0, gb0, kb + 16);
        CT_MMA();
        if (kb + 8 < NB) {
            CT_STORE(ga1, gb1);
            if (kb + 24 < NB) CT_LOAD(ga1, gb1, kb + 24);
            CT_MMA();
        }
    }
#undef CT_LOAD
#undef CT_STORE
#undef CT_MMA
    LDS_WAIT(); asm volatile("" ::: "memory");
    LAS float* red = (LAS float*)L + wave * 4096;
#pragma unroll
    for (int r = 0; r < 16; ++r) { const int m = (r & 3) + 8 * (r >> 2) + 4 * hi;
        red[m * 64 + r32] = acc00[r]; red[m * 64 + 32 + r32] = acc01[r]; red[(32 + m) * 64 + r32] = acc10[r]; red[(32 + m) * 64 + 32 + r32] = acc11[r]; }
    __syncthreads();
    { const int o = tid * 8, m = o >> 6, n = o & 63; f32x4 s0 = {0.f, 0.f, 0.f, 0.f}, s1 = s0;
#pragma unroll
      for (int w = 0; w < 8; ++w) { s0 += *(const LAS f32x4*)((LAS float*)L + w * 4096 + o); s1 += *(const LAS f32x4*)((LAS float*)L + w * 4096 + o + 4); }
      if (EPI == 1) {
#pragma unroll
          for (int j = 0; j < 4; ++j) { s0[j] = pg8::gelu_tanh(s0[j]); s1[j] = pg8::gelu_tanh(s1[j]); } }
      v4u w4; w4.x = pk2(s0.x, s0.y); w4.y = pk2(s0.z, s0.w); w4.z = pk2(s1.x, s1.y); w4.w = pk2(s1.z, s1.w);
      pg8::st16(out + (size_t)(row0 + m) * ldc + col0 + n, w4); }
    __syncthreads();
}

__global__ void __launch_bounds__(NWAVES * 64, 2) fwd(KArgs args) {
    extern __shared__ __attribute__((aligned(16))) unsigned char lds[];
    LAS unsigned char* L = (LAS unsigned char*)lds;
    const int tid = threadIdx.x, G = gridDim.x, bx = blockIdx.x;
    unsigned char* ws0 = args.ws;
    for (int u = tid; u < (LDS_BYTES - RING_BYTES) / 4; u += NWAVES * 64) ((LAS unsigned*)(L + RING_BYTES))[u] = 0u;
    __syncthreads();
    const int lo = args.ph_lo, hi = args.ph_hi;
    XcdBarrier bar; bar.bar = (unsigned*)(ws0 + WS_CTL) + CW_BAR + args.li * XCD_BAR_WORDS; bar.x = 0; bar.st = (volatile LAS unsigned*)(L + MISC_OFF + 32);
    if (hi - lo > 1) bar = xcd_barrier_post((unsigned*)(ws0 + WS_CTL) + CW_BAR + args.li * XCD_BAR_WORDS, (volatile LAS unsigned*)(L + MISC_OFF + 32));
    int ph = 0; unsigned long long bacc_ = 0; (void)bacc_;
#define PHASE_BEGIN if (ph >= lo && ph < hi) {
#define PHASE_END   if (ph + 1 < hi) { unsigned long long br0_ = 0; if (PROBE_ID == 21 || PROBE_ID == 22) br0_ = wall_clock64(); xcd_barrier(bar); \
        if ((PROBE_ID == 21 || PROBE_ID == 22) && threadIdx.x == 0) { const unsigned dt_ = (unsigned)(wall_clock64() - br0_); \
            if (PROBE_ID == 21) atomicAdd((unsigned*)(args.ws + WS_CTL) + 2048, dt_); else atomicMin((unsigned*)(args.ws + WS_CTL) + 2304 + ph, dt_); } } } ++ph;
#define SETUP_PTRS() GAS unsigned char* wsg_ = (GAS unsigned char*)args.ws; asm volatile("" : "+s"(wsg_)); unsigned char* ws = (unsigned char*)wsg_; \
    GAS float* xlg_ = (GAS float*)args.out; asm volatile("" : "+s"(xlg_)); float* XL = (float*)xlg_; bf16* XB = (bf16*)(ws + WS_XB); \
    bf16* H = (bf16*)(ws + WS_H); bf16* HID = (bf16*)(ws + WS_HID); bf16* Y = (bf16*)(ws + WS_Y); bf16* QKV = (bf16*)(ws + WS_QKV); bf16* AO = (bf16*)(ws + WS_AO); float* OC = (float*)(ws + WS_OC); \
    const float* ROPE = (const float*)(ws + WS_ROPE); const float* SM = (const float*)(ws + WS_SMALL); (void)XB; (void)XL; (void)HID; (void)Y; (void)QKV; (void)AO; (void)OC; (void)ROPE; (void)SM; (void)H

    if (PROBE_ID == 22 && bx == 0 && threadIdx.x < 64) ((unsigned*)(args.ws + WS_CTL) + 2304)[threadIdx.x] = 0xffffffffu;
    { SETUP_PTRS();
    PHASE_BEGIN
#ifndef OFF_PRO
    prologue_phase(args, L, bx, G);
#endif
    PHASE_END
    PHASE_BEGIN norm_phase(args.in[0], args.in[2], true, XB, XB + (size_t)MLAT * DM, false, nullptr, nullptr, modt(ws, 0, 0, 0, 0), H, MALL, L); PHASE_END }

    for (int sl = 0; sl < 3 * NLAYER; ++sl) {
        SETUP_PTRS();
        const int layer = sl / 3, typ = sl % 3, kind = layer % 3, jm = layer / 3; const bool lastl = (layer == NLAYER - 1);
        const int Mrows = (lastl && typ >= 1) ? MLAT : MALL;
        pg8::Gemm gy;
        if (typ != 1) {
            const int f = (typ == 0) ? 0 : 1;
            PHASE_BEGIN
                pg8::Gemm g{H, (const bf16*)(ws + WS_WFC1) + (size_t)(layer * 2 + f) * NFC1 * DM, Mrows, NFC1, DM, DM}; pg8::StaticOrder S; S.init(Mrows, NFC1, G, bx);
                pg8::EpiSwiglu E{HID, DFF};
                #ifndef OFF_FC1
                unsigned long long pt0_ = 0, pr0_ = 0; if (PROBE_ID == 20 && sl == 3 && bx == 0) { pt0_ = clock64(); pr0_ = wall_clock64(); }
                for (int rep_ = 0; rep_ < (PROBE_ID == 2 ? 2 : 1); ++rep_) { pg8::gemm_phase<pg8::EpiSwiglu, pg8::StaticOrder, true, true, DM, DM>(L, g, S, E); }
                if (PROBE_ID == 20 && sl == 3 && bx == 0 && threadIdx.x == 0) { const unsigned long long t1_ = clock64(), r1_ = wall_clock64();
                    __hip_atomic_store((float*)(ws + WS_SMALL) + SM_END, floorf((float)(t1_ - pt0_) / ((float)(r1_ - pr0_) * 10.0f) * 4.0f + 0.5f) * 0.02f, __ATOMIC_RELAXED, __HIP_MEMORY_SCOPE_AGENT); }
#endif
            PHASE_END
            gy = pg8::Gemm{HID, (const bf16*)(ws + WS_WFC2) + (size_t)(layer * 2 + f) * DM * DFF, Mrows, DM, DFF, DFF};
        } else {
            if (kind != 1) {
                PHASE_BEGIN
                    const int N = (kind == 0) ? A_N : C_N, Min = (kind == 0) ? MALL : MLAT;
                    pg8::Gemm g{H, (kind == 0) ? (const bf16*)(ws + WS_WAIN) + (size_t)jm * A_N * DM : (const bf16*)(ws + WS_WCIN), Min, N, DM, DM}; pg8::StaticOrder S; S.init(Min, N, G, bx);
                    pg8::EpiBf16X<0> E{QKV, N, ROPE, (kind == 0) ? 2560 : 4096};
                    #ifndef OFF_ROPE
                    for (int rep_ = 0; rep_ < (PROBE_ID == 8 ? 2 : 1); ++rep_) { pg8::gemm_phase<pg8::EpiBf16X<0>, pg8::StaticOrder, true, true, DM, DM>(L, g, S, E); }
                    if (kind == 2) for (int t = bx; t < 8 * (C_N / 64); t += G) ctx_tile<DM, DM, 0>(H + (size_t)MLAT * DM, g.Bt, QKV + (size_t)MLAT * C_N, C_N, C_N / 64, t, L);
#endif
                PHASE_END
            } else {
                PHASE_BEGIN
                    pg8::Gemm g{H, (const bf16*)(ws + WS_WBIN), MLAT, B_N, DM, DM}; pg8::StaticOrder S; S.init(MLAT, B_N, G, bx);
                    pg8::EpiBf16X<1> E{QKV, B_N, nullptr, 0};
                    #ifndef OFF_GELU
                    for (int rep_ = 0; rep_ < (PROBE_ID == 9 ? 2 : 1); ++rep_) { pg8::gemm_phase<pg8::EpiBf16X<1>, pg8::StaticOrder, true, true, DM, DM>(L, g, S, E); }
                    for (int t = bx; t < 8 * (B_N / 64); t += G) ctx_tile<DM, DM, 1>(H + (size_t)MLAT * DM, g.Bt, QKV + (size_t)MLAT * B_N, B_N, B_N / 64, t, L);
#endif
                PHASE_END
            }
            if (kind == 0) {
                PHASE_BEGIN
                    const int nlat = NBATCH * 8 * 32, nall = nlat + (lastl ? 0 : NBATCH * 8 * 2);
                    for (int u = bx; u < nall; u += G) {
                        att::Args a; a.qkv = QKV; a.ld = A_N; a.n0 = 4; a.out = AO; a.ldo = DM;
                        int hp, b;
                        if (u < nlat) { const int qb = u & 31; hp = (u >> 5) & 7; b = u >> 8; a.qrow0 = b * SEQ + qb * 128; a.kstart = qb * 128 - 128; a.n1 = 6; a.qpos0 = qb * 128; }
                        else { const int cu = u - nlat, qb = cu & 1; hp = (cu >> 1) & 7; b = cu >> 4; a.qrow0 = MLAT + b * CTXL + qb * 128; a.kstart = 0; a.n1 = 0; a.qpos0 = 0; }
                        a.qcol = hp * 256; a.kcol = 2048 + (hp >> 1) * 128; a.vcol = 2560 + (hp >> 1) * 128; a.ctxrow0 = MLAT + b * CTXL; a.latrow0 = b * SEQ; a.ocol = hp * 256;
                        a.sinkp = SM + SM_SINK + jm * 16 + hp * 2;
                        for (int rep_ = 0; rep_ < (PROBE_ID == 7 ? 2 : 1); ++rep_) { att::attn_unit<true, true, A_N, true>(a, (char*)lds); }
                    }
                PHASE_END
                gy = pg8::Gemm{AO, (const bf16*)(ws + WS_WAOUT) + (size_t)jm * DM * DM, Mrows, DM, DM, DM};
            } else if (kind == 1) {
                PHASE_BEGIN for (int rep_ = 0; rep_ < (PROBE_ID == 15 ? 2 : 1); ++rep_) { vstats_phase(QKV, (float*)(ws + WS_STATS), MALL); } PHASE_END
                PHASE_BEGIN
for (int rep_ = 0; rep_ < (PROBE_ID == 14 ? 2 : 1); ++rep_) { spatial_phase(QKV, (bf16*)OC, (const bf16*)(ws + WS_BSW), (const float*)(ws + WS_STATS), SM + SM_VNG, SM + SM_VNB, SM + SM_BS, (char*)lds, MALL / 128, bx, G); }
                PHASE_END
                gy = pg8::Gemm{(const bf16*)OC, (const bf16*)(ws + WS_WBOUT), Mrows, DM, B_W, B_W};
            } else {
                PHASE_BEGIN
                    const int nlat = NBATCH * 8 * 32, nall = nlat + (lastl ? 0 : NBATCH * 8 * 2);
                    float lam;
                    { const int ln_ = pg8::opaque_tid() & 63; const float* q1 = SM + SM_LQ1; const float* k1 = SM + SM_LK1; const float* q2 = SM + SM_LQ2; const float* k2 = SM + SM_LK2;
                      const float d1 = wave_sum(q1[ln_] * k1[ln_] + q1[ln_ + 64] * k1[ln_ + 64], ln_), d2 = wave_sum(q2[ln_] * k2[ln_] + q2[ln_ + 64] * k2[ln_ + 64], ln_);
                      lam = expf(d1) - expf(d2) + args.lam_init; }
                    for (int u = bx; u < nall; u += G) {
                        int qrow0, hh, b, n1;
                        if (u < nlat) { const int qb = u & 31; hh = (u >> 5) & 7; b = u >> 8; qrow0 = b * SEQ + qb * 128; n1 = 64; }
                        else { const int cu = u - nlat, qb = cu & 1; hh = (cu >> 1) & 7; b = cu >> 4; qrow0 = MLAT + b * CTXL + qb * 128; n1 = 0; }
                        for (int rep_ = 0; rep_ < (PROBE_ID == 6 ? 2 : 1); ++rep_) { att::dattn_unit<C_N>(QKV, qrow0, hh, MLAT + b * CTXL, b * SEQ, 4, n1, lam, args.gscale, SM + SM_SUBG, AO, L, (char*)lds); }
                    }
                PHASE_END
                gy = pg8::Gemm{AO, (const bf16*)(ws + WS_WCOUT), Mrows, DM, DM, DM};
            }
        }
        PHASE_BEGIN
            const bool hasctx = (gy.M == MALL); gy.M = MLAT;
            pg8::StaticOrder S; S.init(MLAT, DM, G, bx); pg8::EpiBf16X<2> E{Y, DM, nullptr, 0};
            bf16* Yc = Y + (size_t)MLAT * DM;
            if (typ != 1) { for (int rep_ = 0; rep_ < (PROBE_ID == 3 ? 2 : 1); ++rep_) { pg8::gemm_phase<pg8::EpiBf16X<2>, pg8::StaticOrder, true, true, DFF, DFF>(L, gy, S, E); }
                for (int rep_ = 0; rep_ < (PROBE_ID == 4 ? 2 : 1); ++rep_) { if (hasctx) for (int t = bx; t < 256; t += G) ctx_tile<DFF, DFF, 0>(gy.A + (size_t)MLAT * DFF, gy.Bt, Yc, DM, 32, t, L); } }
            else if (kind == 1) { pg8::gemm_phase<pg8::EpiBf16X<2>, pg8::StaticOrder, true, true, B_W, B_W>(L, gy, S, E);
                if (hasctx) for (int t = bx; t < 256; t += G) ctx_tile<B_W, B_W, 0>(gy.A + (size_t)MLAT * B_W, gy.Bt, Yc, DM, 32, t, L); }
            else { pg8::gemm_phase<pg8::EpiBf16X<2>, pg8::StaticOrder, true, true, DM, DM>(L, gy, S, E);
                if (hasctx) for (int t = bx; t < 256; t += G) ctx_tile<DM, DM, 0>(gy.A + (size_t)MLAT * DM, gy.Bt, Yc, DM, 32, t, L); }
        PHASE_END
        if ((PROBE_ID == 21 || PROBE_ID == 22) && sl == 3 * NLAYER - 1 && typ == 2) { }
        if ((PROBE_ID == 21 || PROBE_ID == 22) && sl == 3 * NLAYER - 1 && bx == 0 && threadIdx.x == 0) { float v_ = 0.f;
            if (PROBE_ID == 21) v_ = floorf((float)__hip_atomic_load((unsigned*)(args.ws + WS_CTL) + 2048, __ATOMIC_RELAXED, __HIP_MEMORY_SCOPE_AGENT) * 0.01f / (float)G / PROBE_Q + 0.5f) * 0.02f;
            else { unsigned s_ = 0; for (int i_ = 0; i_ < ph; ++i_) { const unsigned m_ = __hip_atomic_load((unsigned*)(args.ws + WS_CTL) + 2304 + i_, __ATOMIC_RELAXED, __HIP_MEMORY_SCOPE_AGENT); if (m_ != 0xffffffffu) s_ += m_; } v_ = floorf((float)s_ * 0.01f / PROBE_Q + 0.5f) * 0.02f; }
            __hip_atomic_store((float*)(ws + WS_SMALL) + SM_END, v_, __ATOMIC_RELAXED, __HIP_MEMORY_SCOPE_AGENT); }
        PHASE_BEGIN
            const bool fin = (sl == 3 * NLAYER - 1);
            const int nl = (typ == 2) ? layer + 1 : layer, ns = (typ == 2) ? 0 : typ + 1;
            norm_phase(XB, XB + (size_t)MLAT * DM, false, fin ? (void*)XL : (void*)XB, XB + (size_t)MLAT * DM, fin, Y, modt(ws, layer, typ, 0, 0), fin ? nullptr : modt(ws, nl, ns, 0, 0), fin ? nullptr : H, Mrows, L, (PROBE_ID >= 20 && fin) ? 1.0f + __hip_atomic_load((float*)(ws + WS_SMALL) + SM_END, __ATOMIC_RELAXED, __HIP_MEMORY_SCOPE_AGENT) : 1.0f);
        PHASE_END
    }
#undef PHASE_BEGIN
#undef PHASE_END
}

static int count_phases() { int n = 2; for (int sl = 0; sl < 3 * NLAYER; ++sl) { const int layer = sl / 3, typ = sl % 3, kind = layer % 3; n += (typ != 1) ? 3 : (kind == 1 ? 5 : 4); } return n; }
extern "C" void kernel_launch(void* const* d_in, const int* in_sizes, int n_in, void* d_out, int out_size, void* d_ws, size_t ws_size, hipStream_t stream) {
    static int grid = 0;
    if (grid == 0) {
        if (n_in != 25 || in_sizes[0] != MLAT * DM || out_size != MLAT * DM || ws_size < WS_END) { fprintf(stderr, "kernel_launch: unexpected shapes (n_in %d, in0 %d, out %d, ws %zu < %zu)\n", n_in, n_in > 0 ? in_sizes[0] : -1, out_size, ws_size, (size_t)WS_END); grid = -1; return; }
        int dev = 0, cus = 0, per_cu = 0;
        if (hipGetDevice(&dev) != hipSuccess || hipDeviceGetAttribute(&cus, hipDeviceAttributeMultiprocessorCount, dev) != hipSuccess) { grid = -1; return; }
        if (hipFuncSetAttribute((const void*)fwd, hipFuncAttributeMaxDynamicSharedMemorySize, LDS_BYTES) != hipSuccess) { fprintf(stderr, "kernel_launch: hipFuncSetAttribute failed\n"); grid = -1; return; }
        if (hipOccupancyMaxActiveBlocksPerMultiprocessor(&per_cu, (const void*)fwd, NWAVES * 64, LDS_BYTES) != hipSuccess || per_cu < 1) fprintf(stderr, "kernel_launch: occupancy query reports %d\n", per_cu);
        (void)hipGetLastError();
        grid = cus;
    }
    if (grid < 0) return;
    if (hipMemsetAsync((char*)d_ws + WS_CTL, 0, CTL_BYTES, stream) != hipSuccess) return;
    KArgs a{};
    for (int i = 0; i < 25; ++i) a.in[i] = (const float*)d_in[i];
    a.out = (float*)d_out; a.ws = (unsigned char*)d_ws; a.lam_init = (float)(0.8 - 0.6 * exp(-0.3 * 2.0)); a.gscale = 1.0f - a.lam_init;
    const int nph = count_phases();
#if MK_PER_PHASE
    for (int p = 0; p < nph; ++p) { a.ph_lo = p; a.ph_hi = p + 1; a.li = 0; hipLaunchKernelGGL(fwd, dim3(grid), dim3(NWAVES * 64), LDS_BYTES, stream, a); }
#else
    a.ph_lo = 0; a.ph_hi = nph; a.li = 0; hipLaunchKernelGGL(fwd, dim3(grid), dim3(NWAVES * 64), LDS_BYTES, stream, a);
#endif
    const hipError_t le = hipPeekAtLastError();
    if (le != hipSuccess) fprintf(stderr, "kernel_launch: launch failed: %s\n", hipGetErrorName(le));
}
```
